# Optimizing an MI355X kernel written in HIP

```python
import jax, jax.numpy as jnp
from jax import lax
import numpy as np

D_MODEL = 1024
BATCH = 8
SEQ = 8192
DEPTH = 1

FFN_HIDDEN = 2816
H_A = 4
DK_A = 128
DV_A = 256
CONV_W = 4
CHUNK = 64
H_B = 8
DH_B = 128
SB_BLOCK = 128
PLE_DIM = 256
LN_EPS = 1e-5
DEEPNORM_ALPHA = (2 * DEPTH) ** 0.25
DEEPNORM_BETA = (8 * DEPTH) ** -0.25

A_QK_W = 2 * H_A * DK_A
A_V_W = H_A * DV_A
A_O_W = H_A * DV_A
B_QKV_W = 3 * H_B * DH_B
GATE_W = 2 * D_MODEL
SPLIT_IDX = list(np.cumsum([A_QK_W, A_V_W, A_O_W, H_A, H_A, B_QKV_W]))
N_IN = A_QK_W + A_V_W + A_O_W + 2 * H_A + B_QKV_W + GATE_W

kernel_name = "hybrid_mlstm_stickbreaking_macaron_deepnorm"


def layer_norm(x, g, b):
    xf = x.astype(jnp.float32)
    mu = jnp.mean(xf, axis=-1, keepdims=True)
    var = jnp.mean(jnp.square(xf - mu), axis=-1, keepdims=True)
    y = (xf - mu) * lax.rsqrt(var + LN_EPS) * g.astype(jnp.float32) + b.astype(jnp.float32)
    return y.astype(x.dtype)


def swiglu(x, wg, wu, wd):
    return (jax.nn.silu(x @ wg) * (x @ wu)) @ wd


def causal_conv(u, w, b):
    c = u.shape[-1]
    y = lax.conv_general_dilated(u, w[:, None, :], window_strides=(1,), padding=((CONV_W - 1, 0),),
                                 dimension_numbers=("NWC", "WIO", "NWC"), feature_group_count=c)
    return y + b


def head_norm(h, g):
    mu = jnp.mean(h, axis=-1, keepdims=True)
    var = jnp.mean(jnp.square(h - mu), axis=-1, keepdims=True)
    return (h - mu) * lax.rsqrt(var + LN_EPS) * g.astype(jnp.float32)


def mlstm_chunkwise(q, k, v, i_pre, log_f):
    bsz, s, h, dk = q.shape
    dv = v.shape[-1]
    nc = s // CHUNK
    f32 = jnp.float32
    qc = q.astype(f32).reshape(bsz, nc, CHUNK, h, dk).transpose(1, 0, 3, 2, 4)
    kc = k.astype(f32).reshape(bsz, nc, CHUNK, h, dk).transpose(1, 0, 3, 2, 4)
    vc = v.astype(f32).reshape(bsz, nc, CHUNK, h, dv).transpose(1, 0, 3, 2, 4)
    ic = i_pre.astype(f32).reshape(bsz, nc, CHUNK, h).transpose(1, 0, 3, 2)
    fc = log_f.astype(f32).reshape(bsz, nc, CHUNK, h).transpose(1, 0, 3, 2)
    tril = jnp.tril(jnp.ones((CHUNK, CHUNK), dtype=bool))

    def step(carry, inp):
        c_st, n_st, m_st = carry
        qb, kb, vb, ib, fb = inp
        bcum = jnp.cumsum(fb, axis=-1)
        dmat = jnp.where(tril, bcum[..., :, None] - bcum[..., None, :] + ib[..., None, :], -jnp.inf)
        inter = bcum + m_st[..., None]
        m_t = jnp.maximum(inter, jnp.max(dmat, axis=-1))
        w_inter = jnp.exp(inter - m_t)
        scores = jnp.einsum("bhtd,bhsd->bhts", qb, kb) * jnp.exp(dmat - m_t[..., None])
        num = w_inter[..., None] * jnp.einsum("bhtd,bhde->bhte", qb, c_st) + jnp.einsum("bhts,bhse->bhte", scores, vb)
        den = w_inter * jnp.einsum("bhtd,bhd->bht", qb, n_st) + jnp.sum(scores, axis=-1)
        h_out = num / jnp.maximum(jnp.abs(den), jnp.exp(-m_t))[..., None]
        b_last = bcum[..., -1]
        g = b_last[..., None] - bcum + ib
        m_new = jnp.maximum(b_last + m_st, jnp.max(g, axis=-1))
        a_prev = jnp.exp(b_last + m_st - m_new)
        w_in = jnp.exp(g - m_new[..., None])
        c_new = a_prev[..., None, None] * c_st + jnp.einsum("bhs,bhsd,bhse->bhde", w_in, kb, vb)
        n_new = a_prev[..., None] * n_st + jnp.einsum("bhs,bhsd->bhd", w_in, kb)
        return (c_new, n_new, m_new), h_out

    init = (jnp.zeros((bsz, h, dk, dv), f32), jnp.zeros((bsz, h, dk), f32), jnp.zeros((bsz, h), f32))
    _, hs = lax.scan(step, init, (qc, kc, vc, ic, fc))
    return hs.transpose(1, 0, 3, 2, 4).reshape(bsz, s, h, dv)


def stick_breaking_attention(q, k, v):
    bsz, s, h, dh = q.shape
    nq = s // SB_BLOCK
    scale = DH_B ** -0.5
    kt = k.transpose(0, 2, 1, 3)
    vt = v.transpose(0, 2, 1, 3)
    qblocks = q.transpose(0, 2, 1, 3).reshape(bsz, h, nq, SB_BLOCK, dh).transpose(2, 0, 1, 3, 4)
    s_pos = jnp.arange(s)

    def block(args):
        qb, bi = args
        z = jnp.einsum("bhtd,bhsd->bhts", qb, kt).astype(jnp.float32) * scale
        t_pos = bi * SB_BLOCK + jnp.arange(SB_BLOCK)
        mask = s_pos[None, :] < t_pos[:, None]
        log_keep = jnp.where(mask, -jax.nn.softplus(z), 0.0)
        later = lax.cumsum(log_keep, axis=3, reverse=True) - log_keep
        weights = jnp.where(mask, jnp.exp(jax.nn.log_sigmoid(z) + later), 0.0)
        return jnp.einsum("bhts,bhsd->bhtd", weights.astype(vt.dtype), vt)

    out = lax.map(block, (qblocks, jnp.arange(nq)))
    return out.transpose(1, 0, 3, 2, 4).reshape(bsz, s, h * dh)


def token_mix(x, w_in, b_in, b_forget, conv_w, conv_b, mh_norm_g, w_branch_a, w_branch_b, w_mix_out):
    bsz, s, _ = x.shape
    proj = x @ w_in + b_in
    qk_a, v_a, o_a, i_a, f_a, qkv_b, gates = jnp.split(proj, SPLIT_IDX, axis=-1)
    qk_a = jax.nn.silu(causal_conv(qk_a, conv_w, conv_b))
    q_a = qk_a[..., : A_QK_W // 2].reshape(bsz, s, H_A, DK_A)
    k_a = qk_a[..., A_QK_W // 2:].reshape(bsz, s, H_A, DK_A) * (DK_A ** -0.5)
    v_a = v_a.reshape(bsz, s, H_A, DV_A)
    log_f = jax.nn.log_sigmoid((f_a + b_forget).astype(jnp.float32))
    h_a = mlstm_chunkwise(q_a, k_a, v_a, i_a, log_f)
    y_a = (head_norm(h_a, mh_norm_g).reshape(bsz, s, A_V_W) * jax.nn.sigmoid(o_a.astype(jnp.float32))).astype(x.dtype)
    q_b, k_b, v_b = jnp.split(qkv_b, 3, axis=-1)
    y_b = stick_breaking_attention(q_b.reshape(bsz, s, H_B, DH_B), k_b.reshape(bsz, s, H_B, DH_B),
                                   v_b.reshape(bsz, s, H_B, DH_B)).astype(x.dtype)
    g_a, g_b = jnp.split(gates, 2, axis=-1)
    merged = jax.nn.sigmoid(g_a) * (y_a @ w_branch_a) + jax.nn.sigmoid(g_b) * (y_b @ w_branch_b)
    return merged @ w_mix_out


def setup_inputs(seed: int = 0) -> dict:
    key = jax.random.key(seed)
    ks = jax.random.split(key, 20)
    f32 = jnp.float32

    def dense(k, shape, fan_in, scale=1.0):
        return jax.random.normal(k, shape, f32) * (scale * fan_in ** -0.5)

    x = jax.random.normal(ks[0], (BATCH, SEQ, D_MODEL), f32)
    p = jax.random.normal(ks[1], (DEPTH, BATCH, SEQ, PLE_DIM), f32)
    ln_g = 1.0 + 0.02 * jax.random.normal(ks[2], (DEPTH, 4, D_MODEL), f32)
    ln_b = 0.02 * jax.random.normal(ks[3], (DEPTH, 4, D_MODEL), f32)
    ffn_wg = dense(ks[4], (DEPTH, 2, D_MODEL, FFN_HIDDEN), D_MODEL)
    ffn_wu = dense(ks[5], (DEPTH, 2, D_MODEL, FFN_HIDDEN), D_MODEL)
    ffn_wd = dense(ks[6], (DEPTH, 2, FFN_HIDDEN, D_MODEL), FFN_HIDDEN, DEEPNORM_BETA)
    w_in = dense(ks[7], (DEPTH, D_MODEL, N_IN), D_MODEL)
    b_in = 0.01 * jax.random.normal(ks[8], (DEPTH, N_IN), f32)
    b_forget = jnp.linspace(3.0, 6.0, H_A, dtype=f32)[None, :] + 0.1 * jax.random.normal(ks[9], (DEPTH, H_A), f32)
    conv_w = dense(ks[10], (DEPTH, CONV_W, A_QK_W), CONV_W)
    conv_b = 0.01 * jax.random.normal(ks[11], (DEPTH, A_QK_W), f32)
    mh_norm_g = 1.0 + 0.02 * jax.random.normal(ks[12], (DEPTH, H_A, DV_A), f32)
    w_branch_a = dense(ks[13], (DEPTH, A_V_W, D_MODEL), A_V_W)
    w_branch_b = dense(ks[14], (DEPTH, H_B * DH_B, D_MODEL), H_B * DH_B)
    w_mix_out = dense(ks[15], (DEPTH, D_MODEL, D_MODEL), D_MODEL, DEEPNORM_BETA)
    w_ple = dense(ks[16], (DEPTH, PLE_DIM, D_MODEL), PLE_DIM, DEEPNORM_BETA)
    w_ple_gate = dense(ks[17], (DEPTH, D_MODEL, D_MODEL), D_MODEL)
    b_ple_gate = 0.01 * jax.random.normal(ks[18], (DEPTH, D_MODEL), f32)
    return {"x": x, "p": p, "ln_g": ln_g, "ln_b": ln_b, "ffn_wg": ffn_wg, "ffn_wu": ffn_wu,
            "ffn_wd": ffn_wd, "w_in": w_in, "b_in": b_in, "b_forget": b_forget, "conv_w": conv_w,
            "conv_b": conv_b, "mh_norm_g": mh_norm_g, "w_branch_a": w_branch_a,
            "w_branch_b": w_branch_b, "w_mix_out": w_mix_out, "w_ple": w_ple,
            "w_ple_gate": w_ple_gate, "b_ple_gate": b_ple_gate}


def reference(x, p, ln_g, ln_b, ffn_wg, ffn_wu, ffn_wd, w_in, b_in, b_forget, conv_w, conv_b,
              mh_norm_g, w_branch_a, w_branch_b, w_mix_out, w_ple, w_ple_gate, b_ple_gate):
    for i in range(DEPTH):
        x = layer_norm(DEEPNORM_ALPHA * x + 0.5 * swiglu(x, ffn_wg[i, 0], ffn_wu[i, 0], ffn_wd[i, 0]),
                       ln_g[i, 0], ln_b[i, 0])
        mix = token_mix(x, w_in[i], b_in[i], b_forget[i], conv_w[i], conv_b[i], mh_norm_g[i],
                        w_branch_a[i], w_branch_b[i], w_mix_out[i])
        x = layer_norm(DEEPNORM_ALPHA * x + mix, ln_g[i, 1], ln_b[i, 1])
        x = layer_norm(DEEPNORM_ALPHA * x + 0.5 * swiglu(x, ffn_wg[i, 1], ffn_wu[i, 1], ffn_wd[i, 1]),
                       ln_g[i, 2], ln_b[i, 2])
        gate = jax.nn.sigmoid(x @ w_ple_gate[i] + b_ple_gate[i])
        x = layer_norm(DEEPNORM_ALPHA * x + gate * (p[i] @ w_ple[i]), ln_g[i, 3], ln_b[i, 3])
    return x
```

```cpp
#include <hip/hip_runtime.h>
#include <hip/hip_cooperative_groups.h>
#include <cstdio>
namespace cg = cooperative_groups;

#ifndef ONE_LAUNCH
#define ONE_LAUNCH 1
#endif

#define LAS __attribute__((address_space(3)))
typedef unsigned short bf16_t;
typedef short bf16x8 __attribute__((ext_vector_type(8)));
typedef float f32x4 __attribute__((ext_vector_type(4)));
typedef float f32x2 __attribute__((ext_vector_type(2)));
typedef unsigned u32x4 __attribute__((ext_vector_type(4)));
typedef unsigned u32x2 __attribute__((ext_vector_type(2)));

constexpr int MTOK = 65536, DM = 1024, FH = 2816, SEQ = 8192;
constexpr int NIN_PAD = 8448;
constexpr float ALPHA = 1.189207115002721f;
constexpr float LN_EPS = 1e-5f;
constexpr float LOG2E = 1.4426950408889634f;
constexpr int NTHREADS = 512;

constexpr size_t QB_ = 33554432ull;
constexpr size_t WS_W = 0;
constexpr size_t W_GU1 = 0;
constexpr size_t W_D1 = W_GU1 + 5632ull * 1024 * 2;
constexpr size_t W_GU2 = W_D1 + 1024ull * 2816 * 2;
constexpr size_t W_D2 = W_GU2 + 5632ull * 1024 * 2;
constexpr size_t W_IN = W_D2 + 1024ull * 2816 * 2;
constexpr size_t W_A = W_IN + 8448ull * 1024 * 2;
constexpr size_t W_B = W_A + 1024ull * 1024 * 2;
constexpr size_t W_O = W_B + 1024ull * 1024 * 2;
constexpr size_t W_PG = W_O + 1024ull * 1024 * 2;
constexpr size_t W_P = W_PG + 1024ull * 1024 * 2;
constexpr size_t W_BIAS = W_P + 1024ull * 256 * 2;
static_assert(W_BIAS + 8448 * 4 <= 2 * QB_, "weights overflow");
constexpr size_t WS_PB = 2 * QB_;
constexpr size_t WS_MISC = 3 * QB_;
constexpr size_t MISC_IF = WS_MISC;
constexpr size_t MISC_CNT = WS_MISC + 2097152ull;
constexpr size_t WS_X = 4 * QB_;
constexpr size_t WS_H = 8 * QB_;
constexpr size_t WS_QK = 8 * QB_, WS_VA = 12 * QB_, WS_OA = 16 * QB_, WS_QB = 20 * QB_, WS_KB = 24 * QB_, WS_VB = 28 * QB_;
constexpr size_t WS_T = WS_QK, WS_MG = WS_KB, WS_PG = 8 * QB_;
constexpr size_t WS_END = 32 * QB_;
constexpr int STATE_FLOATS = 32768 + 128;

typedef __bf16 bf16x2_t __attribute__((ext_vector_type(2)));
__device__ __forceinline__ unsigned cvt_pk_bf16(float lo, float hi) { f32x2 v = {lo, hi}; bf16x2_t r = __builtin_convertvector(v, bf16x2_t); return __builtin_bit_cast(unsigned, r); }
__device__ __forceinline__ float bf_lo(unsigned u) { return __uint_as_float(u << 16); }
__device__ __forceinline__ float bf_hi(unsigned u) { return __uint_as_float(u & 0xffff0000u); }
__device__ __forceinline__ float fast_exp2(float x) { return __builtin_amdgcn_exp2f(x); }
__device__ __forceinline__ float fast_log2(float x) { return __builtin_amdgcn_logf(x); }
__device__ __forceinline__ float fast_rcp(float x) { return __builtin_amdgcn_rcpf(x); }
__device__ __forceinline__ float sigmoid_f(float x) { return fast_rcp(1.0f + fast_exp2(-x * LOG2E)); }
__device__ __forceinline__ f32x4 mfma16(bf16x8 a, bf16x8 b, f32x4 c) { return __builtin_amdgcn_mfma_f32_16x16x32_bf16(a, b, c, 0, 0, 0); }
__device__ __forceinline__ bf16x8 mk8(u32x2 lo, u32x2 hi) { u32x4 v; v.x = lo.x; v.y = lo.y; v.z = hi.x; v.w = hi.y; return __builtin_bit_cast(bf16x8, v); }
__device__ __forceinline__ float wave_sum(float v) {
#pragma unroll
    for (int o = 32; o > 0; o >>= 1) v += __shfl_xor(v, o);
    return v;
}
__device__ __forceinline__ float wave_max(float v) {
#pragma unroll
    for (int o = 32; o > 0; o >>= 1) v = fmaxf(v, __shfl_xor(v, o));
    return v;
}
__device__ __forceinline__ float wave_incl_sum(float v, int lane) {
#pragma unroll
    for (int o = 1; o < 64; o <<= 1) { float t = __shfl_up(v, o); if (lane >= o) v += t; }
    return v;
}
__device__ __forceinline__ float wave_incl_max(float v, int lane) {
#pragma unroll
    for (int o = 1; o < 64; o <<= 1) { float t = __shfl_up(v, o); if (lane >= o) v = fmaxf(v, t); }
    return v;
}

namespace pg8 {
constexpr int BM = 256, BK = 64, HALF = 128, HTB = HALF * BK * 2, STAGE_BYTES = 8 * HTB, NXCD = 8, WGM = 8;
__host__ __device__ __forceinline__ int lds_byte(int r, int c) { const int st = (r >> 4) * 2 + (c >> 5), rr = r & 15, cc = c & 31, ob = rr * 64 + cc * 2; return st * 1024 + (ob ^ (((ob >> 9) & 1) << 5)); }
__host__ __device__ __forceinline__ void stage_rc(int b, int& R, int& C) { const int st = b / 1024, sb = b % 1024, swz = sb ^ (((sb >> 9) & 1) << 5); R = (st >> 1) * 16 + swz / 64; C = (st & 1) * 32 + (swz % 64) / 2; }
__host__ __device__ __forceinline__ int perm32(int rho) { const int n = rho >> 4, i = rho & 15; return 8 * (i >> 2) + 4 * n + (i & 3); }
struct Unit { int pm, pn; };
struct Gemm { const bf16_t* A; const bf16_t* Bt; int M, N, K; };
struct StaticOrder {
    int nM, nN, nwg, G, c;
    __device__ void init(int M, int N, int G_, int c_) { nM = M / BM; nN = N / BM; nwg = nM * nN; G = G_; c = c_; }
    __device__ bool next(int i, Unit& u) const {
        const long L = (long)i * G + c; if (L >= nwg) return false;
        int wgid = (int)L; { const int q = nwg / NXCD, r = nwg % NXCD, xcd = wgid % NXCD, off = wgid / NXCD; wgid = (xcd < r ? xcd * (q + 1) : r * (q + 1) + (xcd - r) * q) + off; }
        const int nig = WGM * nN, gid = wgid / nig, fm = gid * WGM, gsz = (nM - fm) < WGM ? (nM - fm) : WGM;
        u.pm = fm + ((wgid % nig) % gsz); u.pn = (wgid % nig) / gsz; return true;
    }
};
template <class Epi, class Sched>
__device__ __forceinline__ void gemm_phase(LAS unsigned char* lds, const Gemm g, const Sched& S, const Epi& E) {
    const int tid = threadIdx.x, wid = __builtin_amdgcn_readfirstlane(tid >> 6), lane = tid & 63, wr = wid >> 2, wc = wid & 3, fr = lane & 15, fq = lane >> 4;
    const int K = g.K, nt = K / BK;
    unsigned voffA[2], voffB[2];
#pragma unroll
    for (int i = 0; i < 2; ++i) { int R, C; stage_rc(tid * 16 + i * 8192, R, C); const int Rb = ((R & ~31) + perm32(R & 31));
        voffA[i] = (unsigned)(R * K + C) * 2u; voffB[i] = (unsigned)(Rb * K + C) * 2u; }
    const size_t kstep = (size_t)(BK * 2);
    const size_t hstep = (size_t)HALF * K * 2;
    const size_t tstep = 2 * hstep;
    const unsigned ldsw = (unsigned)wid * 1024u;
    const int aoff = lds_byte(wr * 64 + fr, fq * 8), boff = lds_byte(wc * 32 + fr, fq * 8);
#define PG8_SA(b, h) (((b) * 2 + (h)) * HTB)
#define PG8_SB(b, h) ((4 + (b) * 2 + (h)) * HTB)
#define PG8_STAGE(bufoff, gbase, voff) do { _Pragma("unroll") for (int _i = 0; _i < 2; ++_i) \
        __builtin_amdgcn_global_load_lds((const unsigned*)((const char*)(gbase) + (voff)[_i]), (LAS unsigned*)(lds + (bufoff) + ldsw + _i * 8192), 16, 0, 0); } while (0)
#define PG8_LDA(dst, b, h) do { _Pragma("unroll") for (int m = 0; m < 4; ++m) _Pragma("unroll") for (int k = 0; k < 2; ++k) dst[m][k] = *(const LAS bf16x8*)(lds + PG8_SA(b, h) + aoff + m * 2048 + k * 1024); } while (0)
#define PG8_LDB(dst, b, h) do { _Pragma("unroll") for (int n = 0; n < 2; ++n) _Pragma("unroll") for (int k = 0; k < 2; ++k) dst[n][k] = *(const LAS bf16x8*)(lds + PG8_SB(b, h) + boff + n * 2048 + k * 1024); } while (0)
#define PG8_MMA(ai, bj, At, Bt) do { __builtin_amdgcn_s_setprio(1); _Pragma("unroll") for (int m = 0; m < 4; ++m) _Pragma("unroll") for (int n = 0; n < 2; ++n) _Pragma("unroll") for (int k = 0; k < 2; ++k) \
        acc[ai][bj][m][n] = __builtin_amdgcn_mfma_f32_16x16x32_bf16(Bt[n][k], At[m][k], acc[ai][bj][m][n], 0, 0, 0); __builtin_amdgcn_s_setprio(0); } while (0)
#define PG8_WAIT_V(n) asm volatile("s_waitcnt vmcnt(" #n ")" ::: "memory")
#define PG8_WAIT_L(n) asm volatile("s_waitcnt lgkmcnt(" #n ")" ::: "memory")
#define PG8_BAR __builtin_amdgcn_s_barrier()
#define PG8_SCHED __builtin_amdgcn_sched_barrier(0)
    Unit cur, nxt; int ui = 0;
    if (!S.next(0, cur)) return;
    f32x4 acc[2][2][4][2];
#pragma unroll
    for (int a = 0; a < 2; ++a)
#pragma unroll
        for (int b = 0; b < 2; ++b)
#pragma unroll
            for (int m = 0; m < 4; ++m)
#pragma unroll
                for (int n = 0; n < 2; ++n) acc[a][b][m][n] = (f32x4){0.f, 0.f, 0.f, 0.f};
    bf16x8 At[4][2], B0[2][2], B1[2][2];
    const char* cA = (const char*)g.A + (size_t)cur.pm * tstep; const char* cB = (const char*)g.Bt + (size_t)cur.pn * tstep;
    PG8_STAGE(PG8_SB(0, 0), cB, voffB); PG8_STAGE(PG8_SA(0, 0), cA, voffA); PG8_STAGE(PG8_SB(0, 1), cB + hstep, voffB); PG8_STAGE(PG8_SA(0, 1), cA + hstep, voffA);
    if (wr == 1) PG8_BAR;
    PG8_WAIT_V(4); PG8_BAR;
    PG8_STAGE(PG8_SB(1, 0), cB + kstep, voffB); PG8_STAGE(PG8_SA(1, 0), cA + kstep, voffA); PG8_STAGE(PG8_SB(1, 1), cB + hstep + kstep, voffB);
    PG8_WAIT_V(6); PG8_BAR;
    for (;;) {
        const bool has_next = S.next(ui + 1, nxt);
        const char* nA = has_next ? (const char*)g.A + (size_t)nxt.pm * tstep : cA; const char* nB = has_next ? (const char*)g.Bt + (size_t)nxt.pn * tstep : cB;
        for (int t = 0; t < nt; t += 2) {
            const bool last = (t == nt - 2);
            const char* a1 = cA + (size_t)(t + 1) * kstep;
            const char* a2 = last ? nA : cA + (size_t)(t + 2) * kstep; const char* b2 = last ? nB : cB + (size_t)(t + 2) * kstep;
            const char* a3 = a2 + kstep; const char* b3 = b2 + kstep;
            PG8_LDB(B0, 0, 0); PG8_SCHED; PG8_LDA(At, 0, 0); PG8_STAGE(PG8_SA(1, 1), a1 + hstep, voffA);
            PG8_WAIT_L(8); PG8_BAR; PG8_WAIT_L(0); PG8_MMA(0, 0, At, B0); PG8_BAR; PG8_SCHED;
            PG8_LDB(B1, 0, 1); PG8_STAGE(PG8_SB(0, 0), b2, voffB);
            PG8_BAR; PG8_WAIT_L(0); PG8_MMA(0, 1, At, B1); PG8_BAR;
            PG8_LDA(At, 0, 1); PG8_STAGE(PG8_SA(0, 0), a2, voffA);
            PG8_BAR; PG8_WAIT_L(0); PG8_MMA(1, 0, At, B0); PG8_BAR; PG8_SCHED;
            PG8_STAGE(PG8_SB(0, 1), b2 + hstep, voffB);
            PG8_WAIT_V(6); PG8_BAR; PG8_MMA(1, 1, At, B1); PG8_BAR;
            PG8_LDB(B0, 1, 0); PG8_SCHED; PG8_LDA(At, 1, 0); PG8_STAGE(PG8_SA(0, 1), a2 + hstep, voffA);
            PG8_WAIT_L(8); PG8_BAR; PG8_WAIT_L(0); PG8_MMA(0, 0, At, B0); PG8_BAR; PG8_SCHED;
            PG8_LDB(B1, 1, 1); PG8_STAGE(PG8_SB(1, 0), b3, voffB);
            PG8_BAR; PG8_WAIT_L(0); PG8_MMA(0, 1, At, B1); PG8_BAR;
            PG8_LDA(At, 1, 1); PG8_STAGE(PG8_SA(1, 0), a3, voffA);
            PG8_BAR; PG8_WAIT_L(0); PG8_MMA(1, 0, At, B0); PG8_BAR; PG8_SCHED;
            PG8_STAGE(PG8_SB(1, 1), b3 + hstep, voffB);
            PG8_WAIT_V(6); PG8_BAR; PG8_MMA(1, 1, At, B1); PG8_BAR;
        }
        E(acc, cur, wr, wc, fr, fq);
        if (!has_next) break;
#pragma unroll
        for (int a = 0; a < 2; ++a)
#pragma unroll
            for (int b = 0; b < 2; ++b)
#pragma unroll
                for (int m = 0; m < 4; ++m)
#pragma unroll
                    for (int n = 0; n < 2; ++n) acc[a][b][m][n] = (f32x4){0.f, 0.f, 0.f, 0.f};
        cur = nxt; cA = nA; cB = nB; ++ui;
    }
    PG8_WAIT_V(0);
    if (wr == 0) PG8_BAR;
    PG8_BAR;
#undef PG8_SA
#undef PG8_SB
#undef PG8_STAGE
#undef PG8_LDA
#undef PG8_LDB
#undef PG8_MMA
#undef PG8_WAIT_V
#undef PG8_WAIT_L
#undef PG8_BAR
#undef PG8_SCHED
}
}
using pg8::Unit;

#define EPI_ROWS(ai, m) (u.pm * 256 + (ai) * 128 + wr * 64 + (m) * 16 + fr)
struct EpiSwiglu {
    bf16_t* H;
    __device__ __forceinline__ void operator()(const f32x4 (&acc)[2][2][4][2], const Unit& u, int wr, int wc, int fr, int fq) const {
        const int col = u.pn * 128 + wc * 32 + 8 * fq;
#pragma unroll
        for (int ai = 0; ai < 2; ++ai)
#pragma unroll
            for (int m = 0; m < 4; ++m) {
                const size_t row = EPI_ROWS(ai, m);
                float h[8];
#pragma unroll
                for (int n = 0; n < 2; ++n)
#pragma unroll
                    for (int j = 0; j < 4; ++j) { const float g = acc[ai][0][m][n][j], uu = acc[ai][1][m][n][j]; h[4 * n + j] = g * uu * sigmoid_f(g); }
                u32x4 w; w.x = cvt_pk_bf16(h[0], h[1]); w.y = cvt_pk_bf16(h[2], h[3]); w.z = cvt_pk_bf16(h[4], h[5]); w.w = cvt_pk_bf16(h[6], h[7]);
                *(u32x4*)(H + row * FH + col) = w;
            }
    }
};
template <bool RES_BF16, bool HAS_MUL>
struct EpiResid {
    const void* res; const bf16_t* mul; float* Y; float scale;
    __device__ __forceinline__ void operator()(const f32x4 (&acc)[2][2][4][2], const Unit& u, int wr, int wc, int fr, int fq) const {
#pragma unroll
        for (int ai = 0; ai < 2; ++ai)
#pragma unroll
            for (int m = 0; m < 4; ++m) {
                const size_t row = EPI_ROWS(ai, m);
#pragma unroll
                for (int bj = 0; bj < 2; ++bj) {
                    const size_t off = row * DM + u.pn * 256 + bj * 128 + wc * 32 + 8 * fq;
                    float r[8];
                    if (RES_BF16) { const u32x4 rv = *(const u32x4*)((const bf16_t*)res + off);
                        r[0] = bf_lo(rv.x); r[1] = bf_hi(rv.x); r[2] = bf_lo(rv.y); r[3] = bf_hi(rv.y); r[4] = bf_lo(rv.z); r[5] = bf_hi(rv.z); r[6] = bf_lo(rv.w); r[7] = bf_hi(rv.w); }
                    else { const f32x4 a = *(const f32x4*)((const float*)res + off), b = *(const f32x4*)((const float*)res + off + 4);
                        r[0] = a[0]; r[1] = a[1]; r[2] = a[2]; r[3] = a[3]; r[4] = b[0]; r[5] = b[1]; r[6] = b[2]; r[7] = b[3]; }
                    float mv[8];
                    if (HAS_MUL) { const u32x4 rv = *(const u32x4*)(mul + off);
                        mv[0] = bf_lo(rv.x); mv[1] = bf_hi(rv.x); mv[2] = bf_lo(rv.y); mv[3] = bf_hi(rv.y); mv[4] = bf_lo(rv.z); mv[5] = bf_hi(rv.z); mv[6] = bf_lo(rv.w); mv[7] = bf_hi(rv.w); }
                    f32x4 o0, o1;
#pragma unroll
                    for (int j = 0; j < 4; ++j) {
                        const float a0 = acc[ai][bj][m][0][j] * scale, a1 = acc[ai][bj][m][1][j] * scale;
                        o0[j] = ALPHA * r[j] + (HAS_MUL ? mv[j] * a0 : a0); o1[j] = ALPHA * r[4 + j] + (HAS_MUL ? mv[4 + j] * a1 : a1); }
                    *(f32x4*)(Y + off) = o0; *(f32x4*)(Y + off + 4) = o1;
                }
            }
    }
};
struct EpiWin {
    bf16_t* proj; bf16_t* gates; float* ifg; const float* bias;
    __device__ __forceinline__ void operator()(const f32x4 (&acc)[2][2][4][2], const Unit& u, int wr, int wc, int fr, int fq) const {
        const int pn = u.pn;
        if (pn == 32) {
            if (wc == 0 && fq == 0) {
                const f32x4 bi = *(const f32x4*)(bias + 8192), bf = *(const f32x4*)(bias + 8196);
#pragma unroll
                for (int ai = 0; ai < 2; ++ai)
#pragma unroll
                    for (int m = 0; m < 4; ++m) {
                        const size_t row = EPI_ROWS(ai, m);
                        f32x4 iv = acc[ai][0][m][0] + bi, fv = acc[ai][0][m][1] + bf, lf;
#pragma unroll
                        for (int j = 0; j < 4; ++j) { const float xx = fv[j]; lf[j] = xx >= 0.f ? -log1pf(expf(-xx)) : xx - log1pf(expf(xx)); }
                        *(f32x4*)(ifg + row * 8) = iv; *(f32x4*)(ifg + row * 8 + 4) = lf;
                    }
            }
            return;
        }
        bf16_t* dst; int ld, c0; int act = 0; float sc = 1.0f;
        if (pn < 24) { const int sec = pn >> 2; dst = proj + (size_t)sec * ((size_t)MTOK * DM); ld = DM; c0 = (pn & 3) * 256; if (sec == 2) act = 1; if (sec == 3) sc = 0.08838834764831845f * LOG2E; }
        else { dst = gates; ld = 2 * DM; c0 = (pn - 24) * 256; act = 1; }
#pragma unroll
        for (int bj = 0; bj < 2; ++bj) {
            const int cl = bj * 128 + wc * 32 + 8 * fq;
            const f32x4 b0 = *(const f32x4*)(bias + pn * 256 + cl), b1 = *(const f32x4*)(bias + pn * 256 + cl + 4);
#pragma unroll
            for (int ai = 0; ai < 2; ++ai)
#pragma unroll
                for (int m = 0; m < 4; ++m) {
                    const size_t row = EPI_ROWS(ai, m);
                    f32x4 v0 = acc[ai][bj][m][0] + b0, v1 = acc[ai][bj][m][1] + b1;
                    if (act) {
#pragma unroll
                        for (int j = 0; j < 4; ++j) { v0[j] = sigmoid_f(v0[j]); v1[j] = sigmoid_f(v1[j]); } }
                    else { v0 *= sc; v1 *= sc; }
                    u32x4 w; w.x = cvt_pk_bf16(v0[0], v0[1]); w.y = cvt_pk_bf16(v0[2], v0[3]); w.z = cvt_pk_bf16(v1[0], v1[1]); w.w = cvt_pk_bf16(v1[2], v1[3]);
                    *(u32x4*)(dst + row * ld + c0 + cl) = w;
                }
        }
    }
};
template <bool ADD>
struct EpiGateMul {
    const bf16_t* gate; int goff; const bf16_t* tin; bf16_t* out;
    __device__ __forceinline__ void operator()(const f32x4 (&acc)[2][2][4][2], const Unit& u, int wr, int wc, int fr, int fq) const {
#pragma unroll
        for (int ai = 0; ai < 2; ++ai)
#pragma unroll
            for (int m = 0; m < 4; ++m) {
                const size_t row = EPI_ROWS(ai, m);
#pragma unroll
                for (int bj = 0; bj < 2; ++bj) {
                    const int c = u.pn * 256 + bj * 128 + wc * 32 + 8 * fq;
                    const u32x4 gv = *(const u32x4*)(gate + row * (2 * DM) + goff + c);
                    float gg[8] = {bf_lo(gv.x), bf_hi(gv.x), bf_lo(gv.y), bf_hi(gv.y), bf_lo(gv.z), bf_hi(gv.z), bf_lo(gv.w), bf_hi(gv.w)};
                    float tt[8] = {0.f, 0.f, 0.f, 0.f, 0.f, 0.f, 0.f, 0.f};
                    if (ADD) { const u32x4 tv = *(const u32x4*)(tin + row * DM + c);
                        tt[0] = bf_lo(tv.x); tt[1] = bf_hi(tv.x); tt[2] = bf_lo(tv.y); tt[3] = bf_hi(tv.y); tt[4] = bf_lo(tv.z); tt[5] = bf_hi(tv.z); tt[6] = bf_lo(tv.w); tt[7] = bf_hi(tv.w); }
                    float o[8];
#pragma unroll
                    for (int j = 0; j < 4; ++j) { o[j] = tt[j] + gg[j] * acc[ai][bj][m][0][j]; o[4 + j] = tt[4 + j] + gg[4 + j] * acc[ai][bj][m][1][j]; }
                    u32x4 w; w.x = cvt_pk_bf16(o[0], o[1]); w.y = cvt_pk_bf16(o[2], o[3]); w.z = cvt_pk_bf16(o[4], o[5]); w.w = cvt_pk_bf16(o[6], o[7]);
                    *(u32x4*)(out + row * DM + c) = w;
                }
            }
    }
};
struct EpiSigBias {
    const float* bias; bf16_t* out;
    __device__ __forceinline__ void operator()(const f32x4 (&acc)[2][2][4][2], const Unit& u, int wr, int wc, int fr, int fq) const {
#pragma unroll
        for (int bj = 0; bj < 2; ++bj) {
            const int c = u.pn * 256 + bj * 128 + wc * 32 + 8 * fq;
            const f32x4 b0 = *(const f32x4*)(bias + c), b1 = *(const f32x4*)(bias + c + 4);
#pragma unroll
            for (int ai = 0; ai < 2; ++ai)
#pragma unroll
                for (int m = 0; m < 4; ++m) {
                    const size_t row = EPI_ROWS(ai, m);
                    f32x4 v0 = acc[ai][bj][m][0] + b0, v1 = acc[ai][bj][m][1] + b1;
#pragma unroll
                    for (int j = 0; j < 4; ++j) { v0[j] = sigmoid_f(v0[j]); v1[j] = sigmoid_f(v1[j]); }
                    u32x4 w; w.x = cvt_pk_bf16(v0[0], v0[1]); w.y = cvt_pk_bf16(v0[2], v0[3]); w.z = cvt_pk_bf16(v1[0], v1[1]); w.w = cvt_pk_bf16(v1[2], v1[3]);
                    *(u32x4*)(out + row * DM + c) = w;
                }
        }
    }
};

struct Params {
    const float *x, *p, *ln_g, *ln_b, *wg, *wu, *wd, *w_in, *b_in, *b_forget, *conv_w, *conv_b, *mh_g, *w_a, *w_b, *w_o, *w_ple, *w_pg, *b_pg;
    float* out; unsigned char* ws;
    int ph_lo, ph_hi, coop, pad;
};

__device__ void cvt_bf16_phase(const float* src, bf16_t* dst, size_t n8) {
    const size_t stride = (size_t)gridDim.x * NTHREADS;
    for (size_t i = (size_t)blockIdx.x * NTHREADS + threadIdx.x; i < n8; i += stride) {
        const f32x4 a = *(const f32x4*)(src + i * 8), b = *(const f32x4*)(src + i * 8 + 4);
        u32x4 w; w.x = cvt_pk_bf16(a[0], a[1]); w.y = cvt_pk_bf16(a[2], a[3]); w.z = cvt_pk_bf16(b[0], b[1]); w.w = cvt_pk_bf16(b[2], b[3]);
        *(u32x4*)(dst + i * 8) = w;
    }
}
template <int MODE>
__device__ __forceinline__ float tsrc_val(const float* w0, const float* w1, int ldn, int k, int n) {
    if (MODE == 0) return w0[(size_t)k * ldn + n];
    if (MODE == 1) { const int pn = n >> 8, sel = (n >> 7) & 1, i = n & 127; const float* w = sel ? w1 : w0; return w[(size_t)k * ldn + pn * 128 + i]; }
    int col; if (n < 3072) col = n; else if (n < 8192) col = n + 8; else if (n < 8200) col = 3072 + (n - 8192); else return 0.f;
    return w0[(size_t)k * ldn + col];
}
template <int MODE>
__device__ __forceinline__ void transpose_mat(LAS float* tile, const float* w0, const float* w1, int ldn, bf16_t* dst, int NP, int K, int& base) {
    const int tid = threadIdx.x;
    const int tn = NP / 128, tk = K / 128, nt = tn * tk;
    int first = ((int)blockIdx.x - base) % (int)gridDim.x; if (first < 0) first += gridDim.x;
    for (int t = first; t < nt; t += gridDim.x) {
        const int n0 = (t / tk) * 128, k0 = (t % tk) * 128;
#pragma unroll 8
        for (int e = 0; e < 32; ++e) { const int idx = e * NTHREADS + tid, kk = idx >> 7, nn = idx & 127; tile[kk * 129 + nn] = tsrc_val<MODE>(w0, w1, ldn, k0 + kk, n0 + nn); }
        __syncthreads();
#pragma unroll 8
        for (int e = 0; e < 16; ++e) { const int idx = e * NTHREADS + tid, nn = idx >> 6, kk = (idx & 63) * 2;
            *(unsigned*)(dst + (size_t)(n0 + nn) * K + k0 + kk) = cvt_pk_bf16(tile[kk * 129 + nn], tile[(kk + 1) * 129 + nn]); }
        __syncthreads();
    }
    base += nt;
}
__device__ void prep_phase(const Params& P, LAS unsigned char* lds) {
    unsigned char* ws = P.ws;
    cvt_bf16_phase(P.x, (bf16_t*)(ws + WS_X), (size_t)MTOK * DM / 8);
    if (blockIdx.x == 0 && threadIdx.x < 64) ((unsigned*)(ws + MISC_CNT))[threadIdx.x] = 0u;
    for (int n = blockIdx.x * NTHREADS + threadIdx.x; n < NIN_PAD; n += gridDim.x * NTHREADS) {
        float b;
        if (n < 3072) b = P.b_in[n]; else if (n < 8192) b = P.b_in[n + 8]; else if (n < 8196) b = P.b_in[3072 + n - 8192];
        else if (n < 8200) b = P.b_in[3072 + n - 8192] + P.b_forget[n - 8196]; else b = 0.f;
        ((float*)(ws + W_BIAS))[n] = b;
    }
    LAS float* tile = (LAS float*)lds;
    int base = 0;
    transpose_mat<1>(tile, P.wg, P.wu, FH, (bf16_t*)(ws + W_GU1), 5632, 1024, base);
    transpose_mat<0>(tile, P.wd, nullptr, DM, (bf16_t*)(ws + W_D1), 1024, FH, base);
    transpose_mat<1>(tile, P.wg + (size_t)DM * FH, P.wu + (size_t)DM * FH, FH, (bf16_t*)(ws + W_GU2), 5632, 1024, base);
    transpose_mat<0>(tile, P.wd + (size_t)DM * FH, nullptr, DM, (bf16_t*)(ws + W_D2), 1024, FH, base);
    transpose_mat<2>(tile, P.w_in, nullptr, 8200, (bf16_t*)(ws + W_IN), NIN_PAD, 1024, base);
    transpose_mat<0>(tile, P.w_a, nullptr, DM, (bf16_t*)(ws + W_A), 1024, 1024, base);
    transpose_mat<0>(tile, P.w_b, nullptr, DM, (bf16_t*)(ws + W_B), 1024, 1024, base);
    transpose_mat<0>(tile, P.w_o, nullptr, DM, (bf16_t*)(ws + W_O), 1024, 1024, base);
    transpose_mat<0>(tile, P.w_pg, nullptr, DM, (bf16_t*)(ws + W_PG), 1024, 1024, base);
    transpose_mat<0>(tile, P.w_ple, nullptr, DM, (bf16_t*)(ws + W_P), 1024, 256, base);
}
template <bool OUT_BF16>
__device__ void ln_phase(const float* Y, const float* g, const float* b, void* out) {
    const int wid = threadIdx.x >> 6, lane = threadIdx.x & 63;
    f32x4 gv[4], bv[4];
#pragma unroll
    for (int i = 0; i < 4; ++i) { gv[i] = *(const f32x4*)(g + i * 256 + lane * 4); bv[i] = *(const f32x4*)(b + i * 256 + lane * 4); }
    for (int row = blockIdx.x * 8 + wid; row < MTOK; row += gridDim.x * 8) {
        const float* y = Y + (size_t)row * DM;
        f32x4 v[4]; float s = 0.f;
#pragma unroll
        for (int i = 0; i < 4; ++i) { v[i] = *(const f32x4*)(y + i * 256 + lane * 4); s += (v[i][0] + v[i][1]) + (v[i][2] + v[i][3]); }
        const float mean = wave_sum(s) * (1.0f / DM);
        float q = 0.f;
#pragma unroll
        for (int i = 0; i < 4; ++i) { const f32x4 d = v[i] - mean; q += (d[0] * d[0] + d[1] * d[1]) + (d[2] * d[2] + d[3] * d[3]); }
        const float rstd = rsqrtf(wave_sum(q) * (1.0f / DM) + LN_EPS);
#pragma unroll
        for (int i = 0; i < 4; ++i) {
            const f32x4 o = (v[i] - mean) * rstd * gv[i] + bv[i];
            if (OUT_BF16) { u32x2 w; w.x = cvt_pk_bf16(o[0], o[1]); w.y = cvt_pk_bf16(o[2], o[3]); *(u32x2*)((bf16_t*)out + (size_t)row * DM + i * 256 + lane * 4) = w; }
            else *(f32x4*)((float*)out + (size_t)row * DM + i * 256 + lane * 4) = o;
        }
    }
}

constexpr int L_QI = 0, L_KI = 17408, L_KT = 34816, L_VT = 53248, L_PI = 90112, L_F = 99328;
constexpr int F_N = 0, F_QN = 128, F_RS = 192, F_HS = 320, F_BL = 1344, F_GM = 1472, F_M = 1600, F_CW = 1732, F_SA = 3012, F_SB2 = 3028, F_SMU = 4052, F_SWI = 5076, F_SWN = 6100, F_SEM = 7124, F_END = 8148;
constexpr int MIX_LDS = L_F + F_END * 4;

__device__ void mlstm_prologue(const Params& P, LAS unsigned char* lds, int b, int h, int gi) {
    LAS float* F = (LAS float*)(lds + L_F);
    const float* ifg = (const float*)(P.ws + MISC_IF);
    const int tid = threadIdx.x, w = tid >> 6, lane = tid & 63;
    const int nch = 16 * (gi + 1);
    for (int c = w; c < nch; c += 8) {
        const size_t tok = (size_t)b * SEQ + c * 64 + lane;
        const float iv = ifg[tok * 8 + h], lf = ifg[tok * 8 + 4 + h];
        const float bc = wave_incl_sum(lf, lane);
        const float bl = __shfl(bc, 63);
        const float gm = wave_max(bl - bc + iv);
        if (lane == 0) { F[F_BL + c] = bl; F[F_GM + c] = gm; }
    }
    for (int i = tid; i < 1280; i += NTHREADS) {
        const int j = i >> 8, ch = i & 255; const int gc = ch < 128 ? h * 128 + ch : 512 + h * 128 + (ch - 128);
        F[F_CW + i] = j < 4 ? P.conv_w[j * 1024 + gc] : P.conv_b[gc];
    }
    if (tid < 128) F[F_N + tid] = 0.f;
    __syncthreads();
    if (tid == 0) { float m = 0.f; F[F_M] = 0.f; for (int c = 0; c < nch; ++c) { m = fmaxf(F[F_BL + c] + m, F[F_GM + c]); F[F_M + c + 1] = m; } }
    __syncthreads();
    for (int lc = w; lc < 16; lc += 8) {
        const int c = gi * 16 + lc;
        const size_t tok = (size_t)b * SEQ + c * 64 + lane;
        const float iv = ifg[tok * 8 + h], lf = ifg[tok * 8 + 4 + h];
        const float bc = wave_incl_sum(lf, lane);
        const float bl = __shfl(bc, 63);
        const float mst = F[F_M + c], mnew = F[F_M + c + 1];
        const float beta = iv - bc;
        const float mu = fmaxf(mst, wave_incl_max(beta, lane));
        F[F_SB2 + lc * 64 + lane] = beta * LOG2E;
        F[F_SMU + lc * 64 + lane] = mu * LOG2E;
        F[F_SWI + lc * 64 + lane] = expf(mst - mu);
        F[F_SWN + lc * 64 + lane] = expf(bl - bc + iv - mnew);
        F[F_SEM + lc * 64 + lane] = expf(-(bc + mu));
        if (lane == 0) F[F_SA + lc] = expf(bl + mst - mnew);
    }
    __syncthreads();
}

template <bool NEED_Q>
__device__ __forceinline__ void mlstm_load(const Params& P, LAS unsigned char* lds, int b, int h, int c, int lc) {
    LAS float* F = (LAS float*)(lds + L_F);
    const bf16_t* QK = (const bf16_t*)(P.ws + WS_QK);
    const bf16_t* VA = (const bf16_t*)(P.ws + WS_VA);
    const int tid = threadIdx.x, tg = tid & 15, cg = tid >> 4;
    {
        u32x4 vr[4];
#pragma unroll
        for (int tt = 0; tt < 4; ++tt) vr[tt] = *(const u32x4*)(VA + ((size_t)b * SEQ + c * 64 + 4 * tg + tt) * DM + h * 256 + 8 * cg);
#pragma unroll
        for (int e = 0; e < 8; ++e) {
            unsigned short x0, x1, x2, x3;
            { const unsigned a0 = vr[0][e >> 1], a1 = vr[1][e >> 1], a2 = vr[2][e >> 1], a3 = vr[3][e >> 1];
              if (e & 1) { x0 = a0 >> 16; x1 = a1 >> 16; x2 = a2 >> 16; x3 = a3 >> 16; } else { x0 = a0 & 0xffff; x1 = a1 & 0xffff; x2 = a2 & 0xffff; x3 = a3 & 0xffff; } }
            u32x2 wv; wv.x = (unsigned)x0 | ((unsigned)x1 << 16); wv.y = (unsigned)x2 | ((unsigned)x3 << 16);
            *(LAS u32x2*)(lds + L_VT + (8 * cg + e) * 144 + 8 * tg) = wv;
        }
    }
    __builtin_amdgcn_sched_barrier(0);
    if (NEED_Q || cg >= 16) {
        const int gc = cg < 16 ? h * 128 + 8 * cg : 512 + h * 128 + 8 * (cg - 16);
        u32x4 raw[7];
#pragma unroll
        for (int i = 0; i < 7; ++i) {
            const int pos = c * 64 + 4 * tg - 3 + i;
            raw[i] = pos >= 0 ? *(const u32x4*)(QK + ((size_t)b * SEQ + pos) * DM + gc) : (u32x4){0u, 0u, 0u, 0u};
        }
        float o[4][8];
#pragma unroll
        for (int e = 0; e < 8; ++e) {
            float rv[7];
#pragma unroll
            for (int i = 0; i < 7; ++i) rv[i] = (e & 1) ? bf_hi(raw[i][e >> 1]) : bf_lo(raw[i][e >> 1]);
            const float w0 = F[F_CW + 0 * 256 + 8 * cg + e], w1 = F[F_CW + 1 * 256 + 8 * cg + e], w2 = F[F_CW + 2 * 256 + 8 * cg + e], w3 = F[F_CW + 3 * 256 + 8 * cg + e], cb = F[F_CW + 4 * 256 + 8 * cg + e];
#pragma unroll
            for (int tt = 0; tt < 4; ++tt) { const float v = cb + w0 * rv[tt] + w1 * rv[tt + 1] + w2 * rv[tt + 2] + w3 * rv[tt + 3]; o[tt][e] = v * sigmoid_f(v); }
            __builtin_amdgcn_sched_barrier(0);
        }
        if (cg < 16) {
#pragma unroll
            for (int tt = 0; tt < 4; ++tt) { u32x4 wv; wv.x = cvt_pk_bf16(o[tt][0], o[tt][1]); wv.y = cvt_pk_bf16(o[tt][2], o[tt][3]); wv.z = cvt_pk_bf16(o[tt][4], o[tt][5]); wv.w = cvt_pk_bf16(o[tt][6], o[tt][7]);
                *(LAS u32x4*)(lds + L_QI + (4 * tg + tt) * 272 + 16 * cg) = wv; }
        } else {
            const int kc = cg - 16;
            const f32x4 wn = *(const LAS f32x4*)(F + F_SWN + lc * 64 + 4 * tg);
#pragma unroll
            for (int tt = 0; tt < 4; ++tt) {
#pragma unroll
                for (int e = 0; e < 8; ++e) o[tt][e] *= 0.08838834764831845f;
                u32x4 wv; wv.x = cvt_pk_bf16(o[tt][0], o[tt][1]); wv.y = cvt_pk_bf16(o[tt][2], o[tt][3]); wv.z = cvt_pk_bf16(o[tt][4], o[tt][5]); wv.w = cvt_pk_bf16(o[tt][6], o[tt][7]);
                *(LAS u32x4*)(lds + L_KI + (4 * tg + tt) * 272 + 16 * kc) = wv; }
#pragma unroll
            for (int e = 0; e < 8; ++e) { u32x2 wv; wv.x = cvt_pk_bf16(o[0][e] * wn[0], o[1][e] * wn[1]); wv.y = cvt_pk_bf16(o[2][e] * wn[2], o[3][e] * wn[3]);
                *(LAS u32x2*)(lds + L_KT + (8 * kc + e) * 144 + 8 * tg) = wv; }
        }
    }
}

__device__ __forceinline__ void mlstm_update(LAS unsigned char* lds, f32x4 (&C)[2][8], int lc, int w, int r, int g) {
    LAS float* F = (LAS float*)(lds + L_F);
    const float a = F[F_SA + lc];
    const LAS unsigned char* vp = lds + (L_VT + (32 * w + r) * 144 + 16 * g);
    const LAS unsigned char* kp = lds + (L_KT + r * 144 + 16 * g);
#pragma unroll
    for (int dvb = 0; dvb < 2; ++dvb)
#pragma unroll
        for (int dkb = 0; dkb < 8; ++dkb) C[dvb][dkb] *= a;
#pragma unroll
    for (int ks = 0; ks < 2; ++ks) {
        bf16x8 vf[2];
#pragma unroll
        for (int dvb = 0; dvb < 2; ++dvb) vf[dvb] = *(const LAS bf16x8*)(vp + (16 * dvb * 144 + 64 * ks));
#pragma unroll
        for (int dkb = 0; dkb < 8; ++dkb) {
            const bf16x8 kf = *(const LAS bf16x8*)(kp + (16 * dkb * 144 + 64 * ks));
#pragma unroll
            for (int dvb = 0; dvb < 2; ++dvb) C[dvb][dkb] = mfma16(kf, vf[dvb], C[dvb][dkb]);
        }
        __builtin_amdgcn_sched_barrier(0);
    }
    const int tid = threadIdx.x, dk = tid >> 2, part = tid & 3;
    const u32x4 k0 = *(const LAS u32x4*)(lds + L_KT + dk * 144 + 32 * part), k1 = *(const LAS u32x4*)(lds + L_KT + dk * 144 + 32 * part + 16);
    float s = 0.f;
#pragma unroll
    for (int i = 0; i < 4; ++i) s += bf_lo(k0[i]) + bf_hi(k0[i]) + bf_lo(k1[i]) + bf_hi(k1[i]);
    s += __shfl_xor(s, 1); s += __shfl_xor(s, 2);
    if (part == 0) F[F_N + dk] = a * F[F_N + dk] + s;
}

__device__ void mlstm_phase1(const Params& P, LAS unsigned char* lds) {
    const int tid = threadIdx.x, w = tid >> 6, lane = tid & 63, r = lane & 15, g = lane >> 4;
    LAS float* F = (LAS float*)(lds + L_F);
    for (int task = blockIdx.x; task < 256; task += gridDim.x) {
        const int gi = task & 7, st = task >> 3, b = st >> 2, h = st & 3;
        if (gi == 7) continue;
        mlstm_prologue(P, lds, b, h, gi);
        f32x4 C[2][8];
#pragma unroll
        for (int i = 0; i < 2; ++i)
#pragma unroll
            for (int j = 0; j < 8; ++j) C[i][j] = (f32x4){0.f, 0.f, 0.f, 0.f};
        for (int lc = 0; lc < 16; ++lc) {
            mlstm_load<false>(P, lds, b, h, gi * 16 + lc, lc);
            __syncthreads();
            mlstm_update(lds, C, lc, w, r, g);
            __syncthreads();
        }
        float* slot = (float*)(P.ws + WS_PB) + (size_t)(st * 7 + gi) * STATE_FLOATS;
#pragma unroll
        for (int dvb = 0; dvb < 2; ++dvb)
#pragma unroll
            for (int dkb = 0; dkb < 8; ++dkb) *(f32x4*)(slot + (((w * 2 + dvb) * 8 + dkb) * 64 + lane) * 4) = C[dvb][dkb];
        if (tid < 128) slot[32768 + tid] = F[F_N + tid];
        __syncthreads();
    }
}

__device__ void mlstm_phase2(const Params& P, LAS unsigned char* lds) {
    const int tid = threadIdx.x, w = tid >> 6, lane = tid & 63, r = lane & 15, g = lane >> 4;
    LAS float* F = (LAS float*)(lds + L_F);
    const bf16_t* OA = (const bf16_t*)(P.ws + WS_OA);
    bf16_t* VA = (bf16_t*)(P.ws + WS_VA);
    for (int task = blockIdx.x; task < 256; task += gridDim.x) {
        const int gi = task & 7, st = task >> 3, b = st >> 2, h = st & 3;
        mlstm_prologue(P, lds, b, h, gi);
        f32x4 C[2][8];
#pragma unroll
        for (int i = 0; i < 2; ++i)
#pragma unroll
            for (int j = 0; j < 8; ++j) C[i][j] = (f32x4){0.f, 0.f, 0.f, 0.f};
        float nreg = 0.f;
        for (int j = 0; j < gi; ++j) {
            float Bj = 0.f;
            for (int c = 0; c < 16; ++c) Bj += F[F_BL + j * 16 + c];
            const float Aj = expf(Bj + F[F_M + 16 * j] - F[F_M + 16 * j + 16]);
            const float* slot = (const float*)(P.ws + WS_PB) + (size_t)(st * 7 + j) * STATE_FLOATS;
#pragma unroll
            for (int dvb = 0; dvb < 2; ++dvb)
#pragma unroll
                for (int dkb = 0; dkb < 8; ++dkb) C[dvb][dkb] = C[dvb][dkb] * Aj + *(const f32x4*)(slot + (((w * 2 + dvb) * 8 + dkb) * 64 + lane) * 4);
            if (tid < 128) nreg = nreg * Aj + slot[32768 + tid];
        }
        if (tid < 128) F[F_N + tid] = nreg;
        __syncthreads();
        for (int lc = 0; lc < 16; ++lc) {
            const int c = gi * 16 + lc;
            mlstm_load<true>(P, lds, b, h, c, lc);
            __syncthreads();
            {
                const int tb = w >> 1, par = w & 1;
                const LAS unsigned char* qpS = lds + (L_QI + (16 * tb + r) * 272 + 16 * g);
                const LAS unsigned char* kpS = lds + (L_KI + (16 * par + r) * 272 + 16 * g);
                LAS unsigned char* ppS = lds + (L_PI + (16 * tb + r) * 144 + 32 * par + 8 * g);
                bf16x8 qf[4];
#pragma unroll
                for (int kd = 0; kd < 4; ++kd) qf[kd] = *(const LAS bf16x8*)(qpS + 64 * kd);
                const float mu2 = F[F_SMU + lc * 64 + 16 * tb + r];
                float rs = 0.f;
#pragma unroll
                for (int sbi = 0; sbi < 2; ++sbi) {
                    const int sb = par + 2 * sbi;
                    u32x2 pw = (u32x2){0u, 0u};
                    if (sb <= tb) {
                        f32x4 acc = (f32x4){0.f, 0.f, 0.f, 0.f};
#pragma unroll
                        for (int kd = 0; kd < 4; ++kd) { const bf16x8 kf = *(const LAS bf16x8*)(kpS + (32 * sbi * 272 + 64 * kd)); acc = mfma16(kf, qf[kd], acc); }
                        const f32x4 b2 = *(const LAS f32x4*)(F + F_SB2 + lc * 64 + 16 * sb + 4 * g);
                        float pv[4];
#pragma unroll
                        for (int j = 0; j < 4; ++j) { const int s = 16 * sb + 4 * g + j, t = 16 * tb + r; pv[j] = (s <= t) ? acc[j] * fast_exp2(b2[j] - mu2) : 0.f; }
                        pw.x = cvt_pk_bf16(pv[0], pv[1]); pw.y = cvt_pk_bf16(pv[2], pv[3]);
                        rs += bf_lo(pw.x) + bf_hi(pw.x) + bf_lo(pw.y) + bf_hi(pw.y);
                    }
                    *(LAS u32x2*)(ppS + 64 * sbi) = pw;
                }
                rs += __shfl_xor(rs, 16); rs += __shfl_xor(rs, 32);
                if (g == 0) F[F_RS + par * 64 + 16 * tb + r] = rs;
            }
            __builtin_amdgcn_sched_barrier(0);
            const LAS unsigned char* q8p = lds + (L_QI + r * 272 + 8 * g);
            f32x4 num[2][4];
#pragma unroll
            for (int i = 0; i < 2; ++i)
#pragma unroll
                for (int j = 0; j < 4; ++j) num[i][j] = (f32x4){0.f, 0.f, 0.f, 0.f};
#pragma unroll
            for (int kk = 0; kk < 4; ++kk) {
                bf16x8 af[2];
#pragma unroll
                for (int dvb = 0; dvb < 2; ++dvb) {
                    u32x2 lo, hi; lo.x = cvt_pk_bf16(C[dvb][2 * kk][0], C[dvb][2 * kk][1]); lo.y = cvt_pk_bf16(C[dvb][2 * kk][2], C[dvb][2 * kk][3]);
                    hi.x = cvt_pk_bf16(C[dvb][2 * kk + 1][0], C[dvb][2 * kk + 1][1]); hi.y = cvt_pk_bf16(C[dvb][2 * kk + 1][2], C[dvb][2 * kk + 1][3]);
                    af[dvb] = mk8(lo, hi);
                }
#pragma unroll
                for (int tb = 0; tb < 4; ++tb) {
                    const u32x2 q0 = *(const LAS u32x2*)(q8p + (16 * tb * 272 + 64 * kk)), q1 = *(const LAS u32x2*)(q8p + (16 * tb * 272 + 64 * kk + 32));
                    const bf16x8 bq = mk8(q0, q1);
#pragma unroll
                    for (int dvb = 0; dvb < 2; ++dvb) num[dvb][tb] = mfma16(af[dvb], bq, num[dvb][tb]);
                }
                __builtin_amdgcn_sched_barrier(0);
            }
#pragma unroll
            for (int tb = 0; tb < 4; ++tb) { const float wi = F[F_SWI + lc * 64 + 16 * tb + r];
#pragma unroll
                for (int dvb = 0; dvb < 2; ++dvb) num[dvb][tb] *= wi; }
            {
                const int t = tid >> 3, part = tid & 7;
                const u32x4 q0 = *(const LAS u32x4*)(lds + L_QI + t * 272 + 32 * part), q1 = *(const LAS u32x4*)(lds + L_QI + t * 272 + 32 * part + 16);
                float s = 0.f;
#pragma unroll
                for (int i = 0; i < 4; ++i) {
                    s += bf_lo(q0[i]) * F[F_N + 16 * part + 2 * i] + bf_hi(q0[i]) * F[F_N + 16 * part + 2 * i + 1];
                    s += bf_lo(q1[i]) * F[F_N + 16 * part + 8 + 2 * i] + bf_hi(q1[i]) * F[F_N + 16 * part + 8 + 2 * i + 1];
                }
                s += __shfl_xor(s, 1); s += __shfl_xor(s, 2); s += __shfl_xor(s, 4);
                if (part == 0) F[F_QN + t] = s;
            }
            __builtin_amdgcn_sched_barrier(0);
            __syncthreads();
            const LAS unsigned char* vpC = lds + (L_VT + (32 * w + r) * 144 + 16 * g);
            const LAS unsigned char* ppC = lds + (L_PI + r * 144 + 16 * g);
#pragma unroll
            for (int ks = 0; ks < 2; ++ks) {
                bf16x8 vf[2];
#pragma unroll
                for (int dvb = 0; dvb < 2; ++dvb) vf[dvb] = *(const LAS bf16x8*)(vpC + (16 * dvb * 144 + 64 * ks));
#pragma unroll
                for (int tb = 0; tb < 4; ++tb) {
                    if (ks == 0 || tb >= 2) {
                        const bf16x8 pb = *(const LAS bf16x8*)(ppC + (16 * tb * 144 + 64 * ks));
#pragma unroll
                        for (int dvb = 0; dvb < 2; ++dvb) num[dvb][tb] = mfma16(vf[dvb], pb, num[dvb][tb]);
                    }
                }
                __builtin_amdgcn_sched_barrier(0);
            }
#pragma unroll
            for (int tb = 0; tb < 4; ++tb) {
                const int t = 16 * tb + r;
                const float den = F[F_SWI + lc * 64 + t] * F[F_QN + t] + F[F_RS + t] + F[F_RS + 64 + t];
                const float inv = 1.0f / fmaxf(fabsf(den), F[F_SEM + lc * 64 + t]);
                float s1 = 0.f, s2 = 0.f;
#pragma unroll
                for (int dvb = 0; dvb < 2; ++dvb) { num[dvb][tb] *= inv;
#pragma unroll
                    for (int j = 0; j < 4; ++j) { const float v = num[dvb][tb][j]; s1 += v; s2 += v * v; } }
                s1 += __shfl_xor(s1, 16); s1 += __shfl_xor(s1, 32); s2 += __shfl_xor(s2, 16); s2 += __shfl_xor(s2, 32);
                if (g == 0) { F[F_HS + (w * 64 + t) * 2] = s1; F[F_HS + (w * 64 + t) * 2 + 1] = s2; }
                __builtin_amdgcn_sched_barrier(0);
            }
            mlstm_update(lds, C, lc, w, r, g);
            __builtin_amdgcn_sched_barrier(0);
            __syncthreads();
#pragma unroll
            for (int tb = 0; tb < 4; ++tb) {
                const int t = 16 * tb + r;
                float s1 = 0.f, s2 = 0.f;
#pragma unroll
                for (int ww = 0; ww < 8; ++ww) { s1 += F[F_HS + (ww * 64 + t) * 2]; s2 += F[F_HS + (ww * 64 + t) * 2 + 1]; }
                const float mean = s1 * (1.0f / 256.0f), var = fmaxf(s2 * (1.0f / 256.0f) - mean * mean, 0.f), rstd = rsqrtf(var + LN_EPS);
                const size_t tok = (size_t)b * SEQ + c * 64 + t;
#pragma unroll
                for (int dvb = 0; dvb < 2; ++dvb) {
                    const int dv0 = 32 * w + 16 * dvb + 4 * g;
                    const f32x4 gn = *(const f32x4*)(P.mh_g + h * 256 + dv0);
                    const u32x2 og = *(const u32x2*)(OA + tok * DM + h * 256 + dv0);
                    const float y0 = (num[dvb][tb][0] - mean) * rstd * gn[0] * bf_lo(og.x), y1 = (num[dvb][tb][1] - mean) * rstd * gn[1] * bf_hi(og.x);
                    const float y2 = (num[dvb][tb][2] - mean) * rstd * gn[2] * bf_lo(og.y), y3 = (num[dvb][tb][3] - mean) * rstd * gn[3] * bf_hi(og.y);
                    u32x2 wv; wv.x = cvt_pk_bf16(y0, y1); wv.y = cvt_pk_bf16(y2, y3);
                    *(u32x2*)(VA + tok * DM + h * 256 + dv0) = wv;
                }
            }
        }
        __syncthreads();
    }
}

constexpr int A_KI = 0, A_VT = 17408, A_FL = 35840;
constexpr float SB_DONE_LOG2 = -40.0f;

__device__ void attn_phase(const Params& P, LAS unsigned char* lds) {
    const int tid = threadIdx.x, w = tid >> 6, lane = tid & 63, r = lane & 15, g = lane >> 4;
    bf16_t* QB = (bf16_t*)(P.ws + WS_QB);
    const bf16_t* KB = (const bf16_t*)(P.ws + WS_KB);
    const bf16_t* VB = (const bf16_t*)(P.ws + WS_VB);
    unsigned* cnt = (unsigned*)(P.ws + MISC_CNT);
    LAS int* FL = (LAS int*)(lds + A_FL);
    for (;;) {
        if (tid == 0) FL[32] = (int)atomicAdd(cnt, 1u);
        __syncthreads();
        const int item = FL[32];
        __syncthreads();
        if (item >= 4096) break;
        const int qb = 63 - (item >> 6), b = (item >> 3) & 7, h = item & 7;
        const int q0w = qb * 128 + 16 * w;
        const size_t qtok = (size_t)b * SEQ + q0w + r;
        bf16x8 qf[4];
#pragma unroll
        for (int kd = 0; kd < 4; ++kd) qf[kd] = *(const bf16x8*)(QB + qtok * DM + h * 128 + 32 * kd + 8 * g);
        f32x4 O[8];
#pragma unroll
        for (int i = 0; i < 8; ++i) O[i] = (f32x4){0.f, 0.f, 0.f, 0.f};
        float R = 0.f;
        int wdone = 0, it = 0;
        for (int kt = 2 * qb + 1; kt >= 0; --kt, ++it) {
            if (tid < 256) {
                const int tg = tid & 15, cg = tid >> 4;
                u32x4 vr[4];
#pragma unroll
                for (int tt = 0; tt < 4; ++tt) vr[tt] = *(const u32x4*)(VB + ((size_t)b * SEQ + kt * 64 + 4 * tg + tt) * DM + h * 128 + 8 * cg);
#pragma unroll
                for (int e = 0; e < 8; ++e) {
                    unsigned short x0, x1, x2, x3;
                    { const unsigned a0 = vr[0][e >> 1], a1 = vr[1][e >> 1], a2 = vr[2][e >> 1], a3 = vr[3][e >> 1];
                      if (e & 1) { x0 = a0 >> 16; x1 = a1 >> 16; x2 = a2 >> 16; x3 = a3 >> 16; } else { x0 = a0 & 0xffff; x1 = a1 & 0xffff; x2 = a2 & 0xffff; x3 = a3 & 0xffff; } }
                    u32x2 wv; wv.x = (unsigned)x0 | ((unsigned)x1 << 16); wv.y = (unsigned)x2 | ((unsigned)x3 << 16);
                    *(LAS u32x2*)(lds + A_VT + (8 * cg + e) * 144 + 8 * tg) = wv;
                }
            } else {
                const int t2 = tid - 256, row = t2 >> 2, ch = t2 & 3;
                const bf16_t* src = KB + ((size_t)b * SEQ + kt * 64 + row) * DM + h * 128 + 32 * ch;
#pragma unroll
                for (int i = 0; i < 4; ++i) *(LAS u32x4*)(lds + A_KI + row * 272 + 64 * ch + 16 * i) = *(const u32x4*)(src + 8 * i);
            }
            __syncthreads();
            const int key0 = kt * 64;
            if (!wdone && key0 <= q0w + 14) {
                const int qpos = q0w + r;
                float wgt[4][4];
                float Rrun = R;
#pragma unroll
                for (int sb = 3; sb >= 0; --sb) {
                    f32x4 acc = (f32x4){0.f, 0.f, 0.f, 0.f};
#pragma unroll
                    for (int kd = 0; kd < 4; ++kd) { const bf16x8 kf = *(const LAS bf16x8*)(lds + A_KI + (16 * sb + r) * 272 + 64 * kd + 16 * g); acc = mfma16(kf, qf[kd], acc); }
                    float lk[4], z[4];
#pragma unroll
                    for (int j = 0; j < 4; ++j) {
                        const int key = key0 + 16 * sb + 4 * g + j;
                        z[j] = fminf(acc[j], 80.0f);
                        lk[j] = (key < qpos) ? -fast_log2(1.0f + fast_exp2(z[j])) : 0.f;
                    }
                    const float s3 = lk[3], s2 = s3 + lk[2], s1 = s2 + lk[1], s0 = s1 + lk[0];
                    const float t1 = __shfl_xor(s0, 16), t2 = __shfl_xor(s0, 32), t3 = __shfl_xor(t1, 32);
                    const float above = g == 0 ? (t1 + t2 + t3) : (g == 1 ? (t2 + t3) : (g == 2 ? t1 : 0.f));
                    const float base = Rrun + above;
                    const float sj[4] = {s0, s1, s2, s3};
#pragma unroll
                    for (int j = 0; j < 4; ++j) { const int key = key0 + 16 * sb + 4 * g + j; wgt[sb][j] = (key < qpos) ? fast_exp2(z[j] + base + sj[j]) : 0.f; }
                    Rrun += (s0 + t1) + (t2 + t3);
                }
                R = Rrun;
#pragma unroll
                for (int ks = 0; ks < 2; ++ks) {
                    u32x2 lo, hi; lo.x = cvt_pk_bf16(wgt[2 * ks][0], wgt[2 * ks][1]); lo.y = cvt_pk_bf16(wgt[2 * ks][2], wgt[2 * ks][3]);
                    hi.x = cvt_pk_bf16(wgt[2 * ks + 1][0], wgt[2 * ks + 1][1]); hi.y = cvt_pk_bf16(wgt[2 * ks + 1][2], wgt[2 * ks + 1][3]);
                    const bf16x8 pf = mk8(lo, hi);
#pragma unroll
                    for (int db = 0; db < 8; ++db) {
                        const u32x2 v0 = *(const LAS u32x2*)(lds + A_VT + (16 * db + r) * 144 + 64 * ks + 8 * g), v1 = *(const LAS u32x2*)(lds + A_VT + (16 * db + r) * 144 + 64 * ks + 32 + 8 * g);
                        O[db] = mfma16(mk8(v0, v1), pf, O[db]);
                    }
                }
                wdone = __all(R < SB_DONE_LOG2) ? 1 : 0;
            }
            if (lane == 0) FL[(it & 1) * 8 + w] = wdone;
            __syncthreads();
            int alld = 1;
#pragma unroll
            for (int i = 0; i < 8; ++i) alld &= FL[(it & 1) * 8 + i];
            if (alld) break;
        }
#pragma unroll
        for (int db = 0; db < 8; ++db) { u32x2 wv; wv.x = cvt_pk_bf16(O[db][0], O[db][1]); wv.y = cvt_pk_bf16(O[db][2], O[db][3]);
            *(u32x2*)(QB + qtok * DM + h * 128 + 16 * db + 4 * g) = wv; }
        __syncthreads();
    }
}


#ifdef DIAG
__device__ void diag_count_f32(const float* p, size_t n, float thr, unsigned* ctr) {
    unsigned c = 0;
    for (size_t i = (size_t)blockIdx.x * NTHREADS + threadIdx.x; i < n; i += (size_t)gridDim.x * NTHREADS) { const float v = p[i]; if (!(fabsf(v) <= thr)) ++c; }
    if (c) atomicAdd(ctr, c);
}
__device__ void diag_count_bf16(const bf16_t* p, size_t n, float thr, unsigned* ctr) {
    unsigned c = 0;
    for (size_t i = (size_t)blockIdx.x * NTHREADS + threadIdx.x; i < n; i += (size_t)gridDim.x * NTHREADS) { const float v = __uint_as_float((unsigned)p[i] << 16); if (!(fabsf(v) <= thr)) ++c; }
    if (c) atomicAdd(ctr, c);
}
#endif
constexpr int LDS_BYTES = 135168;
static_assert(MIX_LDS <= LDS_BYTES && 128 * 129 * 4 <= LDS_BYTES && pg8::STAGE_BYTES <= LDS_BYTES, "LDS budget");
constexpr int NPHASE = 17;

template <class Epi>
__device__ __forceinline__ void run_gemm(LAS unsigned char* lds, const bf16_t* A, const bf16_t* Bt, int N, int K, const Epi& E) {
    pg8::Gemm g{A, Bt, MTOK, N, K};
    pg8::StaticOrder S; S.init(MTOK, N, gridDim.x, blockIdx.x);
    pg8::gemm_phase<Epi, pg8::StaticOrder>(lds, g, S, E);
}

__global__ void __launch_bounds__(NTHREADS, 2) fwd_megakernel(Params P) {
    extern __shared__ __attribute__((aligned(16))) unsigned char smem[];
    LAS unsigned char* lds = (LAS unsigned char*)smem;
    cg::grid_group grid = cg::this_grid();
    unsigned char* ws = P.ws;
    bf16_t* X = (bf16_t*)(ws + WS_X);
    bf16_t* H = (bf16_t*)(ws + WS_H);
    float* Y = P.out;
    bf16_t* gates = (bf16_t*)P.out;
#ifdef ONLYMASK
#define PHASE(k) if (((ONLYMASK >> (k)) & 1) && P.ph_lo <= (k) && (k) < P.ph_hi)
#else
#define PHASE(k) if (P.ph_lo <= (k) && (k) < P.ph_hi)
#endif
#define SYNC() do { if (P.coop) { __builtin_amdgcn_fence(__ATOMIC_RELEASE, "agent"); asm volatile("s_waitcnt vmcnt(0) lgkmcnt(0)" ::: "memory"); grid.sync(); \
        __builtin_amdgcn_fence(__ATOMIC_ACQUIRE, "agent"); asm volatile("s_waitcnt vmcnt(0) lgkmcnt(0)" ::: "memory"); } } while (0)
    PHASE(0) prep_phase(P, lds);
    SYNC();
    PHASE(1) run_gemm(lds, X, (const bf16_t*)(ws + W_GU1), 5632, 1024, EpiSwiglu{H});
    SYNC();
    PHASE(2) run_gemm(lds, H, (const bf16_t*)(ws + W_D1), 1024, FH, EpiResid<false, false>{P.x, nullptr, Y, 0.5f});
    SYNC();
    PHASE(3) ln_phase<true>(Y, P.ln_g, P.ln_b, X);
    SYNC();
    PHASE(4) run_gemm(lds, X, (const bf16_t*)(ws + W_IN), NIN_PAD, 1024, EpiWin{(bf16_t*)(ws + WS_QK), gates, (float*)(ws + MISC_IF), (const float*)(ws + W_BIAS)});
    SYNC();
    PHASE(5) mlstm_phase1(P, lds);
    SYNC();
    PHASE(6) {
#ifndef NO_ML2
        mlstm_phase2(P, lds);
#endif
#ifndef NO_ATT
        attn_phase(P, lds);
#endif
    }
    SYNC();
    PHASE(7) {
        run_gemm(lds, (const bf16_t*)(ws + WS_VA), (const bf16_t*)(ws + W_A), 1024, 1024, EpiGateMul<false>{gates, 0, nullptr, (bf16_t*)(ws + WS_T)});
        run_gemm(lds, (const bf16_t*)(ws + WS_QB), (const bf16_t*)(ws + W_B), 1024, 1024, EpiGateMul<true>{gates, DM, (const bf16_t*)(ws + WS_T), (bf16_t*)(ws + WS_MG)});
    }
    SYNC();
    PHASE(8) run_gemm(lds, (const bf16_t*)(ws + WS_MG), (const bf16_t*)(ws + W_O), 1024, 1024, EpiResid<true, false>{X, nullptr, Y, 1.0f});
    SYNC();
    PHASE(9) ln_phase<true>(Y, P.ln_g + DM, P.ln_b + DM, X);
    SYNC();
    PHASE(10) run_gemm(lds, X, (const bf16_t*)(ws + W_GU2), 5632, 1024, EpiSwiglu{H});
    SYNC();
    PHASE(11) run_gemm(lds, H, (const bf16_t*)(ws + W_D2), 1024, FH, EpiResid<true, false>{X, nullptr, Y, 0.5f});
    SYNC();
    PHASE(12) { ln_phase<true>(Y, P.ln_g + 2 * DM, P.ln_b + 2 * DM, X); cvt_bf16_phase(P.p, (bf16_t*)(ws + WS_PB), (size_t)MTOK * 256 / 8); }
    SYNC();
    PHASE(13) {
        run_gemm(lds, X, (const bf16_t*)(ws + W_PG), 1024, 1024, EpiSigBias{P.b_pg, (bf16_t*)(ws + WS_PG)});
        run_gemm(lds, (const bf16_t*)(ws + WS_PB), (const bf16_t*)(ws + W_P), 1024, 256, EpiResid<true, true>{X, (const bf16_t*)(ws + WS_PG), Y, 1.0f});
    }
    SYNC();
    PHASE(14) ln_phase<false>(Y, P.ln_g + 3 * DM, P.ln_b + 3 * DM, P.out);
#undef PHASE
#undef SYNC
}

extern "C" void kernel_launch(void* const* d_in, const int* in_sizes, int n_in, void* d_out, int out_size, void* d_ws, size_t ws_size, hipStream_t stream) {
    static int grid_blocks = 0;
    if (grid_blocks == 0) {
        if (n_in != 19 || out_size != MTOK * DM || ws_size < WS_END) { fprintf(stderr, "kernel_launch: unexpected shapes (n_in %d, out %d, ws %zu, need %zu)\n", n_in, out_size, ws_size, (size_t)WS_END); grid_blocks = -1; return; }
        int dev = 0, cus = 0, per_cu = 0;
        hipGetDevice(&dev);
        hipDeviceGetAttribute(&cus, hipDeviceAttributeMultiprocessorCount, dev);
        if (hipFuncSetAttribute((const void*)fwd_megakernel, hipFuncAttributeMaxDynamicSharedMemorySize, LDS_BYTES) != hipSuccess) { fprintf(stderr, "kernel_launch: hipFuncSetAttribute failed\n"); grid_blocks = -1; return; }
        if (hipOccupancyMaxActiveBlocksPerMultiprocessor(&per_cu, (const void*)fwd_megakernel, NTHREADS, LDS_BYTES) != hipSuccess || per_cu < 1) { fprintf(stderr, "kernel_launch: occupancy query failed (%d)\n", per_cu); per_cu = 1; (void)hipGetLastError(); }
        grid_blocks = cus * per_cu;
    }
    if (grid_blocks < 0) return;
    Params p{};
    p.x = (const float*)d_in[0]; p.p = (const float*)d_in[1]; p.ln_g = (const float*)d_in[2]; p.ln_b = (const float*)d_in[3];
    p.wg = (const float*)d_in[4]; p.wu = (const float*)d_in[5]; p.wd = (const float*)d_in[6]; p.w_in = (const float*)d_in[7]; p.b_in = (const float*)d_in[8];
    p.b_forget = (const float*)d_in[9]; p.conv_w = (const float*)d_in[10]; p.conv_b = (const float*)d_in[11]; p.mh_g = (const float*)d_in[12];
    p.w_a = (const float*)d_in[13]; p.w_b = (const float*)d_in[14]; p.w_o = (const float*)d_in[15]; p.w_ple = (const float*)d_in[16]; p.w_pg = (const float*)d_in[17]; p.b_pg = (const float*)d_in[18];
    p.out = (float*)d_out; p.ws = (unsigned char*)d_ws; p.pad = 0;
#if ONE_LAUNCH
    p.ph_lo = 0; p.ph_hi = NPHASE; p.coop = 1;
    void* args[] = {&p};
    hipError_t e = hipLaunchCooperativeKernel((const void*)fwd_megakernel, dim3(grid_blocks), dim3(NTHREADS), args, LDS_BYTES, stream);
    if (e != hipSuccess) fprintf(stderr, "cooperative launch failed: %s (grid %d)\n", hipGetErrorString(e), grid_blocks);
#else
    p.coop = 0;
    for (int ph = 0; ph < 15; ++ph) { p.ph_lo = ph; p.ph_hi = ph + 1; hipLaunchKernelGGL(fwd_megakernel, dim3(grid_blocks), dim3(NTHREADS), LDS_BYTES, stream, p); }
#endif
}
```

```cpp
#include <hip/hip_runtime.h>
#include <hip/hip_cooperative_groups.h>
#include <cstdio>
namespace cg = cooperative_groups;

#ifndef ONE_LAUNCH
#define ONE_LAUNCH 1
#endif

#define LAS __attribute__((address_space(3)))
typedef unsigned short bf16_t;
typedef short bf16x8 __attribute__((ext_vector_type(8)));
typedef float f32x4 __attribute__((ext_vector_type(4)));
typedef float f32x2 __attribute__((ext_vector_type(2)));
typedef unsigned u32x4 __attribute__((ext_vector_type(4)));
typedef unsigned u32x2 __attribute__((ext_vector_type(2)));

constexpr int MTOK = 65536, DM = 1024, FH = 2816, SEQ = 8192;
constexpr int NIN_PAD = 8448;
constexpr float ALPHA = 1.189207115002721f;
constexpr float LN_EPS = 1e-5f;
constexpr float LOG2E = 1.4426950408889634f;
constexpr int NTHREADS = 512;

constexpr size_t QB_ = 33554432ull;
constexpr size_t WS_W = 0;
constexpr size_t W_GU1 = 0;
constexpr size_t W_D1 = W_GU1 + 5632ull * 1024 * 2;
constexpr size_t W_GU2 = W_D1 + 1024ull * 2816 * 2;
constexpr size_t W_D2 = W_GU2 + 5632ull * 1024 * 2;
constexpr size_t W_IN = W_D2 + 1024ull * 2816 * 2;
constexpr size_t W_A = W_IN + 8448ull * 1024 * 2;
constexpr size_t W_B = W_A + 1024ull * 1024 * 2;
constexpr size_t W_O = W_B + 1024ull * 1024 * 2;
constexpr size_t W_PG = W_O + 1024ull * 1024 * 2;
constexpr size_t W_P = W_PG + 1024ull * 1024 * 2;
constexpr size_t W_BIAS = W_P + 1024ull * 256 * 2;
static_assert(W_BIAS + 8448 * 4 <= 2 * QB_, "weights overflow");
constexpr size_t WS_PB = 2 * QB_;
constexpr size_t WS_MISC = 3 * QB_;
constexpr size_t MISC_IF = WS_MISC;
constexpr size_t MISC_CNT = WS_MISC + 2097152ull;
constexpr size_t WS_X = 4 * QB_;
constexpr size_t WS_H = 8 * QB_;
constexpr size_t WS_QK = 8 * QB_, WS_VA = 12 * QB_, WS_OA = 16 * QB_, WS_QB = 20 * QB_, WS_KB = 24 * QB_, WS_VB = 28 * QB_;
constexpr size_t WS_T = WS_QK, WS_MG = WS_KB, WS_PG = 8 * QB_;
constexpr size_t WS_END = 32 * QB_;
constexpr int STATE_FLOATS = 32768 + 128;

typedef __bf16 bf16x2_t __attribute__((ext_vector_type(2)));
__device__ __forceinline__ unsigned cvt_pk_bf16(float lo, float hi) { f32x2 v = {lo, hi}; bf16x2_t r = __builtin_convertvector(v, bf16x2_t); return __builtin_bit_cast(unsigned, r); }
__device__ __forceinline__ float bf_lo(unsigned u) { return __uint_as_float(u << 16); }
__device__ __forceinline__ float bf_hi(unsigned u) { return __uint_as_float(u & 0xffff0000u); }
__device__ __forceinline__ float fast_exp2(float x) { return __builtin_amdgcn_exp2f(x); }
__device__ __forceinline__ float fast_log2(float x) { return __builtin_amdgcn_logf(x); }
__device__ __forceinline__ float fast_rcp(float x) { return __builtin_amdgcn_rcpf(x); }
__device__ __forceinline__ float sigmoid_f(float x) { return fast_rcp(1.0f + fast_exp2(-x * LOG2E)); }
__device__ __forceinline__ f32x4 mfma16(bf16x8 a, bf16x8 b, f32x4 c) { return __builtin_amdgcn_mfma_f32_16x16x32_bf16(a, b, c, 0, 0, 0); }
__device__ __forceinline__ bf16x8 mk8(u32x2 lo, u32x2 hi) { u32x4 v; v.x = lo.x; v.y = lo.y; v.z = hi.x; v.w = hi.y; return __builtin_bit_cast(bf16x8, v); }
__device__ __forceinline__ float wave_sum(float v) {
#pragma unroll
    for (int o = 32; o > 0; o >>= 1) v += __shfl_xor(v, o);
    return v;
}
__device__ __forceinline__ float wave_max(float v) {
#pragma unroll
    for (int o = 32; o > 0; o >>= 1) v = fmaxf(v, __shfl_xor(v, o));
    return v;
}
__device__ __forceinline__ float wave_incl_sum(float v, int lane) {
#pragma unroll
    for (int o = 1; o < 64; o <<= 1) { float t = __shfl_up(v, o); if (lane >= o) v += t; }
    return v;
}
__device__ __forceinline__ float wave_incl_max(float v, int lane) {
#pragma unroll
    for (int o = 1; o < 64; o <<= 1) { float t = __shfl_up(v, o); if (lane >= o) v = fmaxf(v, t); }
    return v;
}

namespace pg8 {
constexpr int BM = 256, BK = 64, HALF = 128, HTB = HALF * BK * 2, STAGE_BYTES = 8 * HTB, NXCD = 8, WGM = 8;
__host__ __device__ __forceinline__ int lds_byte(int r, int c) { const int st = (r >> 4) * 2 + (c >> 5), rr = r & 15, cc = c & 31, ob = rr * 64 + cc * 2; return st * 1024 + (ob ^ (((ob >> 9) & 1) << 5)); }
__host__ __device__ __forceinline__ void stage_rc(int b, int& R, int& C) { const int st = b / 1024, sb = b % 1024, swz = sb ^ (((sb >> 9) & 1) << 5); R = (st >> 1) * 16 + swz / 64; C = (st & 1) * 32 + (swz % 64) / 2; }
__host__ __device__ __forceinline__ int perm32(int rho) { const int n = rho >> 4, i = rho & 15; return 8 * (i >> 2) + 4 * n + (i & 3); }
struct Unit { int pm, pn; };
struct Gemm { const bf16_t* A; const bf16_t* Bt; int M, N, K; };
struct StaticOrder {
    int nM, nN, nwg, G, c;
    __device__ void init(int M, int N, int G_, int c_) { nM = M / BM; nN = N / BM; nwg = nM * nN; G = G_; c = c_; }
    __device__ bool next(int i, Unit& u) const {
        const long L = (long)i * G + c; if (L >= nwg) return false;
        int wgid = (int)L; { const int q = nwg / NXCD, r = nwg % NXCD, xcd = wgid % NXCD, off = wgid / NXCD; wgid = (xcd < r ? xcd * (q + 1) : r * (q + 1) + (xcd - r) * q) + off; }
        const int nig = WGM * nN, gid = wgid / nig, fm = gid * WGM, gsz = (nM - fm) < WGM ? (nM - fm) : WGM;
        u.pm = fm + ((wgid % nig) % gsz); u.pn = (wgid % nig) / gsz; return true;
    }
};
template <class Epi, class Sched>
__device__ __forceinline__ void gemm_phase(LAS unsigned char* lds, const Gemm g, const Sched& S, const Epi& E) {
    const int tid = threadIdx.x, wid = __builtin_amdgcn_readfirstlane(tid >> 6), lane = tid & 63, wr = wid >> 2, wc = wid & 3, fr = lane & 15, fq = lane >> 4;
    const int K = g.K, nt = K / BK;
    unsigned voffA[2], voffB[2];
#pragma unroll
    for (int i = 0; i < 2; ++i) { int R, C; stage_rc(tid * 16 + i * 8192, R, C); const int Rb = ((R & ~31) + perm32(R & 31));
        voffA[i] = (unsigned)(R * K + C) * 2u; voffB[i] = (unsigned)(Rb * K + C) * 2u; }
    const size_t kstep = (size_t)(BK * 2);
    const size_t hstep = (size_t)HALF * K * 2;
    const size_t tstep = 2 * hstep;
    const unsigned ldsw = (unsigned)wid * 1024u;
    const int aoff = lds_byte(wr * 64 + fr, fq * 8), boff = lds_byte(wc * 32 + fr, fq * 8);
#define PG8_SA(b, h) (((b) * 2 + (h)) * HTB)
#define PG8_SB(b, h) ((4 + (b) * 2 + (h)) * HTB)
#define PG8_STAGE(bufoff, gbase, voff) do { _Pragma("unroll") for (int _i = 0; _i < 2; ++_i) \
        __builtin_amdgcn_global_load_lds((const unsigned*)((const char*)(gbase) + (voff)[_i]), (LAS unsigned*)(lds + (bufoff) + ldsw + _i * 8192), 16, 0, 0); } while (0)
#define PG8_LDA(dst, b, h) do { _Pragma("unroll") for (int m = 0; m < 4; ++m) _Pragma("unroll") for (int k = 0; k < 2; ++k) dst[m][k] = *(const LAS bf16x8*)(lds + PG8_SA(b, h) + aoff + m * 2048 + k * 1024); } while (0)
#define PG8_LDB(dst, b, h) do { _Pragma("unroll") for (int n = 0; n < 2; ++n) _Pragma("unroll") for (int k = 0; k < 2; ++k) dst[n][k] = *(const LAS bf16x8*)(lds + PG8_SB(b, h) + boff + n * 2048 + k * 1024); } while (0)
#define PG8_MMA(ai, bj, At, Bt) do { __builtin_amdgcn_s_setprio(1); _Pragma("unroll") for (int m = 0; m < 4; ++m) _Pragma("unroll") for (int n = 0; n < 2; ++n) _Pragma("unroll") for (int k = 0; k < 2; ++k) \
        acc[ai][bj][m][n] = __builtin_amdgcn_mfma_f32_16x16x32_bf16(Bt[n][k], At[m][k], acc[ai][bj][m][n], 0, 0, 0); __builtin_amdgcn_s_setprio(0); } while (0)
#define PG8_WAIT_V(n) asm volatile("s_waitcnt vmcnt(" #n ")" ::: "memory")
#define PG8_WAIT_L(n) asm volatile("s_waitcnt lgkmcnt(" #n ")" ::: "memory")
#define PG8_BAR __builtin_amdgcn_s_barrier()
#define PG8_SCHED __builtin_amdgcn_sched_barrier(0)
    Unit cur, nxt; int ui = 0;
    if (!S.next(0, cur)) return;
    f32x4 acc[2][2][4][2];
#pragma unroll
    for (int a = 0; a < 2; ++a)
#pragma unroll
        for (int b = 0; b < 2; ++b)
#pragma unroll
            for (int m = 0; m < 4; ++m)
#pragma unroll
                for (int n = 0; n < 2; ++n) acc[a][b][m][n] = (f32x4){0.f, 0.f, 0.f, 0.f};
    bf16x8 At[4][2], B0[2][2], B1[2][2];
    const char* cA = (const char*)g.A + (size_t)cur.pm * tstep; const char* cB = (const char*)g.Bt + (size_t)cur.pn * tstep;
    PG8_STAGE(PG8_SB(0, 0), cB, voffB); PG8_STAGE(PG8_SA(0, 0), cA, voffA); PG8_STAGE(PG8_SB(0, 1), cB + hstep, voffB); PG8_STAGE(PG8_SA(0, 1), cA + hstep, voffA);
    if (wr == 1) PG8_BAR;
    PG8_WAIT_V(4); PG8_BAR;
    PG8_STAGE(PG8_SB(1, 0), cB + kstep, voffB); PG8_STAGE(PG8_SA(1, 0), cA + kstep, voffA); PG8_STAGE(PG8_SB(1, 1), cB + hstep + kstep, voffB);
    PG8_WAIT_V(6); PG8_BAR;
    for (;;) {
        const bool has_next = S.next(ui + 1, nxt);
        const char* nA = has_next ? (const char*)g.A + (size_t)nxt.pm * tstep : cA; const char* nB = has_next ? (const char*)g.Bt + (size_t)nxt.pn * tstep : cB;
        for (int t = 0; t < nt; t += 2) {
            const bool last = (t == nt - 2);
            const char* a1 = cA + (size_t)(t + 1) * kstep;
            const char* a2 = last ? nA : cA + (size_t)(t + 2) * kstep; const char* b2 = last ? nB : cB + (size_t)(t + 2) * kstep;
            const char* a3 = a2 + kstep; const char* b3 = b2 + kstep;
            PG8_LDB(B0, 0, 0); PG8_SCHED; PG8_LDA(At, 0, 0); PG8_STAGE(PG8_SA(1, 1), a1 + hstep, voffA);
            PG8_WAIT_L(8); PG8_BAR; PG8_WAIT_L(0); PG8_MMA(0, 0, At, B0); PG8_BAR; PG8_SCHED;
            PG8_LDB(B1, 0, 1); PG8_STAGE(PG8_SB(0, 0), b2, voffB);
            PG8_BAR; PG8_WAIT_L(0); PG8_MMA(0, 1, At, B1); PG8_BAR;
            PG8_LDA(At, 0, 1); PG8_STAGE(PG8_SA(0, 0), a2, voffA);
            PG8_BAR; PG8_WAIT_L(0); PG8_MMA(1, 0, At, B0); PG8_BAR; PG8_SCHED;
            PG8_STAGE(PG8_SB(0, 1), b2 + hstep, voffB);
            PG8_WAIT_V(6); PG8_BAR; PG8_MMA(1, 1, At, B1); PG8_BAR;
            PG8_LDB(B0, 1, 0); PG8_SCHED; PG8_LDA(At, 1, 0); PG8_STAGE(PG8_SA(0, 1), a2 + hstep, voffA);
            PG8_WAIT_L(8); PG8_BAR; PG8_WAIT_L(0); PG8_MMA(0, 0, At, B0); PG8_BAR; PG8_SCHED;
            PG8_LDB(B1, 1, 1); PG8_STAGE(PG8_SB(1, 0), b3, voffB);
            PG8_BAR; PG8_WAIT_L(0); PG8_MMA(0, 1, At, B1); PG8_BAR;
            PG8_LDA(At, 1, 1); PG8_STAGE(PG8_SA(1, 0), a3, voffA);
            PG8_BAR; PG8_WAIT_L(0); PG8_MMA(1, 0, At, B0); PG8_BAR; PG8_SCHED;
            PG8_STAGE(PG8_SB(1, 1), b3 + hstep, voffB);
            PG8_WAIT_V(6); PG8_BAR; PG8_MMA(1, 1, At, B1); PG8_BAR;
        }
        E(acc, cur, wr, wc, fr, fq);
        if (!has_next) break;
#pragma unroll
        for (int a = 0; a < 2; ++a)
#pragma unroll
            for (int b = 0; b < 2; ++b)
#pragma unroll
                for (int m = 0; m < 4; ++m)
#pragma unroll
                    for (int n = 0; n < 2; ++n) acc[a][b][m][n] = (f32x4){0.f, 0.f, 0.f, 0.f};
        cur = nxt; cA = nA; cB = nB; ++ui;
    }
    PG8_WAIT_V(0);
    if (wr == 0) PG8_BAR;
    PG8_BAR;
#undef PG8_SA
#undef PG8_SB
#undef PG8_STAGE
#undef PG8_LDA
#undef PG8_LDB
#undef PG8_MMA
#undef PG8_WAIT_V
#undef PG8_WAIT_L
#undef PG8_BAR
#undef PG8_SCHED
}
}
using pg8::Unit;

#define EPI_ROWS(ai, m) (u.pm * 256 + (ai) * 128 + wr * 64 + (m) * 16 + fr)
struct EpiSwiglu {
    bf16_t* H;
    __device__ __forceinline__ void operator()(const f32x4 (&acc)[2][2][4][2], const Unit& u, int wr, int wc, int fr, int fq) const {
        const int col = u.pn * 128 + wc * 32 + 8 * fq;
#pragma unroll
        for (int ai = 0; ai < 2; ++ai)
#pragma unroll
            for (int m = 0; m < 4; ++m) {
                const size_t row = EPI_ROWS(ai, m);
                float h[8];
#pragma unroll
                for (int n = 0; n < 2; ++n)
#pragma unroll
                    for (int j = 0; j < 4; ++j) { const float g = acc[ai][0][m][n][j], uu = acc[ai][1][m][n][j]; h[4 * n + j] = g * uu * sigmoid_f(g); }
                u32x4 w; w.x = cvt_pk_bf16(h[0], h[1]); w.y = cvt_pk_bf16(h[2], h[3]); w.z = cvt_pk_bf16(h[4], h[5]); w.w = cvt_pk_bf16(h[6], h[7]);
                *(u32x4*)(H + row * FH + col) = w;
            }
    }
};
template <bool RES_BF16, bool HAS_MUL>
struct EpiResid {
    const void* res; const bf16_t* mul; float* Y; float scale;
    __device__ __forceinline__ void operator()(const f32x4 (&acc)[2][2][4][2], const Unit& u, int wr, int wc, int fr, int fq) const {
#pragma unroll
        for (int ai = 0; ai < 2; ++ai)
#pragma unroll
            for (int m = 0; m < 4; ++m) {
                const size_t row = EPI_ROWS(ai, m);
#pragma unroll
                for (int bj = 0; bj < 2; ++bj) {
                    const size_t off = row * DM + u.pn * 256 + bj * 128 + wc * 32 + 8 * fq;
                    float r[8];
                    if (RES_BF16) { const u32x4 rv = *(const u32x4*)((const bf16_t*)res + off);
                        r[0] = bf_lo(rv.x); r[1] = bf_hi(rv.x); r[2] = bf_lo(rv.y); r[3] = bf_hi(rv.y); r[4] = bf_lo(rv.z); r[5] = bf_hi(rv.z); r[6] = bf_lo(rv.w); r[7] = bf_hi(rv.w); }
                    else { const f32x4 a = *(const f32x4*)((const float*)res + off), b = *(const f32x4*)((const float*)res + off + 4);
                        r[0] = a[0]; r[1] = a[1]; r[2] = a[2]; r[3] = a[3]; r[4] = b[0]; r[5] = b[1]; r[6] = b[2]; r[7] = b[3]; }
                    float mv[8];
                    if (HAS_MUL) { const u32x4 rv = *(const u32x4*)(mul + off);
                        mv[0] = bf_lo(rv.x); mv[1] = bf_hi(rv.x); mv[2] = bf_lo(rv.y); mv[3] = bf_hi(rv.y); mv[4] = bf_lo(rv.z); mv[5] = bf_hi(rv.z); mv[6] = bf_lo(rv.w); mv[7] = bf_hi(rv.w); }
                    f32x4 o0, o1;
#pragma unroll
                    for (int j = 0; j < 4; ++j) {
                        const float a0 = acc[ai][bj][m][0][j] * scale, a1 = acc[ai][bj][m][1][j] * scale;
                        o0[j] = ALPHA * r[j] + (HAS_MUL ? mv[j] * a0 : a0); o1[j] = ALPHA * r[4 + j] + (HAS_MUL ? mv[4 + j] * a1 : a1); }
                    *(f32x4*)(Y + off) = o0; *(f32x4*)(Y + off + 4) = o1;
                }
            }
    }
};
struct EpiWin {
    bf16_t* proj; bf16_t* gates; float* ifg; const float* bias;
    __device__ __forceinline__ void operator()(const f32x4 (&acc)[2][2][4][2], const Unit& u, int wr, int wc, int fr, int fq) const {
        const int pn = u.pn;
        if (pn == 32) {
            if (wc == 0 && fq == 0) {
                const f32x4 bi = *(const f32x4*)(bias + 8192), bf = *(const f32x4*)(bias + 8196);
#pragma unroll
                for (int ai = 0; ai < 2; ++ai)
#pragma unroll
                    for (int m = 0; m < 4; ++m) {
                        const size_t row = EPI_ROWS(ai, m);
                        f32x4 iv = acc[ai][0][m][0] + bi, fv = acc[ai][0][m][1] + bf, lf;
#pragma unroll
                        for (int j = 0; j < 4; ++j) { const float xx = fv[j]; lf[j] = xx >= 0.f ? -log1pf(expf(-xx)) : xx - log1pf(expf(xx)); }
                        *(f32x4*)(ifg + row * 8) = iv; *(f32x4*)(ifg + row * 8 + 4) = lf;
                    }
            }
            return;
        }
        bf16_t* dst; int ld, c0; int act = 0; float sc = 1.0f;
        if (pn < 24) { const int sec = pn >> 2; dst = proj + (size_t)sec * ((size_t)MTOK * DM); ld = DM; c0 = (pn & 3) * 256; if (sec == 2) act = 1; if (sec == 3) sc = 0.08838834764831845f * LOG2E; }
        else { dst = gates; ld = 2 * DM; c0 = (pn - 24) * 256; act = 1; }
#pragma unroll
        for (int bj = 0; bj < 2; ++bj) {
            const int cl = bj * 128 + wc * 32 + 8 * fq;
            const f32x4 b0 = *(const f32x4*)(bias + pn * 256 + cl), b1 = *(const f32x4*)(bias + pn * 256 + cl + 4);
#pragma unroll
            for (int ai = 0; ai < 2; ++ai)
#pragma unroll
                for (int m = 0; m < 4; ++m) {
                    const size_t row = EPI_ROWS(ai, m);
                    f32x4 v0 = acc[ai][bj][m][0] + b0, v1 = acc[ai][bj][m][1] + b1;
                    if (act) {
#pragma unroll
                        for (int j = 0; j < 4; ++j) { v0[j] = sigmoid_f(v0[j]); v1[j] = sigmoid_f(v1[j]); } }
                    else { v0 *= sc; v1 *= sc; }
                    u32x4 w; w.x = cvt_pk_bf16(v0[0], v0[1]); w.y = cvt_pk_bf16(v0[2], v0[3]); w.z = cvt_pk_bf16(v1[0], v1[1]); w.w = cvt_pk_bf16(v1[2], v1[3]);
                    *(u32x4*)(dst + row * ld + c0 + cl) = w;
                }
        }
    }
};
template <bool ADD>
struct EpiGateMul {
    const bf16_t* gate; int goff; const bf16_t* tin; bf16_t* out;
    __device__ __forceinline__ void operator()(const f32x4 (&acc)[2][2][4][2], const Unit& u, int wr, int wc, int fr, int fq) const {
#pragma unroll
        for (int ai = 0; ai < 2; ++ai)
#pragma unroll
            for (int m = 0; m < 4; ++m) {
                const size_t row = EPI_ROWS(ai, m);
#pragma unroll
                for (int bj = 0; bj < 2; ++bj) {
                    const int c = u.pn * 256 + bj * 128 + wc * 32 + 8 * fq;
                    const u32x4 gv = *(const u32x4*)(gate + row * (2 * DM) + goff + c);
                    float gg[8] = {bf_lo(gv.x), bf_hi(gv.x), bf_lo(gv.y), bf_hi(gv.y), bf_lo(gv.z), bf_hi(gv.z), bf_lo(gv.w), bf_hi(gv.w)};
                    float tt[8] = {0.f, 0.f, 0.f, 0.f, 0.f, 0.f, 0.f, 0.f};
                    if (ADD) { const u32x4 tv = *(const u32x4*)(tin + row * DM + c);
                        tt[0] = bf_lo(tv.x); tt[1] = bf_hi(tv.x); tt[2] = bf_lo(tv.y); tt[3] = bf_hi(tv.y); tt[4] = bf_lo(tv.z); tt[5] = bf_hi(tv.z); tt[6] = bf_lo(tv.w); tt[7] = bf_hi(tv.w); }
                    float o[8];
#pragma unroll
                    for (int j = 0; j < 4; ++j) { o[j] = tt[j] + gg[j] * acc[ai][bj][m][0][j]; o[4 + j] = tt[4 + j] + gg[4 + j] * acc[ai][bj][m][1][j]; }
                    u32x4 w; w.x = cvt_pk_bf16(o[0], o[1]); w.y = cvt_pk_bf16(o[2], o[3]); w.z = cvt_pk_bf16(o[4], o[5]); w.w = cvt_pk_bf16(o[6], o[7]);
                    *(u32x4*)(out + row * DM + c) = w;
                }
            }
    }
};
struct EpiSigBias {
    const float* bias; bf16_t* out;
    __device__ __forceinline__ void operator()(const f32x4 (&acc)[2][2][4][2], const Unit& u, int wr, int wc, int fr, int fq) const {
#pragma unroll
        for (int bj = 0; bj < 2; ++bj) {
            const int c = u.pn * 256 + bj * 128 + wc * 32 + 8 * fq;
            const f32x4 b0 = *(const f32x4*)(bias + c), b1 = *(const f32x4*)(bias + c + 4);
#pragma unroll
            for (int ai = 0; ai < 2; ++ai)
#pragma unroll
                for (int m = 0; m < 4; ++m) {
                    const size_t row = EPI_ROWS(ai, m);
                    f32x4 v0 = acc[ai][bj][m][0] + b0, v1 = acc[ai][bj][m][1] + b1;
#pragma unroll
                    for (int j = 0; j < 4; ++j) { v0[j] = sigmoid_f(v0[j]); v1[j] = sigmoid_f(v1[j]); }
                    u32x4 w; w.x = cvt_pk_bf16(v0[0], v0[1]); w.y = cvt_pk_bf16(v0[2], v0[3]); w.z = cvt_pk_bf16(v1[0], v1[1]); w.w = cvt_pk_bf16(v1[2], v1[3]);
                    *(u32x4*)(out + row * DM + c) = w;
                }
        }
    }
};

struct Params {
    const float *x, *p, *ln_g, *ln_b, *wg, *wu, *wd, *w_in, *b_in, *b_forget, *conv_w, *conv_b, *mh_g, *w_a, *w_b, *w_o, *w_ple, *w_pg, *b_pg;
    float* out; unsigned char* ws;
    int ph_lo, ph_hi, coop, pad;
};

__device__ void cvt_bf16_phase(const float* src, bf16_t* dst, size_t n8) {
    const size_t stride = (size_t)gridDim.x * NTHREADS;
    for (size_t i = (size_t)blockIdx.x * NTHREADS + threadIdx.x; i < n8; i += stride) {
        const f32x4 a = *(const f32x4*)(src + i * 8), b = *(const f32x4*)(src + i * 8 + 4);
        u32x4 w; w.x = cvt_pk_bf16(a[0], a[1]); w.y = cvt_pk_bf16(a[2], a[3]); w.z = cvt_pk_bf16(b[0], b[1]); w.w = cvt_pk_bf16(b[2], b[3]);
        *(u32x4*)(dst + i * 8) = w;
    }
}
template <int MODE>
__device__ __forceinline__ float tsrc_val(const float* w0, const float* w1, int ldn, int k, int n) {
    if (MODE == 0) return w0[(size_t)k * ldn + n];
    if (MODE == 1) { const int pn = n >> 8, sel = (n >> 7) & 1, i = n & 127; const float* w = sel ? w1 : w0; return w[(size_t)k * ldn + pn * 128 + i]; }
    int col; if (n < 3072) col = n; else if (n < 8192) col = n + 8; else if (n < 8200) col = 3072 + (n - 8192); else return 0.f;
    return w0[(size_t)k * ldn + col];
}
template <int MODE>
__device__ __forceinline__ void transpose_mat(LAS float* tile, const float* w0, const float* w1, int ldn, bf16_t* dst, int NP, int K, int& base) {
    const int tid = threadIdx.x;
    const int tn = NP / 128, tk = K / 128, nt = tn * tk;
    int first = ((int)blockIdx.x - base) % (int)gridDim.x; if (first < 0) first += gridDim.x;
    for (int t = first; t < nt; t += gridDim.x) {
        const int n0 = (t / tk) * 128, k0 = (t % tk) * 128;
#pragma unroll 8
        for (int e = 0; e < 32; ++e) { const int idx = e * NTHREADS + tid, kk = idx >> 7, nn = idx & 127; tile[kk * 129 + nn] = tsrc_val<MODE>(w0, w1, ldn, k0 + kk, n0 + nn); }
        __syncthreads();
#pragma unroll 8
        for (int e = 0; e < 16; ++e) { const int idx = e * NTHREADS + tid, nn = idx >> 6, kk = (idx & 63) * 2;
            *(unsigned*)(dst + (size_t)(n0 + nn) * K + k0 + kk) = cvt_pk_bf16(tile[kk * 129 + nn], tile[(kk + 1) * 129 + nn]); }
        __syncthreads();
    }
    base += nt;
}
__device__ void prep_phase(const Params& P, LAS unsigned char* lds) {
    unsigned char* ws = P.ws;
    cvt_bf16_phase(P.x, (bf16_t*)(ws + WS_X), (size_t)MTOK * DM / 8);
    if (blockIdx.x == 0 && threadIdx.x < 64) ((unsigned*)(ws + MISC_CNT))[threadIdx.x] = 0u;
    for (int n = blockIdx.x * NTHREADS + threadIdx.x; n < NIN_PAD; n += gridDim.x * NTHREADS) {
        float b;
        if (n < 3072) b = P.b_in[n]; else if (n < 8192) b = P.b_in[n + 8]; else if (n < 8196) b = P.b_in[3072 + n - 8192];
        else if (n < 8200) b = P.b_in[3072 + n - 8192] + P.b_forget[n - 8196]; else b = 0.f;
        ((float*)(ws + W_BIAS))[n] = b;
    }
    LAS float* tile = (LAS float*)lds;
    int base = 0;
    transpose_mat<1>(tile, P.wg, P.wu, FH, (bf16_t*)(ws + W_GU1), 5632, 1024, base);
    transpose_mat<0>(tile, P.wd, nullptr, DM, (bf16_t*)(ws + W_D1), 1024, FH, base);
    transpose_mat<1>(tile, P.wg + (size_t)DM * FH, P.wu + (size_t)DM * FH, FH, (bf16_t*)(ws + W_GU2), 5632, 1024, base);
    transpose_mat<0>(tile, P.wd + (size_t)DM * FH, nullptr, DM, (bf16_t*)(ws + W_D2), 1024, FH, base);
    transpose_mat<2>(tile, P.w_in, nullptr, 8200, (bf16_t*)(ws + W_IN), NIN_PAD, 1024, base);
    transpose_mat<0>(tile, P.w_a, nullptr, DM, (bf16_t*)(ws + W_A), 1024, 1024, base);
    transpose_mat<0>(tile, P.w_b, nullptr, DM, (bf16_t*)(ws + W_B), 1024, 1024, base);
    transpose_mat<0>(tile, P.w_o, nullptr, DM, (bf16_t*)(ws + W_O), 1024, 1024, base);
    transpose_mat<0>(tile, P.w_pg, nullptr, DM, (bf16_t*)(ws + W_PG), 1024, 1024, base);
    transpose_mat<0>(tile, P.w_ple, nullptr, DM, (bf16_t*)(ws + W_P), 1024, 256, base);
}
template <bool OUT_BF16>
__device__ void ln_phase(const float* Y, const float* g, const float* b, void* out) {
    const int wid = threadIdx.x >> 6, lane = threadIdx.x & 63;
    f32x4 gv[4], bv[4];
#pragma unroll
    for (int i = 0; i < 4; ++i) { gv[i] = *(const f32x4*)(g + i * 256 + lane * 4); bv[i] = *(const f32x4*)(b + i * 256 + lane * 4); }
    for (int row = blockIdx.x * 8 + wid; row < MTOK; row += gridDim.x * 8) {
        const float* y = Y + (size_t)row * DM;
        f32x4 v[4]; float s = 0.f;
#pragma unroll
        for (int i = 0; i < 4; ++i) { v[i] = *(const f32x4*)(y + i * 256 + lane * 4); s += (v[i][0] + v[i][1]) + (v[i][2] + v[i][3]); }
        const float mean = wave_sum(s) * (1.0f / DM);
        float q = 0.f;
#pragma unroll
        for (int i = 0; i < 4; ++i) { const f32x4 d = v[i] - mean; q += (d[0] * d[0] + d[1] * d[1]) + (d[2] * d[2] + d[3] * d[3]); }
        const float rstd = rsqrtf(wave_sum(q) * (1.0f / DM) + LN_EPS);
#pragma unroll
        for (int i = 0; i < 4; ++i) {
            const f32x4 o = (v[i] - mean) * rstd * gv[i] + bv[i];
            if (OUT_BF16) { u32x2 w; w.x = cvt_pk_bf16(o[0], o[1]); w.y = cvt_pk_bf16(o[2], o[3]); *(u32x2*)((bf16_t*)out + (size_t)row * DM + i * 256 + lane * 4) = w; }
            else *(f32x4*)((float*)out + (size_t)row * DM + i * 256 + lane * 4) = o;
        }
    }
}

constexpr int L_QI = 0, L_KI = 17408, L_KT = 34816, L_VT = 53248, L_PI = 90112, L_F = 99328;
constexpr int F_N = 0, F_QN = 128, F_RS = 192, F_HS = 320, F_BL = 1344, F_GM = 1472, F_M = 1600, F_CW = 1732, F_SA = 3012, F_SB2 = 3028, F_SMU = 4052, F_SWI = 5076, F_SWN = 6100, F_SEM = 7124, F_END = 8148;
constexpr int MIX_LDS = L_F + F_END * 4;

__device__ void mlstm_prologue(const Params& P, LAS unsigned char* lds, int b, int h, int gi) {
    LAS float* F = (LAS float*)(lds + L_F);
    const float* ifg = (const float*)(P.ws + MISC_IF);
    const int tid = threadIdx.x, w = tid >> 6, lane = tid & 63;
    const int nch = 16 * (gi + 1);
    for (int c = w; c < nch; c += 8) {
        const size_t tok = (size_t)b * SEQ + c * 64 + lane;
        const float iv = ifg[tok * 8 + h], lf = ifg[tok * 8 + 4 + h];
        const float bc = wave_incl_sum(lf, lane);
        const float bl = __shfl(bc, 63);
        const float gm = wave_max(bl - bc + iv);
        if (lane == 0) { F[F_BL + c] = bl; F[F_GM + c] = gm; }
    }
    for (int i = tid; i < 1280; i += NTHREADS) {
        const int j = i >> 8, ch = i & 255; const int gc = ch < 128 ? h * 128 + ch : 512 + h * 128 + (ch - 128);
        F[F_CW + i] = j < 4 ? P.conv_w[j * 1024 + gc] : P.conv_b[gc];
    }
    if (tid < 128) F[F_N + tid] = 0.f;
    __syncthreads();
    if (tid == 0) { float m = 0.f; F[F_M] = 0.f; for (int c = 0; c < nch; ++c) { m = fmaxf(F[F_BL + c] + m, F[F_GM + c]); F[F_M + c + 1] = m; } }
    __syncthreads();
    for (int lc = w; lc < 16; lc += 8) {
        const int c = gi * 16 + lc;
        const size_t tok = (size_t)b * SEQ + c * 64 + lane;
        const float iv = ifg[tok * 8 + h], lf = ifg[tok * 8 + 4 + h];
        const float bc = wave_incl_sum(lf, lane);
        const float bl = __shfl(bc, 63);
        const float mst = F[F_M + c], mnew = F[F_M + c + 1];
        const float beta = iv - bc;
        const float mu = fmaxf(mst, wave_incl_max(beta, lane));
        F[F_SB2 + lc * 64 + lane] = beta * LOG2E;
        F[F_SMU + lc * 64 + lane] = mu * LOG2E;
        F[F_SWI + lc * 64 + lane] = expf(mst - mu);
        F[F_SWN + lc * 64 + lane] = expf(bl - bc + iv - mnew);
        F[F_SEM + lc * 64 + lane] = expf(-(bc + mu));
        if (lane == 0) F[F_SA + lc] = expf(bl + mst - mnew);
    }
    __syncthreads();
}

template <bool NEED_Q>
__device__ __forceinline__ void mlstm_load(const Params& P, LAS unsigned char* lds, int b, int h, int c, int lc) {
    LAS float* F = (LAS float*)(lds + L_F);
    const bf16_t* QK = (const bf16_t*)(P.ws + WS_QK);
    const bf16_t* VA = (const bf16_t*)(P.ws + WS_VA);
    const int tid = threadIdx.x, tg = tid & 15, cg = tid >> 4;
    {
        u32x4 vr[4];
#pragma unroll
        for (int tt = 0; tt < 4; ++tt) vr[tt] = *(const u32x4*)(VA + ((size_t)b * SEQ + c * 64 + 4 * tg + tt) * DM + h * 256 + 8 * cg);
#pragma unroll
        for (int e = 0; e < 8; ++e) {
            unsigned short x0, x1, x2, x3;
            { const unsigned a0 = vr[0][e >> 1], a1 = vr[1][e >> 1], a2 = vr[2][e >> 1], a3 = vr[3][e >> 1];
              if (e & 1) { x0 = a0 >> 16; x1 = a1 >> 16; x2 = a2 >> 16; x3 = a3 >> 16; } else { x0 = a0 & 0xffff; x1 = a1 & 0xffff; x2 = a2 & 0xffff; x3 = a3 & 0xffff; } }
            u32x2 wv; wv.x = (unsigned)x0 | ((unsigned)x1 << 16); wv.y = (unsigned)x2 | ((unsigned)x3 << 16);
            *(LAS u32x2*)(lds + L_VT + (8 * cg + e) * 144 + 8 * tg) = wv;
        }
    }
    __builtin_amdgcn_sched_barrier(0);
    if (NEED_Q || cg >= 16) {
        const int gc = cg < 16 ? h * 128 + 8 * cg : 512 + h * 128 + 8 * (cg - 16);
        u32x4 raw[7];
#pragma unroll
        for (int i = 0; i < 7; ++i) {
            const int pos = c * 64 + 4 * tg - 3 + i;
            raw[i] = pos >= 0 ? *(const u32x4*)(QK + ((size_t)b * SEQ + pos) * DM + gc) : (u32x4){0u, 0u, 0u, 0u};
        }
        float o[4][8];
#pragma unroll
        for (int e = 0; e < 8; ++e) {
            float rv[7];
#pragma unroll
            for (int i = 0; i < 7; ++i) rv[i] = (e & 1) ? bf_hi(raw[i][e >> 1]) : bf_lo(raw[i][e >> 1]);
            const float w0 = F[F_CW + 0 * 256 + 8 * cg + e], w1 = F[F_CW + 1 * 256 + 8 * cg + e], w2 = F[F_CW + 2 * 256 + 8 * cg + e], w3 = F[F_CW + 3 * 256 + 8 * cg + e], cb = F[F_CW + 4 * 256 + 8 * cg + e];
#pragma unroll
            for (int tt = 0; tt < 4; ++tt) { const float v = cb + w0 * rv[tt] + w1 * rv[tt + 1] + w2 * rv[tt + 2] + w3 * rv[tt + 3]; o[tt][e] = v * sigmoid_f(v); }
            __builtin_amdgcn_sched_barrier(0);
        }
        if (cg < 16) {
#pragma unroll
            for (int tt = 0; tt < 4; ++tt) { u32x4 wv; wv.x = cvt_pk_bf16(o[tt][0], o[tt][1]); wv.y = cvt_pk_bf16(o[tt][2], o[tt][3]); wv.z = cvt_pk_bf16(o[tt][4], o[tt][5]); wv.w = cvt_pk_bf16(o[tt][6], o[tt][7]);
                *(LAS u32x4*)(lds + L_QI + (4 * tg + tt) * 272 + 16 * cg) = wv; }
        } else {
            const int kc = cg - 16;
            const f32x4 wn = *(const LAS f32x4*)(F + F_SWN + lc * 64 + 4 * tg);
#pragma unroll
            for (int tt = 0; tt < 4; ++tt) {
#pragma unroll
                for (int e = 0; e < 8; ++e) o[tt][e] *= 0.08838834764831845f;
                u32x4 wv; wv.x = cvt_pk_bf16(o[tt][0], o[tt][1]); wv.y = cvt_pk_bf16(o[tt][2], o[tt][3]); wv.z = cvt_pk_bf16(o[tt][4], o[tt][5]); wv.w = cvt_pk_bf16(o[tt][6], o[tt][7]);
                *(LAS u32x4*)(lds + L_KI + (4 * tg + tt) * 272 + 16 * kc) = wv; }
#pragma unroll
            for (int e = 0; e < 8; ++e) { u32x2 wv; wv.x = cvt_pk_bf16(o[0][e] * wn[0], o[1][e] * wn[1]); wv.y = cvt_pk_bf16(o[2][e] * wn[2], o[3][e] * wn[3]);
                *(LAS u32x2*)(lds + L_KT + (8 * kc + e) * 144 + 8 * tg) = wv; }
        }
    }
}

__device__ __forceinline__ void mlstm_update(LAS unsigned char* lds, f32x4 (&C)[2][8], int lc, int w, int r, int g) {
    LAS float* F = (LAS float*)(lds + L_F);
    const float a = F[F_SA + lc];
    const LAS unsigned char* vp = lds + (L_VT + (32 * w + r) * 144 + 16 * g);
    const LAS unsigned char* kp = lds + (L_KT + r * 144 + 16 * g);
#pragma unroll
    for (int dvb = 0; dvb < 2; ++dvb)
#pragma unroll
        for (int dkb = 0; dkb < 8; ++dkb) C[dvb][dkb] *= a;
#pragma unroll
    for (int ks = 0; ks < 2; ++ks) {
        bf16x8 vf[2];
#pragma unroll
        for (int dvb = 0; dvb < 2; ++dvb) vf[dvb] = *(const LAS bf16x8*)(vp + (16 * dvb * 144 + 64 * ks));
#pragma unroll
        for (int dkb = 0; dkb < 8; ++dkb) {
            const bf16x8 kf = *(const LAS bf16x8*)(kp + (16 * dkb * 144 + 64 * ks));
#pragma unroll
            for (int dvb = 0; dvb < 2; ++dvb) C[dvb][dkb] = mfma16(kf, vf[dvb], C[dvb][dkb]);
        }
        __builtin_amdgcn_sched_barrier(0);
    }
    const int tid = threadIdx.x, dk = tid >> 2, part = tid & 3;
    const u32x4 k0 = *(const LAS u32x4*)(lds + L_KT + dk * 144 + 32 * part), k1 = *(const LAS u32x4*)(lds + L_KT + dk * 144 + 32 * part + 16);
    float s = 0.f;
#pragma unroll
    for (int i = 0; i < 4; ++i) s += bf_lo(k0[i]) + bf_hi(k0[i]) + bf_lo(k1[i]) + bf_hi(k1[i]);
    s += __shfl_xor(s, 1); s += __shfl_xor(s, 2);
    if (part == 0) F[F_N + dk] = a * F[F_N + dk] + s;
}

__device__ void mlstm_phase1(const Params& P, LAS unsigned char* lds) {
    const int tid = threadIdx.x, w = tid >> 6, lane = tid & 63, r = lane & 15, g = lane >> 4;
    LAS float* F = (LAS float*)(lds + L_F);
    for (int task = blockIdx.x; task < 256; task += gridDim.x) {
        const int gi = task & 7, st = task >> 3, b = st >> 2, h = st & 3;
        if (gi == 7) continue;
        mlstm_prologue(P, lds, b, h, gi);
        f32x4 C[2][8];
#pragma unroll
        for (int i = 0; i < 2; ++i)
#pragma unroll
            for (int j = 0; j < 8; ++j) C[i][j] = (f32x4){0.f, 0.f, 0.f, 0.f};
        for (int lc = 0; lc < 16; ++lc) {
            mlstm_load<false>(P, lds, b, h, gi * 16 + lc, lc);
            __syncthreads();
            mlstm_update(lds, C, lc, w, r, g);
            __syncthreads();
        }
        float* slot = (float*)(P.ws + WS_PB) + (size_t)(st * 7 + gi) * STATE_FLOATS;
#pragma unroll
        for (int dvb = 0; dvb < 2; ++dvb)
#pragma unroll
            for (int dkb = 0; dkb < 8; ++dkb) *(f32x4*)(slot + (((w * 2 + dvb) * 8 + dkb) * 64 + lane) * 4) = C[dvb][dkb];
        if (tid < 128) slot[32768 + tid] = F[F_N + tid];
        __syncthreads();
    }
}

__device__ void mlstm_phase2(const Params& P, LAS unsigned char* lds) {
    const int tid = threadIdx.x, w = tid >> 6, lane = tid & 63, r = lane & 15, g = lane >> 4;
    LAS float* F = (LAS float*)(lds + L_F);
    const bf16_t* OA = (const bf16_t*)(P.ws + WS_OA);
    bf16_t* VA = (bf16_t*)(P.ws + WS_VA);
    for (int task = blockIdx.x; task < 256; task += gridDim.x) {
        const int gi = task & 7, st = task >> 3, b = st >> 2, h = st & 3;
        mlstm_prologue(P, lds, b, h, gi);
        f32x4 C[2][8];
#pragma unroll
        for (int i = 0; i < 2; ++i)
#pragma unroll
            for (int j = 0; j < 8; ++j) C[i][j] = (f32x4){0.f, 0.f, 0.f, 0.f};
        float nreg = 0.f;
        for (int j = 0; j < gi; ++j) {
            float Bj = 0.f;
            for (int c = 0; c < 16; ++c) Bj += F[F_BL + j * 16 + c];
            const float Aj = expf(Bj + F[F_M + 16 * j] - F[F_M + 16 * j + 16]);
            const float* slot = (const float*)(P.ws + WS_PB) + (size_t)(st * 7 + j) * STATE_FLOATS;
#pragma unroll
            for (int dvb = 0; dvb < 2; ++dvb)
#pragma unroll
                for (int dkb = 0; dkb < 8; ++dkb) C[dvb][dkb] = C[dvb][dkb] * Aj + *(const f32x4*)(slot + (((w * 2 + dvb) * 8 + dkb) * 64 + lane) * 4);
            if (tid < 128) nreg = nreg * Aj + slot[32768 + tid];
        }
        if (tid < 128) F[F_N + tid] = nreg;
        __syncthreads();
        for (int lc = 0; lc < 16; ++lc) {
            const int c = gi * 16 + lc;
            mlstm_load<true>(P, lds, b, h, c, lc);
            __syncthreads();
            {
                const int tb = w >> 1, par = w & 1;
                const LAS unsigned char* qpS = lds + (L_QI + (16 * tb + r) * 272 + 16 * g);
                const LAS unsigned char* kpS = lds + (L_KI + (16 * par + r) * 272 + 16 * g);
                LAS unsigned char* ppS = lds + (L_PI + (16 * tb + r) * 144 + 32 * par + 8 * g);
                bf16x8 qf[4];
#pragma unroll
                for (int kd = 0; kd < 4; ++kd) qf[kd] = *(const LAS bf16x8*)(qpS + 64 * kd);
                const float mu2 = F[F_SMU + lc * 64 + 16 * tb + r];
                float rs = 0.f;
#pragma unroll
                for (int sbi = 0; sbi < 2; ++sbi) {
                    const int sb = par + 2 * sbi;
                    u32x2 pw = (u32x2){0u, 0u};
                    if (sb <= tb) {
                        f32x4 acc = (f32x4){0.f, 0.f, 0.f, 0.f};
#pragma unroll
                        for (int kd = 0; kd < 4; ++kd) { const bf16x8 kf = *(const LAS bf16x8*)(kpS + (32 * sbi * 272 + 64 * kd)); acc = mfma16(kf, qf[kd], acc); }
                        const f32x4 b2 = *(const LAS f32x4*)(F + F_SB2 + lc * 64 + 16 * sb + 4 * g);
                        float pv[4];
#pragma unroll
                        for (int j = 0; j < 4; ++j) { const int s = 16 * sb + 4 * g + j, t = 16 * tb + r; pv[j] = (s <= t) ? acc[j] * fast_exp2(b2[j] - mu2) : 0.f; }
                        pw.x = cvt_pk_bf16(pv[0], pv[1]); pw.y = cvt_pk_bf16(pv[2], pv[3]);
                        rs += bf_lo(pw.x) + bf_hi(pw.x) + bf_lo(pw.y) + bf_hi(pw.y);
                    }
                    *(LAS u32x2*)(ppS + 64 * sbi) = pw;
                }
                rs += __shfl_xor(rs, 16); rs += __shfl_xor(rs, 32);
                if (g == 0) F[F_RS + par * 64 + 16 * tb + r] = rs;
            }
            __builtin_amdgcn_sched_barrier(0);
            const LAS unsigned char* q8p = lds + (L_QI + r * 272 + 8 * g);
            f32x4 num[2][4];
#pragma unroll
            for (int i = 0; i < 2; ++i)
#pragma unroll
                for (int j = 0; j < 4; ++j) num[i][j] = (f32x4){0.f, 0.f, 0.f, 0.f};
#pragma unroll
            for (int kk = 0; kk < 4; ++kk) {
                bf16x8 af[2];
#pragma unroll
                for (int dvb = 0; dvb < 2; ++dvb) {
                    u32x2 lo, hi; lo.x = cvt_pk_bf16(C[dvb][2 * kk][0], C[dvb][2 * kk][1]); lo.y = cvt_pk_bf16(C[dvb][2 * kk][2], C[dvb][2 * kk][3]);
                    hi.x = cvt_pk_bf16(C[dvb][2 * kk + 1][0], C[dvb][2 * kk + 1][1]); hi.y = cvt_pk_bf16(C[dvb][2 * kk + 1][2], C[dvb][2 * kk + 1][3]);
                    af[dvb] = mk8(lo, hi);
                }
#pragma unroll
                for (int tb = 0; tb < 4; ++tb) {
                    const u32x2 q0 = *(const LAS u32x2*)(q8p + (16 * tb * 272 + 64 * kk)), q1 = *(const LAS u32x2*)(q8p + (16 * tb * 272 + 64 * kk + 32));
                    const bf16x8 bq = mk8(q0, q1);
#pragma unroll
                    for (int dvb = 0; dvb < 2; ++dvb) num[dvb][tb] = mfma16(af[dvb], bq, num[dvb][tb]);
                }
                __builtin_amdgcn_sched_barrier(0);
            }
#pragma unroll
            for (int tb = 0; tb < 4; ++tb) { const float wi = F[F_SWI + lc * 64 + 16 * tb + r];
#pragma unroll
                for (int dvb = 0; dvb < 2; ++dvb) num[dvb][tb] *= wi; }
            {
                const int t = tid >> 3, part = tid & 7;
                const u32x4 q0 = *(const LAS u32x4*)(lds + L_QI + t * 272 + 32 * part), q1 = *(const LAS u32x4*)(lds + L_QI + t * 272 + 32 * part + 16);
                float s = 0.f;
#pragma unroll
                for (int i = 0; i < 4; ++i) {
                    s += bf_lo(q0[i]) * F[F_N + 16 * part + 2 * i] + bf_hi(q0[i]) * F[F_N + 16 * part + 2 * i + 1];
                    s += bf_lo(q1[i]) * F[F_N + 16 * part + 8 + 2 * i] + bf_hi(q1[i]) * F[F_N + 16 * part + 8 + 2 * i + 1];
                }
                s += __shfl_xor(s, 1); s += __shfl_xor(s, 2); s += __shfl_xor(s, 4);
                if (part == 0) F[F_QN + t] = s;
            }
            __builtin_amdgcn_sched_barrier(0);
            __syncthreads();
            const LAS unsigned char* vpC = lds + (L_VT + (32 * w + r) * 144 + 16 * g);
            const LAS unsigned char* ppC = lds + (L_PI + r * 144 + 16 * g);
#pragma unroll
            for (int ks = 0; ks < 2; ++ks) {
                bf16x8 vf[2];
#pragma unroll
                for (int dvb = 0; dvb < 2; ++dvb) vf[dvb] = *(const LAS bf16x8*)(vpC + (16 * dvb * 144 + 64 * ks));
#pragma unroll
                for (int tb = 0; tb < 4; ++tb) {
                    if (ks == 0 || tb >= 2) {
                        const bf16x8 pb = *(const LAS bf16x8*)(ppC + (16 * tb * 144 + 64 * ks));
#pragma unroll
                        for (int dvb = 0; dvb < 2; ++dvb) num[dvb][tb] = mfma16(vf[dvb], pb, num[dvb][tb]);
                    }
                }
                __builtin_amdgcn_sched_barrier(0);
            }
#pragma unroll
            for (int tb = 0; tb < 4; ++tb) {
                const int t = 16 * tb + r;
                const float den = F[F_SWI + lc * 64 + t] * F[F_QN + t] + F[F_RS + t] + F[F_RS + 64 + t];
                const float inv = 1.0f / fmaxf(fabsf(den), F[F_SEM + lc * 64 + t]);
                float s1 = 0.f, s2 = 0.f;
#pragma unroll
                for (int dvb = 0; dvb < 2; ++dvb) { num[dvb][tb] *= inv;
#pragma unroll
                    for (int j = 0; j < 4; ++j) { const float v = num[dvb][tb][j]; s1 += v; s2 += v * v; } }
                s1 += __shfl_xor(s1, 16); s1 += __shfl_xor(s1, 32); s2 += __shfl_xor(s2, 16); s2 += __shfl_xor(s2, 32);
                if (g == 0) { F[F_HS + (w * 64 + t) * 2] = s1; F[F_HS + (w * 64 + t) * 2 + 1] = s2; }
                __builtin_amdgcn_sched_barrier(0);
            }
            mlstm_update(lds, C, lc, w, r, g);
            __builtin_amdgcn_sched_barrier(0);
            __syncthreads();
#pragma unroll
            for (int tb = 0; tb < 4; ++tb) {
                const int t = 16 * tb + r;
                float s1 = 0.f, s2 = 0.f;
#pragma unroll
                for (int ww = 0; ww < 8; ++ww) { s1 += F[F_HS + (ww * 64 + t) * 2]; s2 += F[F_HS + (ww * 64 + t) * 2 + 1]; }
                const float mean = s1 * (1.0f / 256.0f), var = fmaxf(s2 * (1.0f / 256.0f) - mean * mean, 0.f), rstd = rsqrtf(var + LN_EPS);
                const size_t tok = (size_t)b * SEQ + c * 64 + t;
#pragma unroll
                for (int dvb = 0; dvb < 2; ++dvb) {
                    const int dv0 = 32 * w + 16 * dvb + 4 * g;
                    const f32x4 gn = *(const f32x4*)(P.mh_g + h * 256 + dv0);
                    const u32x2 og = *(const u32x2*)(OA + tok * DM + h * 256 + dv0);
                    const float y0 = (num[dvb][tb][0] - mean) * rstd * gn[0] * bf_lo(og.x), y1 = (num[dvb][tb][1] - mean) * rstd * gn[1] * bf_hi(og.x);
                    const float y2 = (num[dvb][tb][2] - mean) * rstd * gn[2] * bf_lo(og.y), y3 = (num[dvb][tb][3] - mean) * rstd * gn[3] * bf_hi(og.y);
                    u32x2 wv; wv.x = cvt_pk_bf16(y0, y1); wv.y = cvt_pk_bf16(y2, y3);
                    *(u32x2*)(VA + tok * DM + h * 256 + dv0) = wv;
                }
            }
        }
        __syncthreads();
    }
}

constexpr int A_KI = 0, A_VT = 17408, A_FL = 35840;
constexpr float SB_DONE_LOG2 = -40.0f;

__device__ void attn_phase(const Params& P, LAS unsigned char* lds) {
    const int tid = threadIdx.x, w = tid >> 6, lane = tid & 63, r = lane & 15, g = lane >> 4;
    bf16_t* QB = (bf16_t*)(P.ws + WS_QB);
    const bf16_t* KB = (const bf16_t*)(P.ws + WS_KB);
    const bf16_t* VB = (const bf16_t*)(P.ws + WS_VB);
    unsigned* cnt = (unsigned*)(P.ws + MISC_CNT);
    LAS int* FL = (LAS int*)(lds + A_FL);
    for (;;) {
        if (tid == 0) FL[32] = (int)atomicAdd(cnt, 1u);
        __syncthreads();
        const int item = FL[32];
        __syncthreads();
        if (item >= 4096) break;
        const int qb = 63 - (item >> 6), b = (item >> 3) & 7, h = item & 7;
        const int q0w = qb * 128 + 16 * w;
        const size_t qtok = (size_t)b * SEQ + q0w + r;
        bf16x8 qf[4];
#pragma unroll
        for (int kd = 0; kd < 4; ++kd) qf[kd] = *(const bf16x8*)(QB + qtok * DM + h * 128 + 32 * kd + 8 * g);
        f32x4 O[8];
#pragma unroll
        for (int i = 0; i < 8; ++i) O[i] = (f32x4){0.f, 0.f, 0.f, 0.f};
        float R = 0.f;
        int wdone = 0, it = 0;
        for (int kt = 2 * qb + 1; kt >= 0; --kt, ++it) {
            if (tid < 256) {
                const int tg = tid & 15, cg = tid >> 4;
                u32x4 vr[4];
#pragma unroll
                for (int tt = 0; tt < 4; ++tt) vr[tt] = *(const u32x4*)(VB + ((size_t)b * SEQ + kt * 64 + 4 * tg + tt) * DM + h * 128 + 8 * cg);
#pragma unroll
                for (int e = 0; e < 8; ++e) {
                    unsigned short x0, x1, x2, x3;
                    { const unsigned a0 = vr[0][e >> 1], a1 = vr[1][e >> 1], a2 = vr[2][e >> 1], a3 = vr[3][e >> 1];
                      if (e & 1) { x0 = a0 >> 16; x1 = a1 >> 16; x2 = a2 >> 16; x3 = a3 >> 16; } else { x0 = a0 & 0xffff; x1 = a1 & 0xffff; x2 = a2 & 0xffff; x3 = a3 & 0xffff; } }
                    u32x2 wv; wv.x = (unsigned)x0 | ((unsigned)x1 << 16); wv.y = (unsigned)x2 | ((unsigned)x3 << 16);
                    *(LAS u32x2*)(lds + A_VT + (8 * cg + e) * 144 + 8 * tg) = wv;
                }
            } else {
                const int t2 = tid - 256, row = t2 >> 2, ch = t2 & 3;
                const bf16_t* src = KB + ((size_t)b * SEQ + kt * 64 + row) * DM + h * 128 + 32 * ch;
#pragma unroll
                for (int i = 0; i < 4; ++i) *(LAS u32x4*)(lds + A_KI + row * 272 + 64 * ch + 16 * i) = *(const u32x4*)(src + 8 * i);
            }
            __syncthreads();
            const int key0 = kt * 64;
            if (!wdone && key0 <= q0w + 14) {
                const int qpos = q0w + r;
                float wgt[4][4];
                float Rrun = R;
#pragma unroll
                for (int sb = 3; sb >= 0; --sb) {
                    f32x4 acc = (f32x4){0.f, 0.f, 0.f, 0.f};
#pragma unroll
                    for (int kd = 0; kd < 4; ++kd) { const bf16x8 kf = *(const LAS bf16x8*)(lds + A_KI + (16 * sb + r) * 272 + 64 * kd + 16 * g); acc = mfma16(kf, qf[kd], acc); }
                    float lk[4], z[4];
#pragma unroll
                    for (int j = 0; j < 4; ++j) {
                        const int key = key0 + 16 * sb + 4 * g + j;
                        z[j] = fminf(acc[j], 80.0f);
                        lk[j] = (key < qpos) ? -fast_log2(1.0f + fast_exp2(z[j])) : 0.f;
                    }
                    const float s3 = lk[3], s2 = s3 + lk[2], s1 = s2 + lk[1], s0 = s1 + lk[0];
                    const float t1 = __shfl_xor(s0, 16), t2 = __shfl_xor(s0, 32), t3 = __shfl_xor(t1, 32);
                    const float above = g == 0 ? (t1 + t2 + t3) : (g == 1 ? (t2 + t3) : (g == 2 ? t1 : 0.f));
                    const float base = Rrun + above;
                    const float sj[4] = {s0, s1, s2, s3};
#pragma unroll
                    for (int j = 0; j < 4; ++j) { const int key = key0 + 16 * sb + 4 * g + j; wgt[sb][j] = (key < qpos) ? fast_exp2(z[j] + base + sj[j]) : 0.f; }
                    Rrun += (s0 + t1) + (t2 + t3);
                }
                R = Rrun;
#pragma unroll
                for (int ks = 0; ks < 2; ++ks) {
                    u32x2 lo, hi; lo.x = cvt_pk_bf16(wgt[2 * ks][0], wgt[2 * ks][1]); lo.y = cvt_pk_bf16(wgt[2 * ks][2], wgt[2 * ks][3]);
                    hi.x = cvt_pk_bf16(wgt[2 * ks + 1][0], wgt[2 * ks + 1][1]); hi.y = cvt_pk_bf16(wgt[2 * ks + 1][2], wgt[2 * ks + 1][3]);
                    const bf16x8 pf = mk8(lo, hi);
#pragma unroll
                    for (int db = 0; db < 8; ++db) {
                        const u32x2 v0 = *(const LAS u32x2*)(lds + A_VT + (16 * db + r) * 144 + 64 * ks + 8 * g), v1 = *(const LAS u32x2*)(lds + A_VT + (16 * db + r) * 144 + 64 * ks + 32 + 8 * g);
                        O[db] = mfma16(mk8(v0, v1), pf, O[db]);
                    }
                }
                wdone = __all(R < SB_DONE_LOG2) ? 1 : 0;
            }
            if (lane == 0) FL[(it & 1) * 8 + w] = wdone;
            __syncthreads();
            int alld = 1;
#pragma unroll
            for (int i = 0; i < 8; ++i) alld &= FL[(it & 1) * 8 + i];
            if (alld) break;
        }
#pragma unroll
        for (int db = 0; db < 8; ++db) { u32x2 wv; wv.x = cvt_pk_bf16(O[db][0], O[db][1]); wv.y = cvt_pk_bf16(O[db][2], O[db][3]);
            *(u32x2*)(QB + qtok * DM + h * 128 + 16 * db + 4 * g) = wv; }
        __syncthreads();
    }
}


#ifdef DIAG
__device__ void diag_count_f32(const float* p, size_t n, float thr, unsigned* ctr) {
    unsigned c = 0;
    for (size_t i = (size_t)blockIdx.x * NTHREADS + threadIdx.x; i < n; i += (size_t)gridDim.x * NTHREADS) { const float v = p[i]; if (!(fabsf(v) <= thr)) ++c; }
    if (c) atomicAdd(ctr, c);
}
__device__ void diag_count_bf16(const bf16_t* p, size_t n, float thr, unsigned* ctr) {
    unsigned c = 0;
    for (size_t i = (size_t)blockIdx.x * NTHREADS + threadIdx.x; i < n; i += (size_t)gridDim.x * NTHREADS) { const float v = __uint_as_float((unsigned)p[i] << 16); if (!(fabsf(v) <= thr)) ++c; }
    if (c) atomicAdd(ctr, c);
}
#endif
constexpr int LDS_BYTES = 135168;
static_assert(MIX_LDS <= LDS_BYTES && 128 * 129 * 4 <= LDS_BYTES && pg8::STAGE_BYTES <= LDS_BYTES, "LDS budget");
constexpr int NPHASE = 17;

template <class Epi>
__device__ __forceinline__ void run_gemm(LAS unsigned char* lds, const bf16_t* A, const bf16_t* Bt, int N, int K, const Epi& E) {
    pg8::Gemm g{A, Bt, MTOK, N, K};
    pg8::StaticOrder S; S.init(MTOK, N, gridDim.x, blockIdx.x);
    pg8::gemm_phase<Epi, pg8::StaticOrder>(lds, g, S, E);
}

__global__ void __launch_bounds__(NTHREADS, 2) fwd_megakernel(Params P) {
    extern __shared__ __attribute__((aligned(16))) unsigned char smem[];
    LAS unsigned char* lds = (LAS unsigned char*)smem;
    cg::grid_group grid = cg::this_grid();
    unsigned char* ws = P.ws;
    bf16_t* X = (bf16_t*)(ws + WS_X);
    bf16_t* H = (bf16_t*)(ws + WS_H);
    float* Y = P.out;
    bf16_t* gates = (bf16_t*)P.out;
#ifdef ONLYMASK
#define PHASE(k) if (((ONLYMASK >> (k)) & 1) && P.ph_lo <= (k) && (k) < P.ph_hi)
#else
#define PHASE(k) if (P.ph_lo <= (k) && (k) < P.ph_hi)
#endif
#define SYNC() do { if (P.coop) { asm volatile("s_waitcnt vmcnt(0) lgkmcnt(0)" ::: "memory"); grid.sync(); \
        __builtin_amdgcn_fence(__ATOMIC_ACQUIRE, "agent"); asm volatile("s_waitcnt vmcnt(0)" ::: "memory"); } } while (0)
    PHASE(0) prep_phase(P, lds);
    SYNC();
    PHASE(1) run_gemm(lds, X, (const bf16_t*)(ws + W_GU1), 5632, 1024, EpiSwiglu{H});
    SYNC();
    PHASE(2) run_gemm(lds, H, (const bf16_t*)(ws + W_D1), 1024, FH, EpiResid<false, false>{P.x, nullptr, Y, 0.5f});
    SYNC();
    PHASE(3) ln_phase<true>(Y, P.ln_g, P.ln_b, X);
    SYNC();
    PHASE(4) run_gemm(lds, X, (const bf16_t*)(ws + W_IN), NIN_PAD, 1024, EpiWin{(bf16_t*)(ws + WS_QK), gates, (float*)(ws + MISC_IF), (const float*)(ws + W_BIAS)});
    SYNC();
    PHASE(5) mlstm_phase1(P, lds);
    SYNC();
    PHASE(6) {
#ifndef NO_ML2
        mlstm_phase2(P, lds);
#endif
#ifndef NO_ATT
        attn_phase(P, lds);
#endif
    }
    SYNC();
    PHASE(7) {
        run_gemm(lds, (const bf16_t*)(ws + WS_VA), (const bf16_t*)(ws + W_A), 1024, 1024, EpiGateMul<false>{gates, 0, nullptr, (bf16_t*)(ws + WS_T)});
        run_gemm(lds, (const bf16_t*)(ws + WS_QB), (const bf16_t*)(ws + W_B), 1024, 1024, EpiGateMul<true>{gates, DM, (const bf16_t*)(ws + WS_T), (bf16_t*)(ws + WS_MG)});
    }
    SYNC();
    PHASE(8) run_gemm(lds, (const bf16_t*)(ws + WS_MG), (const bf16_t*)(ws + W_O), 1024, 1024, EpiResid<true, false>{X, nullptr, Y, 1.0f});
    SYNC();
    PHASE(9) ln_phase<true>(Y, P.ln_g + DM, P.ln_b + DM, X);
    SYNC();
    PHASE(10) run_gemm(lds, X, (const bf16_t*)(ws + W_GU2), 5632, 1024, EpiSwiglu{H});
    SYNC();
    PHASE(11) run_gemm(lds, H, (const bf16_t*)(ws + W_D2), 1024, FH, EpiResid<true, false>{X, nullptr, Y, 0.5f});
    SYNC();
    PHASE(12) { ln_phase<true>(Y, P.ln_g + 2 * DM, P.ln_b + 2 * DM, X); cvt_bf16_phase(P.p, (bf16_t*)(ws + WS_PB), (size_t)MTOK * 256 / 8); }
    SYNC();
    PHASE(13) {
        run_gemm(lds, X, (const bf16_t*)(ws + W_PG), 1024, 1024, EpiSigBias{P.b_pg, (bf16_t*)(ws + WS_PG)});
        run_gemm(lds, (const bf16_t*)(ws + WS_PB), (const bf16_t*)(ws + W_P), 1024, 256, EpiResid<true, true>{X, (const bf16_t*)(ws + WS_PG), Y, 1.0f});
    }
    SYNC();
    PHASE(14) ln_phase<false>(Y, P.ln_g + 3 * DM, P.ln_b + 3 * DM, P.out);
#undef PHASE
#undef SYNC
}

extern "C" void kernel_launch(void* const* d_in, const int* in_sizes, int n_in, void* d_out, int out_size, void* d_ws, size_t ws_size, hipStream_t stream) {
    static int grid_blocks = 0;
    if (grid_blocks == 0) {
        if (n_in != 19 || out_size != MTOK * DM || ws_size < WS_END) { fprintf(stderr, "kernel_launch: unexpected shapes (n_in %d, out %d, ws %zu, need %zu)\n", n_in, out_size, ws_size, (size_t)WS_END); grid_blocks = -1; return; }
        int dev = 0, cus = 0, per_cu = 0;
        hipGetDevice(&dev);
        hipDeviceGetAttribute(&cus, hipDeviceAttributeMultiprocessorCount, dev);
        if (hipFuncSetAttribute((const void*)fwd_megakernel, hipFuncAttributeMaxDynamicSharedMemorySize, LDS_BYTES) != hipSuccess) { fprintf(stderr, "kernel_launch: hipFuncSetAttribute failed\n"); grid_blocks = -1; return; }
        if (hipOccupancyMaxActiveBlocksPerMultiprocessor(&per_cu, (const void*)fwd_megakernel, NTHREADS, LDS_BYTES) != hipSuccess || per_cu < 1) { fprintf(stderr, "kernel_launch: occupancy query failed (%d)\n", per_cu); per_cu = 1; (void)hipGetLastError(); }
        grid_blocks = cus * per_cu;
    }
    if (grid_blocks < 0) return;
    Params p{};
    p.x = (const float*)d_in[0]; p.p = (const float*)d_in[1]; p.ln_g = (const float*)d_in[2]; p.ln_b = (const float*)d_in[3];
    p.wg = (const float*)d_in[4]; p.wu = (const float*)d_in[5]; p.wd = (const float*)d_in[6]; p.w_in = (const float*)d_in[7]; p.b_in = (const float*)d_in[8];
    p.b_forget = (const float*)d_in[9]; p.conv_w = (const float*)d_in[10]; p.conv_b = (const float*)d_in[11]; p.mh_g = (const float*)d_in[12];
    p.w_a = (const float*)d_in[13]; p.w_b = (const float*)d_in[14]; p.w_o = (const float*)d_in[15]; p.w_ple = (const float*)d_in[16]; p.w_pg = (const float*)d_in[17]; p.b_pg = (const float*)d_in[18];
    p.out = (float*)d_out; p.ws = (unsigned char*)d_ws; p.pad = 0;
#if ONE_LAUNCH
    p.ph_lo = 0; p.ph_hi = NPHASE; p.coop = 1;
    void* args[] = {&p};
    hipError_t e = hipLaunchCooperativeKernel((const void*)fwd_megakernel, dim3(grid_blocks), dim3(NTHREADS), args, LDS_BYTES, stream);
    if (e != hipSuccess) fprintf(stderr, "cooperative launch failed: %s (grid %d)\n", hipGetErrorString(e), grid_blocks);
#else
    p.coop = 0;
    for (int ph = 0; ph < 15; ++ph) { p.ph_lo = ph; p.ph_hi = ph + 1; hipLaunchKernelGGL(fwd_megakernel, dim3(grid_blocks), dim3(NTHREADS), LDS_BYTES, stream, p); }
#endif
}
```

```cpp
#include <hip/hip_runtime.h>
#include <hip/hip_cooperative_groups.h>
#include <cstdio>
namespace cg = cooperative_groups;

#ifndef ONE_LAUNCH
#define ONE_LAUNCH 1
#endif

#define LAS __attribute__((address_space(3)))
typedef unsigned short bf16_t;
typedef short bf16x8 __attribute__((ext_vector_type(8)));
typedef float f32x4 __attribute__((ext_vector_type(4)));
typedef float f32x2 __attribute__((ext_vector_type(2)));
typedef unsigned u32x4 __attribute__((ext_vector_type(4)));
typedef unsigned u32x2 __attribute__((ext_vector_type(2)));

constexpr int MTOK = 65536, DM = 1024, FH = 2816, SEQ = 8192;
constexpr int NIN_PAD = 8448;
constexpr float ALPHA = 1.189207115002721f;
constexpr float LN_EPS = 1e-5f;
constexpr float LOG2E = 1.4426950408889634f;
constexpr int NTHREADS = 512;

constexpr size_t QB_ = 33554432ull;
constexpr size_t WS_W = 0;
constexpr size_t W_GU1 = 0;
constexpr size_t W_D1 = W_GU1 + 5632ull * 1024 * 2;
constexpr size_t W_GU2 = W_D1 + 1024ull * 2816 * 2;
constexpr size_t W_D2 = W_GU2 + 5632ull * 1024 * 2;
constexpr size_t W_IN = W_D2 + 1024ull * 2816 * 2;
constexpr size_t W_A = W_IN + 8448ull * 1024 * 2;
constexpr size_t W_B = W_A + 1024ull * 1024 * 2;
constexpr size_t W_O = W_B + 1024ull * 1024 * 2;
constexpr size_t W_PG = W_O + 1024ull * 1024 * 2;
constexpr size_t W_P = W_PG + 1024ull * 1024 * 2;
constexpr size_t W_BIAS = W_P + 1024ull * 256 * 2;
static_assert(W_BIAS + 8448 * 4 <= 2 * QB_, "weights overflow");
constexpr size_t WS_PB = 2 * QB_;
constexpr size_t WS_MISC = 3 * QB_;
constexpr size_t MISC_IF = WS_MISC;
constexpr size_t MISC_CNT = WS_MISC + 2097152ull;
constexpr size_t WS_X = 4 * QB_;
constexpr size_t WS_H = 8 * QB_;
constexpr size_t WS_QK = 8 * QB_, WS_VA = 12 * QB_, WS_OA = 16 * QB_, WS_QB = 20 * QB_, WS_KB = 24 * QB_, WS_VB = 28 * QB_;
constexpr size_t WS_T = WS_QK, WS_MG = WS_KB, WS_PG = 8 * QB_;
constexpr size_t WS_END = 32 * QB_;
constexpr int STATE_FLOATS = 32768 + 128;

typedef __bf16 bf16x2_t __attribute__((ext_vector_type(2)));
__device__ __forceinline__ unsigned cvt_pk_bf16(float lo, float hi) { f32x2 v = {lo, hi}; bf16x2_t r = __builtin_convertvector(v, bf16x2_t); return __builtin_bit_cast(unsigned, r); }
__device__ __forceinline__ float bf_lo(unsigned u) { return __uint_as_float(u << 16); }
__device__ __forceinline__ float bf_hi(unsigned u) { return __uint_as_float(u & 0xffff0000u); }
__device__ __forceinline__ float fast_exp2(float x) { return __builtin_amdgcn_exp2f(x); }
__device__ __forceinline__ float fast_log2(float x) { return __builtin_amdgcn_logf(x); }
__device__ __forceinline__ float fast_rcp(float x) { return __builtin_amdgcn_rcpf(x); }
__device__ __forceinline__ float sigmoid_f(float x) { return fast_rcp(1.0f + fast_exp2(-x * LOG2E)); }
__device__ __forceinline__ f32x4 mfma16(bf16x8 a, bf16x8 b, f32x4 c) { return __builtin_amdgcn_mfma_f32_16x16x32_bf16(a, b, c, 0, 0, 0); }
__device__ __forceinline__ bf16x8 mk8(u32x2 lo, u32x2 hi) { u32x4 v; v.x = lo.x; v.y = lo.y; v.z = hi.x; v.w = hi.y; return __builtin_bit_cast(bf16x8, v); }
__device__ __forceinline__ float wave_sum(float v) {
#pragma unroll
    for (int o = 32; o > 0; o >>= 1) v += __shfl_xor(v, o);
    return v;
}
__device__ __forceinline__ float wave_max(float v) {
#pragma unroll
    for (int o = 32; o > 0; o >>= 1) v = fmaxf(v, __shfl_xor(v, o));
    return v;
}
__device__ __forceinline__ float wave_incl_sum(float v, int lane) {
#pragma unroll
    for (int o = 1; o < 64; o <<= 1) { float t = __shfl_up(v, o); if (lane >= o) v += t; }
    return v;
}
__device__ __forceinline__ float wave_incl_max(float v, int lane) {
#pragma unroll
    for (int o = 1; o < 64; o <<= 1) { float t = __shfl_up(v, o); if (lane >= o) v = fmaxf(v, t); }
    return v;
}

namespace pg8 {
constexpr int BM = 256, BK = 64, HALF = 128, HTB = HALF * BK * 2, STAGE_BYTES = 8 * HTB, NXCD = 8, WGM = 8;
__host__ __device__ __forceinline__ int lds_byte(int r, int c) { const int st = (r >> 4) * 2 + (c >> 5), rr = r & 15, cc = c & 31, ob = rr * 64 + cc * 2; return st * 1024 + (ob ^ (((ob >> 9) & 1) << 5)); }
__host__ __device__ __forceinline__ void stage_rc(int b, int& R, int& C) { const int st = b / 1024, sb = b % 1024, swz = sb ^ (((sb >> 9) & 1) << 5); R = (st >> 1) * 16 + swz / 64; C = (st & 1) * 32 + (swz % 64) / 2; }
__host__ __device__ __forceinline__ int perm32(int rho) { const int n = rho >> 4, i = rho & 15; return 8 * (i >> 2) + 4 * n + (i & 3); }
struct Unit { int pm, pn; };
struct Gemm { const bf16_t* A; const bf16_t* Bt; int M, N, K; };
struct StaticOrder {
    int nM, nN, nwg, G, c;
    __device__ void init(int M, int N, int G_, int c_) { nM = M / BM; nN = N / BM; nwg = nM * nN; G = G_; c = c_; }
    __device__ bool next(int i, Unit& u) const {
        const long L = (long)i * G + c; if (L >= nwg) return false;
        int wgid = (int)L; { const int q = nwg / NXCD, r = nwg % NXCD, xcd = wgid % NXCD, off = wgid / NXCD; wgid = (xcd < r ? xcd * (q + 1) : r * (q + 1) + (xcd - r) * q) + off; }
        const int nig = WGM * nN, gid = wgid / nig, fm = gid * WGM, gsz = (nM - fm) < WGM ? (nM - fm) : WGM;
        u.pm = fm + ((wgid % nig) % gsz); u.pn = (wgid % nig) / gsz; return true;
    }
};
template <class Epi, class Sched>
__device__ __forceinline__ void gemm_phase(LAS unsigned char* lds, const Gemm g, const Sched& S, const Epi& E) {
    const int tid = threadIdx.x, wid = __builtin_amdgcn_readfirstlane(tid >> 6), lane = tid & 63, wr = wid >> 2, wc = wid & 3, fr = lane & 15, fq = lane >> 4;
    const int K = g.K, nt = K / BK;
    unsigned voffA[2], voffB[2];
#pragma unroll
    for (int i = 0; i < 2; ++i) { int R, C; stage_rc(tid * 16 + i * 8192, R, C); const int Rb = ((R & ~31) + perm32(R & 31));
        voffA[i] = (unsigned)(R * K + C) * 2u; voffB[i] = (unsigned)(Rb * K + C) * 2u; }
    const size_t kstep = (size_t)(BK * 2);
    const size_t hstep = (size_t)HALF * K * 2;
    const size_t tstep = 2 * hstep;
    const unsigned ldsw = (unsigned)wid * 1024u;
    const int aoff = lds_byte(wr * 64 + fr, fq * 8), boff = lds_byte(wc * 32 + fr, fq * 8);
#define PG8_SA(b, h) (((b) * 2 + (h)) * HTB)
#define PG8_SB(b, h) ((4 + (b) * 2 + (h)) * HTB)
#define PG8_STAGE(bufoff, gbase, voff) do { _Pragma("unroll") for (int _i = 0; _i < 2; ++_i) \
        __builtin_amdgcn_global_load_lds((const unsigned*)((const char*)(gbase) + (voff)[_i]), (LAS unsigned*)(lds + (bufoff) + ldsw + _i * 8192), 16, 0, 0); } while (0)
#define PG8_LDA(dst, b, h) do { _Pragma("unroll") for (int m = 0; m < 4; ++m) _Pragma("unroll") for (int k = 0; k < 2; ++k) dst[m][k] = *(const LAS bf16x8*)(lds + PG8_SA(b, h) + aoff + m * 2048 + k * 1024); } while (0)
#define PG8_LDB(dst, b, h) do { _Pragma("unroll") for (int n = 0; n < 2; ++n) _Pragma("unroll") for (int k = 0; k < 2; ++k) dst[n][k] = *(const LAS bf16x8*)(lds + PG8_SB(b, h) + boff + n * 2048 + k * 1024); } while (0)
#define PG8_MMA(ai, bj, At, Bt) do { __builtin_amdgcn_s_setprio(1); _Pragma("unroll") for (int m = 0; m < 4; ++m) _Pragma("unroll") for (int n = 0; n < 2; ++n) _Pragma("unroll") for (int k = 0; k < 2; ++k) \
        acc[ai][bj][m][n] = __builtin_amdgcn_mfma_f32_16x16x32_bf16(Bt[n][k], At[m][k], acc[ai][bj][m][n], 0, 0, 0); __builtin_amdgcn_s_setprio(0); } while (0)
#define PG8_WAIT_V(n) asm volatile("s_waitcnt vmcnt(" #n ")" ::: "memory")
#define PG8_WAIT_L(n) asm volatile("s_waitcnt lgkmcnt(" #n ")" ::: "memory")
#define PG8_BAR __builtin_amdgcn_s_barrier()
#define PG8_SCHED __builtin_amdgcn_sched_barrier(0)
    Unit cur, nxt; int ui = 0;
    if (!S.next(0, cur)) return;
    f32x4 acc[2][2][4][2];
#pragma unroll
    for (int a = 0; a < 2; ++a)
#pragma unroll
        for (int b = 0; b < 2; ++b)
#pragma unroll
            for (int m = 0; m < 4; ++m)
#pragma unroll
                for (int n = 0; n < 2; ++n) acc[a][b][m][n] = (f32x4){0.f, 0.f, 0.f, 0.f};
    bf16x8 At[4][2], B0[2][2], B1[2][2];
    const char* cA = (const char*)g.A + (size_t)cur.pm * tstep; const char* cB = (const char*)g.Bt + (size_t)cur.pn * tstep;
    PG8_STAGE(PG8_SB(0, 0), cB, voffB); PG8_STAGE(PG8_SA(0, 0), cA, voffA); PG8_STAGE(PG8_SB(0, 1), cB + hstep, voffB); PG8_STAGE(PG8_SA(0, 1), cA + hstep, voffA);
    if (wr == 1) PG8_BAR;
    PG8_WAIT_V(4); PG8_BAR;
    PG8_STAGE(PG8_SB(1, 0), cB + kstep, voffB); PG8_STAGE(PG8_SA(1, 0), cA + kstep, voffA); PG8_STAGE(PG8_SB(1, 1), cB + hstep + kstep, voffB);
    PG8_WAIT_V(6); PG8_BAR;
    for (;;) {
        const bool has_next = S.next(ui + 1, nxt);
        const char* nA = has_next ? (const char*)g.A + (size_t)nxt.pm * tstep : cA; const char* nB = has_next ? (const char*)g.Bt + (size_t)nxt.pn * tstep : cB;
        for (int t = 0; t < nt; t += 2) {
            const bool last = (t == nt - 2);
            const char* a1 = cA + (size_t)(t + 1) * kstep;
            const char* a2 = last ? nA : cA + (size_t)(t + 2) * kstep; const char* b2 = last ? nB : cB + (size_t)(t + 2) * kstep;
            const char* a3 = a2 + kstep; const char* b3 = b2 + kstep;
            PG8_LDB(B0, 0, 0); PG8_SCHED; PG8_LDA(At, 0, 0); PG8_STAGE(PG8_SA(1, 1), a1 + hstep, voffA);
            PG8_WAIT_L(8); PG8_BAR; PG8_WAIT_L(0); PG8_MMA(0, 0, At, B0); PG8_BAR; PG8_SCHED;
            PG8_LDB(B1, 0, 1); PG8_STAGE(PG8_SB(0, 0), b2, voffB);
            PG8_BAR; PG8_WAIT_L(0); PG8_MMA(0, 1, At, B1); PG8_BAR;
            PG8_LDA(At, 0, 1); PG8_STAGE(PG8_SA(0, 0), a2, voffA);
            PG8_BAR; PG8_WAIT_L(0); PG8_MMA(1, 0, At, B0); PG8_BAR; PG8_SCHED;
            PG8_STAGE(PG8_SB(0, 1), b2 + hstep, voffB);
            PG8_WAIT_V(6); PG8_BAR; PG8_MMA(1, 1, At, B1); PG8_BAR;
            PG8_LDB(B0, 1, 0); PG8_SCHED; PG8_LDA(At, 1, 0); PG8_STAGE(PG8_SA(0, 1), a2 + hstep, voffA);
            PG8_WAIT_L(8); PG8_BAR; PG8_WAIT_L(0); PG8_MMA(0, 0, At, B0); PG8_BAR; PG8_SCHED;
            PG8_LDB(B1, 1, 1); PG8_STAGE(PG8_SB(1, 0), b3, voffB);
            PG8_BAR; PG8_WAIT_L(0); PG8_MMA(0, 1, At, B1); PG8_BAR;
            PG8_LDA(At, 1, 1); PG8_STAGE(PG8_SA(1, 0), a3, voffA);
            PG8_BAR; PG8_WAIT_L(0); PG8_MMA(1, 0, At, B0); PG8_BAR; PG8_SCHED;
            PG8_STAGE(PG8_SB(1, 1), b3 + hstep, voffB);
            PG8_WAIT_V(6); PG8_BAR; PG8_MMA(1, 1, At, B1); PG8_BAR;
        }
        E(acc, cur, wr, wc, fr, fq);
        if (!has_next) break;
#pragma unroll
        for (int a = 0; a < 2; ++a)
#pragma unroll
            for (int b = 0; b < 2; ++b)
#pragma unroll
                for (int m = 0; m < 4; ++m)
#pragma unroll
                    for (int n = 0; n < 2; ++n) acc[a][b][m][n] = (f32x4){0.f, 0.f, 0.f, 0.f};
        cur = nxt; cA = nA; cB = nB; ++ui;
    }
    PG8_WAIT_V(0);
    if (wr == 0) PG8_BAR;
    PG8_BAR;
#undef PG8_SA
#undef PG8_SB
#undef PG8_STAGE
#undef PG8_LDA
#undef PG8_LDB
#undef PG8_MMA
#undef PG8_WAIT_V
#undef PG8_WAIT_L
#undef PG8_BAR
#undef PG8_SCHED
}
}
using pg8::Unit;

#define EPI_ROWS(ai, m) (u.pm * 256 + (ai) * 128 + wr * 64 + (m) * 16 + fr)
struct EpiSwiglu {
    bf16_t* H;
    __device__ __forceinline__ void operator()(const f32x4 (&acc)[2][2][4][2], const Unit& u, int wr, int wc, int fr, int fq) const {
        const int col = u.pn * 128 + wc * 32 + 8 * fq;
#pragma unroll
        for (int ai = 0; ai < 2; ++ai)
#pragma unroll
            for (int m = 0; m < 4; ++m) {
                const size_t row = EPI_ROWS(ai, m);
                float h[8];
#pragma unroll
                for (int n = 0; n < 2; ++n)
#pragma unroll
                    for (int j = 0; j < 4; ++j) { const float g = acc[ai][0][m][n][j], uu = acc[ai][1][m][n][j]; h[4 * n + j] = g * uu * sigmoid_f(g); }
                u32x4 w; w.x = cvt_pk_bf16(h[0], h[1]); w.y = cvt_pk_bf16(h[2], h[3]); w.z = cvt_pk_bf16(h[4], h[5]); w.w = cvt_pk_bf16(h[6], h[7]);
                *(u32x4*)(H + row * FH + col) = w;
            }
    }
};
template <bool RES_BF16, bool HAS_MUL>
struct EpiResid {
    const void* res; const bf16_t* mul; float* Y; float scale;
    __device__ __forceinline__ void operator()(const f32x4 (&acc)[2][2][4][2], const Unit& u, int wr, int wc, int fr, int fq) const {
#pragma unroll
        for (int ai = 0; ai < 2; ++ai)
#pragma unroll
            for (int m = 0; m < 4; ++m) {
                const size_t row = EPI_ROWS(ai, m);
#pragma unroll
                for (int bj = 0; bj < 2; ++bj) {
                    const size_t off = row * DM + u.pn * 256 + bj * 128 + wc * 32 + 8 * fq;
                    float r[8];
                    if (RES_BF16) { const u32x4 rv = *(const u32x4*)((const bf16_t*)res + off);
                        r[0] = bf_lo(rv.x); r[1] = bf_hi(rv.x); r[2] = bf_lo(rv.y); r[3] = bf_hi(rv.y); r[4] = bf_lo(rv.z); r[5] = bf_hi(rv.z); r[6] = bf_lo(rv.w); r[7] = bf_hi(rv.w); }
                    else { const f32x4 a = *(const f32x4*)((const float*)res + off), b = *(const f32x4*)((const float*)res + off + 4);
                        r[0] = a[0]; r[1] = a[1]; r[2] = a[2]; r[3] = a[3]; r[4] = b[0]; r[5] = b[1]; r[6] = b[2]; r[7] = b[3]; }
                    float mv[8];
                    if (HAS_MUL) { const u32x4 rv = *(const u32x4*)(mul + off);
                        mv[0] = bf_lo(rv.x); mv[1] = bf_hi(rv.x); mv[2] = bf_lo(rv.y); mv[3] = bf_hi(rv.y); mv[4] = bf_lo(rv.z); mv[5] = bf_hi(rv.z); mv[6] = bf_lo(rv.w); mv[7] = bf_hi(rv.w); }
                    f32x4 o0, o1;
#pragma unroll
                    for (int j = 0; j < 4; ++j) {
                        const float a0 = acc[ai][bj][m][0][j] * scale, a1 = acc[ai][bj][m][1][j] * scale;
                        o0[j] = ALPHA * r[j] + (HAS_MUL ? mv[j] * a0 : a0); o1[j] = ALPHA * r[4 + j] + (HAS_MUL ? mv[4 + j] * a1 : a1); }
                    *(f32x4*)(Y + off) = o0; *(f32x4*)(Y + off + 4) = o1;
                }
            }
    }
};
struct EpiWin {
    bf16_t* proj; bf16_t* gates; float* ifg; const float* bias;
    __device__ __forceinline__ void operator()(const f32x4 (&acc)[2][2][4][2], const Unit& u, int wr, int wc, int fr, int fq) const {
        const int pn = u.pn;
        if (pn == 32) {
            if (wc == 0 && fq == 0) {
                const f32x4 bi = *(const f32x4*)(bias + 8192), bf = *(const f32x4*)(bias + 8196);
#pragma unroll
                for (int ai = 0; ai < 2; ++ai)
#pragma unroll
                    for (int m = 0; m < 4; ++m) {
                        const size_t row = EPI_ROWS(ai, m);
                        f32x4 iv = acc[ai][0][m][0] + bi, fv = acc[ai][0][m][1] + bf, lf;
#pragma unroll
                        for (int j = 0; j < 4; ++j) { const float xx = fv[j]; lf[j] = xx >= 0.f ? -log1pf(expf(-xx)) : xx - log1pf(expf(xx)); }
                        *(f32x4*)(ifg + row * 8) = iv; *(f32x4*)(ifg + row * 8 + 4) = lf;
                    }
            }
            return;
        }
        bf16_t* dst; int ld, c0; int act = 0; float sc = 1.0f;
        if (pn < 24) { const int sec = pn >> 2; dst = proj + (size_t)sec * ((size_t)MTOK * DM); ld = DM; c0 = (pn & 3) * 256; if (sec == 2) act = 1; if (sec == 3) sc = 0.08838834764831845f * LOG2E; }
        else { dst = gates; ld = 2 * DM; c0 = (pn - 24) * 256; act = 1; }
#pragma unroll
        for (int bj = 0; bj < 2; ++bj) {
            const int cl = bj * 128 + wc * 32 + 8 * fq;
            const f32x4 b0 = *(const f32x4*)(bias + pn * 256 + cl), b1 = *(const f32x4*)(bias + pn * 256 + cl + 4);
#pragma unroll
            for (int ai = 0; ai < 2; ++ai)
#pragma unroll
                for (int m = 0; m < 4; ++m) {
                    const size_t row = EPI_ROWS(ai, m);
                    f32x4 v0 = acc[ai][bj][m][0] + b0, v1 = acc[ai][bj][m][1] + b1;
                    if (act) {
#pragma unroll
                        for (int j = 0; j < 4; ++j) { v0[j] = sigmoid_f(v0[j]); v1[j] = sigmoid_f(v1[j]); } }
                    else { v0 *= sc; v1 *= sc; }
                    u32x4 w; w.x = cvt_pk_bf16(v0[0], v0[1]); w.y = cvt_pk_bf16(v0[2], v0[3]); w.z = cvt_pk_bf16(v1[0], v1[1]); w.w = cvt_pk_bf16(v1[2], v1[3]);
                    *(u32x4*)(dst + row * ld + c0 + cl) = w;
                }
        }
    }
};
template <bool ADD>
struct EpiGateMul {
    const bf16_t* gate; int goff; const bf16_t* tin; bf16_t* out;
    __device__ __forceinline__ void operator()(const f32x4 (&acc)[2][2][4][2], const Unit& u, int wr, int wc, int fr, int fq) const {
#pragma unroll
        for (int ai = 0; ai < 2; ++ai)
#pragma unroll
            for (int m = 0; m < 4; ++m) {
                const size_t row = EPI_ROWS(ai, m);
#pragma unroll
                for (int bj = 0; bj < 2; ++bj) {
                    const int c = u.pn * 256 + bj * 128 + wc * 32 + 8 * fq;
                    const u32x4 gv = *(const u32x4*)(gate + row * (2 * DM) + goff + c);
                    float gg[8] = {bf_lo(gv.x), bf_hi(gv.x), bf_lo(gv.y), bf_hi(gv.y), bf_lo(gv.z), bf_hi(gv.z), bf_lo(gv.w), bf_hi(gv.w)};
                    float tt[8] = {0.f, 0.f, 0.f, 0.f, 0.f, 0.f, 0.f, 0.f};
                    if (ADD) { const u32x4 tv = *(const u32x4*)(tin + row * DM + c);
                        tt[0] = bf_lo(tv.x); tt[1] = bf_hi(tv.x); tt[2] = bf_lo(tv.y); tt[3] = bf_hi(tv.y); tt[4] = bf_lo(tv.z); tt[5] = bf_hi(tv.z); tt[6] = bf_lo(tv.w); tt[7] = bf_hi(tv.w); }
                    float o[8];
#pragma unroll
                    for (int j = 0; j < 4; ++j) { o[j] = tt[j] + gg[j] * acc[ai][bj][m][0][j]; o[4 + j] = tt[4 + j] + gg[4 + j] * acc[ai][bj][m][1][j]; }
                    u32x4 w; w.x = cvt_pk_bf16(o[0], o[1]); w.y = cvt_pk_bf16(o[2], o[3]); w.z = cvt_pk_bf16(o[4], o[5]); w.w = cvt_pk_bf16(o[6], o[7]);
                    *(u32x4*)(out + row * DM + c) = w;
                }
            }
    }
};
struct EpiSigBias {
    const float* bias; bf16_t* out;
    __device__ __forceinline__ void operator()(const f32x4 (&acc)[2][2][4][2], const Unit& u, int wr, int wc, int fr, int fq) const {
#pragma unroll
        for (int bj = 0; bj < 2; ++bj) {
            const int c = u.pn * 256 + bj * 128 + wc * 32 + 8 * fq;
            const f32x4 b0 = *(const f32x4*)(bias + c), b1 = *(const f32x4*)(bias + c + 4);
#pragma unroll
            for (int ai = 0; ai < 2; ++ai)
#pragma unroll
                for (int m = 0; m < 4; ++m) {
                    const size_t row = EPI_ROWS(ai, m);
                    f32x4 v0 = acc[ai][bj][m][0] + b0, v1 = acc[ai][bj][m][1] + b1;
#pragma unroll
                    for (int j = 0; j < 4; ++j) { v0[j] = sigmoid_f(v0[j]); v1[j] = sigmoid_f(v1[j]); }
                    u32x4 w; w.x = cvt_pk_bf16(v0[0], v0[1]); w.y = cvt_pk_bf16(v0[2], v0[3]); w.z = cvt_pk_bf16(v1[0], v1[1]); w.w = cvt_pk_bf16(v1[2], v1[3]);
                    *(u32x4*)(out + row * DM + c) = w;
                }
        }
    }
};

struct Params {
    const float *x, *p, *ln_g, *ln_b, *wg, *wu, *wd, *w_in, *b_in, *b_forget, *conv_w, *conv_b, *mh_g, *w_a, *w_b, *w_o, *w_ple, *w_pg, *b_pg;
    float* out; unsigned char* ws;
    int ph_lo, ph_hi, coop, pad;
};

__device__ void cvt_bf16_phase(const float* src, bf16_t* dst, size_t n8) {
    const size_t stride = (size_t)gridDim.x * NTHREADS;
    for (size_t i = (size_t)blockIdx.x * NTHREADS + threadIdx.x; i < n8; i += stride) {
        const f32x4 a = *(const f32x4*)(src + i * 8), b = *(const f32x4*)(src + i * 8 + 4);
        u32x4 w; w.x = cvt_pk_bf16(a[0], a[1]); w.y = cvt_pk_bf16(a[2], a[3]); w.z = cvt_pk_bf16(b[0], b[1]); w.w = cvt_pk_bf16(b[2], b[3]);
        *(u32x4*)(dst + i * 8) = w;
    }
}
template <int MODE>
__device__ __forceinline__ float tsrc_val(const float* w0, const float* w1, int ldn, int k, int n) {
    if (MODE == 0) return w0[(size_t)k * ldn + n];
    if (MODE == 1) { const int pn = n >> 8, sel = (n >> 7) & 1, i = n & 127; const float* w = sel ? w1 : w0; return w[(size_t)k * ldn + pn * 128 + i]; }
    int col; if (n < 3072) col = n; else if (n < 8192) col = n + 8; else if (n < 8200) col = 3072 + (n - 8192); else return 0.f;
    return w0[(size_t)k * ldn + col];
}
template <int MODE>
__device__ __forceinline__ void transpose_mat(LAS float* tile, const float* w0, const float* w1, int ldn, bf16_t* dst, int NP, int K, int& base) {
    const int tid = threadIdx.x;
    const int tn = NP / 128, tk = K / 128, nt = tn * tk;
    int first = ((int)blockIdx.x - base) % (int)gridDim.x; if (first < 0) first += gridDim.x;
    for (int t = first; t < nt; t += gridDim.x) {
        const int n0 = (t / tk) * 128, k0 = (t % tk) * 128;
#pragma unroll 8
        for (int e = 0; e < 32; ++e) { const int idx = e * NTHREADS + tid, kk = idx >> 7, nn = idx & 127; tile[kk * 129 + nn] = tsrc_val<MODE>(w0, w1, ldn, k0 + kk, n0 + nn); }
        __syncthreads();
#pragma unroll 8
        for (int e = 0; e < 16; ++e) { const int idx = e * NTHREADS + tid, nn = idx >> 6, kk = (idx & 63) * 2;
            *(unsigned*)(dst + (size_t)(n0 + nn) * K + k0 + kk) = cvt_pk_bf16(tile[kk * 129 + nn], tile[(kk + 1) * 129 + nn]); }
        __syncthreads();
    }
    base += nt;
}
__device__ void prep_phase(const Params& P, LAS unsigned char* lds) {
    unsigned char* ws = P.ws;
    cvt_bf16_phase(P.x, (bf16_t*)(ws + WS_X), (size_t)MTOK * DM / 8);
    if (blockIdx.x == 0 && threadIdx.x < 64) ((unsigned*)(ws + MISC_CNT))[threadIdx.x] = 0u;
    for (int n = blockIdx.x * NTHREADS + threadIdx.x; n < NIN_PAD; n += gridDim.x * NTHREADS) {
        float b;
        if (n < 3072) b = P.b_in[n]; else if (n < 8192) b = P.b_in[n + 8]; else if (n < 8196) b = P.b_in[3072 + n - 8192];
        else if (n < 8200) b = P.b_in[3072 + n - 8192] + P.b_forget[n - 8196]; else b = 0.f;
        ((float*)(ws + W_BIAS))[n] = b;
    }
    LAS float* tile = (LAS float*)lds;
    int base = 0;
    transpose_mat<1>(tile, P.wg, P.wu, FH, (bf16_t*)(ws + W_GU1), 5632, 1024, base);
    transpose_mat<0>(tile, P.wd, nullptr, DM, (bf16_t*)(ws + W_D1), 1024, FH, base);
    transpose_mat<1>(tile, P.wg + (size_t)DM * FH, P.wu + (size_t)DM * FH, FH, (bf16_t*)(ws + W_GU2), 5632, 1024, base);
    transpose_mat<0>(tile, P.wd + (size_t)DM * FH, nullptr, DM, (bf16_t*)(ws + W_D2), 1024, FH, base);
    transpose_mat<2>(tile, P.w_in, nullptr, 8200, (bf16_t*)(ws + W_IN), NIN_PAD, 1024, base);
    transpose_mat<0>(tile, P.w_a, nullptr, DM, (bf16_t*)(ws + W_A), 1024, 1024, base);
    transpose_mat<0>(tile, P.w_b, nullptr, DM, (bf16_t*)(ws + W_B), 1024, 1024, base);
    transpose_mat<0>(tile, P.w_o, nullptr, DM, (bf16_t*)(ws + W_O), 1024, 1024, base);
    transpose_mat<0>(tile, P.w_pg, nullptr, DM, (bf16_t*)(ws + W_PG), 1024, 1024, base);
    transpose_mat<0>(tile, P.w_ple, nullptr, DM, (bf16_t*)(ws + W_P), 1024, 256, base);
}
template <bool OUT_BF16>
__device__ void ln_phase(const float* Y, const float* g, const float* b, void* out) {
    const int wid = threadIdx.x >> 6, lane = threadIdx.x & 63;
    f32x4 gv[4], bv[4];
#pragma unroll
    for (int i = 0; i < 4; ++i) { gv[i] = *(const f32x4*)(g + i * 256 + lane * 4); bv[i] = *(const f32x4*)(b + i * 256 + lane * 4); }
    for (int row0 = (blockIdx.x * 8 + wid) * 2; row0 < MTOK; row0 += gridDim.x * 16) {
        f32x4 v[2][4]; float s[2] = {0.f, 0.f};
#pragma unroll
        for (int r = 0; r < 2; ++r)
#pragma unroll
            for (int i = 0; i < 4; ++i) v[r][i] = *(const f32x4*)(Y + (size_t)(row0 + r) * DM + i * 256 + lane * 4);
#pragma unroll
        for (int r = 0; r < 2; ++r) {
#pragma unroll
            for (int i = 0; i < 4; ++i) s[r] += (v[r][i][0] + v[r][i][1]) + (v[r][i][2] + v[r][i][3]);
            const float mean = wave_sum(s[r]) * (1.0f / DM);
            float q = 0.f;
#pragma unroll
            for (int i = 0; i < 4; ++i) { const f32x4 d = v[r][i] - mean; q += (d[0] * d[0] + d[1] * d[1]) + (d[2] * d[2] + d[3] * d[3]); }
            const float rstd = rsqrtf(wave_sum(q) * (1.0f / DM) + LN_EPS);
#pragma unroll
            for (int i = 0; i < 4; ++i) {
                const f32x4 o = (v[r][i] - mean) * rstd * gv[i] + bv[i];
                if (OUT_BF16) { u32x2 w; w.x = cvt_pk_bf16(o[0], o[1]); w.y = cvt_pk_bf16(o[2], o[3]); *(u32x2*)((bf16_t*)out + (size_t)(row0 + r) * DM + i * 256 + lane * 4) = w; }
                else *(f32x4*)((float*)out + (size_t)(row0 + r) * DM + i * 256 + lane * 4) = o;
            }
        }
    }
}

constexpr int L_QI = 0, L_KI = 17408, L_KT = 34816, L_VT = 53248, L_PI = 90112, L_F = 99328;
constexpr int F_N = 0, F_QN = 128, F_RS = 192, F_HS = 320, F_BL = 1344, F_GM = 1472, F_M = 1600, F_CW = 1732, F_SA = 3012, F_SB2 = 3028, F_SMU = 4052, F_SWI = 5076, F_SWN = 6100, F_SEM = 7124, F_END = 8148;
constexpr int MIX_LDS = L_F + F_END * 4;

__device__ void mlstm_prologue(const Params& P, LAS unsigned char* lds, int b, int h, int gi) {
    LAS float* F = (LAS float*)(lds + L_F);
    const float* ifg = (const float*)(P.ws + MISC_IF);
    const int tid = threadIdx.x, w = tid >> 6, lane = tid & 63;
    const int nch = 16 * (gi + 1);
    for (int c = w; c < nch; c += 8) {
        const size_t tok = (size_t)b * SEQ + c * 64 + lane;
        const float iv = ifg[tok * 8 + h], lf = ifg[tok * 8 + 4 + h];
        const float bc = wave_incl_sum(lf, lane);
        const float bl = __shfl(bc, 63);
        const float gm = wave_max(bl - bc + iv);
        if (lane == 0) { F[F_BL + c] = bl; F[F_GM + c] = gm; }
    }
    for (int i = tid; i < 1280; i += NTHREADS) {
        const int j = i >> 8, ch = i & 255; const int gc = ch < 128 ? h * 128 + ch : 512 + h * 128 + (ch - 128);
        F[F_CW + i] = j < 4 ? P.conv_w[j * 1024 + gc] : P.conv_b[gc];
    }
    if (tid < 128) F[F_N + tid] = 0.f;
    __syncthreads();
    if (tid == 0) { float m = 0.f; F[F_M] = 0.f; for (int c = 0; c < nch; ++c) { m = fmaxf(F[F_BL + c] + m, F[F_GM + c]); F[F_M + c + 1] = m; } }
    __syncthreads();
    for (int lc = w; lc < 16; lc += 8) {
        const int c = gi * 16 + lc;
        const size_t tok = (size_t)b * SEQ + c * 64 + lane;
        const float iv = ifg[tok * 8 + h], lf = ifg[tok * 8 + 4 + h];
        const float bc = wave_incl_sum(lf, lane);
        const float bl = __shfl(bc, 63);
        const float mst = F[F_M + c], mnew = F[F_M + c + 1];
        const float beta = iv - bc;
        const float mu = fmaxf(mst, wave_incl_max(beta, lane));
        F[F_SB2 + lc * 64 + lane] = beta * LOG2E;
        F[F_SMU + lc * 64 + lane] = mu * LOG2E;
        F[F_SWI + lc * 64 + lane] = expf(mst - mu);
        F[F_SWN + lc * 64 + lane] = expf(bl - bc + iv - mnew);
        F[F_SEM + lc * 64 + lane] = expf(-(bc + mu));
        if (lane == 0) F[F_SA + lc] = expf(bl + mst - mnew);
    }
    __syncthreads();
}

template <bool NEED_Q>
__device__ __forceinline__ void mlstm_load(const Params& P, LAS unsigned char* lds, int b, int h, int c, int lc) {
    LAS float* F = (LAS float*)(lds + L_F);
    const bf16_t* QK = (const bf16_t*)(P.ws + WS_QK);
    const bf16_t* VA = (const bf16_t*)(P.ws + WS_VA);
    const int tid = threadIdx.x, tg = tid & 15, cg = tid >> 4;
    {
        u32x4 vr[4];
#pragma unroll
        for (int tt = 0; tt < 4; ++tt) vr[tt] = *(const u32x4*)(VA + ((size_t)b * SEQ + c * 64 + 4 * tg + tt) * DM + h * 256 + 8 * cg);
#pragma unroll
        for (int e = 0; e < 8; ++e) {
            unsigned short x0, x1, x2, x3;
            { const unsigned a0 = vr[0][e >> 1], a1 = vr[1][e >> 1], a2 = vr[2][e >> 1], a3 = vr[3][e >> 1];
              if (e & 1) { x0 = a0 >> 16; x1 = a1 >> 16; x2 = a2 >> 16; x3 = a3 >> 16; } else { x0 = a0 & 0xffff; x1 = a1 & 0xffff; x2 = a2 & 0xffff; x3 = a3 & 0xffff; } }
            u32x2 wv; wv.x = (unsigned)x0 | ((unsigned)x1 << 16); wv.y = (unsigned)x2 | ((unsigned)x3 << 16);
            *(LAS u32x2*)(lds + L_VT + (8 * cg + e) * 144 + 8 * tg) = wv;
        }
    }
    __builtin_amdgcn_sched_barrier(0);
    if (NEED_Q || cg >= 16) {
        const int gc = cg < 16 ? h * 128 + 8 * cg : 512 + h * 128 + 8 * (cg - 16);
        u32x4 raw[7];
#pragma unroll
        for (int i = 0; i < 7; ++i) {
            const int pos = c * 64 + 4 * tg - 3 + i;
            raw[i] = pos >= 0 ? *(const u32x4*)(QK + ((size_t)b * SEQ + pos) * DM + gc) : (u32x4){0u, 0u, 0u, 0u};
        }
        float o[4][8];
#pragma unroll
        for (int e = 0; e < 8; ++e) {
            float rv[7];
#pragma unroll
            for (int i = 0; i < 7; ++i) rv[i] = (e & 1) ? bf_hi(raw[i][e >> 1]) : bf_lo(raw[i][e >> 1]);
            const float w0 = F[F_CW + 0 * 256 + 8 * cg + e], w1 = F[F_CW + 1 * 256 + 8 * cg + e], w2 = F[F_CW + 2 * 256 + 8 * cg + e], w3 = F[F_CW + 3 * 256 + 8 * cg + e], cb = F[F_CW + 4 * 256 + 8 * cg + e];
#pragma unroll
            for (int tt = 0; tt < 4; ++tt) { const float v = cb + w0 * rv[tt] + w1 * rv[tt + 1] + w2 * rv[tt + 2] + w3 * rv[tt + 3]; o[tt][e] = v * sigmoid_f(v); }
            __builtin_amdgcn_sched_barrier(0);
        }
        if (cg < 16) {
#pragma unroll
            for (int tt = 0; tt < 4; ++tt) { u32x4 wv; wv.x = cvt_pk_bf16(o[tt][0], o[tt][1]); wv.y = cvt_pk_bf16(o[tt][2], o[tt][3]); wv.z = cvt_pk_bf16(o[tt][4], o[tt][5]); wv.w = cvt_pk_bf16(o[tt][6], o[tt][7]);
                *(LAS u32x4*)(lds + L_QI + (4 * tg + tt) * 272 + 16 * cg) = wv; }
        } else {
            const int kc = cg - 16;
            const f32x4 wn = *(const LAS f32x4*)(F + F_SWN + lc * 64 + 4 * tg);
#pragma unroll
            for (int tt = 0; tt < 4; ++tt) {
#pragma unroll
                for (int e = 0; e < 8; ++e) o[tt][e] *= 0.08838834764831845f;
                u32x4 wv; wv.x = cvt_pk_bf16(o[tt][0], o[tt][1]); wv.y = cvt_pk_bf16(o[tt][2], o[tt][3]); wv.z = cvt_pk_bf16(o[tt][4], o[tt][5]); wv.w = cvt_pk_bf16(o[tt][6], o[tt][7]);
                *(LAS u32x4*)(lds + L_KI + (4 * tg + tt) * 272 + 16 * kc) = wv; }
#pragma unroll
            for (int e = 0; e < 8; ++e) { u32x2 wv; wv.x = cvt_pk_bf16(o[0][e] * wn[0], o[1][e] * wn[1]); wv.y = cvt_pk_bf16(o[2][e] * wn[2], o[3][e] * wn[3]);
                *(LAS u32x2*)(lds + L_KT + (8 * kc + e) * 144 + 8 * tg) = wv; }
        }
    }
}

__device__ __forceinline__ void mlstm_update(LAS unsigned char* lds, f32x4 (&C)[2][8], int lc, int w, int r, int g) {
    LAS float* F = (LAS float*)(lds + L_F);
    const float a = F[F_SA + lc];
    const LAS unsigned char* vp = lds + (L_VT + (32 * w + r) * 144 + 16 * g);
    const LAS unsigned char* kp = lds + (L_KT + r * 144 + 16 * g);
#pragma unroll
    for (int dvb = 0; dvb < 2; ++dvb)
#pragma unroll
        for (int dkb = 0; dkb < 8; ++dkb) C[dvb][dkb] *= a;
#pragma unroll
    for (int ks = 0; ks < 2; ++ks) {
        bf16x8 vf[2];
#pragma unroll
        for (int dvb = 0; dvb < 2; ++dvb) vf[dvb] = *(const LAS bf16x8*)(vp + (16 * dvb * 144 + 64 * ks));
#pragma unroll
        for (int dkb = 0; dkb < 8; ++dkb) {
            const bf16x8 kf = *(const LAS bf16x8*)(kp + (16 * dkb * 144 + 64 * ks));
#pragma unroll
            for (int dvb = 0; dvb < 2; ++dvb) C[dvb][dkb] = mfma16(kf, vf[dvb], C[dvb][dkb]);
        }
        __builtin_amdgcn_sched_barrier(0);
    }
    const int tid = threadIdx.x, dk = tid >> 2, part = tid & 3;
    const u32x4 k0 = *(const LAS u32x4*)(lds + L_KT + dk * 144 + 32 * part), k1 = *(const LAS u32x4*)(lds + L_KT + dk * 144 + 32 * part + 16);
    float s = 0.f;
#pragma unroll
    for (int i = 0; i < 4; ++i) s += bf_lo(k0[i]) + bf_hi(k0[i]) + bf_lo(k1[i]) + bf_hi(k1[i]);
    s += __shfl_xor(s, 1); s += __shfl_xor(s, 2);
    if (part == 0) F[F_N + dk] = a * F[F_N + dk] + s;
}

__device__ void mlstm_phase1(const Params& P, LAS unsigned char* lds) {
    const int tid = threadIdx.x, w = tid >> 6, lane = tid & 63, r = lane & 15, g = lane >> 4;
    LAS float* F = (LAS float*)(lds + L_F);
    for (int task = blockIdx.x; task < 256; task += gridDim.x) {
        const int gi = task & 7, st = task >> 3, b = st >> 2, h = st & 3;
        if (gi == 7) continue;
        mlstm_prologue(P, lds, b, h, gi);
        f32x4 C[2][8];
#pragma unroll
        for (int i = 0; i < 2; ++i)
#pragma unroll
            for (int j = 0; j < 8; ++j) C[i][j] = (f32x4){0.f, 0.f, 0.f, 0.f};
        for (int lc = 0; lc < 16; ++lc) {
            mlstm_load<false>(P, lds, b, h, gi * 16 + lc, lc);
            __syncthreads();
            mlstm_update(lds, C, lc, w, r, g);
            __syncthreads();
        }
        float* slot = (float*)(P.ws + WS_PB) + (size_t)(st * 7 + gi) * STATE_FLOATS;
#pragma unroll
        for (int dvb = 0; dvb < 2; ++dvb)
#pragma unroll
            for (int dkb = 0; dkb < 8; ++dkb) *(f32x4*)(slot + (((w * 2 + dvb) * 8 + dkb) * 64 + lane) * 4) = C[dvb][dkb];
        if (tid < 128) slot[32768 + tid] = F[F_N + tid];
        __syncthreads();
    }
}

__device__ void mlstm_phase2(const Params& P, LAS unsigned char* lds) {
    const int tid = threadIdx.x, w = tid >> 6, lane = tid & 63, r = lane & 15, g = lane >> 4;
    LAS float* F = (LAS float*)(lds + L_F);
    const bf16_t* OA = (const bf16_t*)(P.ws + WS_OA);
    bf16_t* VA = (bf16_t*)(P.ws + WS_VA);
    for (int task = blockIdx.x; task < 256; task += gridDim.x) {
        const int gi = task & 7, st = task >> 3, b = st >> 2, h = st & 3;
        mlstm_prologue(P, lds, b, h, gi);
        f32x4 C[2][8];
#pragma unroll
        for (int i = 0; i < 2; ++i)
#pragma unroll
            for (int j = 0; j < 8; ++j) C[i][j] = (f32x4){0.f, 0.f, 0.f, 0.f};
        float nreg = 0.f;
        for (int j = 0; j < gi; ++j) {
            float Bj = 0.f;
            for (int c = 0; c < 16; ++c) Bj += F[F_BL + j * 16 + c];
            const float Aj = expf(Bj + F[F_M + 16 * j] - F[F_M + 16 * j + 16]);
            const float* slot = (const float*)(P.ws + WS_PB) + (size_t)(st * 7 + j) * STATE_FLOATS;
#pragma unroll
            for (int dvb = 0; dvb < 2; ++dvb)
#pragma unroll
                for (int dkb = 0; dkb < 8; ++dkb) C[dvb][dkb] = C[dvb][dkb] * Aj + *(const f32x4*)(slot + (((w * 2 + dvb) * 8 + dkb) * 64 + lane) * 4);
            if (tid < 128) nreg = nreg * Aj + slot[32768 + tid];
        }
        if (tid < 128) F[F_N + tid] = nreg;
        __syncthreads();
        for (int lc = 0; lc < 16; ++lc) {
            const int c = gi * 16 + lc;
            mlstm_load<true>(P, lds, b, h, c, lc);
            __syncthreads();
            {
                const int tb = w >> 1, par = w & 1;
                const LAS unsigned char* qpS = lds + (L_QI + (16 * tb + r) * 272 + 16 * g);
                const LAS unsigned char* kpS = lds + (L_KI + (16 * par + r) * 272 + 16 * g);
                LAS unsigned char* ppS = lds + (L_PI + (16 * tb + r) * 144 + 32 * par + 8 * g);
                bf16x8 qf[4];
#pragma unroll
                for (int kd = 0; kd < 4; ++kd) qf[kd] = *(const LAS bf16x8*)(qpS + 64 * kd);
                const float mu2 = F[F_SMU + lc * 64 + 16 * tb + r];
                float rs = 0.f;
#pragma unroll
                for (int sbi = 0; sbi < 2; ++sbi) {
                    const int sb = par + 2 * sbi;
                    u32x2 pw = (u32x2){0u, 0u};
                    if (sb <= tb) {
                        f32x4 acc = (f32x4){0.f, 0.f, 0.f, 0.f};
#pragma unroll
                        for (int kd = 0; kd < 4; ++kd) { const bf16x8 kf = *(const LAS bf16x8*)(kpS + (32 * sbi * 272 + 64 * kd)); acc = mfma16(kf, qf[kd], acc); }
                        const f32x4 b2 = *(const LAS f32x4*)(F + F_SB2 + lc * 64 + 16 * sb + 4 * g);
                        float pv[4];
#pragma unroll
                        for (int j = 0; j < 4; ++j) { const int s = 16 * sb + 4 * g + j, t = 16 * tb + r; pv[j] = (s <= t) ? acc[j] * fast_exp2(b2[j] - mu2) : 0.f; }
                        pw.x = cvt_pk_bf16(pv[0], pv[1]); pw.y = cvt_pk_bf16(pv[2], pv[3]);
                        rs += bf_lo(pw.x) + bf_hi(pw.x) + bf_lo(pw.y) + bf_hi(pw.y);
                    }
                    *(LAS u32x2*)(ppS + 64 * sbi) = pw;
                }
                rs += __shfl_xor(rs, 16); rs += __shfl_xor(rs, 32);
                if (g == 0) F[F_RS + par * 64 + 16 * tb + r] = rs;
            }
            __builtin_amdgcn_sched_barrier(0);
            const LAS unsigned char* q8p = lds + (L_QI + r * 272 + 8 * g);
            f32x4 num[2][4];
#pragma unroll
            for (int i = 0; i < 2; ++i)
#pragma unroll
                for (int j = 0; j < 4; ++j) num[i][j] = (f32x4){0.f, 0.f, 0.f, 0.f};
#pragma unroll
            for (int kk = 0; kk < 4; ++kk) {
                bf16x8 af[2];
#pragma unroll
                for (int dvb = 0; dvb < 2; ++dvb) {
                    u32x2 lo, hi; lo.x = cvt_pk_bf16(C[dvb][2 * kk][0], C[dvb][2 * kk][1]); lo.y = cvt_pk_bf16(C[dvb][2 * kk][2], C[dvb][2 * kk][3]);
                    hi.x = cvt_pk_bf16(C[dvb][2 * kk + 1][0], C[dvb][2 * kk + 1][1]); hi.y = cvt_pk_bf16(C[dvb][2 * kk + 1][2], C[dvb][2 * kk + 1][3]);
                    af[dvb] = mk8(lo, hi);
                }
#pragma unroll
                for (int tb = 0; tb < 4; ++tb) {
                    const u32x2 q0 = *(const LAS u32x2*)(q8p + (16 * tb * 272 + 64 * kk)), q1 = *(const LAS u32x2*)(q8p + (16 * tb * 272 + 64 * kk + 32));
                    const bf16x8 bq = mk8(q0, q1);
#pragma unroll
                    for (int dvb = 0; dvb < 2; ++dvb) num[dvb][tb] = mfma16(af[dvb], bq, num[dvb][tb]);
                }
                __builtin_amdgcn_sched_barrier(0);
            }
#pragma unroll
            for (int tb = 0; tb < 4; ++tb) { const float wi = F[F_SWI + lc * 64 + 16 * tb + r];
#pragma unroll
                for (int dvb = 0; dvb < 2; ++dvb) num[dvb][tb] *= wi; }
            {
                const int t = tid >> 3, part = tid & 7;
                const u32x4 q0 = *(const LAS u32x4*)(lds + L_QI + t * 272 + 32 * part), q1 = *(const LAS u32x4*)(lds + L_QI + t * 272 + 32 * part + 16);
                float s = 0.f;
#pragma unroll
                for (int i = 0; i < 4; ++i) {
                    s += bf_lo(q0[i]) * F[F_N + 16 * part + 2 * i] + bf_hi(q0[i]) * F[F_N + 16 * part + 2 * i + 1];
                    s += bf_lo(q1[i]) * F[F_N + 16 * part + 8 + 2 * i] + bf_hi(q1[i]) * F[F_N + 16 * part + 8 + 2 * i + 1];
                }
                s += __shfl_xor(s, 1); s += __shfl_xor(s, 2); s += __shfl_xor(s, 4);
                if (part == 0) F[F_QN + t] = s;
            }
            __builtin_amdgcn_sched_barrier(0);
            __syncthreads();
            const LAS unsigned char* vpC = lds + (L_VT + (32 * w + r) * 144 + 16 * g);
            const LAS unsigned char* ppC = lds + (L_PI + r * 144 + 16 * g);
#pragma unroll
            for (int ks = 0; ks < 2; ++ks) {
                bf16x8 vf[2];
#pragma unroll
                for (int dvb = 0; dvb < 2; ++dvb) vf[dvb] = *(const LAS bf16x8*)(vpC + (16 * dvb * 144 + 64 * ks));
#pragma unroll
                for (int tb = 0; tb < 4; ++tb) {
                    if (ks == 0 || tb >= 2) {
                        const bf16x8 pb = *(const LAS bf16x8*)(ppC + (16 * tb * 144 + 64 * ks));
#pragma unroll
                        for (int dvb = 0; dvb < 2; ++dvb) num[dvb][tb] = mfma16(vf[dvb], pb, num[dvb][tb]);
                    }
                }
                __builtin_amdgcn_sched_barrier(0);
            }
#pragma unroll
            for (int tb = 0; tb < 4; ++tb) {
                const int t = 16 * tb + r;
                const float den = F[F_SWI + lc * 64 + t] * F[F_QN + t] + F[F_RS + t] + F[F_RS + 64 + t];
                const float inv = 1.0f / fmaxf(fabsf(den), F[F_SEM + lc * 64 + t]);
                float s1 = 0.f, s2 = 0.f;
#pragma unroll
                for (int dvb = 0; dvb < 2; ++dvb) { num[dvb][tb] *= inv;
#pragma unroll
                    for (int j = 0; j < 4; ++j) { const float v = num[dvb][tb][j]; s1 += v; s2 += v * v; } }
                s1 += __shfl_xor(s1, 16); s1 += __shfl_xor(s1, 32); s2 += __shfl_xor(s2, 16); s2 += __shfl_xor(s2, 32);
                if (g == 0) { F[F_HS + (w * 64 + t) * 2] = s1; F[F_HS + (w * 64 + t) * 2 + 1] = s2; }
                __builtin_amdgcn_sched_barrier(0);
            }
            mlstm_update(lds, C, lc, w, r, g);
            __builtin_amdgcn_sched_barrier(0);
            __syncthreads();
#pragma unroll
            for (int tb = 0; tb < 4; ++tb) {
                const int t = 16 * tb + r;
                float s1 = 0.f, s2 = 0.f;
#pragma unroll
                for (int ww = 0; ww < 8; ++ww) { s1 += F[F_HS + (ww * 64 + t) * 2]; s2 += F[F_HS + (ww * 64 + t) * 2 + 1]; }
                const float mean = s1 * (1.0f / 256.0f), var = fmaxf(s2 * (1.0f / 256.0f) - mean * mean, 0.f), rstd = rsqrtf(var + LN_EPS);
                const size_t tok = (size_t)b * SEQ + c * 64 + t;
#pragma unroll
                for (int dvb = 0; dvb < 2; ++dvb) {
                    const int dv0 = 32 * w + 16 * dvb + 4 * g;
                    const f32x4 gn = *(const f32x4*)(P.mh_g + h * 256 + dv0);
                    const u32x2 og = *(const u32x2*)(OA + tok * DM + h * 256 + dv0);
                    const float y0 = (num[dvb][tb][0] - mean) * rstd * gn[0] * bf_lo(og.x), y1 = (num[dvb][tb][1] - mean) * rstd * gn[1] * bf_hi(og.x);
                    const float y2 = (num[dvb][tb][2] - mean) * rstd * gn[2] * bf_lo(og.y), y3 = (num[dvb][tb][3] - mean) * rstd * gn[3] * bf_hi(og.y);
                    u32x2 wv; wv.x = cvt_pk_bf16(y0, y1); wv.y = cvt_pk_bf16(y2, y3);
                    *(u32x2*)(VA + tok * DM + h * 256 + dv0) = wv;
                }
            }
        }
        __syncthreads();
    }
}

constexpr int A_KI = 0, A_VT = 17408, A_FL = 35840;
constexpr float SB_DONE_LOG2 = -40.0f;

__device__ void attn_phase(const Params& P, LAS unsigned char* lds) {
    const int tid = threadIdx.x, w = tid >> 6, lane = tid & 63, r = lane & 15, g = lane >> 4;
    bf16_t* QB = (bf16_t*)(P.ws + WS_QB);
    const bf16_t* KB = (const bf16_t*)(P.ws + WS_KB);
    const bf16_t* VB = (const bf16_t*)(P.ws + WS_VB);
    unsigned* cnt = (unsigned*)(P.ws + MISC_CNT);
    LAS int* FL = (LAS int*)(lds + A_FL);
    for (;;) {
        if (tid == 0) FL[32] = (int)atomicAdd(cnt, 1u);
        __syncthreads();
        const int item = FL[32];
        __syncthreads();
        if (item >= 4096) break;
        const int qb = 63 - (item >> 6), b = (item >> 3) & 7, h = item & 7;
        const int q0w = qb * 128 + 16 * w;
        const size_t qtok = (size_t)b * SEQ + q0w + r;
        bf16x8 qf[4];
#pragma unroll
        for (int kd = 0; kd < 4; ++kd) qf[kd] = *(const bf16x8*)(QB + qtok * DM + h * 128 + 32 * kd + 8 * g);
        f32x4 O[8];
#pragma unroll
        for (int i = 0; i < 8; ++i) O[i] = (f32x4){0.f, 0.f, 0.f, 0.f};
        float R = 0.f;
        int wdone = 0, it = 0;
        for (int kt = 2 * qb + 1; kt >= 0; --kt, ++it) {
            if (tid < 256) {
                const int tg = tid & 15, cg = tid >> 4;
                u32x4 vr[4];
#pragma unroll
                for (int tt = 0; tt < 4; ++tt) vr[tt] = *(const u32x4*)(VB + ((size_t)b * SEQ + kt * 64 + 4 * tg + tt) * DM + h * 128 + 8 * cg);
#pragma unroll
                for (int e = 0; e < 8; ++e) {
                    unsigned short x0, x1, x2, x3;
                    { const unsigned a0 = vr[0][e >> 1], a1 = vr[1][e >> 1], a2 = vr[2][e >> 1], a3 = vr[3][e >> 1];
                      if (e & 1) { x0 = a0 >> 16; x1 = a1 >> 16; x2 = a2 >> 16; x3 = a3 >> 16; } else { x0 = a0 & 0xffff; x1 = a1 & 0xffff; x2 = a2 & 0xffff; x3 = a3 & 0xffff; } }
                    u32x2 wv; wv.x = (unsigned)x0 | ((unsigned)x1 << 16); wv.y = (unsigned)x2 | ((unsigned)x3 << 16);
                    *(LAS u32x2*)(lds + A_VT + (8 * cg + e) * 144 + 8 * tg) = wv;
                }
            } else {
                const int t2 = tid - 256, row = t2 >> 2, ch = t2 & 3;
                const bf16_t* src = KB + ((size_t)b * SEQ + kt * 64 + row) * DM + h * 128 + 32 * ch;
#pragma unroll
                for (int i = 0; i < 4; ++i) *(LAS u32x4*)(lds + A_KI + row * 272 + 64 * ch + 16 * i) = *(const u32x4*)(src + 8 * i);
            }
            __syncthreads();
            const int key0 = kt * 64;
            if (!wdone && key0 <= q0w + 14) {
                const int qpos = q0w + r;
                float wgt[4][4];
                float Rrun = R;
#pragma unroll
                for (int sb = 3; sb >= 0; --sb) {
                    f32x4 acc = (f32x4){0.f, 0.f, 0.f, 0.f};
#pragma unroll
                    for (int kd = 0; kd < 4; ++kd) { const bf16x8 kf = *(const LAS bf16x8*)(lds + A_KI + (16 * sb + r) * 272 + 64 * kd + 16 * g); acc = mfma16(kf, qf[kd], acc); }
                    float lk[4], z[4];
#pragma unroll
                    for (int j = 0; j < 4; ++j) {
                        const int key = key0 + 16 * sb + 4 * g + j;
                        z[j] = fminf(acc[j], 80.0f);
                        lk[j] = (key < qpos) ? -fast_log2(1.0f + fast_exp2(z[j])) : 0.f;
                    }
                    const float s3 = lk[3], s2 = s3 + lk[2], s1 = s2 + lk[1], s0 = s1 + lk[0];
                    const float t1 = __shfl_xor(s0, 16), t2 = __shfl_xor(s0, 32), t3 = __shfl_xor(t1, 32);
                    const float above = g == 0 ? (t1 + t2 + t3) : (g == 1 ? (t2 + t3) : (g == 2 ? t1 : 0.f));
                    const float base = Rrun + above;
                    const float sj[4] = {s0, s1, s2, s3};
#pragma unroll
                    for (int j = 0; j < 4; ++j) { const int key = key0 + 16 * sb + 4 * g + j; wgt[sb][j] = (key < qpos) ? fast_exp2(z[j] + base + sj[j]) : 0.f; }
                    Rrun += (s0 + t1) + (t2 + t3);
                }
                R = Rrun;
#pragma unroll
                for (int ks = 0; ks < 2; ++ks) {
                    u32x2 lo, hi; lo.x = cvt_pk_bf16(wgt[2 * ks][0], wgt[2 * ks][1]); lo.y = cvt_pk_bf16(wgt[2 * ks][2], wgt[2 * ks][3]);
                    hi.x = cvt_pk_bf16(wgt[2 * ks + 1][0], wgt[2 * ks + 1][1]); hi.y = cvt_pk_bf16(wgt[2 * ks + 1][2], wgt[2 * ks + 1][3]);
                    const bf16x8 pf = mk8(lo, hi);
#pragma unroll
                    for (int db = 0; db < 8; ++db) {
                        const u32x2 v0 = *(const LAS u32x2*)(lds + A_VT + (16 * db + r) * 144 + 64 * ks + 8 * g), v1 = *(const LAS u32x2*)(lds + A_VT + (16 * db + r) * 144 + 64 * ks + 32 + 8 * g);
                        O[db] = mfma16(mk8(v0, v1), pf, O[db]);
                    }
                }
                wdone = __all(R < SB_DONE_LOG2) ? 1 : 0;
            }
            if (lane == 0) FL[(it & 1) * 8 + w] = wdone;
            __syncthreads();
            int alld = 1;
#pragma unroll
            for (int i = 0; i < 8; ++i) alld &= FL[(it & 1) * 8 + i];
            if (alld) break;
        }
#pragma unroll
        for (int db = 0; db < 8; ++db) { u32x2 wv; wv.x = cvt_pk_bf16(O[db][0], O[db][1]); wv.y = cvt_pk_bf16(O[db][2], O[db][3]);
            *(u32x2*)(QB + qtok * DM + h * 128 + 16 * db + 4 * g) = wv; }
        __syncthreads();
    }
}


#ifdef DIAG
__device__ void diag_count_f32(const float* p, size_t n, float thr, unsigned* ctr) {
    unsigned c = 0;
    for (size_t i = (size_t)blockIdx.x * NTHREADS + threadIdx.x; i < n; i += (size_t)gridDim.x * NTHREADS) { const float v = p[i]; if (!(fabsf(v) <= thr)) ++c; }
    if (c) atomicAdd(ctr, c);
}
__device__ void diag_count_bf16(const bf16_t* p, size_t n, float thr, unsigned* ctr) {
    unsigned c = 0;
    for (size_t i = (size_t)blockIdx.x * NTHREADS + threadIdx.x; i < n; i += (size_t)gridDim.x * NTHREADS) { const float v = __uint_as_float((unsigned)p[i] << 16); if (!(fabsf(v) <= thr)) ++c; }
    if (c) atomicAdd(ctr, c);
}
#endif
constexpr int LDS_BYTES = 135168;
static_assert(MIX_LDS <= LDS_BYTES && 128 * 129 * 4 <= LDS_BYTES && pg8::STAGE_BYTES <= LDS_BYTES, "LDS budget");
constexpr int NPHASE = 17;

template <class Epi>
__device__ __forceinline__ void run_gemm(LAS unsigned char* lds, const bf16_t* A, const bf16_t* Bt, int N, int K, const Epi& E) {
    pg8::Gemm g{A, Bt, MTOK, N, K};
    pg8::StaticOrder S; S.init(MTOK, N, gridDim.x, blockIdx.x);
    pg8::gemm_phase<Epi, pg8::StaticOrder>(lds, g, S, E);
}

__global__ void __launch_bounds__(NTHREADS, 2) fwd_megakernel(Params P) {
    extern __shared__ __attribute__((aligned(16))) unsigned char smem[];
    LAS unsigned char* lds = (LAS unsigned char*)smem;
    cg::grid_group grid = cg::this_grid();
    unsigned char* ws = P.ws;
    bf16_t* X = (bf16_t*)(ws + WS_X);
    bf16_t* H = (bf16_t*)(ws + WS_H);
    float* Y = P.out;
    bf16_t* gates = (bf16_t*)P.out;
#ifdef ONLYMASK
#define PHASE(k) if (((ONLYMASK >> (k)) & 1) && P.ph_lo <= (k) && (k) < P.ph_hi)
#else
#define PHASE(k) if (P.ph_lo <= (k) && (k) < P.ph_hi)
#endif
#define SYNC() do { if (P.coop) { asm volatile("s_waitcnt vmcnt(0) lgkmcnt(0)" ::: "memory"); grid.sync(); \
        if (threadIdx.x < 64) { __builtin_amdgcn_fence(__ATOMIC_ACQUIRE, "agent"); asm volatile("s_waitcnt vmcnt(0)" ::: "memory"); } __syncthreads(); } } while (0)
    PHASE(0) prep_phase(P, lds);
    SYNC();
    PHASE(1) run_gemm(lds, X, (const bf16_t*)(ws + W_GU1), 5632, 1024, EpiSwiglu{H});
    SYNC();
    PHASE(2) run_gemm(lds, H, (const bf16_t*)(ws + W_D1), 1024, FH, EpiResid<false, false>{P.x, nullptr, Y, 0.5f});
    SYNC();
    PHASE(3) ln_phase<true>(Y, P.ln_g, P.ln_b, X);
    SYNC();
    PHASE(4) run_gemm(lds, X, (const bf16_t*)(ws + W_IN), NIN_PAD, 1024, EpiWin{(bf16_t*)(ws + WS_QK), gates, (float*)(ws + MISC_IF), (const float*)(ws + W_BIAS)});
    SYNC();
    PHASE(5) mlstm_phase1(P, lds);
    SYNC();
    PHASE(6) {
#ifndef NO_ML2
        mlstm_phase2(P, lds);
#endif
#ifndef NO_ATT
        attn_phase(P, lds);
#endif
    }
    SYNC();
    PHASE(7) {
        run_gemm(lds, (const bf16_t*)(ws + WS_VA), (const bf16_t*)(ws + W_A), 1024, 1024, EpiGateMul<false>{gates, 0, nullptr, (bf16_t*)(ws + WS_T)});
        run_gemm(lds, (const bf16_t*)(ws + WS_QB), (const bf16_t*)(ws + W_B), 1024, 1024, EpiGateMul<true>{gates, DM, (const bf16_t*)(ws + WS_T), (bf16_t*)(ws + WS_MG)});
    }
    SYNC();
    PHASE(8) run_gemm(lds, (const bf16_t*)(ws + WS_MG), (const bf16_t*)(ws + W_O), 1024, 1024, EpiResid<true, false>{X, nullptr, Y, 1.0f});
    SYNC();
    PHASE(9) ln_phase<true>(Y, P.ln_g + DM, P.ln_b + DM, X);
    SYNC();
    PHASE(10) run_gemm(lds, X, (const bf16_t*)(ws + W_GU2), 5632, 1024, EpiSwiglu{H});
    SYNC();
    PHASE(11) run_gemm(lds, H, (const bf16_t*)(ws + W_D2), 1024, FH, EpiResid<true, false>{X, nullptr, Y, 0.5f});
    SYNC();
    PHASE(12) { ln_phase<true>(Y, P.ln_g + 2 * DM, P.ln_b + 2 * DM, X); cvt_bf16_phase(P.p, (bf16_t*)(ws + WS_PB), (size_t)MTOK * 256 / 8); }
    SYNC();
    PHASE(13) {
        run_gemm(lds, X, (const bf16_t*)(ws + W_PG), 1024, 1024, EpiSigBias{P.b_pg, (bf16_t*)(ws + WS_PG)});
        run_gemm(lds, (const bf16_t*)(ws + WS_PB), (const bf16_t*)(ws + W_P), 1024, 256, EpiResid<true, true>{X, (const bf16_t*)(ws + WS_PG), Y, 1.0f});
    }
    SYNC();
    PHASE(14) ln_phase<false>(Y, P.ln_g + 3 * DM, P.ln_b + 3 * DM, P.out);
#undef PHASE
#undef SYNC
}

extern "C" void kernel_launch(void* const* d_in, const int* in_sizes, int n_in, void* d_out, int out_size, void* d_ws, size_t ws_size, hipStream_t stream) {
    static int grid_blocks = 0;
    if (grid_blocks == 0) {
        if (n_in != 19 || out_size != MTOK * DM || ws_size < WS_END) { fprintf(stderr, "kernel_launch: unexpected shapes (n_in %d, out %d, ws %zu, need %zu)\n", n_in, out_size, ws_size, (size_t)WS_END); grid_blocks = -1; return; }
        int dev = 0, cus = 0, per_cu = 0;
        hipGetDevice(&dev);
        hipDeviceGetAttribute(&cus, hipDeviceAttributeMultiprocessorCount, dev);
        if (hipFuncSetAttribute((const void*)fwd_megakernel, hipFuncAttributeMaxDynamicSharedMemorySize, LDS_BYTES) != hipSuccess) { fprintf(stderr, "kernel_launch: hipFuncSetAttribute failed\n"); grid_blocks = -1; return; }
        if (hipOccupancyMaxActiveBlocksPerMultiprocessor(&per_cu, (const void*)fwd_megakernel, NTHREADS, LDS_BYTES) != hipSuccess || per_cu < 1) { fprintf(stderr, "kernel_launch: occupancy query failed (%d)\n", per_cu); per_cu = 1; (void)hipGetLastError(); }
        grid_blocks = cus * per_cu;
    }
    if (grid_blocks < 0) return;
    Params p{};
    p.x = (const float*)d_in[0]; p.p = (const float*)d_in[1]; p.ln_g = (const float*)d_in[2]; p.ln_b = (const float*)d_in[3];
    p.wg = (const float*)d_in[4]; p.wu = (const float*)d_in[5]; p.wd = (const float*)d_in[6]; p.w_in = (const float*)d_in[7]; p.b_in = (const float*)d_in[8];
    p.b_forget = (const float*)d_in[9]; p.conv_w = (const float*)d_in[10]; p.conv_b = (const float*)d_in[11]; p.mh_g = (const float*)d_in[12];
    p.w_a = (const float*)d_in[13]; p.w_b = (const float*)d_in[14]; p.w_o = (const float*)d_in[15]; p.w_ple = (const float*)d_in[16]; p.w_pg = (const float*)d_in[17]; p.b_pg = (const float*)d_in[18];
    p.out = (float*)d_out; p.ws = (unsigned char*)d_ws; p.pad = 0;
#if ONE_LAUNCH
    p.ph_lo = 0; p.ph_hi = NPHASE; p.coop = 1;
    void* args[] = {&p};
    hipError_t e = hipLaunchCooperativeKernel((const void*)fwd_megakernel, dim3(grid_blocks), dim3(NTHREADS), args, LDS_BYTES, stream);
    if (e != hipSuccess) fprintf(stderr, "cooperative launch failed: %s (grid %d)\n", hipGetErrorString(e), grid_blocks);
#else
    p.coop = 0;
    for (int ph = 0; ph < 15; ++ph) { p.ph_lo = ph; p.ph_hi = ph + 1; hipLaunchKernelGGL(fwd_megakernel, dim3(grid_blocks), dim3(NTHREADS), LDS_BYTES, stream, p); }
#endif
}
```

```cpp
#include <hip/hip_runtime.h>
#include <hip/hip_cooperative_groups.h>
#include <cstdio>
namespace cg = cooperative_groups;

#ifndef ONE_LAUNCH
#define ONE_LAUNCH 1
#endif

#define LAS __attribute__((address_space(3)))
typedef unsigned short bf16_t;
typedef short bf16x8 __attribute__((ext_vector_type(8)));
typedef float f32x4 __attribute__((ext_vector_type(4)));
typedef float f32x2 __attribute__((ext_vector_type(2)));
typedef unsigned u32x4 __attribute__((ext_vector_type(4)));
typedef unsigned u32x2 __attribute__((ext_vector_type(2)));

constexpr int MTOK = 65536, DM = 1024, FH = 2816, SEQ = 8192;
constexpr int NIN_PAD = 8448;
constexpr float ALPHA = 1.189207115002721f;
constexpr float LN_EPS = 1e-5f;
constexpr float LOG2E = 1.4426950408889634f;
constexpr int NTHREADS = 512;

constexpr size_t QB_ = 33554432ull;
constexpr size_t WS_W = 0;
constexpr size_t W_GU1 = 0;
constexpr size_t W_D1 = W_GU1 + 5632ull * 1024 * 2;
constexpr size_t W_GU2 = W_D1 + 1024ull * 2816 * 2;
constexpr size_t W_D2 = W_GU2 + 5632ull * 1024 * 2;
constexpr size_t W_IN = W_D2 + 1024ull * 2816 * 2;
constexpr size_t W_A = W_IN + 8448ull * 1024 * 2;
constexpr size_t W_B = W_A + 1024ull * 1024 * 2;
constexpr size_t W_O = W_B + 1024ull * 1024 * 2;
constexpr size_t W_PG = W_O + 1024ull * 1024 * 2;
constexpr size_t W_P = W_PG + 1024ull * 1024 * 2;
constexpr size_t W_BIAS = W_P + 1024ull * 256 * 2;
static_assert(W_BIAS + 8448 * 4 <= 2 * QB_, "weights overflow");
constexpr size_t WS_PB = 2 * QB_;
constexpr size_t WS_MISC = 3 * QB_;
constexpr size_t MISC_IF = WS_MISC;
constexpr size_t MISC_CNT = WS_MISC + 2097152ull;
constexpr size_t WS_X = 4 * QB_;
constexpr size_t WS_H = 8 * QB_;
constexpr size_t WS_QK = 8 * QB_, WS_VA = 12 * QB_, WS_OA = 16 * QB_, WS_QB = 20 * QB_, WS_KB = 24 * QB_, WS_VB = 28 * QB_;
constexpr size_t WS_T = WS_QK, WS_MG = WS_KB, WS_PG = 8 * QB_;
constexpr size_t WS_END = 32 * QB_;
constexpr int STATE_FLOATS = 32768 + 128;

typedef __bf16 bf16x2_t __attribute__((ext_vector_type(2)));
__device__ __forceinline__ unsigned cvt_pk_bf16(float lo, float hi) { f32x2 v = {lo, hi}; bf16x2_t r = __builtin_convertvector(v, bf16x2_t); return __builtin_bit_cast(unsigned, r); }
__device__ __forceinline__ float bf_lo(unsigned u) { return __uint_as_float(u << 16); }
__device__ __forceinline__ float bf_hi(unsigned u) { return __uint_as_float(u & 0xffff0000u); }
__device__ __forceinline__ float fast_exp2(float x) { return __builtin_amdgcn_exp2f(x); }
__device__ __forceinline__ float fast_log2(float x) { return __builtin_amdgcn_logf(x); }
__device__ __forceinline__ float fast_rcp(float x) { return __builtin_amdgcn_rcpf(x); }
__device__ __forceinline__ float sigmoid_f(float x) { return fast_rcp(1.0f + fast_exp2(-x * LOG2E)); }
__device__ __forceinline__ f32x4 mfma16(bf16x8 a, bf16x8 b, f32x4 c) { return __builtin_amdgcn_mfma_f32_16x16x32_bf16(a, b, c, 0, 0, 0); }
__device__ __forceinline__ bf16x8 mk8(u32x2 lo, u32x2 hi) { u32x4 v; v.x = lo.x; v.y = lo.y; v.z = hi.x; v.w = hi.y; return __builtin_bit_cast(bf16x8, v); }
__device__ __forceinline__ float wave_sum(float v) {
#pragma unroll
    for (int o = 32; o > 0; o >>= 1) v += __shfl_xor(v, o);
    return v;
}
__device__ __forceinline__ float wave_max(float v) {
#pragma unroll
    for (int o = 32; o > 0; o >>= 1) v = fmaxf(v, __shfl_xor(v, o));
    return v;
}
__device__ __forceinline__ float wave_incl_sum(float v, int lane) {
#pragma unroll
    for (int o = 1; o < 64; o <<= 1) { float t = __shfl_up(v, o); if (lane >= o) v += t; }
    return v;
}
__device__ __forceinline__ float wave_incl_max(float v, int lane) {
#pragma unroll
    for (int o = 1; o < 64; o <<= 1) { float t = __shfl_up(v, o); if (lane >= o) v = fmaxf(v, t); }
    return v;
}

namespace pg8 {
constexpr int BM = 256, BK = 64, HALF = 128, HTB = HALF * BK * 2, STAGE_BYTES = 8 * HTB, NXCD = 8, WGM = 8;
__host__ __device__ __forceinline__ int lds_byte(int r, int c) { const int st = (r >> 4) * 2 + (c >> 5), rr = r & 15, cc = c & 31, ob = rr * 64 + cc * 2; return st * 1024 + (ob ^ (((ob >> 9) & 1) << 5)); }
__host__ __device__ __forceinline__ void stage_rc(int b, int& R, int& C) { const int st = b / 1024, sb = b % 1024, swz = sb ^ (((sb >> 9) & 1) << 5); R = (st >> 1) * 16 + swz / 64; C = (st & 1) * 32 + (swz % 64) / 2; }
__host__ __device__ __forceinline__ int perm32(int rho) { const int n = rho >> 4, i = rho & 15; return 8 * (i >> 2) + 4 * n + (i & 3); }
struct Unit { int pm, pn; };
struct Gemm { const bf16_t* A; const bf16_t* Bt; int M, N, K; };
struct StaticOrder {
    int nM, nN, nwg, G, c;
    __device__ void init(int M, int N, int G_, int c_) { nM = M / BM; nN = N / BM; nwg = nM * nN; G = G_; c = c_; }
    __device__ bool next(int i, Unit& u) const {
        const long L = (long)i * G + c; if (L >= nwg) return false;
        int wgid = (int)L; { const int q = nwg / NXCD, r = nwg % NXCD, xcd = wgid % NXCD, off = wgid / NXCD; wgid = (xcd < r ? xcd * (q + 1) : r * (q + 1) + (xcd - r) * q) + off; }
        const int nig = WGM * nN, gid = wgid / nig, fm = gid * WGM, gsz = (nM - fm) < WGM ? (nM - fm) : WGM;
        u.pm = fm + ((wgid % nig) % gsz); u.pn = (wgid % nig) / gsz; return true;
    }
};
template <class Epi, class Sched>
__device__ __forceinline__ void gemm_phase(LAS unsigned char* lds, const Gemm g, const Sched& S, const Epi& E) {
    const int tid = threadIdx.x, wid = __builtin_amdgcn_readfirstlane(tid >> 6), lane = tid & 63, wr = wid >> 2, wc = wid & 3, fr = lane & 15, fq = lane >> 4;
    const int K = g.K, nt = K / BK;
    unsigned voffA[2], voffB[2];
#pragma unroll
    for (int i = 0; i < 2; ++i) { int R, C; stage_rc(tid * 16 + i * 8192, R, C); const int Rb = ((R & ~31) + perm32(R & 31));
        voffA[i] = (unsigned)(R * K + C) * 2u; voffB[i] = (unsigned)(Rb * K + C) * 2u; }
    const size_t kstep = (size_t)(BK * 2);
    const size_t hstep = (size_t)HALF * K * 2;
    const size_t tstep = 2 * hstep;
    const unsigned ldsw = (unsigned)wid * 1024u;
    const int aoff = lds_byte(wr * 64 + fr, fq * 8), boff = lds_byte(wc * 32 + fr, fq * 8);
#define PG8_SA(b, h) (((b) * 2 + (h)) * HTB)
#define PG8_SB(b, h) ((4 + (b) * 2 + (h)) * HTB)
#define PG8_STAGE(bufoff, gbase, voff) do { _Pragma("unroll") for (int _i = 0; _i < 2; ++_i) \
        __builtin_amdgcn_global_load_lds((const unsigned*)((const char*)(gbase) + (voff)[_i]), (LAS unsigned*)(lds + (bufoff) + ldsw + _i * 8192), 16, 0, 0); } while (0)
#define PG8_LDA(dst, b, h) do { _Pragma("unroll") for (int m = 0; m < 4; ++m) _Pragma("unroll") for (int k = 0; k < 2; ++k) dst[m][k] = *(const LAS bf16x8*)(lds + PG8_SA(b, h) + aoff + m * 2048 + k * 1024); } while (0)
#define PG8_LDB(dst, b, h) do { _Pragma("unroll") for (int n = 0; n < 2; ++n) _Pragma("unroll") for (int k = 0; k < 2; ++k) dst[n][k] = *(const LAS bf16x8*)(lds + PG8_SB(b, h) + boff + n * 2048 + k * 1024); } while (0)
#define PG8_MMA(ai, bj, At, Bt) do { __builtin_amdgcn_s_setprio(1); _Pragma("unroll") for (int m = 0; m < 4; ++m) _Pragma("unroll") for (int n = 0; n < 2; ++n) _Pragma("unroll") for (int k = 0; k < 2; ++k) \
        acc[ai][bj][m][n] = __builtin_amdgcn_mfma_f32_16x16x32_bf16(Bt[n][k], At[m][k], acc[ai][bj][m][n], 0, 0, 0); __builtin_amdgcn_s_setprio(0); } while (0)
#define PG8_WAIT_V(n) asm volatile("s_waitcnt vmcnt(" #n ")" ::: "memory")
#define PG8_WAIT_L(n) asm volatile("s_waitcnt lgkmcnt(" #n ")" ::: "memory")
#define PG8_BAR __builtin_amdgcn_s_barrier()
#define PG8_SCHED __builtin_amdgcn_sched_barrier(0)
    Unit cur, nxt; int ui = 0;
    if (!S.next(0, cur)) return;
    f32x4 acc[2][2][4][2];
#pragma unroll
    for (int a = 0; a < 2; ++a)
#pragma unroll
        for (int b = 0; b < 2; ++b)
#pragma unroll
            for (int m = 0; m < 4; ++m)
#pragma unroll
                for (int n = 0; n < 2; ++n) acc[a][b][m][n] = (f32x4){0.f, 0.f, 0.f, 0.f};
    bf16x8 At[4][2], B0[2][2], B1[2][2];
    const char* cA = (const char*)g.A + (size_t)cur.pm * tstep; const char* cB = (const char*)g.Bt + (size_t)cur.pn * tstep;
    PG8_STAGE(PG8_SB(0, 0), cB, voffB); PG8_STAGE(PG8_SA(0, 0), cA, voffA); PG8_STAGE(PG8_SB(0, 1), cB + hstep, voffB); PG8_STAGE(PG8_SA(0, 1), cA + hstep, voffA);
    if (wr == 1) PG8_BAR;
    PG8_WAIT_V(4); PG8_BAR;
    PG8_STAGE(PG8_SB(1, 0), cB + kstep, voffB); PG8_STAGE(PG8_SA(1, 0), cA + kstep, voffA); PG8_STAGE(PG8_SB(1, 1), cB + hstep + kstep, voffB);
    PG8_WAIT_V(6); PG8_BAR;
    for (;;) {
        const bool has_next = S.next(ui + 1, nxt);
        const char* nA = has_next ? (const char*)g.A + (size_t)nxt.pm * tstep : cA; const char* nB = has_next ? (const char*)g.Bt + (size_t)nxt.pn * tstep : cB;
        for (int t = 0; t < nt; t += 2) {
            const bool last = (t == nt - 2);
            const char* a1 = cA + (size_t)(t + 1) * kstep;
            const char* a2 = last ? nA : cA + (size_t)(t + 2) * kstep; const char* b2 = last ? nB : cB + (size_t)(t + 2) * kstep;
            const char* a3 = a2 + kstep; const char* b3 = b2 + kstep;
            PG8_LDB(B0, 0, 0); PG8_SCHED; PG8_LDA(At, 0, 0); PG8_STAGE(PG8_SA(1, 1), a1 + hstep, voffA);
            PG8_WAIT_L(8); PG8_BAR; PG8_WAIT_L(0); PG8_MMA(0, 0, At, B0); PG8_BAR; PG8_SCHED;
            PG8_LDB(B1, 0, 1); PG8_STAGE(PG8_SB(0, 0), b2, voffB);
            PG8_BAR; PG8_WAIT_L(0); PG8_MMA(0, 1, At, B1); PG8_BAR;
            PG8_LDA(At, 0, 1); PG8_STAGE(PG8_SA(0, 0), a2, voffA);
            PG8_BAR; PG8_WAIT_L(0); PG8_MMA(1, 0, At, B0); PG8_BAR; PG8_SCHED;
            PG8_STAGE(PG8_SB(0, 1), b2 + hstep, voffB);
            PG8_WAIT_V(6); PG8_BAR; PG8_MMA(1, 1, At, B1); PG8_BAR;
            PG8_LDB(B0, 1, 0); PG8_SCHED; PG8_LDA(At, 1, 0); PG8_STAGE(PG8_SA(0, 1), a2 + hstep, voffA);
            PG8_WAIT_L(8); PG8_BAR; PG8_WAIT_L(0); PG8_MMA(0, 0, At, B0); PG8_BAR; PG8_SCHED;
            PG8_LDB(B1, 1, 1); PG8_STAGE(PG8_SB(1, 0), b3, voffB);
            PG8_BAR; PG8_WAIT_L(0); PG8_MMA(0, 1, At, B1); PG8_BAR;
            PG8_LDA(At, 1, 1); PG8_STAGE(PG8_SA(1, 0), a3, voffA);
            PG8_BAR; PG8_WAIT_L(0); PG8_MMA(1, 0, At, B0); PG8_BAR; PG8_SCHED;
            PG8_STAGE(PG8_SB(1, 1), b3 + hstep, voffB);
            PG8_WAIT_V(6); PG8_BAR; PG8_MMA(1, 1, At, B1); PG8_BAR;
        }
        E(acc, cur, wr, wc, fr, fq);
        if (!has_next) break;
#pragma unroll
        for (int a = 0; a < 2; ++a)
#pragma unroll
            for (int b = 0; b < 2; ++b)
#pragma unroll
                for (int m = 0; m < 4; ++m)
#pragma unroll
                    for (int n = 0; n < 2; ++n) acc[a][b][m][n] = (f32x4){0.f, 0.f, 0.f, 0.f};
        cur = nxt; cA = nA; cB = nB; ++ui;
    }
    PG8_WAIT_V(0);
    if (wr == 0) PG8_BAR;
    PG8_BAR;
#undef PG8_SA
#undef PG8_SB
#undef PG8_STAGE
#undef PG8_LDA
#undef PG8_LDB
#undef PG8_MMA
#undef PG8_WAIT_V
#undef PG8_WAIT_L
#undef PG8_BAR
#undef PG8_SCHED
}
}
using pg8::Unit;

#define EPI_ROWS(ai, m) (u.pm * 256 + (ai) * 128 + wr * 64 + (m) * 16 + fr)
struct EpiSwiglu {
    bf16_t* H;
    __device__ __forceinline__ void operator()(const f32x4 (&acc)[2][2][4][2], const Unit& u, int wr, int wc, int fr, int fq) const {
        const int col = u.pn * 128 + wc * 32 + 8 * fq;
#pragma unroll
        for (int ai = 0; ai < 2; ++ai)
#pragma unroll
            for (int m = 0; m < 4; ++m) {
                const size_t row = EPI_ROWS(ai, m);
                float h[8];
#pragma unroll
                for (int n = 0; n < 2; ++n)
#pragma unroll
                    for (int j = 0; j < 4; ++j) { const float g = acc[ai][0][m][n][j], uu = acc[ai][1][m][n][j]; h[4 * n + j] = g * uu * sigmoid_f(g); }
                u32x4 w; w.x = cvt_pk_bf16(h[0], h[1]); w.y = cvt_pk_bf16(h[2], h[3]); w.z = cvt_pk_bf16(h[4], h[5]); w.w = cvt_pk_bf16(h[6], h[7]);
                *(u32x4*)(H + row * FH + col) = w;
            }
    }
};
template <bool RES_BF16, bool HAS_MUL, bool OUT_BF16 = false>
struct EpiResid {
    const void* res; const bf16_t* mul; float* Y; float scale;
    __device__ __forceinline__ void operator()(const f32x4 (&acc)[2][2][4][2], const Unit& u, int wr, int wc, int fr, int fq) const {
#pragma unroll
        for (int ai = 0; ai < 2; ++ai)
#pragma unroll
            for (int m = 0; m < 4; ++m) {
                const size_t row = EPI_ROWS(ai, m);
#pragma unroll
                for (int bj = 0; bj < 2; ++bj) {
                    const size_t off = row * DM + u.pn * 256 + bj * 128 + wc * 32 + 8 * fq;
                    float r[8];
                    if (RES_BF16) { const u32x4 rv = *(const u32x4*)((const bf16_t*)res + off);
                        r[0] = bf_lo(rv.x); r[1] = bf_hi(rv.x); r[2] = bf_lo(rv.y); r[3] = bf_hi(rv.y); r[4] = bf_lo(rv.z); r[5] = bf_hi(rv.z); r[6] = bf_lo(rv.w); r[7] = bf_hi(rv.w); }
                    else { const f32x4 a = *(const f32x4*)((const float*)res + off), b = *(const f32x4*)((const float*)res + off + 4);
                        r[0] = a[0]; r[1] = a[1]; r[2] = a[2]; r[3] = a[3]; r[4] = b[0]; r[5] = b[1]; r[6] = b[2]; r[7] = b[3]; }
                    float mv[8];
                    if (HAS_MUL) { const u32x4 rv = *(const u32x4*)(mul + off);
                        mv[0] = bf_lo(rv.x); mv[1] = bf_hi(rv.x); mv[2] = bf_lo(rv.y); mv[3] = bf_hi(rv.y); mv[4] = bf_lo(rv.z); mv[5] = bf_hi(rv.z); mv[6] = bf_lo(rv.w); mv[7] = bf_hi(rv.w); }
                    f32x4 o0, o1;
#pragma unroll
                    for (int j = 0; j < 4; ++j) {
                        const float a0 = acc[ai][bj][m][0][j] * scale, a1 = acc[ai][bj][m][1][j] * scale;
                        o0[j] = ALPHA * r[j] + (HAS_MUL ? mv[j] * a0 : a0); o1[j] = ALPHA * r[4 + j] + (HAS_MUL ? mv[4 + j] * a1 : a1); }
                    if (OUT_BF16) { u32x4 w; w.x = cvt_pk_bf16(o0[0], o0[1]); w.y = cvt_pk_bf16(o0[2], o0[3]); w.z = cvt_pk_bf16(o1[0], o1[1]); w.w = cvt_pk_bf16(o1[2], o1[3]); *(u32x4*)((bf16_t*)Y + off) = w; }
                    else { *(f32x4*)(Y + off) = o0; *(f32x4*)(Y + off + 4) = o1; }
                }
            }
    }
};
struct EpiWin {
    bf16_t* proj; bf16_t* gates; float* ifg; const float* bias;
    __device__ __forceinline__ void operator()(const f32x4 (&acc)[2][2][4][2], const Unit& u, int wr, int wc, int fr, int fq) const {
        const int pn = u.pn;
        if (pn == 32) {
            if (wc == 0 && fq == 0) {
                const f32x4 bi = *(const f32x4*)(bias + 8192), bf = *(const f32x4*)(bias + 8196);
#pragma unroll
                for (int ai = 0; ai < 2; ++ai)
#pragma unroll
                    for (int m = 0; m < 4; ++m) {
                        const size_t row = EPI_ROWS(ai, m);
                        f32x4 iv = acc[ai][0][m][0] + bi, fv = acc[ai][0][m][1] + bf, lf;
#pragma unroll
                        for (int j = 0; j < 4; ++j) { const float xx = fv[j]; lf[j] = xx >= 0.f ? -log1pf(expf(-xx)) : xx - log1pf(expf(xx)); }
                        *(f32x4*)(ifg + row * 8) = iv; *(f32x4*)(ifg + row * 8 + 4) = lf;
                    }
            }
            return;
        }
        bf16_t* dst; int ld, c0; int act = 0; float sc = 1.0f;
        if (pn < 24) { const int sec = pn >> 2; dst = proj + (size_t)sec * ((size_t)MTOK * DM); ld = DM; c0 = (pn & 3) * 256; if (sec == 2) act = 1; if (sec == 3) sc = 0.08838834764831845f * LOG2E; }
        else { dst = gates; ld = 2 * DM; c0 = (pn - 24) * 256; act = 1; }
#pragma unroll
        for (int bj = 0; bj < 2; ++bj) {
            const int cl = bj * 128 + wc * 32 + 8 * fq;
            const f32x4 b0 = *(const f32x4*)(bias + pn * 256 + cl), b1 = *(const f32x4*)(bias + pn * 256 + cl + 4);
#pragma unroll
            for (int ai = 0; ai < 2; ++ai)
#pragma unroll
                for (int m = 0; m < 4; ++m) {
                    const size_t row = EPI_ROWS(ai, m);
                    f32x4 v0 = acc[ai][bj][m][0] + b0, v1 = acc[ai][bj][m][1] + b1;
                    if (act) {
#pragma unroll
                        for (int j = 0; j < 4; ++j) { v0[j] = sigmoid_f(v0[j]); v1[j] = sigmoid_f(v1[j]); } }
                    else { v0 *= sc; v1 *= sc; }
                    u32x4 w; w.x = cvt_pk_bf16(v0[0], v0[1]); w.y = cvt_pk_bf16(v0[2], v0[3]); w.z = cvt_pk_bf16(v1[0], v1[1]); w.w = cvt_pk_bf16(v1[2], v1[3]);
                    *(u32x4*)(dst + row * ld + c0 + cl) = w;
                }
        }
    }
};
template <bool ADD>
struct EpiGateMul {
    const bf16_t* gate; int goff; const bf16_t* tin; bf16_t* out;
    __device__ __forceinline__ void operator()(const f32x4 (&acc)[2][2][4][2], const Unit& u, int wr, int wc, int fr, int fq) const {
#pragma unroll
        for (int ai = 0; ai < 2; ++ai)
#pragma unroll
            for (int m = 0; m < 4; ++m) {
                const size_t row = EPI_ROWS(ai, m);
#pragma unroll
                for (int bj = 0; bj < 2; ++bj) {
                    const int c = u.pn * 256 + bj * 128 + wc * 32 + 8 * fq;
                    const u32x4 gv = *(const u32x4*)(gate + row * (2 * DM) + goff + c);
                    float gg[8] = {bf_lo(gv.x), bf_hi(gv.x), bf_lo(gv.y), bf_hi(gv.y), bf_lo(gv.z), bf_hi(gv.z), bf_lo(gv.w), bf_hi(gv.w)};
                    float tt[8] = {0.f, 0.f, 0.f, 0.f, 0.f, 0.f, 0.f, 0.f};
                    if (ADD) { const u32x4 tv = *(const u32x4*)(tin + row * DM + c);
                        tt[0] = bf_lo(tv.x); tt[1] = bf_hi(tv.x); tt[2] = bf_lo(tv.y); tt[3] = bf_hi(tv.y); tt[4] = bf_lo(tv.z); tt[5] = bf_hi(tv.z); tt[6] = bf_lo(tv.w); tt[7] = bf_hi(tv.w); }
                    float o[8];
#pragma unroll
                    for (int j = 0; j < 4; ++j) { o[j] = tt[j] + gg[j] * acc[ai][bj][m][0][j]; o[4 + j] = tt[4 + j] + gg[4 + j] * acc[ai][bj][m][1][j]; }
                    u32x4 w; w.x = cvt_pk_bf16(o[0], o[1]); w.y = cvt_pk_bf16(o[2], o[3]); w.z = cvt_pk_bf16(o[4], o[5]); w.w = cvt_pk_bf16(o[6], o[7]);
                    *(u32x4*)(out + row * DM + c) = w;
                }
            }
    }
};
struct EpiSigBias {
    const float* bias; bf16_t* out;
    __device__ __forceinline__ void operator()(const f32x4 (&acc)[2][2][4][2], const Unit& u, int wr, int wc, int fr, int fq) const {
#pragma unroll
        for (int bj = 0; bj < 2; ++bj) {
            const int c = u.pn * 256 + bj * 128 + wc * 32 + 8 * fq;
            const f32x4 b0 = *(const f32x4*)(bias + c), b1 = *(const f32x4*)(bias + c + 4);
#pragma unroll
            for (int ai = 0; ai < 2; ++ai)
#pragma unroll
                for (int m = 0; m < 4; ++m) {
                    const size_t row = EPI_ROWS(ai, m);
                    f32x4 v0 = acc[ai][bj][m][0] + b0, v1 = acc[ai][bj][m][1] + b1;
#pragma unroll
                    for (int j = 0; j < 4; ++j) { v0[j] = sigmoid_f(v0[j]); v1[j] = sigmoid_f(v1[j]); }
                    u32x4 w; w.x = cvt_pk_bf16(v0[0], v0[1]); w.y = cvt_pk_bf16(v0[2], v0[3]); w.z = cvt_pk_bf16(v1[0], v1[1]); w.w = cvt_pk_bf16(v1[2], v1[3]);
                    *(u32x4*)(out + row * DM + c) = w;
                }
        }
    }
};

struct Params {
    const float *x, *p, *ln_g, *ln_b, *wg, *wu, *wd, *w_in, *b_in, *b_forget, *conv_w, *conv_b, *mh_g, *w_a, *w_b, *w_o, *w_ple, *w_pg, *b_pg;
    float* out; unsigned char* ws;
    int ph_lo, ph_hi, coop, pad;
};

__device__ void cvt_bf16_phase(const float* src, bf16_t* dst, size_t n8) {
    const size_t stride = (size_t)gridDim.x * NTHREADS;
    for (size_t i = (size_t)blockIdx.x * NTHREADS + threadIdx.x; i < n8; i += stride) {
        const f32x4 a = *(const f32x4*)(src + i * 8), b = *(const f32x4*)(src + i * 8 + 4);
        u32x4 w; w.x = cvt_pk_bf16(a[0], a[1]); w.y = cvt_pk_bf16(a[2], a[3]); w.z = cvt_pk_bf16(b[0], b[1]); w.w = cvt_pk_bf16(b[2], b[3]);
        *(u32x4*)(dst + i * 8) = w;
    }
}
template <int MODE>
__device__ __forceinline__ float tsrc_val(const float* w0, const float* w1, int ldn, int k, int n) {
    if (MODE == 0) return w0[(size_t)k * ldn + n];
    if (MODE == 1) { const int pn = n >> 8, sel = (n >> 7) & 1, i = n & 127; const float* w = sel ? w1 : w0; return w[(size_t)k * ldn + pn * 128 + i]; }
    int col; if (n < 3072) col = n; else if (n < 8192) col = n + 8; else if (n < 8200) col = 3072 + (n - 8192); else return 0.f;
    return w0[(size_t)k * ldn + col];
}
template <int MODE>
__device__ __forceinline__ void transpose_mat(LAS float* tile, const float* w0, const float* w1, int ldn, bf16_t* dst, int NP, int K, int& base) {
    const int tid = threadIdx.x;
    const int tn = NP / 128, tk = K / 128, nt = tn * tk;
    int first = ((int)blockIdx.x - base) % (int)gridDim.x; if (first < 0) first += gridDim.x;
    for (int t = first; t < nt; t += gridDim.x) {
        const int n0 = (t / tk) * 128, k0 = (t % tk) * 128;
#pragma unroll 8
        for (int e = 0; e < 32; ++e) { const int idx = e * NTHREADS + tid, kk = idx >> 7, nn = idx & 127; tile[kk * 129 + nn] = tsrc_val<MODE>(w0, w1, ldn, k0 + kk, n0 + nn); }
        __syncthreads();
#pragma unroll 8
        for (int e = 0; e < 16; ++e) { const int idx = e * NTHREADS + tid, nn = idx >> 6, kk = (idx & 63) * 2;
            *(unsigned*)(dst + (size_t)(n0 + nn) * K + k0 + kk) = cvt_pk_bf16(tile[kk * 129 + nn], tile[(kk + 1) * 129 + nn]); }
        __syncthreads();
    }
    base += nt;
}
__device__ void prep_phase(const Params& P, LAS unsigned char* lds) {
    unsigned char* ws = P.ws;
    cvt_bf16_phase(P.x, (bf16_t*)(ws + WS_X), (size_t)MTOK * DM / 8);
    if (blockIdx.x == 0 && threadIdx.x < 64) ((unsigned*)(ws + MISC_CNT))[threadIdx.x] = 0u;
    for (int n = blockIdx.x * NTHREADS + threadIdx.x; n < NIN_PAD; n += gridDim.x * NTHREADS) {
        float b;
        if (n < 3072) b = P.b_in[n]; else if (n < 8192) b = P.b_in[n + 8]; else if (n < 8196) b = P.b_in[3072 + n - 8192];
        else if (n < 8200) b = P.b_in[3072 + n - 8192] + P.b_forget[n - 8196]; else b = 0.f;
        ((float*)(ws + W_BIAS))[n] = b;
    }
    LAS float* tile = (LAS float*)lds;
    int base = 0;
    transpose_mat<1>(tile, P.wg, P.wu, FH, (bf16_t*)(ws + W_GU1), 5632, 1024, base);
    transpose_mat<0>(tile, P.wd, nullptr, DM, (bf16_t*)(ws + W_D1), 1024, FH, base);
    transpose_mat<1>(tile, P.wg + (size_t)DM * FH, P.wu + (size_t)DM * FH, FH, (bf16_t*)(ws + W_GU2), 5632, 1024, base);
    transpose_mat<0>(tile, P.wd + (size_t)DM * FH, nullptr, DM, (bf16_t*)(ws + W_D2), 1024, FH, base);
    transpose_mat<2>(tile, P.w_in, nullptr, 8200, (bf16_t*)(ws + W_IN), NIN_PAD, 1024, base);
    transpose_mat<0>(tile, P.w_a, nullptr, DM, (bf16_t*)(ws + W_A), 1024, 1024, base);
    transpose_mat<0>(tile, P.w_b, nullptr, DM, (bf16_t*)(ws + W_B), 1024, 1024, base);
    transpose_mat<0>(tile, P.w_o, nullptr, DM, (bf16_t*)(ws + W_O), 1024, 1024, base);
    transpose_mat<0>(tile, P.w_pg, nullptr, DM, (bf16_t*)(ws + W_PG), 1024, 1024, base);
    transpose_mat<0>(tile, P.w_ple, nullptr, DM, (bf16_t*)(ws + W_P), 1024, 256, base);
}
template <bool OUT_BF16, bool IN_BF16 = false>
__device__ void ln_phase(const float* Y, const float* g, const float* b, void* out) {
    const int wid = threadIdx.x >> 6, lane = threadIdx.x & 63;
    f32x4 gv[4], bv[4];
#pragma unroll
    for (int i = 0; i < 4; ++i) { gv[i] = *(const f32x4*)(g + i * 256 + lane * 4); bv[i] = *(const f32x4*)(b + i * 256 + lane * 4); }
    for (int row0 = (blockIdx.x * 8 + wid) * 2; row0 < MTOK; row0 += gridDim.x * 16) {
        f32x4 v[2][4]; float s[2] = {0.f, 0.f};
#pragma unroll
        for (int r = 0; r < 2; ++r)
#pragma unroll
            for (int i = 0; i < 4; ++i) {
                if (IN_BF16) { const u32x2 t = *(const u32x2*)((const bf16_t*)Y + (size_t)(row0 + r) * DM + i * 256 + lane * 4); v[r][i] = (f32x4){bf_lo(t.x), bf_hi(t.x), bf_lo(t.y), bf_hi(t.y)}; }
                else v[r][i] = *(const f32x4*)(Y + (size_t)(row0 + r) * DM + i * 256 + lane * 4); }
#pragma unroll
        for (int r = 0; r < 2; ++r) {
#pragma unroll
            for (int i = 0; i < 4; ++i) s[r] += (v[r][i][0] + v[r][i][1]) + (v[r][i][2] + v[r][i][3]);
            const float mean = wave_sum(s[r]) * (1.0f / DM);
            float q = 0.f;
#pragma unroll
            for (int i = 0; i < 4; ++i) { const f32x4 d = v[r][i] - mean; q += (d[0] * d[0] + d[1] * d[1]) + (d[2] * d[2] + d[3] * d[3]); }
            const float rstd = rsqrtf(wave_sum(q) * (1.0f / DM) + LN_EPS);
#pragma unroll
            for (int i = 0; i < 4; ++i) {
                const f32x4 o = (v[r][i] - mean) * rstd * gv[i] + bv[i];
                if (OUT_BF16) { u32x2 w; w.x = cvt_pk_bf16(o[0], o[1]); w.y = cvt_pk_bf16(o[2], o[3]); *(u32x2*)((bf16_t*)out + (size_t)(row0 + r) * DM + i * 256 + lane * 4) = w; }
                else *(f32x4*)((float*)out + (size_t)(row0 + r) * DM + i * 256 + lane * 4) = o;
            }
        }
    }
}

constexpr int L_QI = 0, L_KI = 17408, L_KT = 34816, L_VT = 53248, L_PI = 90112, L_F = 99328;
constexpr int F_N = 0, F_QN = 128, F_RS = 192, F_HS = 320, F_BL = 1344, F_GM = 1472, F_M = 1600, F_CW = 1732, F_SA = 3012, F_SB2 = 3028, F_SMU = 4052, F_SWI = 5076, F_SWN = 6100, F_SEM = 7124, F_END = 8148;
constexpr int MIX_LDS = L_F + F_END * 4;

__device__ void mlstm_prologue(const Params& P, LAS unsigned char* lds, int b, int h, int gi) {
    LAS float* F = (LAS float*)(lds + L_F);
    const float* ifg = (const float*)(P.ws + MISC_IF);
    const int tid = threadIdx.x, w = tid >> 6, lane = tid & 63;
    const int nch = 16 * (gi + 1);
    for (int c = w; c < nch; c += 8) {
        const size_t tok = (size_t)b * SEQ + c * 64 + lane;
        const float iv = ifg[tok * 8 + h], lf = ifg[tok * 8 + 4 + h];
        const float bc = wave_incl_sum(lf, lane);
        const float bl = __shfl(bc, 63);
        const float gm = wave_max(bl - bc + iv);
        if (lane == 0) { F[F_BL + c] = bl; F[F_GM + c] = gm; }
    }
    for (int i = tid; i < 1280; i += NTHREADS) {
        const int j = i >> 8, ch = i & 255; const int gc = ch < 128 ? h * 128 + ch : 512 + h * 128 + (ch - 128);
        F[F_CW + i] = j < 4 ? P.conv_w[j * 1024 + gc] : P.conv_b[gc];
    }
    if (tid < 128) F[F_N + tid] = 0.f;
    __syncthreads();
    if (tid == 0) { float m = 0.f; F[F_M] = 0.f; for (int c = 0; c < nch; ++c) { m = fmaxf(F[F_BL + c] + m, F[F_GM + c]); F[F_M + c + 1] = m; } }
    __syncthreads();
    for (int lc = w; lc < 16; lc += 8) {
        const int c = gi * 16 + lc;
        const size_t tok = (size_t)b * SEQ + c * 64 + lane;
        const float iv = ifg[tok * 8 + h], lf = ifg[tok * 8 + 4 + h];
        const float bc = wave_incl_sum(lf, lane);
        const float bl = __shfl(bc, 63);
        const float mst = F[F_M + c], mnew = F[F_M + c + 1];
        const float beta = iv - bc;
        const float mu = fmaxf(mst, wave_incl_max(beta, lane));
        F[F_SB2 + lc * 64 + lane] = beta * LOG2E;
        F[F_SMU + lc * 64 + lane] = mu * LOG2E;
        F[F_SWI + lc * 64 + lane] = expf(mst - mu);
        F[F_SWN + lc * 64 + lane] = expf(bl - bc + iv - mnew);
        F[F_SEM + lc * 64 + lane] = expf(-(bc + mu));
        if (lane == 0) F[F_SA + lc] = expf(bl + mst - mnew);
    }
    __syncthreads();
}

template <bool NEED_Q>
__device__ __forceinline__ void mlstm_load(const Params& P, LAS unsigned char* lds, int b, int h, int c, int lc) {
    LAS float* F = (LAS float*)(lds + L_F);
    const bf16_t* QK = (const bf16_t*)(P.ws + WS_QK);
    const bf16_t* VA = (const bf16_t*)(P.ws + WS_VA);
    const int tid = threadIdx.x, tg = tid & 15, cg = tid >> 4;
    {
        u32x4 vr[4];
#pragma unroll
        for (int tt = 0; tt < 4; ++tt) vr[tt] = *(const u32x4*)(VA + ((size_t)b * SEQ + c * 64 + 4 * tg + tt) * DM + h * 256 + 8 * cg);
#pragma unroll
        for (int e = 0; e < 8; ++e) {
            unsigned short x0, x1, x2, x3;
            { const unsigned a0 = vr[0][e >> 1], a1 = vr[1][e >> 1], a2 = vr[2][e >> 1], a3 = vr[3][e >> 1];
              if (e & 1) { x0 = a0 >> 16; x1 = a1 >> 16; x2 = a2 >> 16; x3 = a3 >> 16; } else { x0 = a0 & 0xffff; x1 = a1 & 0xffff; x2 = a2 & 0xffff; x3 = a3 & 0xffff; } }
            u32x2 wv; wv.x = (unsigned)x0 | ((unsigned)x1 << 16); wv.y = (unsigned)x2 | ((unsigned)x3 << 16);
            *(LAS u32x2*)(lds + L_VT + (8 * cg + e) * 144 + 8 * tg) = wv;
        }
    }
    __builtin_amdgcn_sched_barrier(0);
    if (NEED_Q || cg >= 16) {
        const int gc = cg < 16 ? h * 128 + 8 * cg : 512 + h * 128 + 8 * (cg - 16);
        u32x4 raw[7];
#pragma unroll
        for (int i = 0; i < 7; ++i) {
            const int pos = c * 64 + 4 * tg - 3 + i;
            raw[i] = pos >= 0 ? *(const u32x4*)(QK + ((size_t)b * SEQ + pos) * DM + gc) : (u32x4){0u, 0u, 0u, 0u};
        }
        float o[4][8];
#pragma unroll
        for (int e = 0; e < 8; ++e) {
            float rv[7];
#pragma unroll
            for (int i = 0; i < 7; ++i) rv[i] = (e & 1) ? bf_hi(raw[i][e >> 1]) : bf_lo(raw[i][e >> 1]);
            const float w0 = F[F_CW + 0 * 256 + 8 * cg + e], w1 = F[F_CW + 1 * 256 + 8 * cg + e], w2 = F[F_CW + 2 * 256 + 8 * cg + e], w3 = F[F_CW + 3 * 256 + 8 * cg + e], cb = F[F_CW + 4 * 256 + 8 * cg + e];
#pragma unroll
            for (int tt = 0; tt < 4; ++tt) { const float v = cb + w0 * rv[tt] + w1 * rv[tt + 1] + w2 * rv[tt + 2] + w3 * rv[tt + 3]; o[tt][e] = v * sigmoid_f(v); }
            __builtin_amdgcn_sched_barrier(0);
        }
        if (cg < 16) {
#pragma unroll
            for (int tt = 0; tt < 4; ++tt) { u32x4 wv; wv.x = cvt_pk_bf16(o[tt][0], o[tt][1]); wv.y = cvt_pk_bf16(o[tt][2], o[tt][3]); wv.z = cvt_pk_bf16(o[tt][4], o[tt][5]); wv.w = cvt_pk_bf16(o[tt][6], o[tt][7]);
                *(LAS u32x4*)(lds + L_QI + (4 * tg + tt) * 272 + 16 * cg) = wv; }
        } else {
            const int kc = cg - 16;
            const f32x4 wn = *(const LAS f32x4*)(F + F_SWN + lc * 64 + 4 * tg);
#pragma unroll
            for (int tt = 0; tt < 4; ++tt) {
#pragma unroll
                for (int e = 0; e < 8; ++e) o[tt][e] *= 0.08838834764831845f;
                u32x4 wv; wv.x = cvt_pk_bf16(o[tt][0], o[tt][1]); wv.y = cvt_pk_bf16(o[tt][2], o[tt][3]); wv.z = cvt_pk_bf16(o[tt][4], o[tt][5]); wv.w = cvt_pk_bf16(o[tt][6], o[tt][7]);
                *(LAS u32x4*)(lds + L_KI + (4 * tg + tt) * 272 + 16 * kc) = wv; }
#pragma unroll
            for (int e = 0; e < 8; ++e) { u32x2 wv; wv.x = cvt_pk_bf16(o[0][e] * wn[0], o[1][e] * wn[1]); wv.y = cvt_pk_bf16(o[2][e] * wn[2], o[3][e] * wn[3]);
                *(LAS u32x2*)(lds + L_KT + (8 * kc + e) * 144 + 8 * tg) = wv; }
        }
    }
}

__device__ __forceinline__ void mlstm_update(LAS unsigned char* lds, f32x4 (&C)[2][8], int lc, int w, int r, int g) {
    LAS float* F = (LAS float*)(lds + L_F);
    const float a = F[F_SA + lc];
    const LAS unsigned char* vp = lds + (L_VT + (32 * w + r) * 144 + 16 * g);
    const LAS unsigned char* kp = lds + (L_KT + r * 144 + 16 * g);
#pragma unroll
    for (int dvb = 0; dvb < 2; ++dvb)
#pragma unroll
        for (int dkb = 0; dkb < 8; ++dkb) C[dvb][dkb] *= a;
#pragma unroll
    for (int ks = 0; ks < 2; ++ks) {
        bf16x8 vf[2];
#pragma unroll
        for (int dvb = 0; dvb < 2; ++dvb) vf[dvb] = *(const LAS bf16x8*)(vp + (16 * dvb * 144 + 64 * ks));
#pragma unroll
        for (int dkb = 0; dkb < 8; ++dkb) {
            const bf16x8 kf = *(const LAS bf16x8*)(kp + (16 * dkb * 144 + 64 * ks));
#pragma unroll
            for (int dvb = 0; dvb < 2; ++dvb) C[dvb][dkb] = mfma16(kf, vf[dvb], C[dvb][dkb]);
        }
        __builtin_amdgcn_sched_barrier(0);
    }
    const int tid = threadIdx.x, dk = tid >> 2, part = tid & 3;
    const u32x4 k0 = *(const LAS u32x4*)(lds + L_KT + dk * 144 + 32 * part), k1 = *(const LAS u32x4*)(lds + L_KT + dk * 144 + 32 * part + 16);
    float s = 0.f;
#pragma unroll
    for (int i = 0; i < 4; ++i) s += bf_lo(k0[i]) + bf_hi(k0[i]) + bf_lo(k1[i]) + bf_hi(k1[i]);
    s += __shfl_xor(s, 1); s += __shfl_xor(s, 2);
    if (part == 0) F[F_N + dk] = a * F[F_N + dk] + s;
}

__device__ void mlstm_phase1(const Params& P, LAS unsigned char* lds) {
    const int tid = threadIdx.x, w = tid >> 6, lane = tid & 63, r = lane & 15, g = lane >> 4;
    LAS float* F = (LAS float*)(lds + L_F);
    for (int task = blockIdx.x; task < 256; task += gridDim.x) {
        const int gi = task & 7, st = task >> 3, b = st >> 2, h = st & 3;
        if (gi == 7) continue;
        mlstm_prologue(P, lds, b, h, gi);
        f32x4 C[2][8];
#pragma unroll
        for (int i = 0; i < 2; ++i)
#pragma unroll
            for (int j = 0; j < 8; ++j) C[i][j] = (f32x4){0.f, 0.f, 0.f, 0.f};
        for (int lc = 0; lc < 16; ++lc) {
            mlstm_load<false>(P, lds, b, h, gi * 16 + lc, lc);
            __syncthreads();
            mlstm_update(lds, C, lc, w, r, g);
            __syncthreads();
        }
        float* slot = (float*)(P.ws + WS_PB) + (size_t)(st * 7 + gi) * STATE_FLOATS;
#pragma unroll
        for (int dvb = 0; dvb < 2; ++dvb)
#pragma unroll
            for (int dkb = 0; dkb < 8; ++dkb) *(f32x4*)(slot + (((w * 2 + dvb) * 8 + dkb) * 64 + lane) * 4) = C[dvb][dkb];
        if (tid < 128) slot[32768 + tid] = F[F_N + tid];
        __syncthreads();
    }
}

__device__ void mlstm_phase2(const Params& P, LAS unsigned char* lds) {
    const int tid = threadIdx.x, w = tid >> 6, lane = tid & 63, r = lane & 15, g = lane >> 4;
    LAS float* F = (LAS float*)(lds + L_F);
    const bf16_t* OA = (const bf16_t*)(P.ws + WS_OA);
    bf16_t* VA = (bf16_t*)(P.ws + WS_VA);
    for (int task = blockIdx.x; task < 256; task += gridDim.x) {
        const int gi = task & 7, st = task >> 3, b = st >> 2, h = st & 3;
        mlstm_prologue(P, lds, b, h, gi);
        f32x4 C[2][8];
#pragma unroll
        for (int i = 0; i < 2; ++i)
#pragma unroll
            for (int j = 0; j < 8; ++j) C[i][j] = (f32x4){0.f, 0.f, 0.f, 0.f};
        float nreg = 0.f;
        for (int j = 0; j < gi; ++j) {
            float Bj = 0.f;
            for (int c = 0; c < 16; ++c) Bj += F[F_BL + j * 16 + c];
            const float Aj = expf(Bj + F[F_M + 16 * j] - F[F_M + 16 * j + 16]);
            const float* slot = (const float*)(P.ws + WS_PB) + (size_t)(st * 7 + j) * STATE_FLOATS;
#pragma unroll
            for (int dvb = 0; dvb < 2; ++dvb)
#pragma unroll
                for (int dkb = 0; dkb < 8; ++dkb) C[dvb][dkb] = C[dvb][dkb] * Aj + *(const f32x4*)(slot + (((w * 2 + dvb) * 8 + dkb) * 64 + lane) * 4);
            if (tid < 128) nreg = nreg * Aj + slot[32768 + tid];
        }
        if (tid < 128) F[F_N + tid] = nreg;
        __syncthreads();
        for (int lc = 0; lc < 16; ++lc) {
            const int c = gi * 16 + lc;
            mlstm_load<true>(P, lds, b, h, c, lc);
            __syncthreads();
            {
                const int tb = w >> 1, par = w & 1;
                const LAS unsigned char* qpS = lds + (L_QI + (16 * tb + r) * 272 + 16 * g);
                const LAS unsigned char* kpS = lds + (L_KI + (16 * par + r) * 272 + 16 * g);
                LAS unsigned char* ppS = lds + (L_PI + (16 * tb + r) * 144 + 32 * par + 8 * g);
                bf16x8 qf[4];
#pragma unroll
                for (int kd = 0; kd < 4; ++kd) qf[kd] = *(const LAS bf16x8*)(qpS + 64 * kd);
                const float mu2 = F[F_SMU + lc * 64 + 16 * tb + r];
                float rs = 0.f;
#pragma unroll
                for (int sbi = 0; sbi < 2; ++sbi) {
                    const int sb = par + 2 * sbi;
                    u32x2 pw = (u32x2){0u, 0u};
                    if (sb <= tb) {
                        f32x4 acc = (f32x4){0.f, 0.f, 0.f, 0.f};
#pragma unroll
                        for (int kd = 0; kd < 4; ++kd) { const bf16x8 kf = *(const LAS bf16x8*)(kpS + (32 * sbi * 272 + 64 * kd)); acc = mfma16(kf, qf[kd], acc); }
                        const f32x4 b2 = *(const LAS f32x4*)(F + F_SB2 + lc * 64 + 16 * sb + 4 * g);
                        float pv[4];
#pragma unroll
                        for (int j = 0; j < 4; ++j) { const int s = 16 * sb + 4 * g + j, t = 16 * tb + r; pv[j] = (s <= t) ? acc[j] * fast_exp2(b2[j] - mu2) : 0.f; }
                        pw.x = cvt_pk_bf16(pv[0], pv[1]); pw.y = cvt_pk_bf16(pv[2], pv[3]);
                        rs += bf_lo(pw.x) + bf_hi(pw.x) + bf_lo(pw.y) + bf_hi(pw.y);
                    }
                    *(LAS u32x2*)(ppS + 64 * sbi) = pw;
                }
                rs += __shfl_xor(rs, 16); rs += __shfl_xor(rs, 32);
                if (g == 0) F[F_RS + par * 64 + 16 * tb + r] = rs;
            }
            __builtin_amdgcn_sched_barrier(0);
            const LAS unsigned char* q8p = lds + (L_QI + r * 272 + 8 * g);
            f32x4 num[2][4];
#pragma unroll
            for (int i = 0; i < 2; ++i)
#pragma unroll
                for (int j = 0; j < 4; ++j) num[i][j] = (f32x4){0.f, 0.f, 0.f, 0.f};
#pragma unroll
            for (int kk = 0; kk < 4; ++kk) {
                bf16x8 af[2];
#pragma unroll
                for (int dvb = 0; dvb < 2; ++dvb) {
                    u32x2 lo, hi; lo.x = cvt_pk_bf16(C[dvb][2 * kk][0], C[dvb][2 * kk][1]); lo.y = cvt_pk_bf16(C[dvb][2 * kk][2], C[dvb][2 * kk][3]);
                    hi.x = cvt_pk_bf16(C[dvb][2 * kk + 1][0], C[dvb][2 * kk + 1][1]); hi.y = cvt_pk_bf16(C[dvb][2 * kk + 1][2], C[dvb][2 * kk + 1][3]);
                    af[dvb] = mk8(lo, hi);
                }
#pragma unroll
                for (int tb = 0; tb < 4; ++tb) {
                    const u32x2 q0 = *(const LAS u32x2*)(q8p + (16 * tb * 272 + 64 * kk)), q1 = *(const LAS u32x2*)(q8p + (16 * tb * 272 + 64 * kk + 32));
                    const bf16x8 bq = mk8(q0, q1);
#pragma unroll
                    for (int dvb = 0; dvb < 2; ++dvb) num[dvb][tb] = mfma16(af[dvb], bq, num[dvb][tb]);
                }
                __builtin_amdgcn_sched_barrier(0);
            }
#pragma unroll
            for (int tb = 0; tb < 4; ++tb) { const float wi = F[F_SWI + lc * 64 + 16 * tb + r];
#pragma unroll
                for (int dvb = 0; dvb < 2; ++dvb) num[dvb][tb] *= wi; }
            {
                const int t = tid >> 3, part = tid & 7;
                const u32x4 q0 = *(const LAS u32x4*)(lds + L_QI + t * 272 + 32 * part), q1 = *(const LAS u32x4*)(lds + L_QI + t * 272 + 32 * part + 16);
                float s = 0.f;
#pragma unroll
                for (int i = 0; i < 4; ++i) {
                    s += bf_lo(q0[i]) * F[F_N + 16 * part + 2 * i] + bf_hi(q0[i]) * F[F_N + 16 * part + 2 * i + 1];
                    s += bf_lo(q1[i]) * F[F_N + 16 * part + 8 + 2 * i] + bf_hi(q1[i]) * F[F_N + 16 * part + 8 + 2 * i + 1];
                }
                s += __shfl_xor(s, 1); s += __shfl_xor(s, 2); s += __shfl_xor(s, 4);
                if (part == 0) F[F_QN + t] = s;
            }
            __builtin_amdgcn_sched_barrier(0);
            __syncthreads();
            const LAS unsigned char* vpC = lds + (L_VT + (32 * w + r) * 144 + 16 * g);
            const LAS unsigned char* ppC = lds + (L_PI + r * 144 + 16 * g);
#pragma unroll
            for (int ks = 0; ks < 2; ++ks) {
                bf16x8 vf[2];
#pragma unroll
                for (int dvb = 0; dvb < 2; ++dvb) vf[dvb] = *(const LAS bf16x8*)(vpC + (16 * dvb * 144 + 64 * ks));
#pragma unroll
                for (int tb = 0; tb < 4; ++tb) {
                    if (ks == 0 || tb >= 2) {
                        const bf16x8 pb = *(const LAS bf16x8*)(ppC + (16 * tb * 144 + 64 * ks));
#pragma unroll
                        for (int dvb = 0; dvb < 2; ++dvb) num[dvb][tb] = mfma16(vf[dvb], pb, num[dvb][tb]);
                    }
                }
                __builtin_amdgcn_sched_barrier(0);
            }
#pragma unroll
            for (int tb = 0; tb < 4; ++tb) {
                const int t = 16 * tb + r;
                const float den = F[F_SWI + lc * 64 + t] * F[F_QN + t] + F[F_RS + t] + F[F_RS + 64 + t];
                const float inv = 1.0f / fmaxf(fabsf(den), F[F_SEM + lc * 64 + t]);
                float s1 = 0.f, s2 = 0.f;
#pragma unroll
                for (int dvb = 0; dvb < 2; ++dvb) { num[dvb][tb] *= inv;
#pragma unroll
                    for (int j = 0; j < 4; ++j) { const float v = num[dvb][tb][j]; s1 += v; s2 += v * v; } }
                s1 += __shfl_xor(s1, 16); s1 += __shfl_xor(s1, 32); s2 += __shfl_xor(s2, 16); s2 += __shfl_xor(s2, 32);
                if (g == 0) { F[F_HS + (w * 64 + t) * 2] = s1; F[F_HS + (w * 64 + t) * 2 + 1] = s2; }
                __builtin_amdgcn_sched_barrier(0);
            }
            mlstm_update(lds, C, lc, w, r, g);
            __builtin_amdgcn_sched_barrier(0);
            __syncthreads();
#pragma unroll
            for (int tb = 0; tb < 4; ++tb) {
                const int t = 16 * tb + r;
                float s1 = 0.f, s2 = 0.f;
#pragma unroll
                for (int ww = 0; ww < 8; ++ww) { s1 += F[F_HS + (ww * 64 + t) * 2]; s2 += F[F_HS + (ww * 64 + t) * 2 + 1]; }
                const float mean = s1 * (1.0f / 256.0f), var = fmaxf(s2 * (1.0f / 256.0f) - mean * mean, 0.f), rstd = rsqrtf(var + LN_EPS);
                const size_t tok = (size_t)b * SEQ + c * 64 + t;
#pragma unroll
                for (int dvb = 0; dvb < 2; ++dvb) {
                    const int dv0 = 32 * w + 16 * dvb + 4 * g;
                    const f32x4 gn = *(const f32x4*)(P.mh_g + h * 256 + dv0);
                    const u32x2 og = *(const u32x2*)(OA + tok * DM + h * 256 + dv0);
                    const float y0 = (num[dvb][tb][0] - mean) * rstd * gn[0] * bf_lo(og.x), y1 = (num[dvb][tb][1] - mean) * rstd * gn[1] * bf_hi(og.x);
                    const float y2 = (num[dvb][tb][2] - mean) * rstd * gn[2] * bf_lo(og.y), y3 = (num[dvb][tb][3] - mean) * rstd * gn[3] * bf_hi(og.y);
                    u32x2 wv; wv.x = cvt_pk_bf16(y0, y1); wv.y = cvt_pk_bf16(y2, y3);
                    *(u32x2*)(VA + tok * DM + h * 256 + dv0) = wv;
                }
            }
        }
        __syncthreads();
    }
}

constexpr int A_KI = 0, A_VT = 17408, A_FL = 35840;
constexpr float SB_DONE_LOG2 = -40.0f;

__device__ void attn_phase(const Params& P, LAS unsigned char* lds) {
    const int tid = threadIdx.x, w = tid >> 6, lane = tid & 63, r = lane & 15, g = lane >> 4;
    bf16_t* QB = (bf16_t*)(P.ws + WS_QB);
    const bf16_t* KB = (const bf16_t*)(P.ws + WS_KB);
    const bf16_t* VB = (const bf16_t*)(P.ws + WS_VB);
    unsigned* cnt = (unsigned*)(P.ws + MISC_CNT);
    LAS int* FL = (LAS int*)(lds + A_FL);
    for (;;) {
        if (tid == 0) FL[32] = (int)atomicAdd(cnt, 1u);
        __syncthreads();
        const int item = FL[32];
        __syncthreads();
        if (item >= 4096) break;
        const int qb = 63 - (item >> 6), b = (item >> 3) & 7, h = item & 7;
        const int q0w = qb * 128 + 16 * w;
        const size_t qtok = (size_t)b * SEQ + q0w + r;
        bf16x8 qf[4];
#pragma unroll
        for (int kd = 0; kd < 4; ++kd) qf[kd] = *(const bf16x8*)(QB + qtok * DM + h * 128 + 32 * kd + 8 * g);
        f32x4 O[8];
#pragma unroll
        for (int i = 0; i < 8; ++i) O[i] = (f32x4){0.f, 0.f, 0.f, 0.f};
        float R = 0.f;
        int wdone = 0, it = 0;
        for (int kt = 2 * qb + 1; kt >= 0; --kt, ++it) {
            if (tid < 256) {
                const int tg = tid & 15, cg = tid >> 4;
                u32x4 vr[4];
#pragma unroll
                for (int tt = 0; tt < 4; ++tt) vr[tt] = *(const u32x4*)(VB + ((size_t)b * SEQ + kt * 64 + 4 * tg + tt) * DM + h * 128 + 8 * cg);
#pragma unroll
                for (int e = 0; e < 8; ++e) {
                    unsigned short x0, x1, x2, x3;
                    { const unsigned a0 = vr[0][e >> 1], a1 = vr[1][e >> 1], a2 = vr[2][e >> 1], a3 = vr[3][e >> 1];
                      if (e & 1) { x0 = a0 >> 16; x1 = a1 >> 16; x2 = a2 >> 16; x3 = a3 >> 16; } else { x0 = a0 & 0xffff; x1 = a1 & 0xffff; x2 = a2 & 0xffff; x3 = a3 & 0xffff; } }
                    u32x2 wv; wv.x = (unsigned)x0 | ((unsigned)x1 << 16); wv.y = (unsigned)x2 | ((unsigned)x3 << 16);
                    *(LAS u32x2*)(lds + A_VT + (8 * cg + e) * 144 + 8 * tg) = wv;
                }
            } else {
                const int t2 = tid - 256, row = t2 >> 2, ch = t2 & 3;
                const bf16_t* src = KB + ((size_t)b * SEQ + kt * 64 + row) * DM + h * 128 + 32 * ch;
#pragma unroll
                for (int i = 0; i < 4; ++i) *(LAS u32x4*)(lds + A_KI + row * 272 + 64 * ch + 16 * i) = *(const u32x4*)(src + 8 * i);
            }
            __syncthreads();
            const int key0 = kt * 64;
            if (!wdone && key0 <= q0w + 14) {
                const int qpos = q0w + r;
                float wgt[4][4];
                float Rrun = R;
#pragma unroll
                for (int sb = 3; sb >= 0; --sb) {
                    f32x4 acc = (f32x4){0.f, 0.f, 0.f, 0.f};
#pragma unroll
                    for (int kd = 0; kd < 4; ++kd) { const bf16x8 kf = *(const LAS bf16x8*)(lds + A_KI + (16 * sb + r) * 272 + 64 * kd + 16 * g); acc = mfma16(kf, qf[kd], acc); }
                    float lk[4], z[4];
#pragma unroll
                    for (int j = 0; j < 4; ++j) {
                        const int key = key0 + 16 * sb + 4 * g + j;
                        z[j] = fminf(acc[j], 80.0f);
                        lk[j] = (key < qpos) ? -fast_log2(1.0f + fast_exp2(z[j])) : 0.f;
                    }
                    const float s3 = lk[3], s2 = s3 + lk[2], s1 = s2 + lk[1], s0 = s1 + lk[0];
                    const float t1 = __shfl_xor(s0, 16), t2 = __shfl_xor(s0, 32), t3 = __shfl_xor(t1, 32);
                    const float above = g == 0 ? (t1 + t2 + t3) : (g == 1 ? (t2 + t3) : (g == 2 ? t1 : 0.f));
                    const float base = Rrun + above;
                    const float sj[4] = {s0, s1, s2, s3};
#pragma unroll
                    for (int j = 0; j < 4; ++j) { const int key = key0 + 16 * sb + 4 * g + j; wgt[sb][j] = (key < qpos) ? fast_exp2(z[j] + base + sj[j]) : 0.f; }
                    Rrun += (s0 + t1) + (t2 + t3);
                }
                R = Rrun;
#pragma unroll
                for (int ks = 0; ks < 2; ++ks) {
                    u32x2 lo, hi; lo.x = cvt_pk_bf16(wgt[2 * ks][0], wgt[2 * ks][1]); lo.y = cvt_pk_bf16(wgt[2 * ks][2], wgt[2 * ks][3]);
                    hi.x = cvt_pk_bf16(wgt[2 * ks + 1][0], wgt[2 * ks + 1][1]); hi.y = cvt_pk_bf16(wgt[2 * ks + 1][2], wgt[2 * ks + 1][3]);
                    const bf16x8 pf = mk8(lo, hi);
#pragma unroll
                    for (int db = 0; db < 8; ++db) {
                        const u32x2 v0 = *(const LAS u32x2*)(lds + A_VT + (16 * db + r) * 144 + 64 * ks + 8 * g), v1 = *(const LAS u32x2*)(lds + A_VT + (16 * db + r) * 144 + 64 * ks + 32 + 8 * g);
                        O[db] = mfma16(mk8(v0, v1), pf, O[db]);
                    }
                }
                wdone = __all(R < SB_DONE_LOG2) ? 1 : 0;
            }
            if (lane == 0) FL[(it & 1) * 8 + w] = wdone;
            __syncthreads();
            int alld = 1;
#pragma unroll
            for (int i = 0; i < 8; ++i) alld &= FL[(it & 1) * 8 + i];
            if (alld) break;
        }
#pragma unroll
        for (int db = 0; db < 8; ++db) { u32x2 wv; wv.x = cvt_pk_bf16(O[db][0], O[db][1]); wv.y = cvt_pk_bf16(O[db][2], O[db][3]);
            *(u32x2*)(QB + qtok * DM + h * 128 + 16 * db + 4 * g) = wv; }
        __syncthreads();
    }
}


#ifdef DIAG
__device__ void diag_count_f32(const float* p, size_t n, float thr, unsigned* ctr) {
    unsigned c = 0;
    for (size_t i = (size_t)blockIdx.x * NTHREADS + threadIdx.x; i < n; i += (size_t)gridDim.x * NTHREADS) { const float v = p[i]; if (!(fabsf(v) <= thr)) ++c; }
    if (c) atomicAdd(ctr, c);
}
__device__ void diag_count_bf16(const bf16_t* p, size_t n, float thr, unsigned* ctr) {
    unsigned c = 0;
    for (size_t i = (size_t)blockIdx.x * NTHREADS + threadIdx.x; i < n; i += (size_t)gridDim.x * NTHREADS) { const float v = __uint_as_float((unsigned)p[i] << 16); if (!(fabsf(v) <= thr)) ++c; }
    if (c) atomicAdd(ctr, c);
}
#endif
constexpr int LDS_BYTES = 135168;
static_assert(MIX_LDS <= LDS_BYTES && 128 * 129 * 4 <= LDS_BYTES && pg8::STAGE_BYTES <= LDS_BYTES, "LDS budget");
constexpr int NPHASE = 17;

template <class Epi>
__device__ __forceinline__ void run_gemm(LAS unsigned char* lds, const bf16_t* A, const bf16_t* Bt, int N, int K, const Epi& E) {
    pg8::Gemm g{A, Bt, MTOK, N, K};
    pg8::StaticOrder S; S.init(MTOK, N, gridDim.x, blockIdx.x);
    pg8::gemm_phase<Epi, pg8::StaticOrder>(lds, g, S, E);
}

__global__ void __launch_bounds__(NTHREADS, 2) fwd_megakernel(Params P) {
    extern __shared__ __attribute__((aligned(16))) unsigned char smem[];
    LAS unsigned char* lds = (LAS unsigned char*)smem;
    cg::grid_group grid = cg::this_grid();
    unsigned char* ws = P.ws;
    bf16_t* X = (bf16_t*)(ws + WS_X);
    bf16_t* H = (bf16_t*)(ws + WS_H);
    float* Y = P.out;
    bf16_t* gates = (bf16_t*)P.out;
#ifdef ONLYMASK
#define PHASE(k) if (((ONLYMASK >> (k)) & 1) && P.ph_lo <= (k) && (k) < P.ph_hi)
#else
#define PHASE(k) if (P.ph_lo <= (k) && (k) < P.ph_hi)
#endif
#define SYNC() do { if (P.coop) { asm volatile("s_waitcnt vmcnt(0) lgkmcnt(0)" ::: "memory"); grid.sync(); \
        if (threadIdx.x < 64) { __builtin_amdgcn_fence(__ATOMIC_ACQUIRE, "agent"); asm volatile("s_waitcnt vmcnt(0)" ::: "memory"); } __syncthreads(); } } while (0)
    PHASE(0) prep_phase(P, lds);
    SYNC();
    PHASE(1) run_gemm(lds, X, (const bf16_t*)(ws + W_GU1), 5632, 1024, EpiSwiglu{H});
    SYNC();
    PHASE(2) run_gemm(lds, H, (const bf16_t*)(ws + W_D1), 1024, FH, EpiResid<false, false, true>{P.x, nullptr, Y, 0.5f});
    SYNC();
    PHASE(3) ln_phase<true, true>(Y, P.ln_g, P.ln_b, X);
    SYNC();
    PHASE(4) run_gemm(lds, X, (const bf16_t*)(ws + W_IN), NIN_PAD, 1024, EpiWin{(bf16_t*)(ws + WS_QK), gates, (float*)(ws + MISC_IF), (const float*)(ws + W_BIAS)});
    SYNC();
    PHASE(5) mlstm_phase1(P, lds);
    SYNC();
    PHASE(6) {
#ifndef NO_ML2
        mlstm_phase2(P, lds);
#endif
#ifndef NO_ATT
        attn_phase(P, lds);
#endif
    }
    SYNC();
    PHASE(7) {
        run_gemm(lds, (const bf16_t*)(ws + WS_VA), (const bf16_t*)(ws + W_A), 1024, 1024, EpiGateMul<false>{gates, 0, nullptr, (bf16_t*)(ws + WS_T)});
        run_gemm(lds, (const bf16_t*)(ws + WS_QB), (const bf16_t*)(ws + W_B), 1024, 1024, EpiGateMul<true>{gates, DM, (const bf16_t*)(ws + WS_T), (bf16_t*)(ws + WS_MG)});
    }
    SYNC();
    PHASE(8) run_gemm(lds, (const bf16_t*)(ws + WS_MG), (const bf16_t*)(ws + W_O), 1024, 1024, EpiResid<true, false, true>{X, nullptr, Y, 1.0f});
    SYNC();
    PHASE(9) ln_phase<true, true>(Y, P.ln_g + DM, P.ln_b + DM, X);
    SYNC();
    PHASE(10) run_gemm(lds, X, (const bf16_t*)(ws + W_GU2), 5632, 1024, EpiSwiglu{H});
    SYNC();
    PHASE(11) run_gemm(lds, H, (const bf16_t*)(ws + W_D2), 1024, FH, EpiResid<true, false, true>{X, nullptr, Y, 0.5f});
    SYNC();
    PHASE(12) { ln_phase<true, true>(Y, P.ln_g + 2 * DM, P.ln_b + 2 * DM, X); cvt_bf16_phase(P.p, (bf16_t*)(ws + WS_PB), (size_t)MTOK * 256 / 8); }
    SYNC();
    PHASE(13) {
        run_gemm(lds, X, (const bf16_t*)(ws + W_PG), 1024, 1024, EpiSigBias{P.b_pg, (bf16_t*)(ws + WS_PG)});
        run_gemm(lds, (const bf16_t*)(ws + WS_PB), (const bf16_t*)(ws + W_P), 1024, 256, EpiResid<true, true>{X, (const bf16_t*)(ws + WS_PG), Y, 1.0f});
    }
    SYNC();
    PHASE(14) ln_phase<false>(Y, P.ln_g + 3 * DM, P.ln_b + 3 * DM, P.out);
#undef PHASE
#undef SYNC
}

extern "C" void kernel_launch(void* const* d_in, const int* in_sizes, int n_in, void* d_out, int out_size, void* d_ws, size_t ws_size, hipStream_t stream) {
    static int grid_blocks = 0;
    if (grid_blocks == 0) {
        if (n_in != 19 || out_size != MTOK * DM || ws_size < WS_END) { fprintf(stderr, "kernel_launch: unexpected shapes (n_in %d, out %d, ws %zu, need %zu)\n", n_in, out_size, ws_size, (size_t)WS_END); grid_blocks = -1; return; }
        int dev = 0, cus = 0, per_cu = 0;
        hipGetDevice(&dev);
        hipDeviceGetAttribute(&cus, hipDeviceAttributeMultiprocessorCount, dev);
        if (hipFuncSetAttribute((const void*)fwd_megakernel, hipFuncAttributeMaxDynamicSharedMemorySize, LDS_BYTES) != hipSuccess) { fprintf(stderr, "kernel_launch: hipFuncSetAttribute failed\n"); grid_blocks = -1; return; }
        if (hipOccupancyMaxActiveBlocksPerMultiprocessor(&per_cu, (const void*)fwd_megakernel, NTHREADS, LDS_BYTES) != hipSuccess || per_cu < 1) { fprintf(stderr, "kernel_launch: occupancy query failed (%d)\n", per_cu); per_cu = 1; (void)hipGetLastError(); }
        grid_blocks = cus * per_cu;
    }
    if (grid_blocks < 0) return;
    Params p{};
    p.x = (const float*)d_in[0]; p.p = (const float*)d_in[1]; p.ln_g = (const float*)d_in[2]; p.ln_b = (const float*)d_in[3];
    p.wg = (const float*)d_in[4]; p.wu = (const float*)d_in[5]; p.wd = (const float*)d_in[6]; p.w_in = (const float*)d_in[7]; p.b_in = (const float*)d_in[8];
    p.b_forget = (const float*)d_in[9]; p.conv_w = (const float*)d_in[10]; p.conv_b = (const float*)d_in[11]; p.mh_g = (const float*)d_in[12];
    p.w_a = (const float*)d_in[13]; p.w_b = (const float*)d_in[14]; p.w_o = (const float*)d_in[15]; p.w_ple = (const float*)d_in[16]; p.w_pg = (const float*)d_in[17]; p.b_pg = (const float*)d_in[18];
    p.out = (float*)d_out; p.ws = (unsigned char*)d_ws; p.pad = 0;
#if ONE_LAUNCH
    p.ph_lo = 0; p.ph_hi = NPHASE; p.coop = 1;
    void* args[] = {&p};
    hipError_t e = hipLaunchCooperativeKernel((const void*)fwd_megakernel, dim3(grid_blocks), dim3(NTHREADS), args, LDS_BYTES, stream);
    if (e != hipSuccess) fprintf(stderr, "cooperative launch failed: %s (grid %d)\n", hipGetErrorString(e), grid_blocks);
#else
    p.coop = 0;
    for (int ph = 0; ph < 15; ++ph) { p.ph_lo = ph; p.ph_hi = ph + 1; hipLaunchKernelGGL(fwd_megakernel, dim3(grid_blocks), dim3(NTHREADS), LDS_BYTES, stream, p); }
#endif
}
```

```cpp
#include <hip/hip_runtime.h>
#include <hip/hip_cooperative_groups.h>
#include <cstdio>
namespace cg = cooperative_groups;

#ifndef ONE_LAUNCH
#define ONE_LAUNCH 1
#endif

#define LAS __attribute__((address_space(3)))
typedef unsigned short bf16_t;
typedef short bf16x8 __attribute__((ext_vector_type(8)));
typedef float f32x4 __attribute__((ext_vector_type(4)));
typedef float f32x2 __attribute__((ext_vector_type(2)));
typedef unsigned u32x4 __attribute__((ext_vector_type(4)));
typedef unsigned u32x2 __attribute__((ext_vector_type(2)));

constexpr int MTOK = 65536, DM = 1024, FH = 2816, SEQ = 8192;
constexpr int NIN_PAD = 8448;
constexpr float ALPHA = 1.189207115002721f;
constexpr float LN_EPS = 1e-5f;
constexpr float LOG2E = 1.4426950408889634f;
constexpr int NTHREADS = 512;

constexpr size_t QB_ = 33554432ull;
constexpr size_t WS_W = 0;
constexpr size_t W_GU1 = 0;
constexpr size_t W_D1 = W_GU1 + 5632ull * 1024 * 2;
constexpr size_t W_GU2 = W_D1 + 1024ull * 2816 * 2;
constexpr size_t W_D2 = W_GU2 + 5632ull * 1024 * 2;
constexpr size_t W_IN = W_D2 + 1024ull * 2816 * 2;
constexpr size_t W_A = W_IN + 8448ull * 1024 * 2;
constexpr size_t W_B = W_A + 1024ull * 1024 * 2;
constexpr size_t W_O = W_B + 1024ull * 1024 * 2;
constexpr size_t W_PG = W_O + 1024ull * 1024 * 2;
constexpr size_t W_P = W_PG + 1024ull * 1024 * 2;
constexpr size_t W_BIAS = W_P + 1024ull * 256 * 2;
static_assert(W_BIAS + 8448 * 4 <= 2 * QB_, "weights overflow");
constexpr size_t WS_PB = 2 * QB_;
constexpr size_t WS_MISC = 3 * QB_;
constexpr size_t MISC_IF = WS_MISC;
constexpr size_t MISC_CNT = WS_MISC + 2097152ull;
constexpr size_t WS_X = 4 * QB_;
constexpr size_t WS_H = 8 * QB_;
constexpr size_t WS_QK = 8 * QB_, WS_VA = 12 * QB_, WS_OA = 16 * QB_, WS_QB = 20 * QB_, WS_KB = 24 * QB_, WS_VB = 28 * QB_;
constexpr size_t WS_T = WS_QK, WS_MG = WS_KB, WS_PG = 8 * QB_;
constexpr size_t WS_END = 32 * QB_;
constexpr int STATE_FLOATS = 32768 + 128;

typedef __bf16 bf16x2_t __attribute__((ext_vector_type(2)));
__device__ __forceinline__ unsigned cvt_pk_bf16(float lo, float hi) { f32x2 v = {lo, hi}; bf16x2_t r = __builtin_convertvector(v, bf16x2_t); return __builtin_bit_cast(unsigned, r); }
__device__ __forceinline__ float bf_lo(unsigned u) { return __uint_as_float(u << 16); }
__device__ __forceinline__ float bf_hi(unsigned u) { return __uint_as_float(u & 0xffff0000u); }
__device__ __forceinline__ float fast_exp2(float x) { return __builtin_amdgcn_exp2f(x); }
__device__ __forceinline__ float fast_log2(float x) { return __builtin_amdgcn_logf(x); }
__device__ __forceinline__ float fast_rcp(float x) { return __builtin_amdgcn_rcpf(x); }
__device__ __forceinline__ float sigmoid_f(float x) { return fast_rcp(1.0f + fast_exp2(-x * LOG2E)); }
__device__ __forceinline__ f32x4 mfma16(bf16x8 a, bf16x8 b, f32x4 c) { return __builtin_amdgcn_mfma_f32_16x16x32_bf16(a, b, c, 0, 0, 0); }
__device__ __forceinline__ bf16x8 mk8(u32x2 lo, u32x2 hi) { u32x4 v; v.x = lo.x; v.y = lo.y; v.z = hi.x; v.w = hi.y; return __builtin_bit_cast(bf16x8, v); }
__device__ __forceinline__ float wave_sum(float v) {
#pragma unroll
    for (int o = 32; o > 0; o >>= 1) v += __shfl_xor(v, o);
    return v;
}
__device__ __forceinline__ float wave_max(float v) {
#pragma unroll
    for (int o = 32; o > 0; o >>= 1) v = fmaxf(v, __shfl_xor(v, o));
    return v;
}
__device__ __forceinline__ float wave_incl_sum(float v, int lane) {
#pragma unroll
    for (int o = 1; o < 64; o <<= 1) { float t = __shfl_up(v, o); if (lane >= o) v += t; }
    return v;
}
__device__ __forceinline__ float wave_incl_max(float v, int lane) {
#pragma unroll
    for (int o = 1; o < 64; o <<= 1) { float t = __shfl_up(v, o); if (lane >= o) v = fmaxf(v, t); }
    return v;
}

namespace pg8 {
constexpr int BM = 256, BK = 64, HALF = 128, HTB = HALF * BK * 2, STAGE_BYTES = 8 * HTB, NXCD = 8, WGM = 8;
__host__ __device__ __forceinline__ int lds_byte(int r, int c) { const int st = (r >> 4) * 2 + (c >> 5), rr = r & 15, cc = c & 31, ob = rr * 64 + cc * 2; return st * 1024 + (ob ^ (((ob >> 9) & 1) << 5)); }
__host__ __device__ __forceinline__ void stage_rc(int b, int& R, int& C) { const int st = b / 1024, sb = b % 1024, swz = sb ^ (((sb >> 9) & 1) << 5); R = (st >> 1) * 16 + swz / 64; C = (st & 1) * 32 + (swz % 64) / 2; }
__host__ __device__ __forceinline__ int perm32(int rho) { const int n = rho >> 4, i = rho & 15; return 8 * (i >> 2) + 4 * n + (i & 3); }
struct Unit { int pm, pn; };
struct Gemm { const bf16_t* A; const bf16_t* Bt; int M, N, K; };
struct StaticOrder {
    int nM, nN, nwg, G, c;
    __device__ void init(int M, int N, int G_, int c_) { nM = M / BM; nN = N / BM; nwg = nM * nN; G = G_; c = c_; }
    __device__ bool next(int i, Unit& u) const {
        const long L = (long)i * G + c; if (L >= nwg) return false;
        int wgid = (int)L; { const int q = nwg / NXCD, r = nwg % NXCD, xcd = wgid % NXCD, off = wgid / NXCD; wgid = (xcd < r ? xcd * (q + 1) : r * (q + 1) + (xcd - r) * q) + off; }
        const int nig = WGM * nN, gid = wgid / nig, fm = gid * WGM, gsz = (nM - fm) < WGM ? (nM - fm) : WGM;
        u.pm = fm + ((wgid % nig) % gsz); u.pn = (wgid % nig) / gsz; return true;
    }
};
template <class Epi, class Sched>
__device__ __forceinline__ void gemm_phase(LAS unsigned char* lds, const Gemm g, const Sched& S, const Epi& E) {
    const int tid = threadIdx.x, wid = __builtin_amdgcn_readfirstlane(tid >> 6), lane = tid & 63, wr = wid >> 2, wc = wid & 3, fr = lane & 15, fq = lane >> 4;
    const int K = g.K, nt = K / BK;
    unsigned voffA[2], voffB[2];
#pragma unroll
    for (int i = 0; i < 2; ++i) { int R, C; stage_rc(tid * 16 + i * 8192, R, C); const int Rb = ((R & ~31) + perm32(R & 31));
        voffA[i] = (unsigned)(R * K + C) * 2u; voffB[i] = (unsigned)(Rb * K + C) * 2u; }
    const size_t kstep = (size_t)(BK * 2);
    const size_t hstep = (size_t)HALF * K * 2;
    const size_t tstep = 2 * hstep;
    const unsigned ldsw = (unsigned)wid * 1024u;
    const int aoff = lds_byte(wr * 64 + fr, fq * 8), boff = lds_byte(wc * 32 + fr, fq * 8);
#define PG8_SA(b, h) (((b) * 2 + (h)) * HTB)
#define PG8_SB(b, h) ((4 + (b) * 2 + (h)) * HTB)
#define PG8_STAGE(bufoff, gbase, voff) do { _Pragma("unroll") for (int _i = 0; _i < 2; ++_i) \
        __builtin_amdgcn_global_load_lds((const unsigned*)((const char*)(gbase) + (voff)[_i]), (LAS unsigned*)(lds + (bufoff) + ldsw + _i * 8192), 16, 0, 0); } while (0)
#define PG8_LDA(dst, b, h) do { _Pragma("unroll") for (int m = 0; m < 4; ++m) _Pragma("unroll") for (int k = 0; k < 2; ++k) dst[m][k] = *(const LAS bf16x8*)(lds + PG8_SA(b, h) + aoff + m * 2048 + k * 1024); } while (0)
#define PG8_LDB(dst, b, h) do { _Pragma("unroll") for (int n = 0; n < 2; ++n) _Pragma("unroll") for (int k = 0; k < 2; ++k) dst[n][k] = *(const LAS bf16x8*)(lds + PG8_SB(b, h) + boff + n * 2048 + k * 1024); } while (0)
#define PG8_MMA(ai, bj, At, Bt) do { __builtin_amdgcn_s_setprio(1); _Pragma("unroll") for (int m = 0; m < 4; ++m) _Pragma("unroll") for (int n = 0; n < 2; ++n) _Pragma("unroll") for (int k = 0; k < 2; ++k) \
        acc[ai][bj][m][n] = __builtin_amdgcn_mfma_f32_16x16x32_bf16(Bt[n][k], At[m][k], acc[ai][bj][m][n], 0, 0, 0); __builtin_amdgcn_s_setprio(0); } while (0)
#define PG8_WAIT_V(n) asm volatile("s_waitcnt vmcnt(" #n ")" ::: "memory")
#define PG8_WAIT_L(n) asm volatile("s_waitcnt lgkmcnt(" #n ")" ::: "memory")
#define PG8_BAR __builtin_amdgcn_s_barrier()
#define PG8_SCHED __builtin_amdgcn_sched_barrier(0)
    Unit cur, nxt; int ui = 0;
    if (!S.next(0, cur)) return;
    f32x4 acc[2][2][4][2];
#pragma unroll
    for (int a = 0; a < 2; ++a)
#pragma unroll
        for (int b = 0; b < 2; ++b)
#pragma unroll
            for (int m = 0; m < 4; ++m)
#pragma unroll
                for (int n = 0; n < 2; ++n) acc[a][b][m][n] = (f32x4){0.f, 0.f, 0.f, 0.f};
    bf16x8 At[4][2], B0[2][2], B1[2][2];
    const char* cA = (const char*)g.A + (size_t)cur.pm * tstep; const char* cB = (const char*)g.Bt + (size_t)cur.pn * tstep;
    PG8_STAGE(PG8_SB(0, 0), cB, voffB); PG8_STAGE(PG8_SA(0, 0), cA, voffA); PG8_STAGE(PG8_SB(0, 1), cB + hstep, voffB); PG8_STAGE(PG8_SA(0, 1), cA + hstep, voffA);
    if (wr == 1) PG8_BAR;
    PG8_WAIT_V(4); PG8_BAR;
    PG8_STAGE(PG8_SB(1, 0), cB + kstep, voffB); PG8_STAGE(PG8_SA(1, 0), cA + kstep, voffA); PG8_STAGE(PG8_SB(1, 1), cB + hstep + kstep, voffB);
    PG8_WAIT_V(6); PG8_BAR;
    for (;;) {
        const bool has_next = S.next(ui + 1, nxt);
        const char* nA = has_next ? (const char*)g.A + (size_t)nxt.pm * tstep : cA; const char* nB = has_next ? (const char*)g.Bt + (size_t)nxt.pn * tstep : cB;
        for (int t = 0; t < nt; t += 2) {
            const bool last = (t == nt - 2);
            const char* a1 = cA + (size_t)(t + 1) * kstep;
            const char* a2 = last ? nA : cA + (size_t)(t + 2) * kstep; const char* b2 = last ? nB : cB + (size_t)(t + 2) * kstep;
            const char* a3 = a2 + kstep; const char* b3 = b2 + kstep;
            PG8_LDB(B0, 0, 0); PG8_SCHED; PG8_LDA(At, 0, 0); PG8_STAGE(PG8_SA(1, 1), a1 + hstep, voffA);
            PG8_WAIT_L(8); PG8_BAR; PG8_WAIT_L(0); PG8_MMA(0, 0, At, B0); PG8_BAR; PG8_SCHED;
            PG8_LDB(B1, 0, 1); PG8_STAGE(PG8_SB(0, 0), b2, voffB);
            PG8_BAR; PG8_WAIT_L(0); PG8_MMA(0, 1, At, B1); PG8_BAR;
            PG8_LDA(At, 0, 1); PG8_STAGE(PG8_SA(0, 0), a2, voffA);
            PG8_BAR; PG8_WAIT_L(0); PG8_MMA(1, 0, At, B0); PG8_BAR; PG8_SCHED;
            PG8_STAGE(PG8_SB(0, 1), b2 + hstep, voffB);
            PG8_WAIT_V(6); PG8_BAR; PG8_MMA(1, 1, At, B1); PG8_BAR;
            PG8_LDB(B0, 1, 0); PG8_SCHED; PG8_LDA(At, 1, 0); PG8_STAGE(PG8_SA(0, 1), a2 + hstep, voffA);
            PG8_WAIT_L(8); PG8_BAR; PG8_WAIT_L(0); PG8_MMA(0, 0, At, B0); PG8_BAR; PG8_SCHED;
            PG8_LDB(B1, 1, 1); PG8_STAGE(PG8_SB(1, 0), b3, voffB);
            PG8_BAR; PG8_WAIT_L(0); PG8_MMA(0, 1, At, B1); PG8_BAR;
            PG8_LDA(At, 1, 1); PG8_STAGE(PG8_SA(1, 0), a3, voffA);
            PG8_BAR; PG8_WAIT_L(0); PG8_MMA(1, 0, At, B0); PG8_BAR; PG8_SCHED;
            PG8_STAGE(PG8_SB(1, 1), b3 + hstep, voffB);
            PG8_WAIT_V(6); PG8_BAR; PG8_MMA(1, 1, At, B1); PG8_BAR;
        }
        E(acc, cur, wr, wc, fr, fq);
        if (!has_next) break;
#pragma unroll
        for (int a = 0; a < 2; ++a)
#pragma unroll
            for (int b = 0; b < 2; ++b)
#pragma unroll
                for (int m = 0; m < 4; ++m)
#pragma unroll
                    for (int n = 0; n < 2; ++n) acc[a][b][m][n] = (f32x4){0.f, 0.f, 0.f, 0.f};
        cur = nxt; cA = nA; cB = nB; ++ui;
    }
    PG8_WAIT_V(0);
    if (wr == 0) PG8_BAR;
    PG8_BAR;
#undef PG8_SA
#undef PG8_SB
#undef PG8_STAGE
#undef PG8_LDA
#undef PG8_LDB
#undef PG8_MMA
#undef PG8_WAIT_V
#undef PG8_WAIT_L
#undef PG8_BAR
#undef PG8_SCHED
}
}
using pg8::Unit;

#define EPI_ROWS(ai, m) (u.pm * 256 + (ai) * 128 + wr * 64 + (m) * 16 + fr)
struct EpiSwiglu {
    bf16_t* H;
    __device__ __forceinline__ void operator()(const f32x4 (&acc)[2][2][4][2], const Unit& u, int wr, int wc, int fr, int fq) const {
        const int col = u.pn * 128 + wc * 32 + 8 * fq;
#pragma unroll
        for (int ai = 0; ai < 2; ++ai)
#pragma unroll
            for (int m = 0; m < 4; ++m) {
                const size_t row = EPI_ROWS(ai, m);
                float h[8];
#pragma unroll
                for (int n = 0; n < 2; ++n)
#pragma unroll
                    for (int j = 0; j < 4; ++j) { const float g = acc[ai][0][m][n][j], uu = acc[ai][1][m][n][j]; h[4 * n + j] = g * uu * sigmoid_f(g); }
                u32x4 w; w.x = cvt_pk_bf16(h[0], h[1]); w.y = cvt_pk_bf16(h[2], h[3]); w.z = cvt_pk_bf16(h[4], h[5]); w.w = cvt_pk_bf16(h[6], h[7]);
                *(u32x4*)(H + row * FH + col) = w;
            }
    }
};
template <bool RES_BF16, bool HAS_MUL, bool OUT_BF16 = false>
struct EpiResid {
    const void* res; const bf16_t* mul; float* Y; float scale;
    __device__ __forceinline__ void operator()(const f32x4 (&acc)[2][2][4][2], const Unit& u, int wr, int wc, int fr, int fq) const {
#pragma unroll
        for (int ai = 0; ai < 2; ++ai)
#pragma unroll
            for (int m = 0; m < 4; ++m) {
                const size_t row = EPI_ROWS(ai, m);
#pragma unroll
                for (int bj = 0; bj < 2; ++bj) {
                    const size_t off = row * DM + u.pn * 256 + bj * 128 + wc * 32 + 8 * fq;
                    float r[8];
                    if (RES_BF16) { const u32x4 rv = *(const u32x4*)((const bf16_t*)res + off);
                        r[0] = bf_lo(rv.x); r[1] = bf_hi(rv.x); r[2] = bf_lo(rv.y); r[3] = bf_hi(rv.y); r[4] = bf_lo(rv.z); r[5] = bf_hi(rv.z); r[6] = bf_lo(rv.w); r[7] = bf_hi(rv.w); }
                    else { const f32x4 a = *(const f32x4*)((const float*)res + off), b = *(const f32x4*)((const float*)res + off + 4);
                        r[0] = a[0]; r[1] = a[1]; r[2] = a[2]; r[3] = a[3]; r[4] = b[0]; r[5] = b[1]; r[6] = b[2]; r[7] = b[3]; }
                    float mv[8];
                    if (HAS_MUL) { const u32x4 rv = *(const u32x4*)(mul + off);
                        mv[0] = bf_lo(rv.x); mv[1] = bf_hi(rv.x); mv[2] = bf_lo(rv.y); mv[3] = bf_hi(rv.y); mv[4] = bf_lo(rv.z); mv[5] = bf_hi(rv.z); mv[6] = bf_lo(rv.w); mv[7] = bf_hi(rv.w); }
                    f32x4 o0, o1;
#pragma unroll
                    for (int j = 0; j < 4; ++j) {
                        const float a0 = acc[ai][bj][m][0][j] * scale, a1 = acc[ai][bj][m][1][j] * scale;
                        o0[j] = ALPHA * r[j] + (HAS_MUL ? mv[j] * a0 : a0); o1[j] = ALPHA * r[4 + j] + (HAS_MUL ? mv[4 + j] * a1 : a1); }
                    if (OUT_BF16) { u32x4 w; w.x = cvt_pk_bf16(o0[0], o0[1]); w.y = cvt_pk_bf16(o0[2], o0[3]); w.z = cvt_pk_bf16(o1[0], o1[1]); w.w = cvt_pk_bf16(o1[2], o1[3]); *(u32x4*)((bf16_t*)Y + off) = w; }
                    else { *(f32x4*)(Y + off) = o0; *(f32x4*)(Y + off + 4) = o1; }
                }
            }
    }
};
struct EpiWin {
    bf16_t* proj; bf16_t* gates; float* ifg; const float* bias;
    __device__ __forceinline__ void operator()(const f32x4 (&acc)[2][2][4][2], const Unit& u, int wr, int wc, int fr, int fq) const {
        const int pn = u.pn;
        if (pn == 32) {
            if (wc == 0 && fq == 0) {
                const f32x4 bi = *(const f32x4*)(bias + 8192), bf = *(const f32x4*)(bias + 8196);
#pragma unroll
                for (int ai = 0; ai < 2; ++ai)
#pragma unroll
                    for (int m = 0; m < 4; ++m) {
                        const size_t row = EPI_ROWS(ai, m);
                        f32x4 iv = acc[ai][0][m][0] + bi, fv = acc[ai][0][m][1] + bf, lf;
#pragma unroll
                        for (int j = 0; j < 4; ++j) { const float xx = fv[j]; lf[j] = xx >= 0.f ? -log1pf(expf(-xx)) : xx - log1pf(expf(xx)); }
                        *(f32x4*)(ifg + row * 8) = iv; *(f32x4*)(ifg + row * 8 + 4) = lf;
                    }
            }
            return;
        }
        bf16_t* dst; int ld, c0; int act = 0; float sc = 1.0f;
        if (pn < 24) { const int sec = pn >> 2; dst = proj + (size_t)sec * ((size_t)MTOK * DM); ld = DM; c0 = (pn & 3) * 256; if (sec == 2) act = 1; if (sec == 3) sc = 0.08838834764831845f * LOG2E; }
        else { dst = gates; ld = 2 * DM; c0 = (pn - 24) * 256; act = 1; }
#pragma unroll
        for (int bj = 0; bj < 2; ++bj) {
            const int cl = bj * 128 + wc * 32 + 8 * fq;
            const f32x4 b0 = *(const f32x4*)(bias + pn * 256 + cl), b1 = *(const f32x4*)(bias + pn * 256 + cl + 4);
#pragma unroll
            for (int ai = 0; ai < 2; ++ai)
#pragma unroll
                for (int m = 0; m < 4; ++m) {
                    const size_t row = EPI_ROWS(ai, m);
                    f32x4 v0 = acc[ai][bj][m][0] + b0, v1 = acc[ai][bj][m][1] + b1;
                    if (act) {
#pragma unroll
                        for (int j = 0; j < 4; ++j) { v0[j] = sigmoid_f(v0[j]); v1[j] = sigmoid_f(v1[j]); } }
                    else { v0 *= sc; v1 *= sc; }
                    u32x4 w; w.x = cvt_pk_bf16(v0[0], v0[1]); w.y = cvt_pk_bf16(v0[2], v0[3]); w.z = cvt_pk_bf16(v1[0], v1[1]); w.w = cvt_pk_bf16(v1[2], v1[3]);
                    *(u32x4*)(dst + row * ld + c0 + cl) = w;
                }
        }
    }
};
template <bool ADD>
struct EpiGateMul {
    const bf16_t* gate; int goff; const bf16_t* tin; bf16_t* out;
    __device__ __forceinline__ void operator()(const f32x4 (&acc)[2][2][4][2], const Unit& u, int wr, int wc, int fr, int fq) const {
#pragma unroll
        for (int ai = 0; ai < 2; ++ai)
#pragma unroll
            for (int m = 0; m < 4; ++m) {
                const size_t row = EPI_ROWS(ai, m);
#pragma unroll
                for (int bj = 0; bj < 2; ++bj) {
                    const int c = u.pn * 256 + bj * 128 + wc * 32 + 8 * fq;
                    const u32x4 gv = *(const u32x4*)(gate + row * (2 * DM) + goff + c);
                    float gg[8] = {bf_lo(gv.x), bf_hi(gv.x), bf_lo(gv.y), bf_hi(gv.y), bf_lo(gv.z), bf_hi(gv.z), bf_lo(gv.w), bf_hi(gv.w)};
                    float tt[8] = {0.f, 0.f, 0.f, 0.f, 0.f, 0.f, 0.f, 0.f};
                    if (ADD) { const u32x4 tv = *(const u32x4*)(tin + row * DM + c);
                        tt[0] = bf_lo(tv.x); tt[1] = bf_hi(tv.x); tt[2] = bf_lo(tv.y); tt[3] = bf_hi(tv.y); tt[4] = bf_lo(tv.z); tt[5] = bf_hi(tv.z); tt[6] = bf_lo(tv.w); tt[7] = bf_hi(tv.w); }
                    float o[8];
#pragma unroll
                    for (int j = 0; j < 4; ++j) { o[j] = tt[j] + gg[j] * acc[ai][bj][m][0][j]; o[4 + j] = tt[4 + j] + gg[4 + j] * acc[ai][bj][m][1][j]; }
                    u32x4 w; w.x = cvt_pk_bf16(o[0], o[1]); w.y = cvt_pk_bf16(o[2], o[3]); w.z = cvt_pk_bf16(o[4], o[5]); w.w = cvt_pk_bf16(o[6], o[7]);
                    *(u32x4*)(out + row * DM + c) = w;
                }
            }
    }
};
struct EpiSigBias {
    const float* bias; bf16_t* out;
    __device__ __forceinline__ void operator()(const f32x4 (&acc)[2][2][4][2], const Unit& u, int wr, int wc, int fr, int fq) const {
#pragma unroll
        for (int bj = 0; bj < 2; ++bj) {
            const int c = u.pn * 256 + bj * 128 + wc * 32 + 8 * fq;
            const f32x4 b0 = *(const f32x4*)(bias + c), b1 = *(const f32x4*)(bias + c + 4);
#pragma unroll
            for (int ai = 0; ai < 2; ++ai)
#pragma unroll
                for (int m = 0; m < 4; ++m) {
                    const size_t row = EPI_ROWS(ai, m);
                    f32x4 v0 = acc[ai][bj][m][0] + b0, v1 = acc[ai][bj][m][1] + b1;
#pragma unroll
                    for (int j = 0; j < 4; ++j) { v0[j] = sigmoid_f(v0[j]); v1[j] = sigmoid_f(v1[j]); }
                    u32x4 w; w.x = cvt_pk_bf16(v0[0], v0[1]); w.y = cvt_pk_bf16(v0[2], v0[3]); w.z = cvt_pk_bf16(v1[0], v1[1]); w.w = cvt_pk_bf16(v1[2], v1[3]);
                    *(u32x4*)(out + row * DM + c) = w;
                }
        }
    }
};

struct Params {
    const float *x, *p, *ln_g, *ln_b, *wg, *wu, *wd, *w_in, *b_in, *b_forget, *conv_w, *conv_b, *mh_g, *w_a, *w_b, *w_o, *w_ple, *w_pg, *b_pg;
    float* out; unsigned char* ws;
    int ph_lo, ph_hi, coop, pad;
};

__device__ void cvt_bf16_phase(const float* src, bf16_t* dst, size_t n8) {
    const size_t stride = (size_t)gridDim.x * NTHREADS;
    for (size_t i = (size_t)blockIdx.x * NTHREADS + threadIdx.x; i < n8; i += stride) {
        const f32x4 a = *(const f32x4*)(src + i * 8), b = *(const f32x4*)(src + i * 8 + 4);
        u32x4 w; w.x = cvt_pk_bf16(a[0], a[1]); w.y = cvt_pk_bf16(a[2], a[3]); w.z = cvt_pk_bf16(b[0], b[1]); w.w = cvt_pk_bf16(b[2], b[3]);
        *(u32x4*)(dst + i * 8) = w;
    }
}
template <int MODE>
__device__ __forceinline__ float tsrc_val(const float* w0, const float* w1, int ldn, int k, int n) {
    if (MODE == 0) return w0[(size_t)k * ldn + n];
    if (MODE == 1) { const int pn = n >> 8, sel = (n >> 7) & 1, i = n & 127; const float* w = sel ? w1 : w0; return w[(size_t)k * ldn + pn * 128 + i]; }
    int col; if (n < 3072) col = n; else if (n < 8192) col = n + 8; else if (n < 8200) col = 3072 + (n - 8192); else return 0.f;
    return w0[(size_t)k * ldn + col];
}
template <int MODE>
__device__ __forceinline__ void transpose_mat(LAS float* tile, const float* w0, const float* w1, int ldn, bf16_t* dst, int NP, int K, int& base) {
    const int tid = threadIdx.x;
    const int tn = NP / 128, tk = K / 128, nt = tn * tk;
    int first = ((int)blockIdx.x - base) % (int)gridDim.x; if (first < 0) first += gridDim.x;
    for (int t = first; t < nt; t += gridDim.x) {
        const int n0 = (t / tk) * 128, k0 = (t % tk) * 128;
#pragma unroll 8
        for (int e = 0; e < 32; ++e) { const int idx = e * NTHREADS + tid, kk = idx >> 7, nn = idx & 127; tile[kk * 129 + nn] = tsrc_val<MODE>(w0, w1, ldn, k0 + kk, n0 + nn); }
        __syncthreads();
#pragma unroll 8
        for (int e = 0; e < 16; ++e) { const int idx = e * NTHREADS + tid, nn = idx >> 6, kk = (idx & 63) * 2;
            *(unsigned*)(dst + (size_t)(n0 + nn) * K + k0 + kk) = cvt_pk_bf16(tile[kk * 129 + nn], tile[(kk + 1) * 129 + nn]); }
        __syncthreads();
    }
    base += nt;
}
__device__ void prep_phase(const Params& P, LAS unsigned char* lds) {
    unsigned char* ws = P.ws;
    cvt_bf16_phase(P.x, (bf16_t*)(ws + WS_X), (size_t)MTOK * DM / 8);
    if (blockIdx.x == 0 && threadIdx.x < 64) ((unsigned*)(ws + MISC_CNT))[threadIdx.x] = 0u;
    for (int n = blockIdx.x * NTHREADS + threadIdx.x; n < NIN_PAD; n += gridDim.x * NTHREADS) {
        float b;
        if (n < 3072) b = P.b_in[n]; else if (n < 8192) b = P.b_in[n + 8]; else if (n < 8196) b = P.b_in[3072 + n - 8192];
        else if (n < 8200) b = P.b_in[3072 + n - 8192] + P.b_forget[n - 8196]; else b = 0.f;
        ((float*)(ws + W_BIAS))[n] = b;
    }
    LAS float* tile = (LAS float*)lds;
    int base = 0;
    transpose_mat<1>(tile, P.wg, P.wu, FH, (bf16_t*)(ws + W_GU1), 5632, 1024, base);
    transpose_mat<0>(tile, P.wd, nullptr, DM, (bf16_t*)(ws + W_D1), 1024, FH, base);
    transpose_mat<1>(tile, P.wg + (size_t)DM * FH, P.wu + (size_t)DM * FH, FH, (bf16_t*)(ws + W_GU2), 5632, 1024, base);
    transpose_mat<0>(tile, P.wd + (size_t)DM * FH, nullptr, DM, (bf16_t*)(ws + W_D2), 1024, FH, base);
    transpose_mat<2>(tile, P.w_in, nullptr, 8200, (bf16_t*)(ws + W_IN), NIN_PAD, 1024, base);
    transpose_mat<0>(tile, P.w_a, nullptr, DM, (bf16_t*)(ws + W_A), 1024, 1024, base);
    transpose_mat<0>(tile, P.w_b, nullptr, DM, (bf16_t*)(ws + W_B), 1024, 1024, base);
    transpose_mat<0>(tile, P.w_o, nullptr, DM, (bf16_t*)(ws + W_O), 1024, 1024, base);
    transpose_mat<0>(tile, P.w_pg, nullptr, DM, (bf16_t*)(ws + W_PG), 1024, 1024, base);
    transpose_mat<0>(tile, P.w_ple, nullptr, DM, (bf16_t*)(ws + W_P), 1024, 256, base);
}
template <bool OUT_BF16, bool IN_BF16 = false>
__device__ void ln_phase(const float* Y, const float* g, const float* b, void* out) {
    const int wid = threadIdx.x >> 6, lane = threadIdx.x & 63;
    f32x4 gv[4], bv[4];
#pragma unroll
    for (int i = 0; i < 4; ++i) { gv[i] = *(const f32x4*)(g + i * 256 + lane * 4); bv[i] = *(const f32x4*)(b + i * 256 + lane * 4); }
    for (int row0 = (blockIdx.x * 8 + wid) * 2; row0 < MTOK; row0 += gridDim.x * 16) {
        f32x4 v[2][4]; float s[2] = {0.f, 0.f};
#pragma unroll
        for (int r = 0; r < 2; ++r)
#pragma unroll
            for (int i = 0; i < 4; ++i) {
                if (IN_BF16) { const u32x2 t = *(const u32x2*)((const bf16_t*)Y + (size_t)(row0 + r) * DM + i * 256 + lane * 4); v[r][i] = (f32x4){bf_lo(t.x), bf_hi(t.x), bf_lo(t.y), bf_hi(t.y)}; }
                else v[r][i] = *(const f32x4*)(Y + (size_t)(row0 + r) * DM + i * 256 + lane * 4); }
#pragma unroll
        for (int r = 0; r < 2; ++r) {
#pragma unroll
            for (int i = 0; i < 4; ++i) s[r] += (v[r][i][0] + v[r][i][1]) + (v[r][i][2] + v[r][i][3]);
            const float mean = wave_sum(s[r]) * (1.0f / DM);
            float q = 0.f;
#pragma unroll
            for (int i = 0; i < 4; ++i) { const f32x4 d = v[r][i] - mean; q += (d[0] * d[0] + d[1] * d[1]) + (d[2] * d[2] + d[3] * d[3]); }
            const float rstd = rsqrtf(wave_sum(q) * (1.0f / DM) + LN_EPS);
#pragma unroll
            for (int i = 0; i < 4; ++i) {
                const f32x4 o = (v[r][i] - mean) * rstd * gv[i] + bv[i];
                if (OUT_BF16) { u32x2 w; w.x = cvt_pk_bf16(o[0], o[1]); w.y = cvt_pk_bf16(o[2], o[3]); *(u32x2*)((bf16_t*)out + (size_t)(row0 + r) * DM + i * 256 + lane * 4) = w; }
                else *(f32x4*)((float*)out + (size_t)(row0 + r) * DM + i * 256 + lane * 4) = o;
            }
        }
    }
}

constexpr int L_QI = 0, L_KI = 17408, L_KT = 34816, L_VT = 53248, L_PI = 90112, L_F = 99328;
constexpr int F_N = 0, F_QN = 128, F_RS = 192, F_HS = 320, F_BL = 1344, F_GM = 1472, F_M = 1600, F_CW = 1732, F_SA = 3012, F_SB2 = 3028, F_SMU = 4052, F_SWI = 5076, F_SWN = 6100, F_SEM = 7124, F_END = 8148;
constexpr int MIX_LDS = L_F + F_END * 4;

__device__ void mlstm_prologue(const Params& P, LAS unsigned char* lds, int b, int h, int gi) {
    LAS float* F = (LAS float*)(lds + L_F);
    const float* ifg = (const float*)(P.ws + MISC_IF);
    const int tid = threadIdx.x, w = tid >> 6, lane = tid & 63;
    const int nch = 16 * (gi + 1);
    for (int c = w; c < nch; c += 8) {
        const size_t tok = (size_t)b * SEQ + c * 64 + lane;
        const float iv = ifg[tok * 8 + h], lf = ifg[tok * 8 + 4 + h];
        const float bc = wave_incl_sum(lf, lane);
        const float bl = __shfl(bc, 63);
        const float gm = wave_max(bl - bc + iv);
        if (lane == 0) { F[F_BL + c] = bl; F[F_GM + c] = gm; }
    }
    for (int i = tid; i < 1280; i += NTHREADS) {
        const int j = i >> 8, ch = i & 255; const int gc = ch < 128 ? h * 128 + ch : 512 + h * 128 + (ch - 128);
        F[F_CW + i] = j < 4 ? P.conv_w[j * 1024 + gc] : P.conv_b[gc];
    }
    if (tid < 128) F[F_N + tid] = 0.f;
    __syncthreads();
    if (tid == 0) { float m = 0.f; F[F_M] = 0.f; for (int c = 0; c < nch; ++c) { m = fmaxf(F[F_BL + c] + m, F[F_GM + c]); F[F_M + c + 1] = m; } }
    __syncthreads();
    for (int lc = w; lc < 16; lc += 8) {
        const int c = gi * 16 + lc;
        const size_t tok = (size_t)b * SEQ + c * 64 + lane;
        const float iv = ifg[tok * 8 + h], lf = ifg[tok * 8 + 4 + h];
        const float bc = wave_incl_sum(lf, lane);
        const float bl = __shfl(bc, 63);
        const float mst = F[F_M + c], mnew = F[F_M + c + 1];
        const float beta = iv - bc;
        const float mu = fmaxf(mst, wave_incl_max(beta, lane));
        F[F_SB2 + lc * 64 + lane] = beta * LOG2E;
        F[F_SMU + lc * 64 + lane] = mu * LOG2E;
        F[F_SWI + lc * 64 + lane] = expf(mst - mu);
        F[F_SWN + lc * 64 + lane] = expf(bl - bc + iv - mnew);
        F[F_SEM + lc * 64 + lane] = expf(-(bc + mu));
        if (lane == 0) F[F_SA + lc] = expf(bl + mst - mnew);
    }
    __syncthreads();
}

template <bool NEED_Q>
__device__ __forceinline__ void mlstm_load(const Params& P, LAS unsigned char* lds, int b, int h, int c, int lc) {
    LAS float* F = (LAS float*)(lds + L_F);
    const bf16_t* QK = (const bf16_t*)(P.ws + WS_QK);
    const bf16_t* VA = (const bf16_t*)(P.ws + WS_VA);
    const int tid = threadIdx.x, tg = tid & 15, cg = tid >> 4;
    {
        u32x4 vr[4];
#pragma unroll
        for (int tt = 0; tt < 4; ++tt) vr[tt] = *(const u32x4*)(VA + ((size_t)b * SEQ + c * 64 + 4 * tg + tt) * DM + h * 256 + 8 * cg);
#pragma unroll
        for (int e = 0; e < 8; ++e) {
            unsigned short x0, x1, x2, x3;
            { const unsigned a0 = vr[0][e >> 1], a1 = vr[1][e >> 1], a2 = vr[2][e >> 1], a3 = vr[3][e >> 1];
              if (e & 1) { x0 = a0 >> 16; x1 = a1 >> 16; x2 = a2 >> 16; x3 = a3 >> 16; } else { x0 = a0 & 0xffff; x1 = a1 & 0xffff; x2 = a2 & 0xffff; x3 = a3 & 0xffff; } }
            u32x2 wv; wv.x = (unsigned)x0 | ((unsigned)x1 << 16); wv.y = (unsigned)x2 | ((unsigned)x3 << 16);
            *(LAS u32x2*)(lds + L_VT + (8 * cg + e) * 144 + 8 * tg) = wv;
        }
    }
    __builtin_amdgcn_sched_barrier(0);
    if (NEED_Q || cg >= 16) {
        const int gc = cg < 16 ? h * 128 + 8 * cg : 512 + h * 128 + 8 * (cg - 16);
        u32x4 raw[7];
#pragma unroll
        for (int i = 0; i < 7; ++i) {
            const int pos = c * 64 + 4 * tg - 3 + i;
            raw[i] = pos >= 0 ? *(const u32x4*)(QK + ((size_t)b * SEQ + pos) * DM + gc) : (u32x4){0u, 0u, 0u, 0u};
        }
        float o[4][8];
#pragma unroll
        for (int e = 0; e < 8; ++e) {
            float rv[7];
#pragma unroll
            for (int i = 0; i < 7; ++i) rv[i] = (e & 1) ? bf_hi(raw[i][e >> 1]) : bf_lo(raw[i][e >> 1]);
            const float w0 = F[F_CW + 0 * 256 + 8 * cg + e], w1 = F[F_CW + 1 * 256 + 8 * cg + e], w2 = F[F_CW + 2 * 256 + 8 * cg + e], w3 = F[F_CW + 3 * 256 + 8 * cg + e], cb = F[F_CW + 4 * 256 + 8 * cg + e];
#pragma unroll
            for (int tt = 0; tt < 4; ++tt) { const float v = cb + w0 * rv[tt] + w1 * rv[tt + 1] + w2 * rv[tt + 2] + w3 * rv[tt + 3]; o[tt][e] = v * sigmoid_f(v); }
            __builtin_amdgcn_sched_barrier(0);
        }
        if (cg < 16) {
#pragma unroll
            for (int tt = 0; tt < 4; ++tt) { u32x4 wv; wv.x = cvt_pk_bf16(o[tt][0], o[tt][1]); wv.y = cvt_pk_bf16(o[tt][2], o[tt][3]); wv.z = cvt_pk_bf16(o[tt][4], o[tt][5]); wv.w = cvt_pk_bf16(o[tt][6], o[tt][7]);
                *(LAS u32x4*)(lds + L_QI + (4 * tg + tt) * 272 + 16 * cg) = wv; }
        } else {
            const int kc = cg - 16;
            const f32x4 wn = *(const LAS f32x4*)(F + F_SWN + lc * 64 + 4 * tg);
#pragma unroll
            for (int tt = 0; tt < 4; ++tt) {
#pragma unroll
                for (int e = 0; e < 8; ++e) o[tt][e] *= 0.08838834764831845f;
                u32x4 wv; wv.x = cvt_pk_bf16(o[tt][0], o[tt][1]); wv.y = cvt_pk_bf16(o[tt][2], o[tt][3]); wv.z = cvt_pk_bf16(o[tt][4], o[tt][5]); wv.w = cvt_pk_bf16(o[tt][6], o[tt][7]);
                *(LAS u32x4*)(lds + L_KI + (4 * tg + tt) * 272 + 16 * kc) = wv; }
#pragma unroll
            for (int e = 0; e < 8; ++e) { u32x2 wv; wv.x = cvt_pk_bf16(o[0][e] * wn[0], o[1][e] * wn[1]); wv.y = cvt_pk_bf16(o[2][e] * wn[2], o[3][e] * wn[3]);
                *(LAS u32x2*)(lds + L_KT + (8 * kc + e) * 144 + 8 * tg) = wv; }
        }
    }
}

__device__ __forceinline__ void mlstm_update(LAS unsigned char* lds, f32x4 (&C)[2][8], int lc, int w, int r, int g) {
    LAS float* F = (LAS float*)(lds + L_F);
    const float a = F[F_SA + lc];
    const LAS unsigned char* vp = lds + (L_VT + (32 * w + r) * 144 + 16 * g);
    const LAS unsigned char* kp = lds + (L_KT + r * 144 + 16 * g);
#pragma unroll
    for (int dvb = 0; dvb < 2; ++dvb)
#pragma unroll
        for (int dkb = 0; dkb < 8; ++dkb) C[dvb][dkb] *= a;
#pragma unroll
    for (int ks = 0; ks < 2; ++ks) {
        bf16x8 vf[2];
#pragma unroll
        for (int dvb = 0; dvb < 2; ++dvb) vf[dvb] = *(const LAS bf16x8*)(vp + (16 * dvb * 144 + 64 * ks));
#pragma unroll
        for (int dkb = 0; dkb < 8; ++dkb) {
            const bf16x8 kf = *(const LAS bf16x8*)(kp + (16 * dkb * 144 + 64 * ks));
#pragma unroll
            for (int dvb = 0; dvb < 2; ++dvb) C[dvb][dkb] = mfma16(kf, vf[dvb], C[dvb][dkb]);
        }
        __builtin_amdgcn_sched_barrier(0);
    }
    const int tid = threadIdx.x, dk = tid >> 2, part = tid & 3;
    const u32x4 k0 = *(const LAS u32x4*)(lds + L_KT + dk * 144 + 32 * part), k1 = *(const LAS u32x4*)(lds + L_KT + dk * 144 + 32 * part + 16);
    float s = 0.f;
#pragma unroll
    for (int i = 0; i < 4; ++i) s += bf_lo(k0[i]) + bf_hi(k0[i]) + bf_lo(k1[i]) + bf_hi(k1[i]);
    s += __shfl_xor(s, 1); s += __shfl_xor(s, 2);
    if (part == 0) F[F_N + dk] = a * F[F_N + dk] + s;
}

__device__ void mlstm_phase1(const Params& P, LAS unsigned char* lds) {
    const int tid = threadIdx.x, w = tid >> 6, lane = tid & 63, r = lane & 15, g = lane >> 4;
    LAS float* F = (LAS float*)(lds + L_F);
    for (int task = blockIdx.x; task < 256; task += gridDim.x) {
        const int gi = task & 7, st = task >> 3, b = st >> 2, h = st & 3;
        if (gi == 7) continue;
        mlstm_prologue(P, lds, b, h, gi);
        f32x4 C[2][8];
#pragma unroll
        for (int i = 0; i < 2; ++i)
#pragma unroll
            for (int j = 0; j < 8; ++j) C[i][j] = (f32x4){0.f, 0.f, 0.f, 0.f};
        for (int lc = 0; lc < 16; ++lc) {
            mlstm_load<false>(P, lds, b, h, gi * 16 + lc, lc);
            __syncthreads();
            mlstm_update(lds, C, lc, w, r, g);
            __syncthreads();
        }
        float* slot = (float*)(P.ws + WS_PB) + (size_t)(st * 7 + gi) * STATE_FLOATS;
#pragma unroll
        for (int dvb = 0; dvb < 2; ++dvb)
#pragma unroll
            for (int dkb = 0; dkb < 8; ++dkb) *(f32x4*)(slot + (((w * 2 + dvb) * 8 + dkb) * 64 + lane) * 4) = C[dvb][dkb];
        if (tid < 128) slot[32768 + tid] = F[F_N + tid];
        __syncthreads();
    }
}

__device__ void mlstm_phase2(const Params& P, LAS unsigned char* lds) {
    const int tid = threadIdx.x, w = tid >> 6, lane = tid & 63, r = lane & 15, g = lane >> 4;
    LAS float* F = (LAS float*)(lds + L_F);
    const bf16_t* OA = (const bf16_t*)(P.ws + WS_OA);
    bf16_t* VA = (bf16_t*)(P.ws + WS_VA);
    for (int task = blockIdx.x; task < 256; task += gridDim.x) {
        const int gi = task & 7, st = task >> 3, b = st >> 2, h = st & 3;
        mlstm_prologue(P, lds, b, h, gi);
        f32x4 C[2][8];
#pragma unroll
        for (int i = 0; i < 2; ++i)
#pragma unroll
            for (int j = 0; j < 8; ++j) C[i][j] = (f32x4){0.f, 0.f, 0.f, 0.f};
        float nreg = 0.f;
        for (int j = 0; j < gi; ++j) {
            float Bj = 0.f;
            for (int c = 0; c < 16; ++c) Bj += F[F_BL + j * 16 + c];
            const float Aj = expf(Bj + F[F_M + 16 * j] - F[F_M + 16 * j + 16]);
            const float* slot = (const float*)(P.ws + WS_PB) + (size_t)(st * 7 + j) * STATE_FLOATS;
#pragma unroll
            for (int dvb = 0; dvb < 2; ++dvb)
#pragma unroll
                for (int dkb = 0; dkb < 8; ++dkb) C[dvb][dkb] = C[dvb][dkb] * Aj + *(const f32x4*)(slot + (((w * 2 + dvb) * 8 + dkb) * 64 + lane) * 4);
            if (tid < 128) nreg = nreg * Aj + slot[32768 + tid];
        }
        if (tid < 128) F[F_N + tid] = nreg;
        __syncthreads();
        for (int lc = 0; lc < 16; ++lc) {
            const int c = gi * 16 + lc;
            mlstm_load<true>(P, lds, b, h, c, lc);
            __syncthreads();
            {
                const int tb = w >> 1, par = w & 1;
                const LAS unsigned char* qpS = lds + (L_QI + (16 * tb + r) * 272 + 16 * g);
                const LAS unsigned char* kpS = lds + (L_KI + (16 * par + r) * 272 + 16 * g);
                LAS unsigned char* ppS = lds + (L_PI + (16 * tb + r) * 144 + 32 * par + 8 * g);
                bf16x8 qf[4];
#pragma unroll
                for (int kd = 0; kd < 4; ++kd) qf[kd] = *(const LAS bf16x8*)(qpS + 64 * kd);
                const float mu2 = F[F_SMU + lc * 64 + 16 * tb + r];
                float rs = 0.f;
#pragma unroll
                for (int sbi = 0; sbi < 2; ++sbi) {
                    const int sb = par + 2 * sbi;
                    u32x2 pw = (u32x2){0u, 0u};
                    if (sb <= tb) {
                        f32x4 acc = (f32x4){0.f, 0.f, 0.f, 0.f};
#pragma unroll
                        for (int kd = 0; kd < 4; ++kd) { const bf16x8 kf = *(const LAS bf16x8*)(kpS + (32 * sbi * 272 + 64 * kd)); acc = mfma16(kf, qf[kd], acc); }
                        const f32x4 b2 = *(const LAS f32x4*)(F + F_SB2 + lc * 64 + 16 * sb + 4 * g);
                        float pv[4];
#pragma unroll
                        for (int j = 0; j < 4; ++j) { const int s = 16 * sb + 4 * g + j, t = 16 * tb + r; pv[j] = (s <= t) ? acc[j] * fast_exp2(b2[j] - mu2) : 0.f; }
                        pw.x = cvt_pk_bf16(pv[0], pv[1]); pw.y = cvt_pk_bf16(pv[2], pv[3]);
                        rs += bf_lo(pw.x) + bf_hi(pw.x) + bf_lo(pw.y) + bf_hi(pw.y);
                    }
                    *(LAS u32x2*)(ppS + 64 * sbi) = pw;
                }
                rs += __shfl_xor(rs, 16); rs += __shfl_xor(rs, 32);
                if (g == 0) F[F_RS + par * 64 + 16 * tb + r] = rs;
            }
            __builtin_amdgcn_sched_barrier(0);
            const LAS unsigned char* q8p = lds + (L_QI + r * 272 + 8 * g);
            f32x4 num[2][4];
#pragma unroll
            for (int i = 0; i < 2; ++i)
#pragma unroll
                for (int j = 0; j < 4; ++j) num[i][j] = (f32x4){0.f, 0.f, 0.f, 0.f};
#pragma unroll
            for (int kk = 0; kk < 4; ++kk) {
                bf16x8 af[2];
#pragma unroll
                for (int dvb = 0; dvb < 2; ++dvb) {
                    u32x2 lo, hi; lo.x = cvt_pk_bf16(C[dvb][2 * kk][0], C[dvb][2 * kk][1]); lo.y = cvt_pk_bf16(C[dvb][2 * kk][2], C[dvb][2 * kk][3]);
                    hi.x = cvt_pk_bf16(C[dvb][2 * kk + 1][0], C[dvb][2 * kk + 1][1]); hi.y = cvt_pk_bf16(C[dvb][2 * kk + 1][2], C[dvb][2 * kk + 1][3]);
                    af[dvb] = mk8(lo, hi);
                }
#pragma unroll
                for (int tb = 0; tb < 4; ++tb) {
                    const u32x2 q0 = *(const LAS u32x2*)(q8p + (16 * tb * 272 + 64 * kk)), q1 = *(const LAS u32x2*)(q8p + (16 * tb * 272 + 64 * kk + 32));
                    const bf16x8 bq = mk8(q0, q1);
#pragma unroll
                    for (int dvb = 0; dvb < 2; ++dvb) num[dvb][tb] = mfma16(af[dvb], bq, num[dvb][tb]);
                }
                __builtin_amdgcn_sched_barrier(0);
            }
#pragma unroll
            for (int tb = 0; tb < 4; ++tb) { const float wi = F[F_SWI + lc * 64 + 16 * tb + r];
#pragma unroll
                for (int dvb = 0; dvb < 2; ++dvb) num[dvb][tb] *= wi; }
            {
                const int t = tid >> 3, part = tid & 7;
                const u32x4 q0 = *(const LAS u32x4*)(lds + L_QI + t * 272 + 32 * part), q1 = *(const LAS u32x4*)(lds + L_QI + t * 272 + 32 * part + 16);
                float s = 0.f;
#pragma unroll
                for (int i = 0; i < 4; ++i) {
                    s += bf_lo(q0[i]) * F[F_N + 16 * part + 2 * i] + bf_hi(q0[i]) * F[F_N + 16 * part + 2 * i + 1];
                    s += bf_lo(q1[i]) * F[F_N + 16 * part + 8 + 2 * i] + bf_hi(q1[i]) * F[F_N + 16 * part + 8 + 2 * i + 1];
                }
                s += __shfl_xor(s, 1); s += __shfl_xor(s, 2); s += __shfl_xor(s, 4);
                if (part == 0) F[F_QN + t] = s;
            }
            __builtin_amdgcn_sched_barrier(0);
            __syncthreads();
            const LAS unsigned char* vpC = lds + (L_VT + (32 * w + r) * 144 + 16 * g);
            const LAS unsigned char* ppC = lds + (L_PI + r * 144 + 16 * g);
#pragma unroll
            for (int ks = 0; ks < 2; ++ks) {
                bf16x8 vf[2];
#pragma unroll
                for (int dvb = 0; dvb < 2; ++dvb) vf[dvb] = *(const LAS bf16x8*)(vpC + (16 * dvb * 144 + 64 * ks));
#pragma unroll
                for (int tb = 0; tb < 4; ++tb) {
                    if (ks == 0 || tb >= 2) {
                        const bf16x8 pb = *(const LAS bf16x8*)(ppC + (16 * tb * 144 + 64 * ks));
#pragma unroll
                        for (int dvb = 0; dvb < 2; ++dvb) num[dvb][tb] = mfma16(vf[dvb], pb, num[dvb][tb]);
                    }
                }
                __builtin_amdgcn_sched_barrier(0);
            }
#pragma unroll
            for (int tb = 0; tb < 4; ++tb) {
                const int t = 16 * tb + r;
                const float den = F[F_SWI + lc * 64 + t] * F[F_QN + t] + F[F_RS + t] + F[F_RS + 64 + t];
                const float inv = 1.0f / fmaxf(fabsf(den), F[F_SEM + lc * 64 + t]);
                float s1 = 0.f, s2 = 0.f;
#pragma unroll
                for (int dvb = 0; dvb < 2; ++dvb) { num[dvb][tb] *= inv;
#pragma unroll
                    for (int j = 0; j < 4; ++j) { const float v = num[dvb][tb][j]; s1 += v; s2 += v * v; } }
                s1 += __shfl_xor(s1, 16); s1 += __shfl_xor(s1, 32); s2 += __shfl_xor(s2, 16); s2 += __shfl_xor(s2, 32);
                if (g == 0) { F[F_HS + (w * 64 + t) * 2] = s1; F[F_HS + (w * 64 + t) * 2 + 1] = s2; }
                __builtin_amdgcn_sched_barrier(0);
            }
            mlstm_update(lds, C, lc, w, r, g);
            __builtin_amdgcn_sched_barrier(0);
            __syncthreads();
#pragma unroll
            for (int tb = 0; tb < 4; ++tb) {
                const int t = 16 * tb + r;
                float s1 = 0.f, s2 = 0.f;
#pragma unroll
                for (int ww = 0; ww < 8; ++ww) { s1 += F[F_HS + (ww * 64 + t) * 2]; s2 += F[F_HS + (ww * 64 + t) * 2 + 1]; }
                const float mean = s1 * (1.0f / 256.0f), var = fmaxf(s2 * (1.0f / 256.0f) - mean * mean, 0.f), rstd = rsqrtf(var + LN_EPS);
                const size_t tok = (size_t)b * SEQ + c * 64 + t;
#pragma unroll
                for (int dvb = 0; dvb < 2; ++dvb) {
                    const int dv0 = 32 * w + 16 * dvb + 4 * g;
                    const f32x4 gn = *(const f32x4*)(P.mh_g + h * 256 + dv0);
                    const u32x2 og = *(const u32x2*)(OA + tok * DM + h * 256 + dv0);
                    const float y0 = (num[dvb][tb][0] - mean) * rstd * gn[0] * bf_lo(og.x), y1 = (num[dvb][tb][1] - mean) * rstd * gn[1] * bf_hi(og.x);
                    const float y2 = (num[dvb][tb][2] - mean) * rstd * gn[2] * bf_lo(og.y), y3 = (num[dvb][tb][3] - mean) * rstd * gn[3] * bf_hi(og.y);
                    u32x2 wv; wv.x = cvt_pk_bf16(y0, y1); wv.y = cvt_pk_bf16(y2, y3);
                    *(u32x2*)(VA + tok * DM + h * 256 + dv0) = wv;
                }
            }
        }
        __syncthreads();
    }
}

constexpr int A_KI = 0, A_VT = 17408, A_FL = 35840;
constexpr float SB_DONE_LOG2 = -40.0f;

__device__ void attn_phase(const Params& P, LAS unsigned char* lds) {
    const int tid = threadIdx.x, w = tid >> 6, lane = tid & 63, r = lane & 15, g = lane >> 4;
    bf16_t* QB = (bf16_t*)(P.ws + WS_QB);
    const bf16_t* KB = (const bf16_t*)(P.ws + WS_KB);
    const bf16_t* VB = (const bf16_t*)(P.ws + WS_VB);
    unsigned* cnt = (unsigned*)(P.ws + MISC_CNT);
    LAS int* FL = (LAS int*)(lds + A_FL);
    for (;;) {
        if (tid == 0) FL[32] = (int)atomicAdd(cnt, 1u);
        __syncthreads();
        const int item = FL[32];
        __syncthreads();
        if (item >= 4096) break;
        const int qb = 63 - (item >> 6), b = (item >> 3) & 7, h = item & 7;
        const int q0w = qb * 128 + 16 * w;
        const size_t qtok = (size_t)b * SEQ + q0w + r;
        bf16x8 qf[4];
#pragma unroll
        for (int kd = 0; kd < 4; ++kd) qf[kd] = *(const bf16x8*)(QB + qtok * DM + h * 128 + 32 * kd + 8 * g);
        f32x4 O[8];
#pragma unroll
        for (int i = 0; i < 8; ++i) O[i] = (f32x4){0.f, 0.f, 0.f, 0.f};
        float R = 0.f;
        int wdone = 0, it = 0;
        u32x4 pre[4];
        const int ptg = tid & 15, pcg = (tid >> 4) & 15, prow = (tid - 256) >> 2, pch = tid & 3;
        auto issue_tile = [&](int kt_) {
            if (tid < 256) {
#pragma unroll
                for (int tt = 0; tt < 4; ++tt) pre[tt] = *(const u32x4*)(VB + ((size_t)b * SEQ + kt_ * 64 + 4 * ptg + tt) * DM + h * 128 + 8 * pcg);
            } else {
                const bf16_t* src_ = KB + ((size_t)b * SEQ + kt_ * 64 + prow) * DM + h * 128 + 32 * pch;
#pragma unroll
                for (int i = 0; i < 4; ++i) pre[i] = *(const u32x4*)(src_ + 8 * i);
            }
        };
        issue_tile(2 * qb + 1);
        for (int kt = 2 * qb + 1; kt >= 0; --kt, ++it) {
            if (tid < 256) {
#pragma unroll
                for (int e = 0; e < 8; ++e) {
                    unsigned short x0, x1, x2, x3;
                    { const unsigned a0 = pre[0][e >> 1], a1 = pre[1][e >> 1], a2 = pre[2][e >> 1], a3 = pre[3][e >> 1];
                      if (e & 1) { x0 = a0 >> 16; x1 = a1 >> 16; x2 = a2 >> 16; x3 = a3 >> 16; } else { x0 = a0 & 0xffff; x1 = a1 & 0xffff; x2 = a2 & 0xffff; x3 = a3 & 0xffff; } }
                    u32x2 wv; wv.x = (unsigned)x0 | ((unsigned)x1 << 16); wv.y = (unsigned)x2 | ((unsigned)x3 << 16);
                    *(LAS u32x2*)(lds + A_VT + (8 * pcg + e) * 144 + 8 * ptg) = wv;
                }
            } else {
#pragma unroll
                for (int i = 0; i < 4; ++i) *(LAS u32x4*)(lds + A_KI + prow * 272 + 64 * pch + 16 * i) = pre[i];
            }
            __syncthreads();
            if (kt > 0) issue_tile(kt - 1);
            const int key0 = kt * 64;
            if (!wdone && key0 <= q0w + 14) {
                const int qpos = q0w + r;
                float wgt[4][4];
                float Rrun = R;
#pragma unroll
                for (int sb = 3; sb >= 0; --sb) {
                    f32x4 acc = (f32x4){0.f, 0.f, 0.f, 0.f};
#pragma unroll
                    for (int kd = 0; kd < 4; ++kd) { const bf16x8 kf = *(const LAS bf16x8*)(lds + A_KI + (16 * sb + r) * 272 + 64 * kd + 16 * g); acc = mfma16(kf, qf[kd], acc); }
                    float lk[4], z[4];
#pragma unroll
                    for (int j = 0; j < 4; ++j) {
                        const int key = key0 + 16 * sb + 4 * g + j;
                        z[j] = fminf(acc[j], 80.0f);
                        lk[j] = (key < qpos) ? -fast_log2(1.0f + fast_exp2(z[j])) : 0.f;
                    }
                    const float s3 = lk[3], s2 = s3 + lk[2], s1 = s2 + lk[1], s0 = s1 + lk[0];
                    const float t1 = __shfl_xor(s0, 16), t2 = __shfl_xor(s0, 32), t3 = __shfl_xor(t1, 32);
                    const float above = g == 0 ? (t1 + t2 + t3) : (g == 1 ? (t2 + t3) : (g == 2 ? t1 : 0.f));
                    const float base = Rrun + above;
                    const float sj[4] = {s0, s1, s2, s3};
#pragma unroll
                    for (int j = 0; j < 4; ++j) { const int key = key0 + 16 * sb + 4 * g + j; wgt[sb][j] = (key < qpos) ? fast_exp2(z[j] + base + sj[j]) : 0.f; }
                    Rrun += (s0 + t1) + (t2 + t3);
                }
                R = Rrun;
#pragma unroll
                for (int ks = 0; ks < 2; ++ks) {
                    u32x2 lo, hi; lo.x = cvt_pk_bf16(wgt[2 * ks][0], wgt[2 * ks][1]); lo.y = cvt_pk_bf16(wgt[2 * ks][2], wgt[2 * ks][3]);
                    hi.x = cvt_pk_bf16(wgt[2 * ks + 1][0], wgt[2 * ks + 1][1]); hi.y = cvt_pk_bf16(wgt[2 * ks + 1][2], wgt[2 * ks + 1][3]);
                    const bf16x8 pf = mk8(lo, hi);
#pragma unroll
                    for (int db = 0; db < 8; ++db) {
                        const u32x2 v0 = *(const LAS u32x2*)(lds + A_VT + (16 * db + r) * 144 + 64 * ks + 8 * g), v1 = *(const LAS u32x2*)(lds + A_VT + (16 * db + r) * 144 + 64 * ks + 32 + 8 * g);
                        O[db] = mfma16(mk8(v0, v1), pf, O[db]);
                    }
                }
                wdone = __all(R < SB_DONE_LOG2) ? 1 : 0;
            }
            if (lane == 0) FL[(it & 1) * 8 + w] = wdone;
            __syncthreads();
            int alld = 1;
#pragma unroll
            for (int i = 0; i < 8; ++i) alld &= FL[(it & 1) * 8 + i];
            if (alld) break;
        }
#pragma unroll
        for (int db = 0; db < 8; ++db) { u32x2 wv; wv.x = cvt_pk_bf16(O[db][0], O[db][1]); wv.y = cvt_pk_bf16(O[db][2], O[db][3]);
            *(u32x2*)(QB + qtok * DM + h * 128 + 16 * db + 4 * g) = wv; }
        __syncthreads();
    }
}


#ifdef DIAG
__device__ void diag_count_f32(const float* p, size_t n, float thr, unsigned* ctr) {
    unsigned c = 0;
    for (size_t i = (size_t)blockIdx.x * NTHREADS + threadIdx.x; i < n; i += (size_t)gridDim.x * NTHREADS) { const float v = p[i]; if (!(fabsf(v) <= thr)) ++c; }
    if (c) atomicAdd(ctr, c);
}
__device__ void diag_count_bf16(const bf16_t* p, size_t n, float thr, unsigned* ctr) {
    unsigned c = 0;
    for (size_t i = (size_t)blockIdx.x * NTHREADS + threadIdx.x; i < n; i += (size_t)gridDim.x * NTHREADS) { const float v = __uint_as_float((unsigned)p[i] << 16); if (!(fabsf(v) <= thr)) ++c; }
    if (c) atomicAdd(ctr, c);
}
#endif
constexpr int LDS_BYTES = 135168;
static_assert(MIX_LDS <= LDS_BYTES && 128 * 129 * 4 <= LDS_BYTES && pg8::STAGE_BYTES <= LDS_BYTES, "LDS budget");
constexpr int NPHASE = 17;

template <class Epi>
__device__ __forceinline__ void run_gemm(LAS unsigned char* lds, const bf16_t* A, const bf16_t* Bt, int N, int K, const Epi& E) {
    pg8::Gemm g{A, Bt, MTOK, N, K};
    pg8::StaticOrder S; S.init(MTOK, N, gridDim.x, blockIdx.x);
    pg8::gemm_phase<Epi, pg8::StaticOrder>(lds, g, S, E);
}

__global__ void __launch_bounds__(NTHREADS, 2) fwd_megakernel(Params P) {
    extern __shared__ __attribute__((aligned(16))) unsigned char smem[];
    LAS unsigned char* lds = (LAS unsigned char*)smem;
    cg::grid_group grid = cg::this_grid();
    unsigned char* ws = P.ws;
    bf16_t* X = (bf16_t*)(ws + WS_X);
    bf16_t* H = (bf16_t*)(ws + WS_H);
    float* Y = P.out;
    bf16_t* gates = (bf16_t*)P.out;
#ifdef ONLYMASK
#define PHASE(k) if (((ONLYMASK >> (k)) & 1) && P.ph_lo <= (k) && (k) < P.ph_hi)
#else
#define PHASE(k) if (P.ph_lo <= (k) && (k) < P.ph_hi)
#endif
#define SYNC() do { if (P.coop) { asm volatile("s_waitcnt vmcnt(0) lgkmcnt(0)" ::: "memory"); grid.sync(); \
        if (threadIdx.x < 64) { __builtin_amdgcn_fence(__ATOMIC_ACQUIRE, "agent"); asm volatile("s_waitcnt vmcnt(0)" ::: "memory"); } __syncthreads(); } } while (0)
    PHASE(0) prep_phase(P, lds);
    SYNC();
    PHASE(1) run_gemm(lds, X, (const bf16_t*)(ws + W_GU1), 5632, 1024, EpiSwiglu{H});
    SYNC();
    PHASE(2) run_gemm(lds, H, (const bf16_t*)(ws + W_D1), 1024, FH, EpiResid<false, false, true>{P.x, nullptr, Y, 0.5f});
    SYNC();
    PHASE(3) ln_phase<true, true>(Y, P.ln_g, P.ln_b, X);
    SYNC();
    PHASE(4) run_gemm(lds, X, (const bf16_t*)(ws + W_IN), NIN_PAD, 1024, EpiWin{(bf16_t*)(ws + WS_QK), gates, (float*)(ws + MISC_IF), (const float*)(ws + W_BIAS)});
    SYNC();
    PHASE(5) mlstm_phase1(P, lds);
    SYNC();
    PHASE(6) {
#ifndef NO_ML2
        mlstm_phase2(P, lds);
#endif
#ifndef NO_ATT
        attn_phase(P, lds);
#endif
    }
    SYNC();
    PHASE(7) {
        run_gemm(lds, (const bf16_t*)(ws + WS_VA), (const bf16_t*)(ws + W_A), 1024, 1024, EpiGateMul<false>{gates, 0, nullptr, (bf16_t*)(ws + WS_T)});
        run_gemm(lds, (const bf16_t*)(ws + WS_QB), (const bf16_t*)(ws + W_B), 1024, 1024, EpiGateMul<true>{gates, DM, (const bf16_t*)(ws + WS_T), (bf16_t*)(ws + WS_MG)});
    }
    SYNC();
    PHASE(8) run_gemm(lds, (const bf16_t*)(ws + WS_MG), (const bf16_t*)(ws + W_O), 1024, 1024, EpiResid<true, false, true>{X, nullptr, Y, 1.0f});
    SYNC();
    PHASE(9) ln_phase<true, true>(Y, P.ln_g + DM, P.ln_b + DM, X);
    SYNC();
    PHASE(10) run_gemm(lds, X, (const bf16_t*)(ws + W_GU2), 5632, 1024, EpiSwiglu{H});
    SYNC();
    PHASE(11) run_gemm(lds, H, (const bf16_t*)(ws + W_D2), 1024, FH, EpiResid<true, false, true>{X, nullptr, Y, 0.5f});
    SYNC();
    PHASE(12) { ln_phase<true, true>(Y, P.ln_g + 2 * DM, P.ln_b + 2 * DM, X); cvt_bf16_phase(P.p, (bf16_t*)(ws + WS_PB), (size_t)MTOK * 256 / 8); }
    SYNC();
    PHASE(13) {
        run_gemm(lds, X, (const bf16_t*)(ws + W_PG), 1024, 1024, EpiSigBias{P.b_pg, (bf16_t*)(ws + WS_PG)});
        run_gemm(lds, (const bf16_t*)(ws + WS_PB), (const bf16_t*)(ws + W_P), 1024, 256, EpiResid<true, true>{X, (const bf16_t*)(ws + WS_PG), Y, 1.0f});
    }
    SYNC();
    PHASE(14) ln_phase<false>(Y, P.ln_g + 3 * DM, P.ln_b + 3 * DM, P.out);
#undef PHASE
#undef SYNC
}

extern "C" void kernel_launch(void* const* d_in, const int* in_sizes, int n_in, void* d_out, int out_size, void* d_ws, size_t ws_size, hipStream_t stream) {
    static int grid_blocks = 0;
    if (grid_blocks == 0) {
        if (n_in != 19 || out_size != MTOK * DM || ws_size < WS_END) { fprintf(stderr, "kernel_launch: unexpected shapes (n_in %d, out %d, ws %zu, need %zu)\n", n_in, out_size, ws_size, (size_t)WS_END); grid_blocks = -1; return; }
        int dev = 0, cus = 0, per_cu = 0;
        hipGetDevice(&dev);
        hipDeviceGetAttribute(&cus, hipDeviceAttributeMultiprocessorCount, dev);
        if (hipFuncSetAttribute((const void*)fwd_megakernel, hipFuncAttributeMaxDynamicSharedMemorySize, LDS_BYTES) != hipSuccess) { fprintf(stderr, "kernel_launch: hipFuncSetAttribute failed\n"); grid_blocks = -1; return; }
        if (hipOccupancyMaxActiveBlocksPerMultiprocessor(&per_cu, (const void*)fwd_megakernel, NTHREADS, LDS_BYTES) != hipSuccess || per_cu < 1) { fprintf(stderr, "kernel_launch: occupancy query failed (%d)\n", per_cu); per_cu = 1; (void)hipGetLastError(); }
        grid_blocks = cus * per_cu;
    }
    if (grid_blocks < 0) return;
    Params p{};
    p.x = (const float*)d_in[0]; p.p = (const float*)d_in[1]; p.ln_g = (const float*)d_in[2]; p.ln_b = (const float*)d_in[3];
    p.wg = (const float*)d_in[4]; p.wu = (const float*)d_in[5]; p.wd = (const float*)d_in[6]; p.w_in = (const float*)d_in[7]; p.b_in = (const float*)d_in[8];
    p.b_forget = (const float*)d_in[9]; p.conv_w = (const float*)d_in[10]; p.conv_b = (const float*)d_in[11]; p.mh_g = (const float*)d_in[12];
    p.w_a = (const float*)d_in[13]; p.w_b = (const float*)d_in[14]; p.w_o = (const float*)d_in[15]; p.w_ple = (const float*)d_in[16]; p.w_pg = (const float*)d_in[17]; p.b_pg = (const float*)d_in[18];
    p.out = (float*)d_out; p.ws = (unsigned char*)d_ws; p.pad = 0;
#if ONE_LAUNCH
    p.ph_lo = 0; p.ph_hi = NPHASE; p.coop = 1;
    void* args[] = {&p};
    hipError_t e = hipLaunchCooperativeKernel((const void*)fwd_megakernel, dim3(grid_blocks), dim3(NTHREADS), args, LDS_BYTES, stream);
    if (e != hipSuccess) fprintf(stderr, "cooperative launch failed: %s (grid %d)\n", hipGetErrorString(e), grid_blocks);
#else
    p.coop = 0;
    for (int ph = 0; ph < 15; ++ph) { p.ph_lo = ph; p.ph_hi = ph + 1; hipLaunchKernelGGL(fwd_megakernel, dim3(grid_blocks), dim3(NTHREADS), LDS_BYTES, stream, p); }
#endif
}
```

```cpp
#include <hip/hip_runtime.h>
#include <hip/hip_cooperative_groups.h>
#include <cstdio>
namespace cg = cooperative_groups;

#ifndef ONE_LAUNCH
#define ONE_LAUNCH 1
#endif

#define LAS __attribute__((address_space(3)))
typedef unsigned short bf16_t;
typedef short bf16x8 __attribute__((ext_vector_type(8)));
typedef float f32x4 __attribute__((ext_vector_type(4)));
typedef float f32x2 __attribute__((ext_vector_type(2)));
typedef unsigned u32x4 __attribute__((ext_vector_type(4)));
typedef unsigned u32x2 __attribute__((ext_vector_type(2)));

constexpr int MTOK = 65536, DM = 1024, FH = 2816, SEQ = 8192;
constexpr int NIN_PAD = 8448;
constexpr float ALPHA = 1.189207115002721f;
constexpr float LN_EPS = 1e-5f;
constexpr float LOG2E = 1.4426950408889634f;
constexpr int NTHREADS = 512;

constexpr size_t QB_ = 33554432ull;
constexpr size_t WS_W = 0;
constexpr size_t W_GU1 = 0;
constexpr size_t W_D1 = W_GU1 + 5632ull * 1024 * 2;
constexpr size_t W_GU2 = W_D1 + 1024ull * 2816 * 2;
constexpr size_t W_D2 = W_GU2 + 5632ull * 1024 * 2;
constexpr size_t W_IN = W_D2 + 1024ull * 2816 * 2;
constexpr size_t W_A = W_IN + 8448ull * 1024 * 2;
constexpr size_t W_B = W_A + 1024ull * 1024 * 2;
constexpr size_t W_O = W_B + 1024ull * 1024 * 2;
constexpr size_t W_PG = W_O + 1024ull * 1024 * 2;
constexpr size_t W_P = W_PG + 1024ull * 1024 * 2;
constexpr size_t W_BIAS = W_P + 1024ull * 256 * 2;
static_assert(W_BIAS + 8448 * 4 <= 2 * QB_, "weights overflow");
constexpr size_t WS_PB = 2 * QB_;
constexpr size_t WS_MISC = 3 * QB_;
constexpr size_t MISC_IF = WS_MISC;
constexpr size_t MISC_CNT = WS_MISC + 2097152ull;
constexpr size_t WS_X = 4 * QB_;
constexpr size_t WS_H = 8 * QB_;
constexpr size_t WS_QK = 8 * QB_, WS_VA = 12 * QB_, WS_OA = 16 * QB_, WS_QB = 20 * QB_, WS_KB = 24 * QB_, WS_VB = 28 * QB_;
constexpr size_t WS_T = WS_QK, WS_MG = WS_KB, WS_PG = 8 * QB_;
constexpr size_t WS_END = 32 * QB_;
constexpr int STATE_FLOATS = 32768 + 128;

typedef __bf16 bf16x2_t __attribute__((ext_vector_type(2)));
__device__ __forceinline__ unsigned cvt_pk_bf16(float lo, float hi) { f32x2 v = {lo, hi}; bf16x2_t r = __builtin_convertvector(v, bf16x2_t); return __builtin_bit_cast(unsigned, r); }
__device__ __forceinline__ float bf_lo(unsigned u) { return __uint_as_float(u << 16); }
__device__ __forceinline__ float bf_hi(unsigned u) { return __uint_as_float(u & 0xffff0000u); }
__device__ __forceinline__ float fast_exp2(float x) { return __builtin_amdgcn_exp2f(x); }
__device__ __forceinline__ float fast_log2(float x) { return __builtin_amdgcn_logf(x); }
__device__ __forceinline__ float fast_rcp(float x) { return __builtin_amdgcn_rcpf(x); }
__device__ __forceinline__ float sigmoid_f(float x) { return fast_rcp(1.0f + fast_exp2(-x * LOG2E)); }
__device__ __forceinline__ f32x4 mfma16(bf16x8 a, bf16x8 b, f32x4 c) { return __builtin_amdgcn_mfma_f32_16x16x32_bf16(a, b, c, 0, 0, 0); }
__device__ __forceinline__ bf16x8 mk8(u32x2 lo, u32x2 hi) { u32x4 v; v.x = lo.x; v.y = lo.y; v.z = hi.x; v.w = hi.y; return __builtin_bit_cast(bf16x8, v); }
__device__ __forceinline__ float wave_sum(float v) {
#pragma unroll
    for (int o = 32; o > 0; o >>= 1) v += __shfl_xor(v, o);
    return v;
}
__device__ __forceinline__ float wave_max(float v) {
#pragma unroll
    for (int o = 32; o > 0; o >>= 1) v = fmaxf(v, __shfl_xor(v, o));
    return v;
}
__device__ __forceinline__ float wave_incl_sum(float v, int lane) {
#pragma unroll
    for (int o = 1; o < 64; o <<= 1) { float t = __shfl_up(v, o); if (lane >= o) v += t; }
    return v;
}
__device__ __forceinline__ float wave_incl_max(float v, int lane) {
#pragma unroll
    for (int o = 1; o < 64; o <<= 1) { float t = __shfl_up(v, o); if (lane >= o) v = fmaxf(v, t); }
    return v;
}

namespace pg8 {
constexpr int BM = 256, BK = 64, HALF = 128, HTB = HALF * BK * 2, STAGE_BYTES = 8 * HTB, NXCD = 8, WGM = 8;
__host__ __device__ __forceinline__ int lds_byte(int r, int c) { const int st = (r >> 4) * 2 + (c >> 5), rr = r & 15, cc = c & 31, ob = rr * 64 + cc * 2; return st * 1024 + (ob ^ (((ob >> 9) & 1) << 5)); }
__host__ __device__ __forceinline__ void stage_rc(int b, int& R, int& C) { const int st = b / 1024, sb = b % 1024, swz = sb ^ (((sb >> 9) & 1) << 5); R = (st >> 1) * 16 + swz / 64; C = (st & 1) * 32 + (swz % 64) / 2; }
__host__ __device__ __forceinline__ int perm32(int rho) { const int n = rho >> 4, i = rho & 15; return 8 * (i >> 2) + 4 * n + (i & 3); }
struct Unit { int pm, pn; };
struct Gemm { const bf16_t* A; const bf16_t* Bt; int M, N, K; };
struct StaticOrder {
    int nM, nN, nwg, G, c;
    __device__ void init(int M, int N, int G_, int c_) { nM = M / BM; nN = N / BM; nwg = nM * nN; G = G_; c = c_; }
    __device__ bool next(int i, Unit& u) const {
        const long L = (long)i * G + c; if (L >= nwg) return false;
        int wgid = (int)L; { const int q = nwg / NXCD, r = nwg % NXCD, xcd = wgid % NXCD, off = wgid / NXCD; wgid = (xcd < r ? xcd * (q + 1) : r * (q + 1) + (xcd - r) * q) + off; }
        const int nig = WGM * nN, gid = wgid / nig, fm = gid * WGM, gsz = (nM - fm) < WGM ? (nM - fm) : WGM;
        u.pm = fm + ((wgid % nig) % gsz); u.pn = (wgid % nig) / gsz; return true;
    }
};
template <class Epi, class Sched, bool ALIGN_EPI = false, bool SP2 = false>
__device__ __forceinline__ void gemm_phase(LAS unsigned char* lds, const Gemm g, const Sched& S, const Epi& E) {
    const int tid = threadIdx.x, wid = __builtin_amdgcn_readfirstlane(tid >> 6), lane = tid & 63, wr = wid >> 2, wc = wid & 3, fr = lane & 15, fq = lane >> 4;
    const int K = g.K, nt = K / BK;
    unsigned voffA[2], voffB[2];
#pragma unroll
    for (int i = 0; i < 2; ++i) { int R, C; stage_rc(tid * 16 + i * 8192, R, C); const int Rb = ((R & ~31) + perm32(R & 31));
        voffA[i] = (unsigned)(R * K + C) * 2u; voffB[i] = (unsigned)(Rb * K + C) * 2u; }
    const size_t kstep = (size_t)(BK * 2);
    const size_t hstep = (size_t)HALF * K * 2;
    const size_t tstep = 2 * hstep;
    const unsigned ldsw = (unsigned)wid * 1024u;
    const int aoff = lds_byte(wr * 64 + fr, fq * 8), boff = lds_byte(wc * 32 + fr, fq * 8);
#define PG8_SA(b, h) (((b) * 2 + (h)) * HTB)
#define PG8_SB(b, h) ((4 + (b) * 2 + (h)) * HTB)
#define PG8_STAGE(bufoff, gbase, voff) do { _Pragma("unroll") for (int _i = 0; _i < 2; ++_i) \
        __builtin_amdgcn_global_load_lds((const unsigned*)((const char*)(gbase) + (voff)[_i]), (LAS unsigned*)(lds + (bufoff) + ldsw + _i * 8192), 16, 0, 0); } while (0)
#define PG8_LDA(dst, b, h) do { _Pragma("unroll") for (int m = 0; m < 4; ++m) _Pragma("unroll") for (int k = 0; k < 2; ++k) dst[m][k] = *(const LAS bf16x8*)(lds + PG8_SA(b, h) + aoff + m * 2048 + k * 1024); } while (0)
#define PG8_LDB(dst, b, h) do { _Pragma("unroll") for (int n = 0; n < 2; ++n) _Pragma("unroll") for (int k = 0; k < 2; ++k) dst[n][k] = *(const LAS bf16x8*)(lds + PG8_SB(b, h) + boff + n * 2048 + k * 1024); } while (0)
#define PG8_MMA(ai, bj, At, Bt) do { __builtin_amdgcn_s_setprio(1); _Pragma("unroll") for (int m = 0; m < 4; ++m) _Pragma("unroll") for (int n = 0; n < 2; ++n) _Pragma("unroll") for (int k = 0; k < 2; ++k) \
        acc[ai][bj][m][n] = __builtin_amdgcn_mfma_f32_16x16x32_bf16(Bt[n][k], At[m][k], acc[ai][bj][m][n], 0, 0, 0); __builtin_amdgcn_s_setprio(0); } while (0)
#define PG8_WAIT_V(n) asm volatile("s_waitcnt vmcnt(" #n ")" ::: "memory")
#define PG8_WAIT_L(n) asm volatile("s_waitcnt lgkmcnt(" #n ")" ::: "memory")
#define PG8_BAR __builtin_amdgcn_s_barrier()
#define PG8_SCHED __builtin_amdgcn_sched_barrier(0)
    Unit cur, nxt; int ui = 0;
    if (!S.next(0, cur)) return;
    f32x4 acc[2][2][4][2];
#pragma unroll
    for (int a = 0; a < 2; ++a)
#pragma unroll
        for (int b = 0; b < 2; ++b)
#pragma unroll
            for (int m = 0; m < 4; ++m)
#pragma unroll
                for (int n = 0; n < 2; ++n) acc[a][b][m][n] = (f32x4){0.f, 0.f, 0.f, 0.f};
    bf16x8 At[4][2], B0[2][2], B1[2][2];
    const char* cA = (const char*)g.A + (size_t)cur.pm * tstep; const char* cB = (const char*)g.Bt + (size_t)cur.pn * tstep;

    if constexpr (SP2) {
        PG8_STAGE(PG8_SB(0, 0), cB, voffB); PG8_STAGE(PG8_SB(0, 1), cB + hstep, voffB); PG8_STAGE(PG8_SA(0, 0), cA, voffA); PG8_STAGE(PG8_SA(0, 1), cA + hstep, voffA);
        if (wr == 1) PG8_BAR;
        PG8_WAIT_V(2); PG8_BAR;
        PG8_STAGE(PG8_SB(1, 0), cB + kstep, voffB); PG8_STAGE(PG8_SA(1, 0), cA + kstep, voffA); PG8_STAGE(PG8_SB(1, 1), cB + hstep + kstep, voffB);
        PG8_WAIT_V(6); PG8_BAR;
    } else {
        PG8_STAGE(PG8_SB(0, 0), cB, voffB); PG8_STAGE(PG8_SA(0, 0), cA, voffA); PG8_STAGE(PG8_SB(0, 1), cB + hstep, voffB); PG8_STAGE(PG8_SA(0, 1), cA + hstep, voffA);
        if (wr == 1) PG8_BAR;
        PG8_WAIT_V(4); PG8_BAR;
        PG8_STAGE(PG8_SB(1, 0), cB + kstep, voffB); PG8_STAGE(PG8_SA(1, 0), cA + kstep, voffA); PG8_STAGE(PG8_SB(1, 1), cB + hstep + kstep, voffB);
        PG8_WAIT_V(6); PG8_BAR;
    }
    for (;;) {
        const bool has_next = S.next(ui + 1, nxt);
        const char* nA = has_next ? (const char*)g.A + (size_t)nxt.pm * tstep : cA; const char* nB = has_next ? (const char*)g.Bt + (size_t)nxt.pn * tstep : cB;
        for (int t = 0; t < nt; t += 2) {
            const bool last = (t == nt - 2);
            const char* a1 = cA + (size_t)(t + 1) * kstep;
            const char* a2 = last ? nA : cA + (size_t)(t + 2) * kstep; const char* b2 = last ? nB : cB + (size_t)(t + 2) * kstep;
            const char* a3 = a2 + kstep; const char* b3 = b2 + kstep;

            if constexpr (SP2) {
            PG8_LDB(B0, 0, 0); PG8_LDB(B1, 0, 1); PG8_SCHED; PG8_LDA(At, 0, 0); PG8_STAGE(PG8_SA(1, 1), a1 + hstep, voffA);
            PG8_WAIT_V(8); PG8_WAIT_L(0); PG8_BAR; PG8_MMA(0, 0, At, B0); PG8_MMA(0, 1, At, B1); PG8_BAR; PG8_SCHED;
            PG8_LDA(At, 0, 1); PG8_STAGE(PG8_SB(0, 0), b2, voffB); PG8_STAGE(PG8_SB(0, 1), b2 + hstep, voffB); PG8_STAGE(PG8_SA(0, 0), a2, voffA);
            PG8_WAIT_V(8); PG8_WAIT_L(0); PG8_BAR; PG8_MMA(1, 0, At, B0); PG8_MMA(1, 1, At, B1); PG8_BAR; PG8_SCHED;
            PG8_LDB(B0, 1, 0); PG8_LDB(B1, 1, 1); PG8_SCHED; PG8_LDA(At, 1, 0); PG8_STAGE(PG8_SA(0, 1), a2 + hstep, voffA);
            PG8_WAIT_V(8); PG8_WAIT_L(0); PG8_BAR; PG8_MMA(0, 0, At, B0); PG8_MMA(0, 1, At, B1); PG8_BAR; PG8_SCHED;
            PG8_LDA(At, 1, 1); PG8_STAGE(PG8_SB(1, 0), b3, voffB); PG8_STAGE(PG8_SB(1, 1), b3 + hstep, voffB); PG8_STAGE(PG8_SA(1, 0), a3, voffA);
            PG8_WAIT_V(8); PG8_WAIT_L(0); PG8_BAR; PG8_MMA(1, 0, At, B0); PG8_MMA(1, 1, At, B1); PG8_BAR; PG8_SCHED;
            } else {
            PG8_LDB(B0, 0, 0); PG8_SCHED; PG8_LDA(At, 0, 0); PG8_STAGE(PG8_SA(1, 1), a1 + hstep, voffA);
            PG8_WAIT_L(8); PG8_BAR; PG8_WAIT_L(0); PG8_MMA(0, 0, At, B0); PG8_BAR; PG8_SCHED;
            PG8_LDB(B1, 0, 1); PG8_STAGE(PG8_SB(0, 0), b2, voffB);
            PG8_BAR; PG8_WAIT_L(0); PG8_MMA(0, 1, At, B1); PG8_BAR;
            PG8_LDA(At, 0, 1); PG8_STAGE(PG8_SA(0, 0), a2, voffA);
            PG8_BAR; PG8_WAIT_L(0); PG8_MMA(1, 0, At, B0); PG8_BAR; PG8_SCHED;
            PG8_STAGE(PG8_SB(0, 1), b2 + hstep, voffB);
            PG8_WAIT_V(6); PG8_BAR; PG8_MMA(1, 1, At, B1); PG8_BAR;
            PG8_LDB(B0, 1, 0); PG8_SCHED; PG8_LDA(At, 1, 0); PG8_STAGE(PG8_SA(0, 1), a2 + hstep, voffA);
            PG8_WAIT_L(8); PG8_BAR; PG8_WAIT_L(0); PG8_MMA(0, 0, At, B0); PG8_BAR; PG8_SCHED;
            PG8_LDB(B1, 1, 1); PG8_STAGE(PG8_SB(1, 0), b3, voffB);
            PG8_BAR; PG8_WAIT_L(0); PG8_MMA(0, 1, At, B1); PG8_BAR;
            PG8_LDA(At, 1, 1); PG8_STAGE(PG8_SA(1, 0), a3, voffA);
            PG8_BAR; PG8_WAIT_L(0); PG8_MMA(1, 0, At, B0); PG8_BAR; PG8_SCHED;
            PG8_STAGE(PG8_SB(1, 1), b3 + hstep, voffB);
            PG8_WAIT_V(6); PG8_BAR; PG8_MMA(1, 1, At, B1); PG8_BAR;
            }
        }
        if constexpr (ALIGN_EPI) { if (wr == 0) PG8_BAR; }
        E(acc, cur, wr, wc, fr, fq);
        if (!has_next) break;
#pragma unroll
        for (int a = 0; a < 2; ++a)
#pragma unroll
            for (int b = 0; b < 2; ++b)
#pragma unroll
                for (int m = 0; m < 4; ++m)
#pragma unroll
                    for (int n = 0; n < 2; ++n) acc[a][b][m][n] = (f32x4){0.f, 0.f, 0.f, 0.f};
        cur = nxt; cA = nA; cB = nB; ++ui;
        if constexpr (ALIGN_EPI) { if (wr == 1) PG8_BAR; }
    }
    PG8_WAIT_V(0);
    if constexpr (!ALIGN_EPI) { if (wr == 0) PG8_BAR; }
    PG8_BAR;
#undef PG8_SA
#undef PG8_SB
#undef PG8_STAGE
#undef PG8_LDA
#undef PG8_LDB
#undef PG8_MMA
#undef PG8_WAIT_V
#undef PG8_WAIT_L
#undef PG8_BAR
#undef PG8_SCHED
}
}
using pg8::Unit;

#define EPI_ROWS(ai, m) (u.pm * 256 + (ai) * 128 + wr * 64 + (m) * 16 + fr)
struct EpiSwiglu {
    bf16_t* H;
    __device__ __forceinline__ void operator()(const f32x4 (&acc)[2][2][4][2], const Unit& u, int wr, int wc, int fr, int fq) const {
        const int col = u.pn * 128 + wc * 32 + 8 * fq;
#pragma unroll
        for (int ai = 0; ai < 2; ++ai)
#pragma unroll
            for (int m = 0; m < 4; ++m) {
                const size_t row = EPI_ROWS(ai, m);
                float h[8];
#pragma unroll
                for (int n = 0; n < 2; ++n)
#pragma unroll
                    for (int j = 0; j < 4; ++j) { const float g = acc[ai][0][m][n][j], uu = acc[ai][1][m][n][j]; h[4 * n + j] = g * uu * sigmoid_f(g); }
                u32x4 w; w.x = cvt_pk_bf16(h[0], h[1]); w.y = cvt_pk_bf16(h[2], h[3]); w.z = cvt_pk_bf16(h[4], h[5]); w.w = cvt_pk_bf16(h[6], h[7]);
                *(u32x4*)(H + row * FH + col) = w;
            }
    }
};
template <bool RES_BF16, bool HAS_MUL, bool OUT_BF16 = false>
struct EpiResid {
    const void* res; const bf16_t* mul; float* Y; float scale;
    __device__ __forceinline__ void operator()(const f32x4 (&acc)[2][2][4][2], const Unit& u, int wr, int wc, int fr, int fq) const {
#pragma unroll
        for (int ai = 0; ai < 2; ++ai)
#pragma unroll
            for (int m = 0; m < 4; ++m) {
                const size_t row = EPI_ROWS(ai, m);
#pragma unroll
                for (int bj = 0; bj < 2; ++bj) {
                    const size_t off = row * DM + u.pn * 256 + bj * 128 + wc * 32 + 8 * fq;
                    float r[8];
                    if (RES_BF16) { const u32x4 rv = *(const u32x4*)((const bf16_t*)res + off);
                        r[0] = bf_lo(rv.x); r[1] = bf_hi(rv.x); r[2] = bf_lo(rv.y); r[3] = bf_hi(rv.y); r[4] = bf_lo(rv.z); r[5] = bf_hi(rv.z); r[6] = bf_lo(rv.w); r[7] = bf_hi(rv.w); }
                    else { const f32x4 a = *(const f32x4*)((const float*)res + off), b = *(const f32x4*)((const float*)res + off + 4);
                        r[0] = a[0]; r[1] = a[1]; r[2] = a[2]; r[3] = a[3]; r[4] = b[0]; r[5] = b[1]; r[6] = b[2]; r[7] = b[3]; }
                    float mv[8];
                    if (HAS_MUL) { const u32x4 rv = *(const u32x4*)(mul + off);
                        mv[0] = bf_lo(rv.x); mv[1] = bf_hi(rv.x); mv[2] = bf_lo(rv.y); mv[3] = bf_hi(rv.y); mv[4] = bf_lo(rv.z); mv[5] = bf_hi(rv.z); mv[6] = bf_lo(rv.w); mv[7] = bf_hi(rv.w); }
                    f32x4 o0, o1;
#pragma unroll
                    for (int j = 0; j < 4; ++j) {
                        const float a0 = acc[ai][bj][m][0][j] * scale, a1 = acc[ai][bj][m][1][j] * scale;
                        o0[j] = ALPHA * r[j] + (HAS_MUL ? mv[j] * a0 : a0); o1[j] = ALPHA * r[4 + j] + (HAS_MUL ? mv[4 + j] * a1 : a1); }
                    if (OUT_BF16) { u32x4 w; w.x = cvt_pk_bf16(o0[0], o0[1]); w.y = cvt_pk_bf16(o0[2], o0[3]); w.z = cvt_pk_bf16(o1[0], o1[1]); w.w = cvt_pk_bf16(o1[2], o1[3]); *(u32x4*)((bf16_t*)Y + off) = w; }
                    else { *(f32x4*)(Y + off) = o0; *(f32x4*)(Y + off + 4) = o1; }
                }
            }
    }
};
struct EpiWin {
    bf16_t* proj; bf16_t* gates; float* ifg; const float* bias;
    __device__ __forceinline__ void operator()(const f32x4 (&acc)[2][2][4][2], const Unit& u, int wr, int wc, int fr, int fq) const {
        const int pn = u.pn;
        if (pn == 32) {
            if (wc == 0 && fq == 0) {
                const f32x4 bi = *(const f32x4*)(bias + 8192), bf = *(const f32x4*)(bias + 8196);
#pragma unroll
                for (int ai = 0; ai < 2; ++ai)
#pragma unroll
                    for (int m = 0; m < 4; ++m) {
                        const size_t row = EPI_ROWS(ai, m);
                        f32x4 iv = acc[ai][0][m][0] + bi, fv = acc[ai][0][m][1] + bf, lf;
#pragma unroll
                        for (int j = 0; j < 4; ++j) { const float xx = fv[j]; lf[j] = xx >= 0.f ? -log1pf(expf(-xx)) : xx - log1pf(expf(xx)); }
                        *(f32x4*)(ifg + row * 8) = iv; *(f32x4*)(ifg + row * 8 + 4) = lf;
                    }
            }
            return;
        }
        bf16_t* dst; int ld, c0; int act = 0; float sc = 1.0f;
        if (pn < 24) { const int sec = pn >> 2; dst = proj + (size_t)sec * ((size_t)MTOK * DM); ld = DM; c0 = (pn & 3) * 256; if (sec == 2) act = 1; if (sec == 3) sc = 0.08838834764831845f * LOG2E; }
        else { dst = gates; ld = 2 * DM; c0 = (pn - 24) * 256; act = 1; }
#pragma unroll
        for (int bj = 0; bj < 2; ++bj) {
            const int cl = bj * 128 + wc * 32 + 8 * fq;
            const f32x4 b0 = *(const f32x4*)(bias + pn * 256 + cl), b1 = *(const f32x4*)(bias + pn * 256 + cl + 4);
#pragma unroll
            for (int ai = 0; ai < 2; ++ai)
#pragma unroll
                for (int m = 0; m < 4; ++m) {
                    const size_t row = EPI_ROWS(ai, m);
                    f32x4 v0 = acc[ai][bj][m][0] + b0, v1 = acc[ai][bj][m][1] + b1;
                    if (act) {
#pragma unroll
                        for (int j = 0; j < 4; ++j) { v0[j] = sigmoid_f(v0[j]); v1[j] = sigmoid_f(v1[j]); } }
                    else { v0 *= sc; v1 *= sc; }
                    u32x4 w; w.x = cvt_pk_bf16(v0[0], v0[1]); w.y = cvt_pk_bf16(v0[2], v0[3]); w.z = cvt_pk_bf16(v1[0], v1[1]); w.w = cvt_pk_bf16(v1[2], v1[3]);
                    *(u32x4*)(dst + row * ld + c0 + cl) = w;
                }
        }
    }
};
template <bool ADD>
struct EpiGateMul {
    const bf16_t* gate; int goff; const bf16_t* tin; bf16_t* out;
    __device__ __forceinline__ void operator()(const f32x4 (&acc)[2][2][4][2], const Unit& u, int wr, int wc, int fr, int fq) const {
#pragma unroll
        for (int ai = 0; ai < 2; ++ai)
#pragma unroll
            for (int m = 0; m < 4; ++m) {
                const size_t row = EPI_ROWS(ai, m);
#pragma unroll
                for (int bj = 0; bj < 2; ++bj) {
                    const int c = u.pn * 256 + bj * 128 + wc * 32 + 8 * fq;
                    const u32x4 gv = *(const u32x4*)(gate + row * (2 * DM) + goff + c);
                    float gg[8] = {bf_lo(gv.x), bf_hi(gv.x), bf_lo(gv.y), bf_hi(gv.y), bf_lo(gv.z), bf_hi(gv.z), bf_lo(gv.w), bf_hi(gv.w)};
                    float tt[8] = {0.f, 0.f, 0.f, 0.f, 0.f, 0.f, 0.f, 0.f};
                    if (ADD) { const u32x4 tv = *(const u32x4*)(tin + row * DM + c);
                        tt[0] = bf_lo(tv.x); tt[1] = bf_hi(tv.x); tt[2] = bf_lo(tv.y); tt[3] = bf_hi(tv.y); tt[4] = bf_lo(tv.z); tt[5] = bf_hi(tv.z); tt[6] = bf_lo(tv.w); tt[7] = bf_hi(tv.w); }
                    float o[8];
#pragma unroll
                    for (int j = 0; j < 4; ++j) { o[j] = tt[j] + gg[j] * acc[ai][bj][m][0][j]; o[4 + j] = tt[4 + j] + gg[4 + j] * acc[ai][bj][m][1][j]; }
                    u32x4 w; w.x = cvt_pk_bf16(o[0], o[1]); w.y = cvt_pk_bf16(o[2], o[3]); w.z = cvt_pk_bf16(o[4], o[5]); w.w = cvt_pk_bf16(o[6], o[7]);
                    *(u32x4*)(out + row * DM + c) = w;
                }
            }
    }
};
struct EpiSigBias {
    const float* bias; bf16_t* out;
    __device__ __forceinline__ void operator()(const f32x4 (&acc)[2][2][4][2], const Unit& u, int wr, int wc, int fr, int fq) const {
#pragma unroll
        for (int bj = 0; bj < 2; ++bj) {
            const int c = u.pn * 256 + bj * 128 + wc * 32 + 8 * fq;
            const f32x4 b0 = *(const f32x4*)(bias + c), b1 = *(const f32x4*)(bias + c + 4);
#pragma unroll
            for (int ai = 0; ai < 2; ++ai)
#pragma unroll
                for (int m = 0; m < 4; ++m) {
                    const size_t row = EPI_ROWS(ai, m);
                    f32x4 v0 = acc[ai][bj][m][0] + b0, v1 = acc[ai][bj][m][1] + b1;
#pragma unroll
                    for (int j = 0; j < 4; ++j) { v0[j] = sigmoid_f(v0[j]); v1[j] = sigmoid_f(v1[j]); }
                    u32x4 w; w.x = cvt_pk_bf16(v0[0], v0[1]); w.y = cvt_pk_bf16(v0[2], v0[3]); w.z = cvt_pk_bf16(v1[0], v1[1]); w.w = cvt_pk_bf16(v1[2], v1[3]);
                    *(u32x4*)(out + row * DM + c) = w;
                }
        }
    }
};

struct Params {
    const float *x, *p, *ln_g, *ln_b, *wg, *wu, *wd, *w_in, *b_in, *b_forget, *conv_w, *conv_b, *mh_g, *w_a, *w_b, *w_o, *w_ple, *w_pg, *b_pg;
    float* out; unsigned char* ws;
    int ph_lo, ph_hi, coop, pad;
};

__device__ void cvt_bf16_phase(const float* src, bf16_t* dst, size_t n8) {
    const size_t stride = (size_t)gridDim.x * NTHREADS;
    size_t i = (size_t)blockIdx.x * NTHREADS + threadIdx.x;
    for (; i + 3 * stride < n8; i += 4 * stride) {
        f32x4 a[4], b[4];
#pragma unroll
        for (int u = 0; u < 4; ++u) { a[u] = *(const f32x4*)(src + (i + u * stride) * 8); b[u] = *(const f32x4*)(src + (i + u * stride) * 8 + 4); }
#pragma unroll
        for (int u = 0; u < 4; ++u) { u32x4 w; w.x = cvt_pk_bf16(a[u][0], a[u][1]); w.y = cvt_pk_bf16(a[u][2], a[u][3]); w.z = cvt_pk_bf16(b[u][0], b[u][1]); w.w = cvt_pk_bf16(b[u][2], b[u][3]);
            *(u32x4*)(dst + (i + u * stride) * 8) = w; }
    }
    for (; i < n8; i += stride) {
        const f32x4 a = *(const f32x4*)(src + i * 8), b = *(const f32x4*)(src + i * 8 + 4);
        u32x4 w; w.x = cvt_pk_bf16(a[0], a[1]); w.y = cvt_pk_bf16(a[2], a[3]); w.z = cvt_pk_bf16(b[0], b[1]); w.w = cvt_pk_bf16(b[2], b[3]);
        *(u32x4*)(dst + i * 8) = w;
    }
}
template <int MODE>
__device__ __forceinline__ float tsrc_val(const float* w0, const float* w1, int ldn, int k, int n) {
    if (MODE == 0) return w0[(size_t)k * ldn + n];
    if (MODE == 1) { const int pn = n >> 8, sel = (n >> 7) & 1, i = n & 127; const float* w = sel ? w1 : w0; return w[(size_t)k * ldn + pn * 128 + i]; }
    int col; if (n < 3072) col = n; else if (n < 8192) col = n + 8; else if (n < 8200) col = 3072 + (n - 8192); else return 0.f;
    return w0[(size_t)k * ldn + col];
}
template <int MODE>
__device__ __forceinline__ void transpose_mat(LAS float* tile, const float* w0, const float* w1, int ldn, bf16_t* dst, int NP, int K, int& base) {
    const int tid = threadIdx.x;
    const int tn = NP / 128, tk = K / 128, nt = tn * tk;
    int first = ((int)blockIdx.x - base) % (int)gridDim.x; if (first < 0) first += gridDim.x;
    for (int t = first; t < nt; t += gridDim.x) {
        const int n0 = (t / tk) * 128, k0 = (t % tk) * 128;
#pragma unroll 8
        for (int e = 0; e < 32; ++e) { const int idx = e * NTHREADS + tid, kk = idx >> 7, nn = idx & 127; tile[kk * 129 + nn] = tsrc_val<MODE>(w0, w1, ldn, k0 + kk, n0 + nn); }
        __syncthreads();
#pragma unroll 8
        for (int e = 0; e < 16; ++e) { const int idx = e * NTHREADS + tid, nn = idx >> 6, kk = (idx & 63) * 2;
            *(unsigned*)(dst + (size_t)(n0 + nn) * K + k0 + kk) = cvt_pk_bf16(tile[kk * 129 + nn], tile[(kk + 1) * 129 + nn]); }
        __syncthreads();
    }
    base += nt;
}
__device__ void prep_phase(const Params& P, LAS unsigned char* lds) {
    unsigned char* ws = P.ws;
    cvt_bf16_phase(P.x, (bf16_t*)(ws + WS_X), (size_t)MTOK * DM / 8);
    if (blockIdx.x == 0 && threadIdx.x < 64) ((unsigned*)(ws + MISC_CNT))[threadIdx.x] = 0u;
    for (int n = blockIdx.x * NTHREADS + threadIdx.x; n < NIN_PAD; n += gridDim.x * NTHREADS) {
        float b;
        if (n < 3072) b = P.b_in[n]; else if (n < 8192) b = P.b_in[n + 8]; else if (n < 8196) b = P.b_in[3072 + n - 8192];
        else if (n < 8200) b = P.b_in[3072 + n - 8192] + P.b_forget[n - 8196]; else b = 0.f;
        ((float*)(ws + W_BIAS))[n] = b;
    }
    LAS float* tile = (LAS float*)lds;
    int base = 0;
    transpose_mat<1>(tile, P.wg, P.wu, FH, (bf16_t*)(ws + W_GU1), 5632, 1024, base);
    transpose_mat<0>(tile, P.wd, nullptr, DM, (bf16_t*)(ws + W_D1), 1024, FH, base);
    transpose_mat<1>(tile, P.wg + (size_t)DM * FH, P.wu + (size_t)DM * FH, FH, (bf16_t*)(ws + W_GU2), 5632, 1024, base);
    transpose_mat<0>(tile, P.wd + (size_t)DM * FH, nullptr, DM, (bf16_t*)(ws + W_D2), 1024, FH, base);
    transpose_mat<2>(tile, P.w_in, nullptr, 8200, (bf16_t*)(ws + W_IN), NIN_PAD, 1024, base);
    transpose_mat<0>(tile, P.w_a, nullptr, DM, (bf16_t*)(ws + W_A), 1024, 1024, base);
    transpose_mat<0>(tile, P.w_b, nullptr, DM, (bf16_t*)(ws + W_B), 1024, 1024, base);
    transpose_mat<0>(tile, P.w_o, nullptr, DM, (bf16_t*)(ws + W_O), 1024, 1024, base);
    transpose_mat<0>(tile, P.w_pg, nullptr, DM, (bf16_t*)(ws + W_PG), 1024, 1024, base);
    transpose_mat<0>(tile, P.w_ple, nullptr, DM, (bf16_t*)(ws + W_P), 1024, 256, base);
}
template <bool OUT_BF16, bool IN_BF16 = false>
__device__ void ln_phase(const float* Y, const float* g, const float* b, void* out) {
    const int wid = threadIdx.x >> 6, lane = threadIdx.x & 63;
    f32x4 gv[4], bv[4];
#pragma unroll
    for (int i = 0; i < 4; ++i) { gv[i] = *(const f32x4*)(g + i * 256 + lane * 4); bv[i] = *(const f32x4*)(b + i * 256 + lane * 4); }
    for (int row0 = (blockIdx.x * 8 + wid) * 2; row0 < MTOK; row0 += gridDim.x * 16) {
        f32x4 v[2][4]; float s[2] = {0.f, 0.f};
#pragma unroll
        for (int r = 0; r < 2; ++r)
#pragma unroll
            for (int i = 0; i < 4; ++i) {
                if (IN_BF16) { const u32x2 t = *(const u32x2*)((const bf16_t*)Y + (size_t)(row0 + r) * DM + i * 256 + lane * 4); v[r][i] = (f32x4){bf_lo(t.x), bf_hi(t.x), bf_lo(t.y), bf_hi(t.y)}; }
                else v[r][i] = *(const f32x4*)(Y + (size_t)(row0 + r) * DM + i * 256 + lane * 4); }
#pragma unroll
        for (int r = 0; r < 2; ++r) {
#pragma unroll
            for (int i = 0; i < 4; ++i) s[r] += (v[r][i][0] + v[r][i][1]) + (v[r][i][2] + v[r][i][3]);
            const float mean = wave_sum(s[r]) * (1.0f / DM);
            float q = 0.f;
#pragma unroll
            for (int i = 0; i < 4; ++i) { const f32x4 d = v[r][i] - mean; q += (d[0] * d[0] + d[1] * d[1]) + (d[2] * d[2] + d[3] * d[3]); }
            const float rstd = rsqrtf(wave_sum(q) * (1.0f / DM) + LN_EPS);
#pragma unroll
            for (int i = 0; i < 4; ++i) {
                const f32x4 o = (v[r][i] - mean) * rstd * gv[i] + bv[i];
                if (OUT_BF16) { u32x2 w; w.x = cvt_pk_bf16(o[0], o[1]); w.y = cvt_pk_bf16(o[2], o[3]); *(u32x2*)((bf16_t*)out + (size_t)(row0 + r) * DM + i * 256 + lane * 4) = w; }
                else *(f32x4*)((float*)out + (size_t)(row0 + r) * DM + i * 256 + lane * 4) = o;
            }
        }
    }
}

constexpr int L_QI = 0, L_KI = 17408, L_KT = 34816, L_VT = 53248, L_PI = 90112, L_F = 99328;
constexpr int F_N = 0, F_QN = 128, F_RS = 192, F_HS = 320, F_BL = 1344, F_GM = 1472, F_M = 1600, F_CW = 1732, F_SA = 3012, F_SB2 = 3028, F_SMU = 4052, F_SWI = 5076, F_SWN = 6100, F_SEM = 7124, F_END = 8148;
constexpr int MIX_LDS = L_F + F_END * 4;

__device__ void mlstm_prologue(const Params& P, LAS unsigned char* lds, int b, int h, int gi) {
    LAS float* F = (LAS float*)(lds + L_F);
    const float* ifg = (const float*)(P.ws + MISC_IF);
    const int tid = threadIdx.x, w = tid >> 6, lane = tid & 63;
    const int nch = 16 * (gi + 1);
    for (int c = w; c < nch; c += 8) {
        const size_t tok = (size_t)b * SEQ + c * 64 + lane;
        const float iv = ifg[tok * 8 + h], lf = ifg[tok * 8 + 4 + h];
        const float bc = wave_incl_sum(lf, lane);
        const float bl = __shfl(bc, 63);
        const float gm = wave_max(bl - bc + iv);
        if (lane == 0) { F[F_BL + c] = bl; F[F_GM + c] = gm; }
    }
    for (int i = tid; i < 1280; i += NTHREADS) {
        const int j = i >> 8, ch = i & 255; const int gc = ch < 128 ? h * 128 + ch : 512 + h * 128 + (ch - 128);
        F[F_CW + i] = j < 4 ? P.conv_w[j * 1024 + gc] : P.conv_b[gc];
    }
    if (tid < 128) F[F_N + tid] = 0.f;
    __syncthreads();
    if (tid == 0) { float m = 0.f; F[F_M] = 0.f; for (int c = 0; c < nch; ++c) { m = fmaxf(F[F_BL + c] + m, F[F_GM + c]); F[F_M + c + 1] = m; } }
    __syncthreads();
    for (int lc = w; lc < 16; lc += 8) {
        const int c = gi * 16 + lc;
        const size_t tok = (size_t)b * SEQ + c * 64 + lane;
        const float iv = ifg[tok * 8 + h], lf = ifg[tok * 8 + 4 + h];
        const float bc = wave_incl_sum(lf, lane);
        const float bl = __shfl(bc, 63);
        const float mst = F[F_M + c], mnew = F[F_M + c + 1];
        const float beta = iv - bc;
        const float mu = fmaxf(mst, wave_incl_max(beta, lane));
        F[F_SB2 + lc * 64 + lane] = beta * LOG2E;
        F[F_SMU + lc * 64 + lane] = mu * LOG2E;
        F[F_SWI + lc * 64 + lane] = expf(mst - mu);
        F[F_SWN + lc * 64 + lane] = expf(bl - bc + iv - mnew);
        F[F_SEM + lc * 64 + lane] = expf(-(bc + mu));
        if (lane == 0) F[F_SA + lc] = expf(bl + mst - mnew);
    }
    __syncthreads();
}

template <bool NEED_Q>
__device__ __forceinline__ void mlstm_load(const Params& P, LAS unsigned char* lds, int b, int h, int c, int lc) {
    LAS float* F = (LAS float*)(lds + L_F);
    const bf16_t* QK = (const bf16_t*)(P.ws + WS_QK);
    const bf16_t* VA = (const bf16_t*)(P.ws + WS_VA);
    const int tid = threadIdx.x, tg = tid & 15, cg = tid >> 4;
    {
        u32x4 vr[4];
#pragma unroll
        for (int tt = 0; tt < 4; ++tt) vr[tt] = *(const u32x4*)(VA + ((size_t)b * SEQ + c * 64 + 4 * tg + tt) * DM + h * 256 + 8 * cg);
#pragma unroll
        for (int e = 0; e < 8; ++e) {
            unsigned short x0, x1, x2, x3;
            { const unsigned a0 = vr[0][e >> 1], a1 = vr[1][e >> 1], a2 = vr[2][e >> 1], a3 = vr[3][e >> 1];
              if (e & 1) { x0 = a0 >> 16; x1 = a1 >> 16; x2 = a2 >> 16; x3 = a3 >> 16; } else { x0 = a0 & 0xffff; x1 = a1 & 0xffff; x2 = a2 & 0xffff; x3 = a3 & 0xffff; } }
            u32x2 wv; wv.x = (unsigned)x0 | ((unsigned)x1 << 16); wv.y = (unsigned)x2 | ((unsigned)x3 << 16);
            *(LAS u32x2*)(lds + L_VT + (8 * cg + e) * 144 + 8 * tg) = wv;
        }
    }
    __builtin_amdgcn_sched_barrier(0);
    if (NEED_Q || cg >= 16) {
        const int gc = cg < 16 ? h * 128 + 8 * cg : 512 + h * 128 + 8 * (cg - 16);
        u32x4 raw[7];
#pragma unroll
        for (int i = 0; i < 7; ++i) {
            const int pos = c * 64 + 4 * tg - 3 + i;
            raw[i] = pos >= 0 ? *(const u32x4*)(QK + ((size_t)b * SEQ + pos) * DM + gc) : (u32x4){0u, 0u, 0u, 0u};
        }
        float o[4][8];
#pragma unroll
        for (int e = 0; e < 8; ++e) {
            float rv[7];
#pragma unroll
            for (int i = 0; i < 7; ++i) rv[i] = (e & 1) ? bf_hi(raw[i][e >> 1]) : bf_lo(raw[i][e >> 1]);
            const float w0 = F[F_CW + 0 * 256 + 8 * cg + e], w1 = F[F_CW + 1 * 256 + 8 * cg + e], w2 = F[F_CW + 2 * 256 + 8 * cg + e], w3 = F[F_CW + 3 * 256 + 8 * cg + e], cb = F[F_CW + 4 * 256 + 8 * cg + e];
#pragma unroll
            for (int tt = 0; tt < 4; ++tt) { const float v = cb + w0 * rv[tt] + w1 * rv[tt + 1] + w2 * rv[tt + 2] + w3 * rv[tt + 3]; o[tt][e] = v * sigmoid_f(v); }
            __builtin_amdgcn_sched_barrier(0);
        }
        if (cg < 16) {
#pragma unroll
            for (int tt = 0; tt < 4; ++tt) { u32x4 wv; wv.x = cvt_pk_bf16(o[tt][0], o[tt][1]); wv.y = cvt_pk_bf16(o[tt][2], o[tt][3]); wv.z = cvt_pk_bf16(o[tt][4], o[tt][5]); wv.w = cvt_pk_bf16(o[tt][6], o[tt][7]);
                *(LAS u32x4*)(lds + L_QI + (4 * tg + tt) * 272 + 16 * cg) = wv; }
        } else {
            const int kc = cg - 16;
            const f32x4 wn = *(const LAS f32x4*)(F + F_SWN + lc * 64 + 4 * tg);
#pragma unroll
            for (int tt = 0; tt < 4; ++tt) {
#pragma unroll
                for (int e = 0; e < 8; ++e) o[tt][e] *= 0.08838834764831845f;
                u32x4 wv; wv.x = cvt_pk_bf16(o[tt][0], o[tt][1]); wv.y = cvt_pk_bf16(o[tt][2], o[tt][3]); wv.z = cvt_pk_bf16(o[tt][4], o[tt][5]); wv.w = cvt_pk_bf16(o[tt][6], o[tt][7]);
                *(LAS u32x4*)(lds + L_KI + (4 * tg + tt) * 272 + 16 * kc) = wv; }
#pragma unroll
            for (int e = 0; e < 8; ++e) { u32x2 wv; wv.x = cvt_pk_bf16(o[0][e] * wn[0], o[1][e] * wn[1]); wv.y = cvt_pk_bf16(o[2][e] * wn[2], o[3][e] * wn[3]);
                *(LAS u32x2*)(lds + L_KT + (8 * kc + e) * 144 + 8 * tg) = wv; }
        }
    }
}

__device__ __forceinline__ void mlstm_update(LAS unsigned char* lds, f32x4 (&C)[2][8], int lc, int w, int r, int g) {
    LAS float* F = (LAS float*)(lds + L_F);
    const float a = F[F_SA + lc];
    const LAS unsigned char* vp = lds + (L_VT + (32 * w + r) * 144 + 16 * g);
    const LAS unsigned char* kp = lds + (L_KT + r * 144 + 16 * g);
#pragma unroll
    for (int dvb = 0; dvb < 2; ++dvb)
#pragma unroll
        for (int dkb = 0; dkb < 8; ++dkb) C[dvb][dkb] *= a;
#pragma unroll
    for (int ks = 0; ks < 2; ++ks) {
        bf16x8 vf[2];
#pragma unroll
        for (int dvb = 0; dvb < 2; ++dvb) vf[dvb] = *(const LAS bf16x8*)(vp + (16 * dvb * 144 + 64 * ks));
#pragma unroll
        for (int dkb = 0; dkb < 8; ++dkb) {
            const bf16x8 kf = *(const LAS bf16x8*)(kp + (16 * dkb * 144 + 64 * ks));
#pragma unroll
            for (int dvb = 0; dvb < 2; ++dvb) C[dvb][dkb] = mfma16(kf, vf[dvb], C[dvb][dkb]);
        }
        __builtin_amdgcn_sched_barrier(0);
    }
    const int tid = threadIdx.x, dk = tid >> 2, part = tid & 3;
    const u32x4 k0 = *(const LAS u32x4*)(lds + L_KT + dk * 144 + 32 * part), k1 = *(const LAS u32x4*)(lds + L_KT + dk * 144 + 32 * part + 16);
    float s = 0.f;
#pragma unroll
    for (int i = 0; i < 4; ++i) s += bf_lo(k0[i]) + bf_hi(k0[i]) + bf_lo(k1[i]) + bf_hi(k1[i]);
    s += __shfl_xor(s, 1); s += __shfl_xor(s, 2);
    if (part == 0) F[F_N + dk] = a * F[F_N + dk] + s;
}

__device__ void mlstm_phase1(const Params& P, LAS unsigned char* lds) {
    const int tid = threadIdx.x, w = tid >> 6, lane = tid & 63, r = lane & 15, g = lane >> 4;
    LAS float* F = (LAS float*)(lds + L_F);
    for (int task = blockIdx.x; task < 256; task += gridDim.x) {
        const int gi = task & 7, st = task >> 3, b = st >> 2, h = st & 3;
        if (gi == 7) continue;
        mlstm_prologue(P, lds, b, h, gi);
        f32x4 C[2][8];
#pragma unroll
        for (int i = 0; i < 2; ++i)
#pragma unroll
            for (int j = 0; j < 8; ++j) C[i][j] = (f32x4){0.f, 0.f, 0.f, 0.f};
        for (int lc = 0; lc < 16; ++lc) {
            mlstm_load<false>(P, lds, b, h, gi * 16 + lc, lc);
            __syncthreads();
            mlstm_update(lds, C, lc, w, r, g);
            __syncthreads();
        }
        float* slot = (float*)(P.ws + WS_PB) + (size_t)(st * 7 + gi) * STATE_FLOATS;
#pragma unroll
        for (int dvb = 0; dvb < 2; ++dvb)
#pragma unroll
            for (int dkb = 0; dkb < 8; ++dkb) *(f32x4*)(slot + (((w * 2 + dvb) * 8 + dkb) * 64 + lane) * 4) = C[dvb][dkb];
        if (tid < 128) slot[32768 + tid] = F[F_N + tid];
        __syncthreads();
    }
}

__device__ void mlstm_phase2(const Params& P, LAS unsigned char* lds) {
    const int tid = threadIdx.x, w = tid >> 6, lane = tid & 63, r = lane & 15, g = lane >> 4;
    LAS float* F = (LAS float*)(lds + L_F);
    const bf16_t* OA = (const bf16_t*)(P.ws + WS_OA);
    bf16_t* VA = (bf16_t*)(P.ws + WS_VA);
    for (int task = blockIdx.x; task < 256; task += gridDim.x) {
        const int gi = task & 7, st = task >> 3, b = st >> 2, h = st & 3;
        mlstm_prologue(P, lds, b, h, gi);
        f32x4 C[2][8];
#pragma unroll
        for (int i = 0; i < 2; ++i)
#pragma unroll
            for (int j = 0; j < 8; ++j) C[i][j] = (f32x4){0.f, 0.f, 0.f, 0.f};
        float nreg = 0.f;
        for (int j = 0; j < gi; ++j) {
            float Bj = 0.f;
            for (int c = 0; c < 16; ++c) Bj += F[F_BL + j * 16 + c];
            const float Aj = expf(Bj + F[F_M + 16 * j] - F[F_M + 16 * j + 16]);
            const float* slot = (const float*)(P.ws + WS_PB) + (size_t)(st * 7 + j) * STATE_FLOATS;
#pragma unroll
            for (int dvb = 0; dvb < 2; ++dvb)
#pragma unroll
                for (int dkb = 0; dkb < 8; ++dkb) C[dvb][dkb] = C[dvb][dkb] * Aj + *(const f32x4*)(slot + (((w * 2 + dvb) * 8 + dkb) * 64 + lane) * 4);
            if (tid < 128) nreg = nreg * Aj + slot[32768 + tid];
        }
        if (tid < 128) F[F_N + tid] = nreg;
        __syncthreads();
        for (int lc = 0; lc < 16; ++lc) {
            const int c = gi * 16 + lc;
            mlstm_load<true>(P, lds, b, h, c, lc);
            __syncthreads();
            {
                const int tb = w >> 1, par = w & 1;
                const LAS unsigned char* qpS = lds + (L_QI + (16 * tb + r) * 272 + 16 * g);
                const LAS unsigned char* kpS = lds + (L_KI + (16 * par + r) * 272 + 16 * g);
                LAS unsigned char* ppS = lds + (L_PI + (16 * tb + r) * 144 + 32 * par + 8 * g);
                bf16x8 qf[4];
#pragma unroll
                for (int kd = 0; kd < 4; ++kd) qf[kd] = *(const LAS bf16x8*)(qpS + 64 * kd);
                const float mu2 = F[F_SMU + lc * 64 + 16 * tb + r];
                float rs = 0.f;
#pragma unroll
                for (int sbi = 0; sbi < 2; ++sbi) {
                    const int sb = par + 2 * sbi;
                    u32x2 pw = (u32x2){0u, 0u};
                    if (sb <= tb) {
                        f32x4 acc = (f32x4){0.f, 0.f, 0.f, 0.f};
#pragma unroll
                        for (int kd = 0; kd < 4; ++kd) { const bf16x8 kf = *(const LAS bf16x8*)(kpS + (32 * sbi * 272 + 64 * kd)); acc = mfma16(kf, qf[kd], acc); }
                        const f32x4 b2 = *(const LAS f32x4*)(F + F_SB2 + lc * 64 + 16 * sb + 4 * g);
                        float pv[4];
#pragma unroll
                        for (int j = 0; j < 4; ++j) { const int s = 16 * sb + 4 * g + j, t = 16 * tb + r; pv[j] = (s <= t) ? acc[j] * fast_exp2(b2[j] - mu2) : 0.f; }
                        pw.x = cvt_pk_bf16(pv[0], pv[1]); pw.y = cvt_pk_bf16(pv[2], pv[3]);
                        rs += bf_lo(pw.x) + bf_hi(pw.x) + bf_lo(pw.y) + bf_hi(pw.y);
                    }
                    *(LAS u32x2*)(ppS + 64 * sbi) = pw;
                }
                rs += __shfl_xor(rs, 16); rs += __shfl_xor(rs, 32);
                if (g == 0) F[F_RS + par * 64 + 16 * tb + r] = rs;
            }
            __builtin_amdgcn_sched_barrier(0);
            const LAS unsigned char* q8p = lds + (L_QI + r * 272 + 8 * g);
            f32x4 num[2][4];
#pragma unroll
            for (int i = 0; i < 2; ++i)
#pragma unroll
                for (int j = 0; j < 4; ++j) num[i][j] = (f32x4){0.f, 0.f, 0.f, 0.f};
#pragma unroll
            for (int kk = 0; kk < 4; ++kk) {
                bf16x8 af[2];
#pragma unroll
                for (int dvb = 0; dvb < 2; ++dvb) {
                    u32x2 lo, hi; lo.x = cvt_pk_bf16(C[dvb][2 * kk][0], C[dvb][2 * kk][1]); lo.y = cvt_pk_bf16(C[dvb][2 * kk][2], C[dvb][2 * kk][3]);
                    hi.x = cvt_pk_bf16(C[dvb][2 * kk + 1][0], C[dvb][2 * kk + 1][1]); hi.y = cvt_pk_bf16(C[dvb][2 * kk + 1][2], C[dvb][2 * kk + 1][3]);
                    af[dvb] = mk8(lo, hi);
                }
#pragma unroll
                for (int tb = 0; tb < 4; ++tb) {
                    const u32x2 q0 = *(const LAS u32x2*)(q8p + (16 * tb * 272 + 64 * kk)), q1 = *(const LAS u32x2*)(q8p + (16 * tb * 272 + 64 * kk + 32));
                    const bf16x8 bq = mk8(q0, q1);
#pragma unroll
                    for (int dvb = 0; dvb < 2; ++dvb) num[dvb][tb] = mfma16(af[dvb], bq, num[dvb][tb]);
                }
                __builtin_amdgcn_sched_barrier(0);
            }
#pragma unroll
            for (int tb = 0; tb < 4; ++tb) { const float wi = F[F_SWI + lc * 64 + 16 * tb + r];
#pragma unroll
                for (int dvb = 0; dvb < 2; ++dvb) num[dvb][tb] *= wi; }
            {
                const int t = tid >> 3, part = tid & 7;
                const u32x4 q0 = *(const LAS u32x4*)(lds + L_QI + t * 272 + 32 * part), q1 = *(const LAS u32x4*)(lds + L_QI + t * 272 + 32 * part + 16);
                float s = 0.f;
#pragma unroll
                for (int i = 0; i < 4; ++i) {
                    s += bf_lo(q0[i]) * F[F_N + 16 * part + 2 * i] + bf_hi(q0[i]) * F[F_N + 16 * part + 2 * i + 1];
                    s += bf_lo(q1[i]) * F[F_N + 16 * part + 8 + 2 * i] + bf_hi(q1[i]) * F[F_N + 16 * part + 8 + 2 * i + 1];
                }
                s += __shfl_xor(s, 1); s += __shfl_xor(s, 2); s += __shfl_xor(s, 4);
                if (part == 0) F[F_QN + t] = s;
            }
            __builtin_amdgcn_sched_barrier(0);
            __syncthreads();
            const LAS unsigned char* vpC = lds + (L_VT + (32 * w + r) * 144 + 16 * g);
            const LAS unsigned char* ppC = lds + (L_PI + r * 144 + 16 * g);
#pragma unroll
            for (int ks = 0; ks < 2; ++ks) {
                bf16x8 vf[2];
#pragma unroll
                for (int dvb = 0; dvb < 2; ++dvb) vf[dvb] = *(const LAS bf16x8*)(vpC + (16 * dvb * 144 + 64 * ks));
#pragma unroll
                for (int tb = 0; tb < 4; ++tb) {
                    if (ks == 0 || tb >= 2) {
                        const bf16x8 pb = *(const LAS bf16x8*)(ppC + (16 * tb * 144 + 64 * ks));
#pragma unroll
                        for (int dvb = 0; dvb < 2; ++dvb) num[dvb][tb] = mfma16(vf[dvb], pb, num[dvb][tb]);
                    }
                }
                __builtin_amdgcn_sched_barrier(0);
            }
#pragma unroll
            for (int tb = 0; tb < 4; ++tb) {
                const int t = 16 * tb + r;
                const float den = F[F_SWI + lc * 64 + t] * F[F_QN + t] + F[F_RS + t] + F[F_RS + 64 + t];
                const float inv = 1.0f / fmaxf(fabsf(den), F[F_SEM + lc * 64 + t]);
                float s1 = 0.f, s2 = 0.f;
#pragma unroll
                for (int dvb = 0; dvb < 2; ++dvb) { num[dvb][tb] *= inv;
#pragma unroll
                    for (int j = 0; j < 4; ++j) { const float v = num[dvb][tb][j]; s1 += v; s2 += v * v; } }
                s1 += __shfl_xor(s1, 16); s1 += __shfl_xor(s1, 32); s2 += __shfl_xor(s2, 16); s2 += __shfl_xor(s2, 32);
                if (g == 0) { F[F_HS + (w * 64 + t) * 2] = s1; F[F_HS + (w * 64 + t) * 2 + 1] = s2; }
                __builtin_amdgcn_sched_barrier(0);
            }
            mlstm_update(lds, C, lc, w, r, g);
            __builtin_amdgcn_sched_barrier(0);
            __syncthreads();
#pragma unroll
            for (int tb = 0; tb < 4; ++tb) {
                const int t = 16 * tb + r;
                float s1 = 0.f, s2 = 0.f;
#pragma unroll
                for (int ww = 0; ww < 8; ++ww) { s1 += F[F_HS + (ww * 64 + t) * 2]; s2 += F[F_HS + (ww * 64 + t) * 2 + 1]; }
                const float mean = s1 * (1.0f / 256.0f), var = fmaxf(s2 * (1.0f / 256.0f) - mean * mean, 0.f), rstd = rsqrtf(var + LN_EPS);
                const size_t tok = (size_t)b * SEQ + c * 64 + t;
#pragma unroll
                for (int dvb = 0; dvb < 2; ++dvb) {
                    const int dv0 = 32 * w + 16 * dvb + 4 * g;
                    const f32x4 gn = *(const f32x4*)(P.mh_g + h * 256 + dv0);
                    const u32x2 og = *(const u32x2*)(OA + tok * DM + h * 256 + dv0);
                    const float y0 = (num[dvb][tb][0] - mean) * rstd * gn[0] * bf_lo(og.x), y1 = (num[dvb][tb][1] - mean) * rstd * gn[1] * bf_hi(og.x);
                    const float y2 = (num[dvb][tb][2] - mean) * rstd * gn[2] * bf_lo(og.y), y3 = (num[dvb][tb][3] - mean) * rstd * gn[3] * bf_hi(og.y);
                    u32x2 wv; wv.x = cvt_pk_bf16(y0, y1); wv.y = cvt_pk_bf16(y2, y3);
                    *(u32x2*)(VA + tok * DM + h * 256 + dv0) = wv;
                }
            }
        }
        __syncthreads();
    }
}

constexpr int A_KI = 0, A_VT = 17408, A_FL = 35840;
constexpr float SB_DONE_LOG2 = -40.0f;

__device__ void attn_phase(const Params& P, LAS unsigned char* lds) {
    const int tid = threadIdx.x, w = tid >> 6, lane = tid & 63, r = lane & 15, g = lane >> 4;
    bf16_t* QB = (bf16_t*)(P.ws + WS_QB);
    const bf16_t* KB = (const bf16_t*)(P.ws + WS_KB);
    const bf16_t* VB = (const bf16_t*)(P.ws + WS_VB);
    unsigned* cnt = (unsigned*)(P.ws + MISC_CNT);
    LAS int* FL = (LAS int*)(lds + A_FL);
    for (;;) {
        if (tid == 0) FL[32] = (int)atomicAdd(cnt, 1u);
        __syncthreads();
        const int item = FL[32];
        __syncthreads();
        if (item >= 4096) break;
        const int qb = 63 - (item >> 6), b = (item >> 3) & 7, h = item & 7;
        const int q0w = qb * 128 + 16 * w;
        const size_t qtok = (size_t)b * SEQ + q0w + r;
        bf16x8 qf[4];
#pragma unroll
        for (int kd = 0; kd < 4; ++kd) qf[kd] = *(const bf16x8*)(QB + qtok * DM + h * 128 + 32 * kd + 8 * g);
        f32x4 O[8];
#pragma unroll
        for (int i = 0; i < 8; ++i) O[i] = (f32x4){0.f, 0.f, 0.f, 0.f};
        float R = 0.f;
        int wdone = 0, it = 0;
        u32x4 pre[4];
        const int ptg = tid & 15, pcg = (tid >> 4) & 15, prow = (tid - 256) >> 2, pch = tid & 3;
        auto issue_tile = [&](int kt_) {
            if (tid < 256) {
#pragma unroll
                for (int tt = 0; tt < 4; ++tt) pre[tt] = *(const u32x4*)(VB + ((size_t)b * SEQ + kt_ * 64 + 4 * ptg + tt) * DM + h * 128 + 8 * pcg);
            } else {
                const bf16_t* src_ = KB + ((size_t)b * SEQ + kt_ * 64 + prow) * DM + h * 128 + 32 * pch;
#pragma unroll
                for (int i = 0; i < 4; ++i) pre[i] = *(const u32x4*)(src_ + 8 * i);
            }
        };
        issue_tile(2 * qb + 1);
        for (int kt = 2 * qb + 1; kt >= 0; --kt, ++it) {
            if (tid < 256) {
#pragma unroll
                for (int e = 0; e < 8; ++e) {
                    unsigned short x0, x1, x2, x3;
                    { const unsigned a0 = pre[0][e >> 1], a1 = pre[1][e >> 1], a2 = pre[2][e >> 1], a3 = pre[3][e >> 1];
                      if (e & 1) { x0 = a0 >> 16; x1 = a1 >> 16; x2 = a2 >> 16; x3 = a3 >> 16; } else { x0 = a0 & 0xffff; x1 = a1 & 0xffff; x2 = a2 & 0xffff; x3 = a3 & 0xffff; } }
                    u32x2 wv; wv.x = (unsigned)x0 | ((unsigned)x1 << 16); wv.y = (unsigned)x2 | ((unsigned)x3 << 16);
                    *(LAS u32x2*)(lds + A_VT + (8 * pcg + e) * 144 + 8 * ptg) = wv;
                }
            } else {
#pragma unroll
                for (int i = 0; i < 4; ++i) *(LAS u32x4*)(lds + A_KI + prow * 272 + 64 * pch + 16 * i) = pre[i];
            }
            __syncthreads();
            if (kt > 0) issue_tile(kt - 1);
            const int key0 = kt * 64;
            if (!wdone && key0 <= q0w + 14) {
                const int qpos = q0w + r;
                float wgt[4][4];
                float Rrun = R;
#pragma unroll
                for (int sb = 3; sb >= 0; --sb) {
                    f32x4 acc = (f32x4){0.f, 0.f, 0.f, 0.f};
#pragma unroll
                    for (int kd = 0; kd < 4; ++kd) { const bf16x8 kf = *(const LAS bf16x8*)(lds + A_KI + (16 * sb + r) * 272 + 64 * kd + 16 * g); acc = mfma16(kf, qf[kd], acc); }
                    float lk[4], z[4];
#pragma unroll
                    for (int j = 0; j < 4; ++j) {
                        const int key = key0 + 16 * sb + 4 * g + j;
                        z[j] = fminf(acc[j], 80.0f);
                        lk[j] = (key < qpos) ? -fast_log2(1.0f + fast_exp2(z[j])) : 0.f;
                    }
                    const float s3 = lk[3], s2 = s3 + lk[2], s1 = s2 + lk[1], s0 = s1 + lk[0];
                    const float t1 = __shfl_xor(s0, 16), t2 = __shfl_xor(s0, 32), t3 = __shfl_xor(t1, 32);
                    const float above = g == 0 ? (t1 + t2 + t3) : (g == 1 ? (t2 + t3) : (g == 2 ? t1 : 0.f));
                    const float base = Rrun + above;
                    const float sj[4] = {s0, s1, s2, s3};
#pragma unroll
                    for (int j = 0; j < 4; ++j) { const int key = key0 + 16 * sb + 4 * g + j; wgt[sb][j] = (key < qpos) ? fast_exp2(z[j] + base + sj[j]) : 0.f; }
                    Rrun += (s0 + t1) + (t2 + t3);
                }
                R = Rrun;
#pragma unroll
                for (int ks = 0; ks < 2; ++ks) {
                    u32x2 lo, hi; lo.x = cvt_pk_bf16(wgt[2 * ks][0], wgt[2 * ks][1]); lo.y = cvt_pk_bf16(wgt[2 * ks][2], wgt[2 * ks][3]);
                    hi.x = cvt_pk_bf16(wgt[2 * ks + 1][0], wgt[2 * ks + 1][1]); hi.y = cvt_pk_bf16(wgt[2 * ks + 1][2], wgt[2 * ks + 1][3]);
                    const bf16x8 pf = mk8(lo, hi);
#pragma unroll
                    for (int db = 0; db < 8; ++db) {
                        const u32x2 v0 = *(const LAS u32x2*)(lds + A_VT + (16 * db + r) * 144 + 64 * ks + 8 * g), v1 = *(const LAS u32x2*)(lds + A_VT + (16 * db + r) * 144 + 64 * ks + 32 + 8 * g);
                        O[db] = mfma16(mk8(v0, v1), pf, O[db]);
                    }
                }
                wdone = __all(R < SB_DONE_LOG2) ? 1 : 0;
            }
            if (lane == 0) FL[(it & 1) * 8 + w] = wdone;
            __syncthreads();
            int alld = 1;
#pragma unroll
            for (int i = 0; i < 8; ++i) alld &= FL[(it & 1) * 8 + i];
            if (alld) break;
        }
#pragma unroll
        for (int db = 0; db < 8; ++db) { u32x2 wv; wv.x = cvt_pk_bf16(O[db][0], O[db][1]); wv.y = cvt_pk_bf16(O[db][2], O[db][3]);
            *(u32x2*)(QB + qtok * DM + h * 128 + 16 * db + 4 * g) = wv; }
        __syncthreads();
    }
}


#ifdef DIAG
__device__ void diag_count_f32(const float* p, size_t n, float thr, unsigned* ctr) {
    unsigned c = 0;
    for (size_t i = (size_t)blockIdx.x * NTHREADS + threadIdx.x; i < n; i += (size_t)gridDim.x * NTHREADS) { const float v = p[i]; if (!(fabsf(v) <= thr)) ++c; }
    if (c) atomicAdd(ctr, c);
}
__device__ void diag_count_bf16(const bf16_t* p, size_t n, float thr, unsigned* ctr) {
    unsigned c = 0;
    for (size_t i = (size_t)blockIdx.x * NTHREADS + threadIdx.x; i < n; i += (size_t)gridDim.x * NTHREADS) { const float v = __uint_as_float((unsigned)p[i] << 16); if (!(fabsf(v) <= thr)) ++c; }
    if (c) atomicAdd(ctr, c);
}
#endif
constexpr int LDS_BYTES = 135168;
static_assert(MIX_LDS <= LDS_BYTES && 128 * 129 * 4 <= LDS_BYTES && pg8::STAGE_BYTES <= LDS_BYTES, "LDS budget");
constexpr int NPHASE = 17;

template <class Epi>
__device__ __forceinline__ void run_gemm(LAS unsigned char* lds, const bf16_t* A, const bf16_t* Bt, int N, int K, const Epi& E) {
    pg8::Gemm g{A, Bt, MTOK, N, K};
    pg8::StaticOrder S; S.init(MTOK, N, gridDim.x, blockIdx.x);
    pg8::gemm_phase<Epi, pg8::StaticOrder, true, true>(lds, g, S, E);
}

__global__ void __launch_bounds__(NTHREADS, 2) fwd_megakernel(Params P) {
    extern __shared__ __attribute__((aligned(16))) unsigned char smem[];
    LAS unsigned char* lds = (LAS unsigned char*)smem;
    cg::grid_group grid = cg::this_grid();
    unsigned char* ws = P.ws;
    bf16_t* X = (bf16_t*)(ws + WS_X);
    bf16_t* H = (bf16_t*)(ws + WS_H);
    float* Y = P.out;
    bf16_t* gates = (bf16_t*)P.out;
#ifdef ONLYMASK
#define PHASE(k) if (((ONLYMASK >> (k)) & 1) && P.ph_lo <= (k) && (k) < P.ph_hi)
#else
#define PHASE(k) if (P.ph_lo <= (k) && (k) < P.ph_hi)
#endif
#define SYNC() do { if (P.coop) { asm volatile("s_waitcnt vmcnt(0) lgkmcnt(0)" ::: "memory"); grid.sync(); \
        if (threadIdx.x < 64) { __builtin_amdgcn_fence(__ATOMIC_ACQUIRE, "agent"); asm volatile("s_waitcnt vmcnt(0)" ::: "memory"); } __syncthreads(); } } while (0)
    PHASE(0) prep_phase(P, lds);
    SYNC();
    PHASE(1) run_gemm(lds, X, (const bf16_t*)(ws + W_GU1), 5632, 1024, EpiSwiglu{H});
    SYNC();
    PHASE(2) run_gemm(lds, H, (const bf16_t*)(ws + W_D1), 1024, FH, EpiResid<false, false, true>{P.x, nullptr, Y, 0.5f});
    SYNC();
    PHASE(3) ln_phase<true, true>(Y, P.ln_g, P.ln_b, X);
    SYNC();
    PHASE(4) run_gemm(lds, X, (const bf16_t*)(ws + W_IN), NIN_PAD, 1024, EpiWin{(bf16_t*)(ws + WS_QK), gates, (float*)(ws + MISC_IF), (const float*)(ws + W_BIAS)});
    SYNC();
    PHASE(5) mlstm_phase1(P, lds);
    SYNC();
    PHASE(6) {
#ifndef NO_ML2
        mlstm_phase2(P, lds);
#endif
#ifndef NO_ATT
        attn_phase(P, lds);
#endif
    }
    SYNC();
    PHASE(7) {
        run_gemm(lds, (const bf16_t*)(ws + WS_VA), (const bf16_t*)(ws + W_A), 1024, 1024, EpiGateMul<false>{gates, 0, nullptr, (bf16_t*)(ws + WS_T)});
        run_gemm(lds, (const bf16_t*)(ws + WS_QB), (const bf16_t*)(ws + W_B), 1024, 1024, EpiGateMul<true>{gates, DM, (const bf16_t*)(ws + WS_T), (bf16_t*)(ws + WS_MG)});
    }
    SYNC();
    PHASE(8) run_gemm(lds, (const bf16_t*)(ws + WS_MG), (const bf16_t*)(ws + W_O), 1024, 1024, EpiResid<true, false, true>{X, nullptr, Y, 1.0f});
    SYNC();
    PHASE(9) ln_phase<true, true>(Y, P.ln_g + DM, P.ln_b + DM, X);
    SYNC();
    PHASE(10) run_gemm(lds, X, (const bf16_t*)(ws + W_GU2), 5632, 1024, EpiSwiglu{H});
    SYNC();
    PHASE(11) run_gemm(lds, H, (const bf16_t*)(ws + W_D2), 1024, FH, EpiResid<true, false, true>{X, nullptr, Y, 0.5f});
    SYNC();
    PHASE(12) { ln_phase<true, true>(Y, P.ln_g + 2 * DM, P.ln_b + 2 * DM, X); cvt_bf16_phase(P.p, (bf16_t*)(ws + WS_PB), (size_t)MTOK * 256 / 8); }
    SYNC();
    PHASE(13) {
        run_gemm(lds, X, (const bf16_t*)(ws + W_PG), 1024, 1024, EpiSigBias{P.b_pg, (bf16_t*)(ws + WS_PG)});
        run_gemm(lds, (const bf16_t*)(ws + WS_PB), (const bf16_t*)(ws + W_P), 1024, 256, EpiResid<true, true>{X, (const bf16_t*)(ws + WS_PG), Y, 1.0f});
    }
    SYNC();
    PHASE(14) ln_phase<false>(Y, P.ln_g + 3 * DM, P.ln_b + 3 * DM, P.out);
#undef PHASE
#undef SYNC
}

extern "C" void kernel_launch(void* const* d_in, const int* in_sizes, int n_in, void* d_out, int out_size, void* d_ws, size_t ws_size, hipStream_t stream) {
    static int grid_blocks = 0;
    if (grid_blocks == 0) {
        if (n_in != 19 || out_size != MTOK * DM || ws_size < WS_END) { fprintf(stderr, "kernel_launch: unexpected shapes (n_in %d, out %d, ws %zu, need %zu)\n", n_in, out_size, ws_size, (size_t)WS_END); grid_blocks = -1; return; }
        int dev = 0, cus = 0, per_cu = 0;
        hipGetDevice(&dev);
        hipDeviceGetAttribute(&cus, hipDeviceAttributeMultiprocessorCount, dev);
        if (hipFuncSetAttribute((const void*)fwd_megakernel, hipFuncAttributeMaxDynamicSharedMemorySize, LDS_BYTES) != hipSuccess) { fprintf(stderr, "kernel_launch: hipFuncSetAttribute failed\n"); grid_blocks = -1; return; }
        if (hipOccupancyMaxActiveBlocksPerMultiprocessor(&per_cu, (const void*)fwd_megakernel, NTHREADS, LDS_BYTES) != hipSuccess || per_cu < 1) { fprintf(stderr, "kernel_launch: occupancy query failed (%d)\n", per_cu); per_cu = 1; (void)hipGetLastError(); }
        grid_blocks = cus * per_cu;
    }
    if (grid_blocks < 0) return;
    Params p{};
    p.x = (const float*)d_in[0]; p.p = (const float*)d_in[1]; p.ln_g = (const float*)d_in[2]; p.ln_b = (const float*)d_in[3];
    p.wg = (const float*)d_in[4]; p.wu = (const float*)d_in[5]; p.wd = (const float*)d_in[6]; p.w_in = (const float*)d_in[7]; p.b_in = (const float*)d_in[8];
    p.b_forget = (const float*)d_in[9]; p.conv_w = (const float*)d_in[10]; p.conv_b = (const float*)d_in[11]; p.mh_g = (const float*)d_in[12];
    p.w_a = (const float*)d_in[13]; p.w_b = (const float*)d_in[14]; p.w_o = (const float*)d_in[15]; p.w_ple = (const float*)d_in[16]; p.w_pg = (const float*)d_in[17]; p.b_pg = (const float*)d_in[18];
    p.out = (float*)d_out; p.ws = (unsigned char*)d_ws; p.pad = 0;
#if ONE_LAUNCH
    p.ph_lo = 0; p.ph_hi = NPHASE; p.coop = 1;
    void* args[] = {&p};
    hipError_t e = hipLaunchCooperativeKernel((const void*)fwd_megakernel, dim3(grid_blocks), dim3(NTHREADS), args, LDS_BYTES, stream);
    if (e != hipSuccess) fprintf(stderr, "cooperative launch failed: %s (grid %d)\n", hipGetErrorString(e), grid_blocks);
#else
    p.coop = 0;
    for (int ph = 0; ph < 15; ++ph) { p.ph_lo = ph; p.ph_hi = ph + 1; hipLaunchKernelGGL(fwd_megakernel, dim3(grid_blocks), dim3(NTHREADS), LDS_BYTES, stream, p); }
#endif
}
```

```cpp
#include <hip/hip_runtime.h>
#include <hip/hip_cooperative_groups.h>
#include <cstdio>
namespace cg = cooperative_groups;

#ifndef ONE_LAUNCH
#define ONE_LAUNCH 1
#endif

#define LAS __attribute__((address_space(3)))
typedef unsigned short bf16_t;
typedef short bf16x8 __attribute__((ext_vector_type(8)));
typedef float f32x4 __attribute__((ext_vector_type(4)));
typedef float f32x2 __attribute__((ext_vector_type(2)));
typedef unsigned u32x4 __attribute__((ext_vector_type(4)));
typedef unsigned u32x2 __attribute__((ext_vector_type(2)));

constexpr int MTOK = 65536, DM = 1024, FH = 2816, SEQ = 8192;
constexpr int NIN_PAD = 8448;
constexpr float ALPHA = 1.189207115002721f;
constexpr float LN_EPS = 1e-5f;
constexpr float LOG2E = 1.4426950408889634f;
constexpr int NTHREADS = 512;

constexpr size_t QB_ = 33554432ull;
constexpr size_t WS_W = 0;
constexpr size_t W_GU1 = 0;
constexpr size_t W_D1 = W_GU1 + 5632ull * 1024 * 2;
constexpr size_t W_GU2 = W_D1 + 1024ull * 2816 * 2;
constexpr size_t W_D2 = W_GU2 + 5632ull * 1024 * 2;
constexpr size_t W_IN = W_D2 + 1024ull * 2816 * 2;
constexpr size_t W_A = W_IN + 8448ull * 1024 * 2;
constexpr size_t W_B = W_A + 1024ull * 1024 * 2;
constexpr size_t W_O = W_B + 1024ull * 1024 * 2;
constexpr size_t W_PG = W_O + 1024ull * 1024 * 2;
constexpr size_t W_P = W_PG + 1024ull * 1024 * 2;
constexpr size_t W_BIAS = W_P + 1024ull * 256 * 2;
static_assert(W_BIAS + 8448 * 4 <= 2 * QB_, "weights overflow");
constexpr size_t WS_PB = 2 * QB_;
constexpr size_t WS_MISC = 3 * QB_;
constexpr size_t MISC_IF = WS_MISC;
constexpr size_t MISC_CNT = WS_MISC + 2097152ull;
constexpr size_t WS_X = 4 * QB_;
constexpr size_t WS_H = 8 * QB_;
constexpr size_t WS_QK = 8 * QB_, WS_VA = 12 * QB_, WS_OA = 16 * QB_, WS_QB = 20 * QB_, WS_KB = 24 * QB_, WS_VB = 28 * QB_;
constexpr size_t WS_T = WS_QK, WS_MG = WS_KB, WS_PG = 8 * QB_;
constexpr size_t WS_END = 32 * QB_;
constexpr int STATE_FLOATS = 32768 + 128;

typedef __bf16 bf16x2_t __attribute__((ext_vector_type(2)));
__device__ __forceinline__ unsigned cvt_pk_bf16(float lo, float hi) { f32x2 v = {lo, hi}; bf16x2_t r = __builtin_convertvector(v, bf16x2_t); return __builtin_bit_cast(unsigned, r); }
__device__ __forceinline__ float bf_lo(unsigned u) { return __uint_as_float(u << 16); }
__device__ __forceinline__ float bf_hi(unsigned u) { return __uint_as_float(u & 0xffff0000u); }
__device__ __forceinline__ float fast_exp2(float x) { return __builtin_amdgcn_exp2f(x); }
__device__ __forceinline__ float fast_log2(float x) { return __builtin_amdgcn_logf(x); }
__device__ __forceinline__ float fast_rcp(float x) { return __builtin_amdgcn_rcpf(x); }
__device__ __forceinline__ float sigmoid_f(float x) { return fast_rcp(1.0f + fast_exp2(-x * LOG2E)); }
__device__ __forceinline__ f32x4 mfma16(bf16x8 a, bf16x8 b, f32x4 c) { return __builtin_amdgcn_mfma_f32_16x16x32_bf16(a, b, c, 0, 0, 0); }
__device__ __forceinline__ bf16x8 mk8(u32x2 lo, u32x2 hi) { u32x4 v; v.x = lo.x; v.y = lo.y; v.z = hi.x; v.w = hi.y; return __builtin_bit_cast(bf16x8, v); }
__device__ __forceinline__ float wave_sum(float v) {
#pragma unroll
    for (int o = 32; o > 0; o >>= 1) v += __shfl_xor(v, o);
    return v;
}
__device__ __forceinline__ float wave_max(float v) {
#pragma unroll
    for (int o = 32; o > 0; o >>= 1) v = fmaxf(v, __shfl_xor(v, o));
    return v;
}
__device__ __forceinline__ float wave_incl_sum(float v, int lane) {
#pragma unroll
    for (int o = 1; o < 64; o <<= 1) { float t = __shfl_up(v, o); if (lane >= o) v += t; }
    return v;
}
__device__ __forceinline__ float wave_incl_max(float v, int lane) {
#pragma unroll
    for (int o = 1; o < 64; o <<= 1) { float t = __shfl_up(v, o); if (lane >= o) v = fmaxf(v, t); }
    return v;
}

namespace pg8 {
constexpr int BM = 256, BK = 64, HALF = 128, HTB = HALF * BK * 2, STAGE_BYTES = 8 * HTB, NXCD = 8, WGM = 8;
__host__ __device__ __forceinline__ int lds_byte(int r, int c) { const int st = (r >> 4) * 2 + (c >> 5), rr = r & 15, cc = c & 31, ob = rr * 64 + cc * 2; return st * 1024 + (ob ^ (((ob >> 9) & 1) << 5)); }
__host__ __device__ __forceinline__ void stage_rc(int b, int& R, int& C) { const int st = b / 1024, sb = b % 1024, swz = sb ^ (((sb >> 9) & 1) << 5); R = (st >> 1) * 16 + swz / 64; C = (st & 1) * 32 + (swz % 64) / 2; }
__host__ __device__ __forceinline__ int perm32(int rho) { const int n = rho >> 4, i = rho & 15; return 8 * (i >> 2) + 4 * n + (i & 3); }
struct Unit { int pm, pn; };
struct Gemm { const bf16_t* A; const bf16_t* Bt; int M, N, K; };
struct StaticOrder {
    int nM, nN, nwg, G, c;
    __device__ void init(int M, int N, int G_, int c_) { nM = M / BM; nN = N / BM; nwg = nM * nN; G = G_; c = c_; }
    __device__ bool next(int i, Unit& u) const {
        const long L = (long)i * G + c; if (L >= nwg) return false;
        int wgid = (int)L; { const int q = nwg / NXCD, r = nwg % NXCD, xcd = wgid % NXCD, off = wgid / NXCD; wgid = (xcd < r ? xcd * (q + 1) : r * (q + 1) + (xcd - r) * q) + off; }
        const int nig = WGM * nN, gid = wgid / nig, fm = gid * WGM, gsz = (nM - fm) < WGM ? (nM - fm) : WGM;
        u.pm = fm + ((wgid % nig) % gsz); u.pn = (wgid % nig) / gsz; return true;
    }
};
template <class Epi, class Sched, bool ALIGN_EPI = false, bool SP2 = false>
__device__ __forceinline__ void gemm_phase(LAS unsigned char* lds, const Gemm g, const Sched& S, const Epi& E) {
    const int tid = threadIdx.x, wid = __builtin_amdgcn_readfirstlane(tid >> 6), lane = tid & 63, wr = wid >> 2, wc = wid & 3, fr = lane & 15, fq = lane >> 4;
    const int K = g.K, nt = K / BK;
    unsigned voffA[2], voffB[2];
#pragma unroll
    for (int i = 0; i < 2; ++i) { int R, C; stage_rc(tid * 16 + i * 8192, R, C); const int Rb = ((R & ~31) + perm32(R & 31));
        voffA[i] = (unsigned)(R * K + C) * 2u; voffB[i] = (unsigned)(Rb * K + C) * 2u; }
    const size_t kstep = (size_t)(BK * 2);
    const size_t hstep = (size_t)HALF * K * 2;
    const size_t tstep = 2 * hstep;
    const unsigned ldsw = (unsigned)wid * 1024u;
    const int aoff = lds_byte(wr * 64 + fr, fq * 8), boff = lds_byte(wc * 32 + fr, fq * 8);
#define PG8_SA(b, h) (((b) * 2 + (h)) * HTB)
#define PG8_SB(b, h) ((4 + (b) * 2 + (h)) * HTB)
#define PG8_STAGE(bufoff, gbase, voff) do { _Pragma("unroll") for (int _i = 0; _i < 2; ++_i) \
        __builtin_amdgcn_global_load_lds((const unsigned*)((const char*)(gbase) + (voff)[_i]), (LAS unsigned*)(lds + (bufoff) + ldsw + _i * 8192), 16, 0, 0); } while (0)
#define PG8_LDA(dst, b, h) do { _Pragma("unroll") for (int m = 0; m < 4; ++m) _Pragma("unroll") for (int k = 0; k < 2; ++k) dst[m][k] = *(const LAS bf16x8*)(lds + PG8_SA(b, h) + aoff + m * 2048 + k * 1024); } while (0)
#define PG8_LDB(dst, b, h) do { _Pragma("unroll") for (int n = 0; n < 2; ++n) _Pragma("unroll") for (int k = 0; k < 2; ++k) dst[n][k] = *(const LAS bf16x8*)(lds + PG8_SB(b, h) + boff + n * 2048 + k * 1024); } while (0)
#define PG8_MMA(ai, bj, At, Bt) do { __builtin_amdgcn_s_setprio(1); _Pragma("unroll") for (int m = 0; m < 4; ++m) _Pragma("unroll") for (int n = 0; n < 2; ++n) _Pragma("unroll") for (int k = 0; k < 2; ++k) \
        acc[ai][bj][m][n] = __builtin_amdgcn_mfma_f32_16x16x32_bf16(Bt[n][k], At[m][k], acc[ai][bj][m][n], 0, 0, 0); __builtin_amdgcn_s_setprio(0); } while (0)
#define PG8_WAIT_V(n) asm volatile("s_waitcnt vmcnt(" #n ")" ::: "memory")
#define PG8_WAIT_L(n) asm volatile("s_waitcnt lgkmcnt(" #n ")" ::: "memory")
#define PG8_BAR __builtin_amdgcn_s_barrier()
#define PG8_SCHED __builtin_amdgcn_sched_barrier(0)
    Unit cur, nxt; int ui = 0;
    if (!S.next(0, cur)) return;
    f32x4 acc[2][2][4][2];
#pragma unroll
    for (int a = 0; a < 2; ++a)
#pragma unroll
        for (int b = 0; b < 2; ++b)
#pragma unroll
            for (int m = 0; m < 4; ++m)
#pragma unroll
                for (int n = 0; n < 2; ++n) acc[a][b][m][n] = (f32x4){0.f, 0.f, 0.f, 0.f};
    bf16x8 At[4][2], B0[2][2], B1[2][2];
    const char* cA = (const char*)g.A + (size_t)cur.pm * tstep; const char* cB = (const char*)g.Bt + (size_t)cur.pn * tstep;

    if constexpr (SP2) {
        PG8_STAGE(PG8_SB(0, 0), cB, voffB); PG8_STAGE(PG8_SB(0, 1), cB + hstep, voffB); PG8_STAGE(PG8_SA(0, 0), cA, voffA); PG8_STAGE(PG8_SA(0, 1), cA + hstep, voffA);
        if (wr == 1) PG8_BAR;
        PG8_WAIT_V(2); PG8_BAR;
        PG8_STAGE(PG8_SB(1, 0), cB + kstep, voffB); PG8_STAGE(PG8_SA(1, 0), cA + kstep, voffA); PG8_STAGE(PG8_SB(1, 1), cB + hstep + kstep, voffB);
        PG8_WAIT_V(6); PG8_BAR;
    } else {
        PG8_STAGE(PG8_SB(0, 0), cB, voffB); PG8_STAGE(PG8_SA(0, 0), cA, voffA); PG8_STAGE(PG8_SB(0, 1), cB + hstep, voffB); PG8_STAGE(PG8_SA(0, 1), cA + hstep, voffA);
        if (wr == 1) PG8_BAR;
        PG8_WAIT_V(4); PG8_BAR;
        PG8_STAGE(PG8_SB(1, 0), cB + kstep, voffB); PG8_STAGE(PG8_SA(1, 0), cA + kstep, voffA); PG8_STAGE(PG8_SB(1, 1), cB + hstep + kstep, voffB);
        PG8_WAIT_V(6); PG8_BAR;
    }
    for (;;) {
        const bool has_next = S.next(ui + 1, nxt);
        const char* nA = has_next ? (const char*)g.A + (size_t)nxt.pm * tstep : cA; const char* nB = has_next ? (const char*)g.Bt + (size_t)nxt.pn * tstep : cB;
        for (int t = 0; t < nt; t += 2) {
            const bool last = (t == nt - 2);
            const char* a1 = cA + (size_t)(t + 1) * kstep;
            const char* a2 = last ? nA : cA + (size_t)(t + 2) * kstep; const char* b2 = last ? nB : cB + (size_t)(t + 2) * kstep;
            const char* a3 = a2 + kstep; const char* b3 = b2 + kstep;

            if constexpr (SP2) {
            PG8_LDB(B0, 0, 0); PG8_LDB(B1, 0, 1); PG8_SCHED; PG8_LDA(At, 0, 0); PG8_STAGE(PG8_SA(1, 1), a1 + hstep, voffA);
            PG8_WAIT_V(8); PG8_WAIT_L(0); PG8_BAR; PG8_MMA(0, 0, At, B0); PG8_MMA(0, 1, At, B1); PG8_BAR; PG8_SCHED;
            PG8_LDA(At, 0, 1); PG8_STAGE(PG8_SB(0, 0), b2, voffB); PG8_STAGE(PG8_SB(0, 1), b2 + hstep, voffB); PG8_STAGE(PG8_SA(0, 0), a2, voffA);
            PG8_WAIT_V(8); PG8_WAIT_L(0); PG8_BAR; PG8_MMA(1, 0, At, B0); PG8_MMA(1, 1, At, B1); PG8_BAR; PG8_SCHED;
            PG8_LDB(B0, 1, 0); PG8_LDB(B1, 1, 1); PG8_SCHED; PG8_LDA(At, 1, 0); PG8_STAGE(PG8_SA(0, 1), a2 + hstep, voffA);
            PG8_WAIT_V(8); PG8_WAIT_L(0); PG8_BAR; PG8_MMA(0, 0, At, B0); PG8_MMA(0, 1, At, B1); PG8_BAR; PG8_SCHED;
            PG8_LDA(At, 1, 1); PG8_STAGE(PG8_SB(1, 0), b3, voffB); PG8_STAGE(PG8_SB(1, 1), b3 + hstep, voffB); PG8_STAGE(PG8_SA(1, 0), a3, voffA);
            PG8_WAIT_V(8); PG8_WAIT_L(0); PG8_BAR; PG8_MMA(1, 0, At, B0); PG8_MMA(1, 1, At, B1); PG8_BAR; PG8_SCHED;
            } else {
            PG8_LDB(B0, 0, 0); PG8_SCHED; PG8_LDA(At, 0, 0); PG8_STAGE(PG8_SA(1, 1), a1 + hstep, voffA);
            PG8_WAIT_L(8); PG8_BAR; PG8_WAIT_L(0); PG8_MMA(0, 0, At, B0); PG8_BAR; PG8_SCHED;
            PG8_LDB(B1, 0, 1); PG8_STAGE(PG8_SB(0, 0), b2, voffB);
            PG8_BAR; PG8_WAIT_L(0); PG8_MMA(0, 1, At, B1); PG8_BAR;
            PG8_LDA(At, 0, 1); PG8_STAGE(PG8_SA(0, 0), a2, voffA);
            PG8_BAR; PG8_WAIT_L(0); PG8_MMA(1, 0, At, B0); PG8_BAR; PG8_SCHED;
            PG8_STAGE(PG8_SB(0, 1), b2 + hstep, voffB);
            PG8_WAIT_V(6); PG8_BAR; PG8_MMA(1, 1, At, B1); PG8_BAR;
            PG8_LDB(B0, 1, 0); PG8_SCHED; PG8_LDA(At, 1, 0); PG8_STAGE(PG8_SA(0, 1), a2 + hstep, voffA);
            PG8_WAIT_L(8); PG8_BAR; PG8_WAIT_L(0); PG8_MMA(0, 0, At, B0); PG8_BAR; PG8_SCHED;
            PG8_LDB(B1, 1, 1); PG8_STAGE(PG8_SB(1, 0), b3, voffB);
            PG8_BAR; PG8_WAIT_L(0); PG8_MMA(0, 1, At, B1); PG8_BAR;
            PG8_LDA(At, 1, 1); PG8_STAGE(PG8_SA(1, 0), a3, voffA);
            PG8_BAR; PG8_WAIT_L(0); PG8_MMA(1, 0, At, B0); PG8_BAR; PG8_SCHED;
            PG8_STAGE(PG8_SB(1, 1), b3 + hstep, voffB);
            PG8_WAIT_V(6); PG8_BAR; PG8_MMA(1, 1, At, B1); PG8_BAR;
            }
        }
        if constexpr (ALIGN_EPI) { if (wr == 0) PG8_BAR; }
        E(acc, cur, wr, wc, fr, fq);
        if (!has_next) break;
#pragma unroll
        for (int a = 0; a < 2; ++a)
#pragma unroll
            for (int b = 0; b < 2; ++b)
#pragma unroll
                for (int m = 0; m < 4; ++m)
#pragma unroll
                    for (int n = 0; n < 2; ++n) acc[a][b][m][n] = (f32x4){0.f, 0.f, 0.f, 0.f};
        cur = nxt; cA = nA; cB = nB; ++ui;
        if constexpr (ALIGN_EPI) { if (wr == 1) PG8_BAR; }
    }
    PG8_WAIT_V(0);
    if constexpr (!ALIGN_EPI) { if (wr == 0) PG8_BAR; }
    PG8_BAR;
#undef PG8_SA
#undef PG8_SB
#undef PG8_STAGE
#undef PG8_LDA
#undef PG8_LDB
#undef PG8_MMA
#undef PG8_WAIT_V
#undef PG8_WAIT_L
#undef PG8_BAR
#undef PG8_SCHED
}
}
using pg8::Unit;

#define EPI_ROWS(ai, m) (u.pm * 256 + (ai) * 128 + wr * 64 + (m) * 16 + fr)
struct EpiSwiglu {
    bf16_t* H;
    __device__ __forceinline__ void operator()(const f32x4 (&acc)[2][2][4][2], const Unit& u, int wr, int wc, int fr, int fq) const {
        const int col = u.pn * 128 + wc * 32 + 8 * fq;
#pragma unroll
        for (int ai = 0; ai < 2; ++ai)
#pragma unroll
            for (int m = 0; m < 4; ++m) {
                const size_t row = EPI_ROWS(ai, m);
                float h[8];
#pragma unroll
                for (int n = 0; n < 2; ++n)
#pragma unroll
                    for (int j = 0; j < 4; ++j) { const float g = acc[ai][0][m][n][j], uu = acc[ai][1][m][n][j]; h[4 * n + j] = g * uu * sigmoid_f(g); }
                u32x4 w; w.x = cvt_pk_bf16(h[0], h[1]); w.y = cvt_pk_bf16(h[2], h[3]); w.z = cvt_pk_bf16(h[4], h[5]); w.w = cvt_pk_bf16(h[6], h[7]);
                *(u32x4*)(H + row * FH + col) = w;
            }
    }
};
template <bool RES_BF16, bool HAS_MUL, bool OUT_BF16 = false>
struct EpiResid {
    const void* res; const bf16_t* mul; float* Y; float scale;
    __device__ __forceinline__ void operator()(const f32x4 (&acc)[2][2][4][2], const Unit& u, int wr, int wc, int fr, int fq) const {
#pragma unroll
        for (int ai = 0; ai < 2; ++ai)
#pragma unroll
            for (int m = 0; m < 4; ++m) {
                const size_t row = EPI_ROWS(ai, m);
#pragma unroll
                for (int bj = 0; bj < 2; ++bj) {
                    const size_t off = row * DM + u.pn * 256 + bj * 128 + wc * 32 + 8 * fq;
                    float r[8];
                    if (RES_BF16) { const u32x4 rv = *(const u32x4*)((const bf16_t*)res + off);
                        r[0] = bf_lo(rv.x); r[1] = bf_hi(rv.x); r[2] = bf_lo(rv.y); r[3] = bf_hi(rv.y); r[4] = bf_lo(rv.z); r[5] = bf_hi(rv.z); r[6] = bf_lo(rv.w); r[7] = bf_hi(rv.w); }
                    else { const f32x4 a = *(const f32x4*)((const float*)res + off), b = *(const f32x4*)((const float*)res + off + 4);
                        r[0] = a[0]; r[1] = a[1]; r[2] = a[2]; r[3] = a[3]; r[4] = b[0]; r[5] = b[1]; r[6] = b[2]; r[7] = b[3]; }
                    float mv[8];
                    if (HAS_MUL) { const u32x4 rv = *(const u32x4*)(mul + off);
                        mv[0] = bf_lo(rv.x); mv[1] = bf_hi(rv.x); mv[2] = bf_lo(rv.y); mv[3] = bf_hi(rv.y); mv[4] = bf_lo(rv.z); mv[5] = bf_hi(rv.z); mv[6] = bf_lo(rv.w); mv[7] = bf_hi(rv.w); }
                    f32x4 o0, o1;
#pragma unroll
                    for (int j = 0; j < 4; ++j) {
                        const float a0 = acc[ai][bj][m][0][j] * scale, a1 = acc[ai][bj][m][1][j] * scale;
                        o0[j] = ALPHA * r[j] + (HAS_MUL ? mv[j] * a0 : a0); o1[j] = ALPHA * r[4 + j] + (HAS_MUL ? mv[4 + j] * a1 : a1); }
                    if (OUT_BF16) { u32x4 w; w.x = cvt_pk_bf16(o0[0], o0[1]); w.y = cvt_pk_bf16(o0[2], o0[3]); w.z = cvt_pk_bf16(o1[0], o1[1]); w.w = cvt_pk_bf16(o1[2], o1[3]); *(u32x4*)((bf16_t*)Y + off) = w; }
                    else { *(f32x4*)(Y + off) = o0; *(f32x4*)(Y + off + 4) = o1; }
                }
            }
    }
};
struct EpiWin {
    bf16_t* proj; bf16_t* gates; float* ifg; const float* bias;
    __device__ __forceinline__ void operator()(const f32x4 (&acc)[2][2][4][2], const Unit& u, int wr, int wc, int fr, int fq) const {
        const int pn = u.pn;
        if (pn == 32) {
            if (wc == 0 && fq == 0) {
                const f32x4 bi = *(const f32x4*)(bias + 8192), bf = *(const f32x4*)(bias + 8196);
#pragma unroll
                for (int ai = 0; ai < 2; ++ai)
#pragma unroll
                    for (int m = 0; m < 4; ++m) {
                        const size_t row = EPI_ROWS(ai, m);
                        f32x4 iv = acc[ai][0][m][0] + bi, fv = acc[ai][0][m][1] + bf, lf;
#pragma unroll
                        for (int j = 0; j < 4; ++j) { const float xx = fv[j]; lf[j] = xx >= 0.f ? -log1pf(expf(-xx)) : xx - log1pf(expf(xx)); }
                        *(f32x4*)(ifg + row * 8) = iv; *(f32x4*)(ifg + row * 8 + 4) = lf;
                    }
            }
            return;
        }
        bf16_t* dst; int ld, c0; int act = 0; float sc = 1.0f;
        if (pn < 24) { const int sec = pn >> 2; dst = proj + (size_t)sec * ((size_t)MTOK * DM); ld = DM; c0 = (pn & 3) * 256; if (sec == 2) act = 1; if (sec == 3) sc = 0.08838834764831845f * LOG2E; }
        else { dst = gates; ld = 2 * DM; c0 = (pn - 24) * 256; act = 1; }
#pragma unroll
        for (int bj = 0; bj < 2; ++bj) {
            const int cl = bj * 128 + wc * 32 + 8 * fq;
            const f32x4 b0 = *(const f32x4*)(bias + pn * 256 + cl), b1 = *(const f32x4*)(bias + pn * 256 + cl + 4);
#pragma unroll
            for (int ai = 0; ai < 2; ++ai)
#pragma unroll
                for (int m = 0; m < 4; ++m) {
                    const size_t row = EPI_ROWS(ai, m);
                    f32x4 v0 = acc[ai][bj][m][0] + b0, v1 = acc[ai][bj][m][1] + b1;
                    if (act) {
#pragma unroll
                        for (int j = 0; j < 4; ++j) { v0[j] = sigmoid_f(v0[j]); v1[j] = sigmoid_f(v1[j]); } }
                    else { v0 *= sc; v1 *= sc; }
                    u32x4 w; w.x = cvt_pk_bf16(v0[0], v0[1]); w.y = cvt_pk_bf16(v0[2], v0[3]); w.z = cvt_pk_bf16(v1[0], v1[1]); w.w = cvt_pk_bf16(v1[2], v1[3]);
                    *(u32x4*)(dst + row * ld + c0 + cl) = w;
                }
        }
    }
};
template <bool ADD>
struct EpiGateMul {
    const bf16_t* gate; int goff; const bf16_t* tin; bf16_t* out;
    __device__ __forceinline__ void operator()(const f32x4 (&acc)[2][2][4][2], const Unit& u, int wr, int wc, int fr, int fq) const {
#pragma unroll
        for (int ai = 0; ai < 2; ++ai)
#pragma unroll
            for (int m = 0; m < 4; ++m) {
                const size_t row = EPI_ROWS(ai, m);
#pragma unroll
                for (int bj = 0; bj < 2; ++bj) {
                    const int c = u.pn * 256 + bj * 128 + wc * 32 + 8 * fq;
                    const u32x4 gv = *(const u32x4*)(gate + row * (2 * DM) + goff + c);
                    float gg[8] = {bf_lo(gv.x), bf_hi(gv.x), bf_lo(gv.y), bf_hi(gv.y), bf_lo(gv.z), bf_hi(gv.z), bf_lo(gv.w), bf_hi(gv.w)};
                    float tt[8] = {0.f, 0.f, 0.f, 0.f, 0.f, 0.f, 0.f, 0.f};
                    if (ADD) { const u32x4 tv = *(const u32x4*)(tin + row * DM + c);
                        tt[0] = bf_lo(tv.x); tt[1] = bf_hi(tv.x); tt[2] = bf_lo(tv.y); tt[3] = bf_hi(tv.y); tt[4] = bf_lo(tv.z); tt[5] = bf_hi(tv.z); tt[6] = bf_lo(tv.w); tt[7] = bf_hi(tv.w); }
                    float o[8];
#pragma unroll
                    for (int j = 0; j < 4; ++j) { o[j] = tt[j] + gg[j] * acc[ai][bj][m][0][j]; o[4 + j] = tt[4 + j] + gg[4 + j] * acc[ai][bj][m][1][j]; }
                    u32x4 w; w.x = cvt_pk_bf16(o[0], o[1]); w.y = cvt_pk_bf16(o[2], o[3]); w.z = cvt_pk_bf16(o[4], o[5]); w.w = cvt_pk_bf16(o[6], o[7]);
                    *(u32x4*)(out + row * DM + c) = w;
                }
            }
    }
};
struct EpiSigBias {
    const float* bias; bf16_t* out;
    __device__ __forceinline__ void operator()(const f32x4 (&acc)[2][2][4][2], const Unit& u, int wr, int wc, int fr, int fq) const {
#pragma unroll
        for (int bj = 0; bj < 2; ++bj) {
            const int c = u.pn * 256 + bj * 128 + wc * 32 + 8 * fq;
            const f32x4 b0 = *(const f32x4*)(bias + c), b1 = *(const f32x4*)(bias + c + 4);
#pragma unroll
            for (int ai = 0; ai < 2; ++ai)
#pragma unroll
                for (int m = 0; m < 4; ++m) {
                    const size_t row = EPI_ROWS(ai, m);
                    f32x4 v0 = acc[ai][bj][m][0] + b0, v1 = acc[ai][bj][m][1] + b1;
#pragma unroll
                    for (int j = 0; j < 4; ++j) { v0[j] = sigmoid_f(v0[j]); v1[j] = sigmoid_f(v1[j]); }
                    u32x4 w; w.x = cvt_pk_bf16(v0[0], v0[1]); w.y = cvt_pk_bf16(v0[2], v0[3]); w.z = cvt_pk_bf16(v1[0], v1[1]); w.w = cvt_pk_bf16(v1[2], v1[3]);
                    *(u32x4*)(out + row * DM + c) = w;
                }
        }
    }
};

struct Params {
    const float *x, *p, *ln_g, *ln_b, *wg, *wu, *wd, *w_in, *b_in, *b_forget, *conv_w, *conv_b, *mh_g, *w_a, *w_b, *w_o, *w_ple, *w_pg, *b_pg;
    float* out; unsigned char* ws;
    int ph_lo, ph_hi, coop, pad;
};

__device__ void cvt_bf16_phase(const float* src, bf16_t* dst, size_t n8) {
    const size_t stride = (size_t)gridDim.x * NTHREADS;
    size_t i = (size_t)blockIdx.x * NTHREADS + threadIdx.x;
    for (; i + 3 * stride < n8; i += 4 * stride) {
        f32x4 a[4], b[4];
#pragma unroll
        for (int u = 0; u < 4; ++u) { a[u] = *(const f32x4*)(src + (i + u * stride) * 8); b[u] = *(const f32x4*)(src + (i + u * stride) * 8 + 4); }
#pragma unroll
        for (int u = 0; u < 4; ++u) { u32x4 w; w.x = cvt_pk_bf16(a[u][0], a[u][1]); w.y = cvt_pk_bf16(a[u][2], a[u][3]); w.z = cvt_pk_bf16(b[u][0], b[u][1]); w.w = cvt_pk_bf16(b[u][2], b[u][3]);
            *(u32x4*)(dst + (i + u * stride) * 8) = w; }
    }
    for (; i < n8; i += stride) {
        const f32x4 a = *(const f32x4*)(src + i * 8), b = *(const f32x4*)(src + i * 8 + 4);
        u32x4 w; w.x = cvt_pk_bf16(a[0], a[1]); w.y = cvt_pk_bf16(a[2], a[3]); w.z = cvt_pk_bf16(b[0], b[1]); w.w = cvt_pk_bf16(b[2], b[3]);
        *(u32x4*)(dst + i * 8) = w;
    }
}
template <int MODE>
__device__ __forceinline__ f32x4 tsrc_val4(const float* w0, const float* w1, int ldn, int k, int n) {
    if (MODE == 0) return *(const f32x4*)(w0 + (size_t)k * ldn + n);
    if (MODE == 1) { const int pn = n >> 8, sel = (n >> 7) & 1, i = n & 127; const float* w = sel ? w1 : w0; return *(const f32x4*)(w + (size_t)k * ldn + pn * 128 + i); }
    int col; if (n < 3072) col = n; else if (n < 8192) col = n + 8; else if (n < 8200) col = 3072 + (n - 8192); else return (f32x4){0.f, 0.f, 0.f, 0.f};
    return *(const f32x4*)(w0 + (size_t)k * ldn + col);
}
template <int MODE>
__device__ __forceinline__ void transpose_mat(LAS float* tile, const float* w0, const float* w1, int ldn, bf16_t* dst, int NP, int K, int& base) {
    const int tid = threadIdx.x;
    const int tn = NP / 128, tk = K / 128, nt = tn * tk;
    int first = ((int)blockIdx.x - base) % (int)gridDim.x; if (first < 0) first += gridDim.x;
    for (int t = first; t < nt; t += gridDim.x) {
        const int n0 = (t / tk) * 128, k0 = (t % tk) * 128;
#pragma unroll
        for (int e = 0; e < 8; ++e) { const int idx = e * NTHREADS + tid, kk = idx >> 5, n4 = (idx & 31) * 4; const f32x4 v = tsrc_val4<MODE>(w0, w1, ldn, k0 + kk, n0 + n4);
            tile[kk * 129 + n4] = v[0]; tile[kk * 129 + n4 + 1] = v[1]; tile[kk * 129 + n4 + 2] = v[2]; tile[kk * 129 + n4 + 3] = v[3]; }
        __syncthreads();
#pragma unroll 8
        for (int e = 0; e < 16; ++e) { const int idx = e * NTHREADS + tid, nn = idx >> 6, kk = (idx & 63) * 2;
            *(unsigned*)(dst + (size_t)(n0 + nn) * K + k0 + kk) = cvt_pk_bf16(tile[kk * 129 + nn], tile[(kk + 1) * 129 + nn]); }
        __syncthreads();
    }
    base += nt;
}
__device__ void prep_phase(const Params& P, LAS unsigned char* lds) {
    unsigned char* ws = P.ws;
    cvt_bf16_phase(P.x, (bf16_t*)(ws + WS_X), (size_t)MTOK * DM / 8);
    if (blockIdx.x == 0 && threadIdx.x < 64) ((unsigned*)(ws + MISC_CNT))[threadIdx.x] = 0u;
    for (int n = blockIdx.x * NTHREADS + threadIdx.x; n < NIN_PAD; n += gridDim.x * NTHREADS) {
        float b;
        if (n < 3072) b = P.b_in[n]; else if (n < 8192) b = P.b_in[n + 8]; else if (n < 8196) b = P.b_in[3072 + n - 8192];
        else if (n < 8200) b = P.b_in[3072 + n - 8192] + P.b_forget[n - 8196]; else b = 0.f;
        ((float*)(ws + W_BIAS))[n] = b;
    }
    LAS float* tile = (LAS float*)lds;
    int base = 0;
    transpose_mat<1>(tile, P.wg, P.wu, FH, (bf16_t*)(ws + W_GU1), 5632, 1024, base);
    transpose_mat<0>(tile, P.wd, nullptr, DM, (bf16_t*)(ws + W_D1), 1024, FH, base);
    transpose_mat<1>(tile, P.wg + (size_t)DM * FH, P.wu + (size_t)DM * FH, FH, (bf16_t*)(ws + W_GU2), 5632, 1024, base);
    transpose_mat<0>(tile, P.wd + (size_t)DM * FH, nullptr, DM, (bf16_t*)(ws + W_D2), 1024, FH, base);
    transpose_mat<2>(tile, P.w_in, nullptr, 8200, (bf16_t*)(ws + W_IN), NIN_PAD, 1024, base);
    transpose_mat<0>(tile, P.w_a, nullptr, DM, (bf16_t*)(ws + W_A), 1024, 1024, base);
    transpose_mat<0>(tile, P.w_b, nullptr, DM, (bf16_t*)(ws + W_B), 1024, 1024, base);
    transpose_mat<0>(tile, P.w_o, nullptr, DM, (bf16_t*)(ws + W_O), 1024, 1024, base);
    transpose_mat<0>(tile, P.w_pg, nullptr, DM, (bf16_t*)(ws + W_PG), 1024, 1024, base);
    transpose_mat<0>(tile, P.w_ple, nullptr, DM, (bf16_t*)(ws + W_P), 1024, 256, base);
}
template <bool OUT_BF16, bool IN_BF16 = false>
__device__ void ln_phase(const float* Y, const float* g, const float* b, void* out) {
    const int wid = threadIdx.x >> 6, lane = threadIdx.x & 63;
    f32x4 gv[4], bv[4];
#pragma unroll
    for (int i = 0; i < 4; ++i) { gv[i] = *(const f32x4*)(g + i * 256 + lane * 4); bv[i] = *(const f32x4*)(b + i * 256 + lane * 4); }
    for (int row0 = (blockIdx.x * 8 + wid) * 2; row0 < MTOK; row0 += gridDim.x * 16) {
        f32x4 v[2][4]; float s[2] = {0.f, 0.f};
#pragma unroll
        for (int r = 0; r < 2; ++r)
#pragma unroll
            for (int i = 0; i < 4; ++i) {
                if (IN_BF16) { const u32x2 t = *(const u32x2*)((const bf16_t*)Y + (size_t)(row0 + r) * DM + i * 256 + lane * 4); v[r][i] = (f32x4){bf_lo(t.x), bf_hi(t.x), bf_lo(t.y), bf_hi(t.y)}; }
                else v[r][i] = *(const f32x4*)(Y + (size_t)(row0 + r) * DM + i * 256 + lane * 4); }
#pragma unroll
        for (int r = 0; r < 2; ++r) {
#pragma unroll
            for (int i = 0; i < 4; ++i) s[r] += (v[r][i][0] + v[r][i][1]) + (v[r][i][2] + v[r][i][3]);
            const float mean = wave_sum(s[r]) * (1.0f / DM);
            float q = 0.f;
#pragma unroll
            for (int i = 0; i < 4; ++i) { const f32x4 d = v[r][i] - mean; q += (d[0] * d[0] + d[1] * d[1]) + (d[2] * d[2] + d[3] * d[3]); }
            const float rstd = rsqrtf(wave_sum(q) * (1.0f / DM) + LN_EPS);
#pragma unroll
            for (int i = 0; i < 4; ++i) {
                const f32x4 o = (v[r][i] - mean) * rstd * gv[i] + bv[i];
                if (OUT_BF16) { u32x2 w; w.x = cvt_pk_bf16(o[0], o[1]); w.y = cvt_pk_bf16(o[2], o[3]); *(u32x2*)((bf16_t*)out + (size_t)(row0 + r) * DM + i * 256 + lane * 4) = w; }
                else *(f32x4*)((float*)out + (size_t)(row0 + r) * DM + i * 256 + lane * 4) = o;
            }
        }
    }
}

constexpr int L_QI = 0, L_KI = 17408, L_KT = 34816, L_VT = 53248, L_PI = 90112, L_F = 99328;
constexpr int F_N = 0, F_QN = 128, F_RS = 192, F_HS = 320, F_BL = 1344, F_GM = 1472, F_M = 1600, F_CW = 1732, F_SA = 3012, F_SB2 = 3028, F_SMU = 4052, F_SWI = 5076, F_SWN = 6100, F_SEM = 7124, F_END = 8148;
constexpr int MIX_LDS = L_F + F_END * 4;

__device__ void mlstm_prologue(const Params& P, LAS unsigned char* lds, int b, int h, int gi) {
    LAS float* F = (LAS float*)(lds + L_F);
    const float* ifg = (const float*)(P.ws + MISC_IF);
    const int tid = threadIdx.x, w = tid >> 6, lane = tid & 63;
    const int nch = 16 * (gi + 1);
    for (int c0 = w; c0 < nch; c0 += 32) {
        float ivv[4], lfv[4];
#pragma unroll
        for (int u = 0; u < 4; ++u) { const int c = c0 + 8 * u; if (c < nch) { const size_t tok = (size_t)b * SEQ + c * 64 + lane; ivv[u] = ifg[tok * 8 + h]; lfv[u] = ifg[tok * 8 + 4 + h]; } else { ivv[u] = 0.f; lfv[u] = 0.f; } }
#pragma unroll
        for (int u = 0; u < 4; ++u) { const int c = c0 + 8 * u; if (c < nch) {
            const float bc = wave_incl_sum(lfv[u], lane);
            const float bl = __shfl(bc, 63);
            const float gm = wave_max(bl - bc + ivv[u]);
            if (lane == 0) { F[F_BL + c] = bl; F[F_GM + c] = gm; } } }
    }
    for (int i = tid; i < 1280; i += NTHREADS) {
        const int j = i >> 8, ch = i & 255; const int gc = ch < 128 ? h * 128 + ch : 512 + h * 128 + (ch - 128);
        F[F_CW + i] = j < 4 ? P.conv_w[j * 1024 + gc] : P.conv_b[gc];
    }
    if (tid < 128) F[F_N + tid] = 0.f;
    __syncthreads();
    if (tid == 0) { float m = 0.f; F[F_M] = 0.f; for (int c = 0; c < nch; ++c) { m = fmaxf(F[F_BL + c] + m, F[F_GM + c]); F[F_M + c + 1] = m; } }
    __syncthreads();
    for (int lc = w; lc < 16; lc += 8) {
        const int c = gi * 16 + lc;
        const size_t tok = (size_t)b * SEQ + c * 64 + lane;
        const float iv = ifg[tok * 8 + h], lf = ifg[tok * 8 + 4 + h];
        const float bc = wave_incl_sum(lf, lane);
        const float bl = __shfl(bc, 63);
        const float mst = F[F_M + c], mnew = F[F_M + c + 1];
        const float beta = iv - bc;
        const float mu = fmaxf(mst, wave_incl_max(beta, lane));
        F[F_SB2 + lc * 64 + lane] = beta * LOG2E;
        F[F_SMU + lc * 64 + lane] = mu * LOG2E;
        F[F_SWI + lc * 64 + lane] = expf(mst - mu);
        F[F_SWN + lc * 64 + lane] = expf(bl - bc + iv - mnew);
        F[F_SEM + lc * 64 + lane] = expf(-(bc + mu));
        if (lane == 0) F[F_SA + lc] = expf(bl + mst - mnew);
    }
    __syncthreads();
}

template <bool NEED_Q>
__device__ __forceinline__ void mlstm_load(const Params& P, LAS unsigned char* lds, int b, int h, int c, int lc) {
    LAS float* F = (LAS float*)(lds + L_F);
    const bf16_t* QK = (const bf16_t*)(P.ws + WS_QK);
    const bf16_t* VA = (const bf16_t*)(P.ws + WS_VA);
    const int tid = threadIdx.x, tg = tid & 15, cg = tid >> 4;
    {
        u32x4 vr[4];
#pragma unroll
        for (int tt = 0; tt < 4; ++tt) vr[tt] = *(const u32x4*)(VA + ((size_t)b * SEQ + c * 64 + 4 * tg + tt) * DM + h * 256 + 8 * cg);
#pragma unroll
        for (int e = 0; e < 8; ++e) {
            unsigned short x0, x1, x2, x3;
            { const unsigned a0 = vr[0][e >> 1], a1 = vr[1][e >> 1], a2 = vr[2][e >> 1], a3 = vr[3][e >> 1];
              if (e & 1) { x0 = a0 >> 16; x1 = a1 >> 16; x2 = a2 >> 16; x3 = a3 >> 16; } else { x0 = a0 & 0xffff; x1 = a1 & 0xffff; x2 = a2 & 0xffff; x3 = a3 & 0xffff; } }
            u32x2 wv; wv.x = (unsigned)x0 | ((unsigned)x1 << 16); wv.y = (unsigned)x2 | ((unsigned)x3 << 16);
            *(LAS u32x2*)(lds + L_VT + (8 * cg + e) * 144 + 8 * tg) = wv;
        }
    }
    __builtin_amdgcn_sched_barrier(0);
    if (NEED_Q || cg >= 16) {
        const int gc = cg < 16 ? h * 128 + 8 * cg : 512 + h * 128 + 8 * (cg - 16);
        u32x4 raw[7];
#pragma unroll
        for (int i = 0; i < 7; ++i) {
            const int pos = c * 64 + 4 * tg - 3 + i;
            raw[i] = pos >= 0 ? *(const u32x4*)(QK + ((size_t)b * SEQ + pos) * DM + gc) : (u32x4){0u, 0u, 0u, 0u};
        }
        float o[4][8];
#pragma unroll
        for (int e = 0; e < 8; ++e) {
            float rv[7];
#pragma unroll
            for (int i = 0; i < 7; ++i) rv[i] = (e & 1) ? bf_hi(raw[i][e >> 1]) : bf_lo(raw[i][e >> 1]);
            const float w0 = F[F_CW + 0 * 256 + 8 * cg + e], w1 = F[F_CW + 1 * 256 + 8 * cg + e], w2 = F[F_CW + 2 * 256 + 8 * cg + e], w3 = F[F_CW + 3 * 256 + 8 * cg + e], cb = F[F_CW + 4 * 256 + 8 * cg + e];
#pragma unroll
            for (int tt = 0; tt < 4; ++tt) { const float v = cb + w0 * rv[tt] + w1 * rv[tt + 1] + w2 * rv[tt + 2] + w3 * rv[tt + 3]; o[tt][e] = v * sigmoid_f(v); }
            __builtin_amdgcn_sched_barrier(0);
        }
        if (cg < 16) {
#pragma unroll
            for (int tt = 0; tt < 4; ++tt) { u32x4 wv; wv.x = cvt_pk_bf16(o[tt][0], o[tt][1]); wv.y = cvt_pk_bf16(o[tt][2], o[tt][3]); wv.z = cvt_pk_bf16(o[tt][4], o[tt][5]); wv.w = cvt_pk_bf16(o[tt][6], o[tt][7]);
                *(LAS u32x4*)(lds + L_QI + (4 * tg + tt) * 272 + 16 * cg) = wv; }
        } else {
            const int kc = cg - 16;
            const f32x4 wn = *(const LAS f32x4*)(F + F_SWN + lc * 64 + 4 * tg);
#pragma unroll
            for (int tt = 0; tt < 4; ++tt) {
#pragma unroll
                for (int e = 0; e < 8; ++e) o[tt][e] *= 0.08838834764831845f;
                u32x4 wv; wv.x = cvt_pk_bf16(o[tt][0], o[tt][1]); wv.y = cvt_pk_bf16(o[tt][2], o[tt][3]); wv.z = cvt_pk_bf16(o[tt][4], o[tt][5]); wv.w = cvt_pk_bf16(o[tt][6], o[tt][7]);
                *(LAS u32x4*)(lds + L_KI + (4 * tg + tt) * 272 + 16 * kc) = wv; }
#pragma unroll
            for (int e = 0; e < 8; ++e) { u32x2 wv; wv.x = cvt_pk_bf16(o[0][e] * wn[0], o[1][e] * wn[1]); wv.y = cvt_pk_bf16(o[2][e] * wn[2], o[3][e] * wn[3]);
                *(LAS u32x2*)(lds + L_KT + (8 * kc + e) * 144 + 8 * tg) = wv; }
        }
    }
}

__device__ __forceinline__ void mlstm_update(LAS unsigned char* lds, f32x4 (&C)[2][8], int lc, int w, int r, int g) {
    LAS float* F = (LAS float*)(lds + L_F);
    const float a = F[F_SA + lc];
    const LAS unsigned char* vp = lds + (L_VT + (32 * w + r) * 144 + 16 * g);
    const LAS unsigned char* kp = lds + (L_KT + r * 144 + 16 * g);
#pragma unroll
    for (int dvb = 0; dvb < 2; ++dvb)
#pragma unroll
        for (int dkb = 0; dkb < 8; ++dkb) C[dvb][dkb] *= a;
#pragma unroll
    for (int ks = 0; ks < 2; ++ks) {
        bf16x8 vf[2];
#pragma unroll
        for (int dvb = 0; dvb < 2; ++dvb) vf[dvb] = *(const LAS bf16x8*)(vp + (16 * dvb * 144 + 64 * ks));
#pragma unroll
        for (int dkb = 0; dkb < 8; ++dkb) {
            const bf16x8 kf = *(const LAS bf16x8*)(kp + (16 * dkb * 144 + 64 * ks));
#pragma unroll
            for (int dvb = 0; dvb < 2; ++dvb) C[dvb][dkb] = mfma16(kf, vf[dvb], C[dvb][dkb]);
        }
        __builtin_amdgcn_sched_barrier(0);
    }
    const int tid = threadIdx.x, dk = tid >> 2, part = tid & 3;
    const u32x4 k0 = *(const LAS u32x4*)(lds + L_KT + dk * 144 + 32 * part), k1 = *(const LAS u32x4*)(lds + L_KT + dk * 144 + 32 * part + 16);
    float s = 0.f;
#pragma unroll
    for (int i = 0; i < 4; ++i) s += bf_lo(k0[i]) + bf_hi(k0[i]) + bf_lo(k1[i]) + bf_hi(k1[i]);
    s += __shfl_xor(s, 1); s += __shfl_xor(s, 2);
    if (part == 0) F[F_N + dk] = a * F[F_N + dk] + s;
}

__device__ void mlstm_phase1(const Params& P, LAS unsigned char* lds) {
    const int tid = threadIdx.x, w = tid >> 6, lane = tid & 63, r = lane & 15, g = lane >> 4;
    LAS float* F = (LAS float*)(lds + L_F);
    for (int task = blockIdx.x; task < 256; task += gridDim.x) {
        const int gi = task & 7, st = task >> 3, b = st >> 2, h = st & 3;
        if (gi == 7) continue;
        mlstm_prologue(P, lds, b, h, gi);
        f32x4 C[2][8];
#pragma unroll
        for (int i = 0; i < 2; ++i)
#pragma unroll
            for (int j = 0; j < 8; ++j) C[i][j] = (f32x4){0.f, 0.f, 0.f, 0.f};
        for (int lc = 0; lc < 16; ++lc) {
            mlstm_load<false>(P, lds, b, h, gi * 16 + lc, lc);
            __syncthreads();
            mlstm_update(lds, C, lc, w, r, g);
            __syncthreads();
        }
        float* slot = (float*)(P.ws + WS_PB) + (size_t)(st * 7 + gi) * STATE_FLOATS;
#pragma unroll
        for (int dvb = 0; dvb < 2; ++dvb)
#pragma unroll
            for (int dkb = 0; dkb < 8; ++dkb) *(f32x4*)(slot + (((w * 2 + dvb) * 8 + dkb) * 64 + lane) * 4) = C[dvb][dkb];
        if (tid < 128) slot[32768 + tid] = F[F_N + tid];
        __syncthreads();
    }
}

__device__ void mlstm_phase2(const Params& P, LAS unsigned char* lds) {
    const int tid = threadIdx.x, w = tid >> 6, lane = tid & 63, r = lane & 15, g = lane >> 4;
    LAS float* F = (LAS float*)(lds + L_F);
    const bf16_t* OA = (const bf16_t*)(P.ws + WS_OA);
    bf16_t* VA = (bf16_t*)(P.ws + WS_VA);
    for (int task = blockIdx.x; task < 256; task += gridDim.x) {
        const int gi = task & 7, st = task >> 3, b = st >> 2, h = st & 3;
        mlstm_prologue(P, lds, b, h, gi);
        f32x4 C[2][8];
#pragma unroll
        for (int i = 0; i < 2; ++i)
#pragma unroll
            for (int j = 0; j < 8; ++j) C[i][j] = (f32x4){0.f, 0.f, 0.f, 0.f};
        float nreg = 0.f;
        for (int j = 0; j < gi; ++j) {
            float Bj = 0.f;
            for (int c = 0; c < 16; ++c) Bj += F[F_BL + j * 16 + c];
            const float Aj = expf(Bj + F[F_M + 16 * j] - F[F_M + 16 * j + 16]);
            const float* slot = (const float*)(P.ws + WS_PB) + (size_t)(st * 7 + j) * STATE_FLOATS;
#pragma unroll
            for (int dvb = 0; dvb < 2; ++dvb)
#pragma unroll
                for (int dkb = 0; dkb < 8; ++dkb) C[dvb][dkb] = C[dvb][dkb] * Aj + *(const f32x4*)(slot + (((w * 2 + dvb) * 8 + dkb) * 64 + lane) * 4);
            if (tid < 128) nreg = nreg * Aj + slot[32768 + tid];
        }
        if (tid < 128) F[F_N + tid] = nreg;
        __syncthreads();
        for (int lc = 0; lc < 16; ++lc) {
            const int c = gi * 16 + lc;
            mlstm_load<true>(P, lds, b, h, c, lc);
            __syncthreads();
            {
                const int tb = w >> 1, par = w & 1;
                const LAS unsigned char* qpS = lds + (L_QI + (16 * tb + r) * 272 + 16 * g);
                const LAS unsigned char* kpS = lds + (L_KI + (16 * par + r) * 272 + 16 * g);
                LAS unsigned char* ppS = lds + (L_PI + (16 * tb + r) * 144 + 32 * par + 8 * g);
                bf16x8 qf[4];
#pragma unroll
                for (int kd = 0; kd < 4; ++kd) qf[kd] = *(const LAS bf16x8*)(qpS + 64 * kd);
                const float mu2 = F[F_SMU + lc * 64 + 16 * tb + r];
                float rs = 0.f;
#pragma unroll
                for (int sbi = 0; sbi < 2; ++sbi) {
                    const int sb = par + 2 * sbi;
                    u32x2 pw = (u32x2){0u, 0u};
                    if (sb <= tb) {
                        f32x4 acc = (f32x4){0.f, 0.f, 0.f, 0.f};
#pragma unroll
                        for (int kd = 0; kd < 4; ++kd) { const bf16x8 kf = *(const LAS bf16x8*)(kpS + (32 * sbi * 272 + 64 * kd)); acc = mfma16(kf, qf[kd], acc); }
                        const f32x4 b2 = *(const LAS f32x4*)(F + F_SB2 + lc * 64 + 16 * sb + 4 * g);
                        float pv[4];
#pragma unroll
                        for (int j = 0; j < 4; ++j) { const int s = 16 * sb + 4 * g + j, t = 16 * tb + r; pv[j] = (s <= t) ? acc[j] * fast_exp2(b2[j] - mu2) : 0.f; }
                        pw.x = cvt_pk_bf16(pv[0], pv[1]); pw.y = cvt_pk_bf16(pv[2], pv[3]);
                        rs += bf_lo(pw.x) + bf_hi(pw.x) + bf_lo(pw.y) + bf_hi(pw.y);
                    }
                    *(LAS u32x2*)(ppS + 64 * sbi) = pw;
                }
                rs += __shfl_xor(rs, 16); rs += __shfl_xor(rs, 32);
                if (g == 0) F[F_RS + par * 64 + 16 * tb + r] = rs;
            }
            __builtin_amdgcn_sched_barrier(0);
            const LAS unsigned char* q8p = lds + (L_QI + r * 272 + 8 * g);
            f32x4 num[2][4];
#pragma unroll
            for (int i = 0; i < 2; ++i)
#pragma unroll
                for (int j = 0; j < 4; ++j) num[i][j] = (f32x4){0.f, 0.f, 0.f, 0.f};
#pragma unroll
            for (int kk = 0; kk < 4; ++kk) {
                bf16x8 af[2];
#pragma unroll
                for (int dvb = 0; dvb < 2; ++dvb) {
                    u32x2 lo, hi; lo.x = cvt_pk_bf16(C[dvb][2 * kk][0], C[dvb][2 * kk][1]); lo.y = cvt_pk_bf16(C[dvb][2 * kk][2], C[dvb][2 * kk][3]);
                    hi.x = cvt_pk_bf16(C[dvb][2 * kk + 1][0], C[dvb][2 * kk + 1][1]); hi.y = cvt_pk_bf16(C[dvb][2 * kk + 1][2], C[dvb][2 * kk + 1][3]);
                    af[dvb] = mk8(lo, hi);
                }
#pragma unroll
                for (int tb = 0; tb < 4; ++tb) {
                    const u32x2 q0 = *(const LAS u32x2*)(q8p + (16 * tb * 272 + 64 * kk)), q1 = *(const LAS u32x2*)(q8p + (16 * tb * 272 + 64 * kk + 32));
                    const bf16x8 bq = mk8(q0, q1);
#pragma unroll
                    for (int dvb = 0; dvb < 2; ++dvb) num[dvb][tb] = mfma16(af[dvb], bq, num[dvb][tb]);
                }
                __builtin_amdgcn_sched_barrier(0);
            }
#pragma unroll
            for (int tb = 0; tb < 4; ++tb) { const float wi = F[F_SWI + lc * 64 + 16 * tb + r];
#pragma unroll
                for (int dvb = 0; dvb < 2; ++dvb) num[dvb][tb] *= wi; }
            {
                const int t = tid >> 3, part = tid & 7;
                const u32x4 q0 = *(const LAS u32x4*)(lds + L_QI + t * 272 + 32 * part), q1 = *(const LAS u32x4*)(lds + L_QI + t * 272 + 32 * part + 16);
                float s = 0.f;
#pragma unroll
                for (int i = 0; i < 4; ++i) {
                    s += bf_lo(q0[i]) * F[F_N + 16 * part + 2 * i] + bf_hi(q0[i]) * F[F_N + 16 * part + 2 * i + 1];
                    s += bf_lo(q1[i]) * F[F_N + 16 * part + 8 + 2 * i] + bf_hi(q1[i]) * F[F_N + 16 * part + 8 + 2 * i + 1];
                }
                s += __shfl_xor(s, 1); s += __shfl_xor(s, 2); s += __shfl_xor(s, 4);
                if (part == 0) F[F_QN + t] = s;
            }
            __builtin_amdgcn_sched_barrier(0);
            __syncthreads();
            const LAS unsigned char* vpC = lds + (L_VT + (32 * w + r) * 144 + 16 * g);
            const LAS unsigned char* ppC = lds + (L_PI + r * 144 + 16 * g);
#pragma unroll
            for (int ks = 0; ks < 2; ++ks) {
                bf16x8 vf[2];
#pragma unroll
                for (int dvb = 0; dvb < 2; ++dvb) vf[dvb] = *(const LAS bf16x8*)(vpC + (16 * dvb * 144 + 64 * ks));
#pragma unroll
                for (int tb = 0; tb < 4; ++tb) {
                    if (ks == 0 || tb >= 2) {
                        const bf16x8 pb = *(const LAS bf16x8*)(ppC + (16 * tb * 144 + 64 * ks));
#pragma unroll
                        for (int dvb = 0; dvb < 2; ++dvb) num[dvb][tb] = mfma16(vf[dvb], pb, num[dvb][tb]);
                    }
                }
                __builtin_amdgcn_sched_barrier(0);
            }
#pragma unroll
            for (int tb = 0; tb < 4; ++tb) {
                const int t = 16 * tb + r;
                const float den = F[F_SWI + lc * 64 + t] * F[F_QN + t] + F[F_RS + t] + F[F_RS + 64 + t];
                const float inv = 1.0f / fmaxf(fabsf(den), F[F_SEM + lc * 64 + t]);
                float s1 = 0.f, s2 = 0.f;
#pragma unroll
                for (int dvb = 0; dvb < 2; ++dvb) { num[dvb][tb] *= inv;
#pragma unroll
                    for (int j = 0; j < 4; ++j) { const float v = num[dvb][tb][j]; s1 += v; s2 += v * v; } }
                s1 += __shfl_xor(s1, 16); s1 += __shfl_xor(s1, 32); s2 += __shfl_xor(s2, 16); s2 += __shfl_xor(s2, 32);
                if (g == 0) { F[F_HS + (w * 64 + t) * 2] = s1; F[F_HS + (w * 64 + t) * 2 + 1] = s2; }
                __builtin_amdgcn_sched_barrier(0);
            }
            mlstm_update(lds, C, lc, w, r, g);
            __builtin_amdgcn_sched_barrier(0);
            __syncthreads();
#pragma unroll
            for (int tb = 0; tb < 4; ++tb) {
                const int t = 16 * tb + r;
                float s1 = 0.f, s2 = 0.f;
#pragma unroll
                for (int ww = 0; ww < 8; ++ww) { s1 += F[F_HS + (ww * 64 + t) * 2]; s2 += F[F_HS + (ww * 64 + t) * 2 + 1]; }
                const float mean = s1 * (1.0f / 256.0f), var = fmaxf(s2 * (1.0f / 256.0f) - mean * mean, 0.f), rstd = rsqrtf(var + LN_EPS);
                const size_t tok = (size_t)b * SEQ + c * 64 + t;
#pragma unroll
                for (int dvb = 0; dvb < 2; ++dvb) {
                    const int dv0 = 32 * w + 16 * dvb + 4 * g;
                    const f32x4 gn = *(const f32x4*)(P.mh_g + h * 256 + dv0);
                    const u32x2 og = *(const u32x2*)(OA + tok * DM + h * 256 + dv0);
                    const float y0 = (num[dvb][tb][0] - mean) * rstd * gn[0] * bf_lo(og.x), y1 = (num[dvb][tb][1] - mean) * rstd * gn[1] * bf_hi(og.x);
                    const float y2 = (num[dvb][tb][2] - mean) * rstd * gn[2] * bf_lo(og.y), y3 = (num[dvb][tb][3] - mean) * rstd * gn[3] * bf_hi(og.y);
                    u32x2 wv; wv.x = cvt_pk_bf16(y0, y1); wv.y = cvt_pk_bf16(y2, y3);
                    *(u32x2*)(VA + tok * DM + h * 256 + dv0) = wv;
                }
            }
        }
        __syncthreads();
    }
}

constexpr int A_KI = 0, A_VT = 17408, A_FL = 35840;
constexpr float SB_DONE_LOG2 = -40.0f;

__device__ void attn_phase(const Params& P, LAS unsigned char* lds) {
    const int tid = threadIdx.x, w = tid >> 6, lane = tid & 63, r = lane & 15, g = lane >> 4;
    bf16_t* QB = (bf16_t*)(P.ws + WS_QB);
    const bf16_t* KB = (const bf16_t*)(P.ws + WS_KB);
    const bf16_t* VB = (const bf16_t*)(P.ws + WS_VB);
    unsigned* cnt = (unsigned*)(P.ws + MISC_CNT);
    LAS int* FL = (LAS int*)(lds + A_FL);
    for (;;) {
        if (tid == 0) FL[32] = (int)atomicAdd(cnt, 1u);
        __syncthreads();
        const int item = FL[32];
        __syncthreads();
        if (item >= 4096) break;
        const int qb = 63 - (item >> 6), b = (item >> 3) & 7, h = item & 7;
        const int q0w = qb * 128 + 16 * w;
        const size_t qtok = (size_t)b * SEQ + q0w + r;
        bf16x8 qf[4];
#pragma unroll
        for (int kd = 0; kd < 4; ++kd) qf[kd] = *(const bf16x8*)(QB + qtok * DM + h * 128 + 32 * kd + 8 * g);
        f32x4 O[8];
#pragma unroll
        for (int i = 0; i < 8; ++i) O[i] = (f32x4){0.f, 0.f, 0.f, 0.f};
        float R = 0.f;
        int wdone = 0, it = 0;
        u32x4 pre[4];
        const int ptg = tid & 15, pcg = (tid >> 4) & 15, prow = (tid - 256) >> 2, pch = tid & 3;
        auto issue_tile = [&](int kt_) {
            if (tid < 256) {
#pragma unroll
                for (int tt = 0; tt < 4; ++tt) pre[tt] = *(const u32x4*)(VB + ((size_t)b * SEQ + kt_ * 64 + 4 * ptg + tt) * DM + h * 128 + 8 * pcg);
            } else {
                const bf16_t* src_ = KB + ((size_t)b * SEQ + kt_ * 64 + prow) * DM + h * 128 + 32 * pch;
#pragma unroll
                for (int i = 0; i < 4; ++i) pre[i] = *(const u32x4*)(src_ + 8 * i);
            }
        };
        issue_tile(2 * qb + 1);
        for (int kt = 2 * qb + 1; kt >= 0; --kt, ++it) {
            if (tid < 256) {
#pragma unroll
                for (int e = 0; e < 8; ++e) {
                    unsigned short x0, x1, x2, x3;
                    { const unsigned a0 = pre[0][e >> 1], a1 = pre[1][e >> 1], a2 = pre[2][e >> 1], a3 = pre[3][e >> 1];
                      if (e & 1) { x0 = a0 >> 16; x1 = a1 >> 16; x2 = a2 >> 16; x3 = a3 >> 16; } else { x0 = a0 & 0xffff; x1 = a1 & 0xffff; x2 = a2 & 0xffff; x3 = a3 & 0xffff; } }
                    u32x2 wv; wv.x = (unsigned)x0 | ((unsigned)x1 << 16); wv.y = (unsigned)x2 | ((unsigned)x3 << 16);
                    *(LAS u32x2*)(lds + A_VT + (8 * pcg + e) * 144 + 8 * ptg) = wv;
                }
            } else {
#pragma unroll
                for (int i = 0; i < 4; ++i) *(LAS u32x4*)(lds + A_KI + prow * 272 + 64 * pch + 16 * i) = pre[i];
            }
            __syncthreads();
            if (kt > 0) issue_tile(kt - 1);
            const int key0 = kt * 64;
            if (!wdone && key0 <= q0w + 14) {
                const int qpos = q0w + r;
                float wgt[4][4];
                float Rrun = R;
#pragma unroll
                for (int sb = 3; sb >= 0; --sb) {
                    f32x4 acc = (f32x4){0.f, 0.f, 0.f, 0.f};
#pragma unroll
                    for (int kd = 0; kd < 4; ++kd) { const bf16x8 kf = *(const LAS bf16x8*)(lds + A_KI + (16 * sb + r) * 272 + 64 * kd + 16 * g); acc = mfma16(kf, qf[kd], acc); }
                    float lk[4], z[4];
#pragma unroll
                    for (int j = 0; j < 4; ++j) {
                        const int key = key0 + 16 * sb + 4 * g + j;
                        z[j] = fminf(acc[j], 80.0f);
                        lk[j] = (key < qpos) ? -fast_log2(1.0f + fast_exp2(z[j])) : 0.f;
                    }
                    const float s3 = lk[3], s2 = s3 + lk[2], s1 = s2 + lk[1], s0 = s1 + lk[0];
                    const float t1 = __shfl_xor(s0, 16), t2 = __shfl_xor(s0, 32), t3 = __shfl_xor(t1, 32);
                    const float above = g == 0 ? (t1 + t2 + t3) : (g == 1 ? (t2 + t3) : (g == 2 ? t1 : 0.f));
                    const float base = Rrun + above;
                    const float sj[4] = {s0, s1, s2, s3};
#pragma unroll
                    for (int j = 0; j < 4; ++j) { const int key = key0 + 16 * sb + 4 * g + j; wgt[sb][j] = (key < qpos) ? fast_exp2(z[j] + base + sj[j]) : 0.f; }
                    Rrun += (s0 + t1) + (t2 + t3);
                }
                R = Rrun;
#pragma unroll
                for (int ks = 0; ks < 2; ++ks) {
                    u32x2 lo, hi; lo.x = cvt_pk_bf16(wgt[2 * ks][0], wgt[2 * ks][1]); lo.y = cvt_pk_bf16(wgt[2 * ks][2], wgt[2 * ks][3]);
                    hi.x = cvt_pk_bf16(wgt[2 * ks + 1][0], wgt[2 * ks + 1][1]); hi.y = cvt_pk_bf16(wgt[2 * ks + 1][2], wgt[2 * ks + 1][3]);
                    const bf16x8 pf = mk8(lo, hi);
#pragma unroll
                    for (int db = 0; db < 8; ++db) {
                        const u32x2 v0 = *(const LAS u32x2*)(lds + A_VT + (16 * db + r) * 144 + 64 * ks + 8 * g), v1 = *(const LAS u32x2*)(lds + A_VT + (16 * db + r) * 144 + 64 * ks + 32 + 8 * g);
                        O[db] = mfma16(mk8(v0, v1), pf, O[db]);
                    }
                }
                wdone = __all(R < SB_DONE_LOG2) ? 1 : 0;
            }
            if (lane == 0) FL[(it & 1) * 8 + w] = wdone;
            __syncthreads();
            int alld = 1;
#pragma unroll
            for (int i = 0; i < 8; ++i) alld &= FL[(it & 1) * 8 + i];
            if (alld) break;
        }
#pragma unroll
        for (int db = 0; db < 8; ++db) { u32x2 wv; wv.x = cvt_pk_bf16(O[db][0], O[db][1]); wv.y = cvt_pk_bf16(O[db][2], O[db][3]);
            *(u32x2*)(QB + qtok * DM + h * 128 + 16 * db + 4 * g) = wv; }
        __syncthreads();
    }
}


#ifdef DIAG
__device__ void diag_count_f32(const float* p, size_t n, float thr, unsigned* ctr) {
    unsigned c = 0;
    for (size_t i = (size_t)blockIdx.x * NTHREADS + threadIdx.x; i < n; i += (size_t)gridDim.x * NTHREADS) { const float v = p[i]; if (!(fabsf(v) <= thr)) ++c; }
    if (c) atomicAdd(ctr, c);
}
__device__ void diag_count_bf16(const bf16_t* p, size_t n, float thr, unsigned* ctr) {
    unsigned c = 0;
    for (size_t i = (size_t)blockIdx.x * NTHREADS + threadIdx.x; i < n; i += (size_t)gridDim.x * NTHREADS) { const float v = __uint_as_float((unsigned)p[i] << 16); if (!(fabsf(v) <= thr)) ++c; }
    if (c) atomicAdd(ctr, c);
}
#endif
constexpr int LDS_BYTES = 135168;
static_assert(MIX_LDS <= LDS_BYTES && 128 * 129 * 4 <= LDS_BYTES && pg8::STAGE_BYTES <= LDS_BYTES, "LDS budget");
constexpr int NPHASE = 17;

template <class Epi>
__device__ __forceinline__ void run_gemm(LAS unsigned char* lds, const bf16_t* A, const bf16_t* Bt, int N, int K, const Epi& E) {
    pg8::Gemm g{A, Bt, MTOK, N, K};
    pg8::StaticOrder S; S.init(MTOK, N, gridDim.x, blockIdx.x);
    pg8::gemm_phase<Epi, pg8::StaticOrder, true, true>(lds, g, S, E);
}

__global__ void __launch_bounds__(NTHREADS, 2) fwd_megakernel(Params P) {
    extern __shared__ __attribute__((aligned(16))) unsigned char smem[];
    LAS unsigned char* lds = (LAS unsigned char*)smem;
    cg::grid_group grid = cg::this_grid();
    unsigned char* ws = P.ws;
    bf16_t* X = (bf16_t*)(ws + WS_X);
    bf16_t* H = (bf16_t*)(ws + WS_H);
    float* Y = P.out;
    bf16_t* gates = (bf16_t*)P.out;
#ifdef ONLYMASK
#define PHASE(k) if (((ONLYMASK >> (k)) & 1) && P.ph_lo <= (k) && (k) < P.ph_hi)
#else
#define PHASE(k) if (P.ph_lo <= (k) && (k) < P.ph_hi)
#endif
#define SYNC() do { if (P.coop) { asm volatile("s_waitcnt vmcnt(0) lgkmcnt(0)" ::: "memory"); grid.sync(); \
        if (threadIdx.x < 64) { __builtin_amdgcn_fence(__ATOMIC_ACQUIRE, "agent"); asm volatile("s_waitcnt vmcnt(0)" ::: "memory"); } __syncthreads(); } } while (0)
    PHASE(0) prep_phase(P, lds);
    SYNC();
    PHASE(1) run_gemm(lds, X, (const bf16_t*)(ws + W_GU1), 5632, 1024, EpiSwiglu{H});
    SYNC();
    PHASE(2) run_gemm(lds, H, (const bf16_t*)(ws + W_D1), 1024, FH, EpiResid<false, false, true>{P.x, nullptr, Y, 0.5f});
    SYNC();
    PHASE(3) ln_phase<true, true>(Y, P.ln_g, P.ln_b, X);
    SYNC();
    PHASE(4) run_gemm(lds, X, (const bf16_t*)(ws + W_IN), NIN_PAD, 1024, EpiWin{(bf16_t*)(ws + WS_QK), gates, (float*)(ws + MISC_IF), (const float*)(ws + W_BIAS)});
    SYNC();
    PHASE(5) mlstm_phase1(P, lds);
    SYNC();
    PHASE(6) {
#ifndef NO_ML2
        mlstm_phase2(P, lds);
#endif
#ifndef NO_ATT
        attn_phase(P, lds);
#endif
    }
    SYNC();
    PHASE(7) {
        run_gemm(lds, (const bf16_t*)(ws + WS_VA), (const bf16_t*)(ws + W_A), 1024, 1024, EpiGateMul<false>{gates, 0, nullptr, (bf16_t*)(ws + WS_T)});
        run_gemm(lds, (const bf16_t*)(ws + WS_QB), (const bf16_t*)(ws + W_B), 1024, 1024, EpiGateMul<true>{gates, DM, (const bf16_t*)(ws + WS_T), (bf16_t*)(ws + WS_MG)});
    }
    SYNC();
    PHASE(8) run_gemm(lds, (const bf16_t*)(ws + WS_MG), (const bf16_t*)(ws + W_O), 1024, 1024, EpiResid<true, false, true>{X, nullptr, Y, 1.0f});
    SYNC();
    PHASE(9) ln_phase<true, true>(Y, P.ln_g + DM, P.ln_b + DM, X);
    SYNC();
    PHASE(10) run_gemm(lds, X, (const bf16_t*)(ws + W_GU2), 5632, 1024, EpiSwiglu{H});
    SYNC();
    PHASE(11) run_gemm(lds, H, (const bf16_t*)(ws + W_D2), 1024, FH, EpiResid<true, false, true>{X, nullptr, Y, 0.5f});
    SYNC();
    PHASE(12) { ln_phase<true, true>(Y, P.ln_g + 2 * DM, P.ln_b + 2 * DM, X); cvt_bf16_phase(P.p, (bf16_t*)(ws + WS_PB), (size_t)MTOK * 256 / 8); }
    SYNC();
    PHASE(13) {
        run_gemm(lds, X, (const bf16_t*)(ws + W_PG), 1024, 1024, EpiSigBias{P.b_pg, (bf16_t*)(ws + WS_PG)});
        run_gemm(lds, (const bf16_t*)(ws + WS_PB), (const bf16_t*)(ws + W_P), 1024, 256, EpiResid<true, true, true>{X, (const bf16_t*)(ws + WS_PG), (float*)(ws + WS_VA), 1.0f});
    }
    SYNC();
    PHASE(14) ln_phase<false, true>((const float*)(ws + WS_VA), P.ln_g + 3 * DM, P.ln_b + 3 * DM, P.out);
#undef PHASE
#undef SYNC
}

extern "C" void kernel_launch(void* const* d_in, const int* in_sizes, int n_in, void* d_out, int out_size, void* d_ws, size_t ws_size, hipStream_t stream) {
    static int grid_blocks = 0;
    if (grid_blocks == 0) {
        if (n_in != 19 || out_size != MTOK * DM || ws_size < WS_END) { fprintf(stderr, "kernel_launch: unexpected shapes (n_in %d, out %d, ws %zu, need %zu)\n", n_in, out_size, ws_size, (size_t)WS_END); grid_blocks = -1; return; }
        int dev = 0, cus = 0, per_cu = 0;
        hipGetDevice(&dev);
        hipDeviceGetAttribute(&cus, hipDeviceAttributeMultiprocessorCount, dev);
        if (hipFuncSetAttribute((const void*)fwd_megakernel, hipFuncAttributeMaxDynamicSharedMemorySize, LDS_BYTES) != hipSuccess) { fprintf(stderr, "kernel_launch: hipFuncSetAttribute failed\n"); grid_blocks = -1; return; }
        if (hipOccupancyMaxActiveBlocksPerMultiprocessor(&per_cu, (const void*)fwd_megakernel, NTHREADS, LDS_BYTES) != hipSuccess || per_cu < 1) { fprintf(stderr, "kernel_launch: occupancy query failed (%d)\n", per_cu); per_cu = 1; (void)hipGetLastError(); }
        grid_blocks = cus * per_cu;
    }
    if (grid_blocks < 0) return;
    Params p{};
    p.x = (const float*)d_in[0]; p.p = (const float*)d_in[1]; p.ln_g = (const float*)d_in[2]; p.ln_b = (const float*)d_in[3];
    p.wg = (const float*)d_in[4]; p.wu = (const float*)d_in[5]; p.wd = (const float*)d_in[6]; p.w_in = (const float*)d_in[7]; p.b_in = (const float*)d_in[8];
    p.b_forget = (const float*)d_in[9]; p.conv_w = (const float*)d_in[10]; p.conv_b = (const float*)d_in[11]; p.mh_g = (const float*)d_in[12];
    p.w_a = (const float*)d_in[13]; p.w_b = (const float*)d_in[14]; p.w_o = (const float*)d_in[15]; p.w_ple = (const float*)d_in[16]; p.w_pg = (const float*)d_in[17]; p.b_pg = (const float*)d_in[18];
    p.out = (float*)d_out; p.ws = (unsigned char*)d_ws; p.pad = 0;
#if ONE_LAUNCH
    p.ph_lo = 0; p.ph_hi = NPHASE; p.coop = 1;
    void* args[] = {&p};
    hipError_t e = hipLaunchCooperativeKernel((const void*)fwd_megakernel, dim3(grid_blocks), dim3(NTHREADS), args, LDS_BYTES, stream);
    if (e != hipSuccess) fprintf(stderr, "cooperative launch failed: %s (grid %d)\n", hipGetErrorString(e), grid_blocks);
#else
    p.coop = 0;
    for (int ph = 0; ph < 15; ++ph) { p.ph_lo = ph; p.ph_hi = ph + 1; hipLaunchKernelGGL(fwd_megakernel, dim3(grid_blocks), dim3(NTHREADS), LDS_BYTES, stream, p); }
#endif
}
```

```cpp
#include <hip/hip_runtime.h>
#include <hip/hip_cooperative_groups.h>
#include <cstdio>
namespace cg = cooperative_groups;

#ifndef ONE_LAUNCH
#define ONE_LAUNCH 1
#endif

#define LAS __attribute__((address_space(3)))
typedef unsigned short bf16_t;
typedef short bf16x8 __attribute__((ext_vector_type(8)));
typedef float f32x4 __attribute__((ext_vector_type(4)));
typedef float f32x2 __attribute__((ext_vector_type(2)));
typedef unsigned u32x4 __attribute__((ext_vector_type(4)));
typedef unsigned u32x2 __attribute__((ext_vector_type(2)));

constexpr int MTOK = 65536, DM = 1024, FH = 2816, SEQ = 8192;
constexpr int NIN_PAD = 8448;
constexpr float ALPHA = 1.189207115002721f;
constexpr float LN_EPS = 1e-5f;
constexpr float LOG2E = 1.4426950408889634f;
constexpr int NTHREADS = 512;

constexpr size_t QB_ = 33554432ull;
constexpr size_t WS_W = 0;
constexpr size_t W_GU1 = 0;
constexpr size_t W_D1 = W_GU1 + 5632ull * 1024 * 2;
constexpr size_t W_GU2 = W_D1 + 1024ull * 2816 * 2;
constexpr size_t W_D2 = W_GU2 + 5632ull * 1024 * 2;
constexpr size_t W_IN = W_D2 + 1024ull * 2816 * 2;
constexpr size_t W_A = W_IN + 8448ull * 1024 * 2;
constexpr size_t W_B = W_A + 1024ull * 1024 * 2;
constexpr size_t W_O = W_B + 1024ull * 1024 * 2;
constexpr size_t W_PG = W_O + 1024ull * 1024 * 2;
constexpr size_t W_P = W_PG + 1024ull * 1024 * 2;
constexpr size_t W_BIAS = W_P + 1024ull * 256 * 2;
static_assert(W_BIAS + 8448 * 4 <= 2 * QB_, "weights overflow");
constexpr size_t WS_PB = 2 * QB_;
constexpr size_t WS_MISC = 3 * QB_;
constexpr size_t MISC_IF = WS_MISC;
constexpr size_t MISC_CNT = WS_MISC + 2097152ull;
constexpr size_t MISC_BAR = MISC_CNT + 4096;
constexpr size_t WS_X = 4 * QB_;
constexpr size_t WS_H = 8 * QB_;
constexpr size_t WS_QK = 8 * QB_, WS_VA = 12 * QB_, WS_OA = 16 * QB_, WS_QB = 20 * QB_, WS_KB = 24 * QB_, WS_VB = 28 * QB_;
constexpr size_t WS_T = WS_QK, WS_MG = WS_KB, WS_PG = 8 * QB_;
constexpr size_t WS_END = 32 * QB_;
constexpr int STATE_FLOATS = 32768 + 128;

typedef __bf16 bf16x2_t __attribute__((ext_vector_type(2)));
__device__ __forceinline__ unsigned cvt_pk_bf16(float lo, float hi) { f32x2 v = {lo, hi}; bf16x2_t r = __builtin_convertvector(v, bf16x2_t); return __builtin_bit_cast(unsigned, r); }
__device__ __forceinline__ float bf_lo(unsigned u) { return __uint_as_float(u << 16); }
__device__ __forceinline__ float bf_hi(unsigned u) { return __uint_as_float(u & 0xffff0000u); }
__device__ __forceinline__ float fast_exp2(float x) { return __builtin_amdgcn_exp2f(x); }
__device__ __forceinline__ float fast_log2(float x) { return __builtin_amdgcn_logf(x); }
__device__ __forceinline__ float fast_rcp(float x) { return __builtin_amdgcn_rcpf(x); }
__device__ __forceinline__ float sigmoid_f(float x) { return fast_rcp(1.0f + fast_exp2(-x * LOG2E)); }
__device__ __forceinline__ f32x4 mfma16(bf16x8 a, bf16x8 b, f32x4 c) { return __builtin_amdgcn_mfma_f32_16x16x32_bf16(a, b, c, 0, 0, 0); }
__device__ __forceinline__ bf16x8 mk8(u32x2 lo, u32x2 hi) { u32x4 v; v.x = lo.x; v.y = lo.y; v.z = hi.x; v.w = hi.y; return __builtin_bit_cast(bf16x8, v); }
__device__ __forceinline__ float wave_sum(float v) {
#pragma unroll
    for (int o = 32; o > 0; o >>= 1) v += __shfl_xor(v, o);
    return v;
}
__device__ __forceinline__ float wave_max(float v) {
#pragma unroll
    for (int o = 32; o > 0; o >>= 1) v = fmaxf(v, __shfl_xor(v, o));
    return v;
}
__device__ __forceinline__ float wave_incl_sum(float v, int lane) {
#pragma unroll
    for (int o = 1; o < 64; o <<= 1) { float t = __shfl_up(v, o); if (lane >= o) v += t; }
    return v;
}
__device__ __forceinline__ float wave_incl_max(float v, int lane) {
#pragma unroll
    for (int o = 1; o < 64; o <<= 1) { float t = __shfl_up(v, o); if (lane >= o) v = fmaxf(v, t); }
    return v;
}

namespace pg8 {
constexpr int BM = 256, BK = 64, HALF = 128, HTB = HALF * BK * 2, STAGE_BYTES = 8 * HTB, NXCD = 8, WGM = 8;
__host__ __device__ __forceinline__ int lds_byte(int r, int c) { const int st = (r >> 4) * 2 + (c >> 5), rr = r & 15, cc = c & 31, ob = rr * 64 + cc * 2; return st * 1024 + (ob ^ (((ob >> 9) & 1) << 5)); }
__host__ __device__ __forceinline__ void stage_rc(int b, int& R, int& C) { const int st = b / 1024, sb = b % 1024, swz = sb ^ (((sb >> 9) & 1) << 5); R = (st >> 1) * 16 + swz / 64; C = (st & 1) * 32 + (swz % 64) / 2; }
__host__ __device__ __forceinline__ int perm32(int rho) { const int n = rho >> 4, i = rho & 15; return 8 * (i >> 2) + 4 * n + (i & 3); }
struct Unit { int pm, pn; };
struct Gemm { const bf16_t* A; const bf16_t* Bt; int M, N, K; };
struct StaticOrder {
    int nM, nN, nwg, G, c;
    __device__ void init(int M, int N, int G_, int c_) { nM = M / BM; nN = N / BM; nwg = nM * nN; G = G_; c = c_; }
    __device__ bool next(int i, Unit& u) const {
        const long L = (long)i * G + c; if (L >= nwg) return false;
        int wgid = (int)L; { const int q = nwg / NXCD, r = nwg % NXCD, xcd = wgid % NXCD, off = wgid / NXCD; wgid = (xcd < r ? xcd * (q + 1) : r * (q + 1) + (xcd - r) * q) + off; }
        const int nig = WGM * nN, gid = wgid / nig, fm = gid * WGM, gsz = (nM - fm) < WGM ? (nM - fm) : WGM;
        u.pm = fm + ((wgid % nig) % gsz); u.pn = (wgid % nig) / gsz; return true;
    }
};
template <class Epi, class Sched, bool ALIGN_EPI = false, bool SP2 = false>
__device__ __forceinline__ void gemm_phase(LAS unsigned char* lds, const Gemm g, const Sched& S, const Epi& E) {
    const int tid = threadIdx.x, wid = __builtin_amdgcn_readfirstlane(tid >> 6), lane = tid & 63, wr = wid >> 2, wc = wid & 3, fr = lane & 15, fq = lane >> 4;
    const int K = g.K, nt = K / BK;
    unsigned voffA[2], voffB[2];
#pragma unroll
    for (int i = 0; i < 2; ++i) { int R, C; stage_rc(tid * 16 + i * 8192, R, C); const int Rb = ((R & ~31) + perm32(R & 31));
        voffA[i] = (unsigned)(R * K + C) * 2u; voffB[i] = (unsigned)(Rb * K + C) * 2u; }
    const size_t kstep = (size_t)(BK * 2);
    const size_t hstep = (size_t)HALF * K * 2;
    const size_t tstep = 2 * hstep;
    const unsigned ldsw = (unsigned)wid * 1024u;
    const int aoff = lds_byte(wr * 64 + fr, fq * 8), boff = lds_byte(wc * 32 + fr, fq * 8);
#define PG8_SA(b, h) (((b) * 2 + (h)) * HTB)
#define PG8_SB(b, h) ((4 + (b) * 2 + (h)) * HTB)
#define PG8_STAGE(bufoff, gbase, voff) do { _Pragma("unroll") for (int _i = 0; _i < 2; ++_i) \
        __builtin_amdgcn_global_load_lds((const unsigned*)((const char*)(gbase) + (voff)[_i]), (LAS unsigned*)(lds + (bufoff) + ldsw + _i * 8192), 16, 0, 0); } while (0)
#define PG8_LDA(dst, b, h) do { _Pragma("unroll") for (int m = 0; m < 4; ++m) _Pragma("unroll") for (int k = 0; k < 2; ++k) dst[m][k] = *(const LAS bf16x8*)(lds + PG8_SA(b, h) + aoff + m * 2048 + k * 1024); } while (0)
#define PG8_LDB(dst, b, h) do { _Pragma("unroll") for (int n = 0; n < 2; ++n) _Pragma("unroll") for (int k = 0; k < 2; ++k) dst[n][k] = *(const LAS bf16x8*)(lds + PG8_SB(b, h) + boff + n * 2048 + k * 1024); } while (0)
#define PG8_MMA(ai, bj, At, Bt) do { __builtin_amdgcn_s_setprio(1); _Pragma("unroll") for (int m = 0; m < 4; ++m) _Pragma("unroll") for (int n = 0; n < 2; ++n) _Pragma("unroll") for (int k = 0; k < 2; ++k) \
        acc[ai][bj][m][n] = __builtin_amdgcn_mfma_f32_16x16x32_bf16(Bt[n][k], At[m][k], acc[ai][bj][m][n], 0, 0, 0); __builtin_amdgcn_s_setprio(0); } while (0)
#define PG8_WAIT_V(n) asm volatile("s_waitcnt vmcnt(" #n ")" ::: "memory")
#define PG8_WAIT_L(n) asm volatile("s_waitcnt lgkmcnt(" #n ")" ::: "memory")
#define PG8_BAR __builtin_amdgcn_s_barrier()
#define PG8_SCHED __builtin_amdgcn_sched_barrier(0)
    Unit cur, nxt; int ui = 0;
    if (!S.next(0, cur)) return;
    f32x4 acc[2][2][4][2];
#pragma unroll
    for (int a = 0; a < 2; ++a)
#pragma unroll
        for (int b = 0; b < 2; ++b)
#pragma unroll
            for (int m = 0; m < 4; ++m)
#pragma unroll
                for (int n = 0; n < 2; ++n) acc[a][b][m][n] = (f32x4){0.f, 0.f, 0.f, 0.f};
    bf16x8 At[4][2], B0[2][2], B1[2][2];
    const char* cA = (const char*)g.A + (size_t)cur.pm * tstep; const char* cB = (const char*)g.Bt + (size_t)cur.pn * tstep;

    if constexpr (SP2) {
        PG8_STAGE(PG8_SB(0, 0), cB, voffB); PG8_STAGE(PG8_SB(0, 1), cB + hstep, voffB); PG8_STAGE(PG8_SA(0, 0), cA, voffA); PG8_STAGE(PG8_SA(0, 1), cA + hstep, voffA);
        if (wr == 1) PG8_BAR;
        PG8_WAIT_V(2); PG8_BAR;
        PG8_STAGE(PG8_SB(1, 0), cB + kstep, voffB); PG8_STAGE(PG8_SA(1, 0), cA + kstep, voffA); PG8_STAGE(PG8_SB(1, 1), cB + hstep + kstep, voffB);
        PG8_WAIT_V(6); PG8_BAR;
    } else {
        PG8_STAGE(PG8_SB(0, 0), cB, voffB); PG8_STAGE(PG8_SA(0, 0), cA, voffA); PG8_STAGE(PG8_SB(0, 1), cB + hstep, voffB); PG8_STAGE(PG8_SA(0, 1), cA + hstep, voffA);
        if (wr == 1) PG8_BAR;
        PG8_WAIT_V(4); PG8_BAR;
        PG8_STAGE(PG8_SB(1, 0), cB + kstep, voffB); PG8_STAGE(PG8_SA(1, 0), cA + kstep, voffA); PG8_STAGE(PG8_SB(1, 1), cB + hstep + kstep, voffB);
        PG8_WAIT_V(6); PG8_BAR;
    }
    for (;;) {
        const bool has_next = S.next(ui + 1, nxt);
        const char* nA = has_next ? (const char*)g.A + (size_t)nxt.pm * tstep : cA; const char* nB = has_next ? (const char*)g.Bt + (size_t)nxt.pn * tstep : cB;
        for (int t = 0; t < nt; t += 2) {
            const bool last = (t == nt - 2);
            const char* a1 = cA + (size_t)(t + 1) * kstep;
            const char* a2 = last ? nA : cA + (size_t)(t + 2) * kstep; const char* b2 = last ? nB : cB + (size_t)(t + 2) * kstep;
            const char* a3 = a2 + kstep; const char* b3 = b2 + kstep;

            if constexpr (SP2) {
            PG8_LDB(B0, 0, 0); PG8_LDB(B1, 0, 1); PG8_SCHED; PG8_LDA(At, 0, 0); PG8_STAGE(PG8_SA(1, 1), a1 + hstep, voffA);
            PG8_WAIT_V(8); PG8_WAIT_L(0); PG8_BAR; PG8_MMA(0, 0, At, B0); PG8_MMA(0, 1, At, B1); PG8_BAR; PG8_SCHED;
            PG8_LDA(At, 0, 1); PG8_STAGE(PG8_SB(0, 0), b2, voffB); PG8_STAGE(PG8_SB(0, 1), b2 + hstep, voffB); PG8_STAGE(PG8_SA(0, 0), a2, voffA);
            PG8_WAIT_V(8); PG8_WAIT_L(0); PG8_BAR; PG8_MMA(1, 0, At, B0); PG8_MMA(1, 1, At, B1); PG8_BAR; PG8_SCHED;
            PG8_LDB(B0, 1, 0); PG8_LDB(B1, 1, 1); PG8_SCHED; PG8_LDA(At, 1, 0); PG8_STAGE(PG8_SA(0, 1), a2 + hstep, voffA);
            PG8_WAIT_V(8); PG8_WAIT_L(0); PG8_BAR; PG8_MMA(0, 0, At, B0); PG8_MMA(0, 1, At, B1); PG8_BAR; PG8_SCHED;
            PG8_LDA(At, 1, 1); PG8_STAGE(PG8_SB(1, 0), b3, voffB); PG8_STAGE(PG8_SB(1, 1), b3 + hstep, voffB); PG8_STAGE(PG8_SA(1, 0), a3, voffA);
            PG8_WAIT_V(8); PG8_WAIT_L(0); PG8_BAR; PG8_MMA(1, 0, At, B0); PG8_MMA(1, 1, At, B1); PG8_BAR; PG8_SCHED;
            } else {
            PG8_LDB(B0, 0, 0); PG8_SCHED; PG8_LDA(At, 0, 0); PG8_STAGE(PG8_SA(1, 1), a1 + hstep, voffA);
            PG8_WAIT_L(8); PG8_BAR; PG8_WAIT_L(0); PG8_MMA(0, 0, At, B0); PG8_BAR; PG8_SCHED;
            PG8_LDB(B1, 0, 1); PG8_STAGE(PG8_SB(0, 0), b2, voffB);
            PG8_BAR; PG8_WAIT_L(0); PG8_MMA(0, 1, At, B1); PG8_BAR;
            PG8_LDA(At, 0, 1); PG8_STAGE(PG8_SA(0, 0), a2, voffA);
            PG8_BAR; PG8_WAIT_L(0); PG8_MMA(1, 0, At, B0); PG8_BAR; PG8_SCHED;
            PG8_STAGE(PG8_SB(0, 1), b2 + hstep, voffB);
            PG8_WAIT_V(6); PG8_BAR; PG8_MMA(1, 1, At, B1); PG8_BAR;
            PG8_LDB(B0, 1, 0); PG8_SCHED; PG8_LDA(At, 1, 0); PG8_STAGE(PG8_SA(0, 1), a2 + hstep, voffA);
            PG8_WAIT_L(8); PG8_BAR; PG8_WAIT_L(0); PG8_MMA(0, 0, At, B0); PG8_BAR; PG8_SCHED;
            PG8_LDB(B1, 1, 1); PG8_STAGE(PG8_SB(1, 0), b3, voffB);
            PG8_BAR; PG8_WAIT_L(0); PG8_MMA(0, 1, At, B1); PG8_BAR;
            PG8_LDA(At, 1, 1); PG8_STAGE(PG8_SA(1, 0), a3, voffA);
            PG8_BAR; PG8_WAIT_L(0); PG8_MMA(1, 0, At, B0); PG8_BAR; PG8_SCHED;
            PG8_STAGE(PG8_SB(1, 1), b3 + hstep, voffB);
            PG8_WAIT_V(6); PG8_BAR; PG8_MMA(1, 1, At, B1); PG8_BAR;
            }
        }
        if constexpr (ALIGN_EPI) { if (wr == 0) PG8_BAR; }
        E(acc, cur, wr, wc, fr, fq);
        if (!has_next) break;
#pragma unroll
        for (int a = 0; a < 2; ++a)
#pragma unroll
            for (int b = 0; b < 2; ++b)
#pragma unroll
                for (int m = 0; m < 4; ++m)
#pragma unroll
                    for (int n = 0; n < 2; ++n) acc[a][b][m][n] = (f32x4){0.f, 0.f, 0.f, 0.f};
        cur = nxt; cA = nA; cB = nB; ++ui;
        if constexpr (ALIGN_EPI) { if (wr == 1) PG8_BAR; }
    }
    PG8_WAIT_V(0);
    if constexpr (!ALIGN_EPI) { if (wr == 0) PG8_BAR; }
    PG8_BAR;
#undef PG8_SA
#undef PG8_SB
#undef PG8_STAGE
#undef PG8_LDA
#undef PG8_LDB
#undef PG8_MMA
#undef PG8_WAIT_V
#undef PG8_WAIT_L
#undef PG8_BAR
#undef PG8_SCHED
}
}
using pg8::Unit;

#define EPI_ROWS(ai, m) (u.pm * 256 + (ai) * 128 + wr * 64 + (m) * 16 + fr)
struct EpiSwiglu {
    bf16_t* H;
    __device__ __forceinline__ void operator()(const f32x4 (&acc)[2][2][4][2], const Unit& u, int wr, int wc, int fr, int fq) const {
        const int col = u.pn * 128 + wc * 32 + 8 * fq;
#pragma unroll
        for (int ai = 0; ai < 2; ++ai)
#pragma unroll
            for (int m = 0; m < 4; ++m) {
                const size_t row = EPI_ROWS(ai, m);
                float h[8];
#pragma unroll
                for (int n = 0; n < 2; ++n)
#pragma unroll
                    for (int j = 0; j < 4; ++j) { const float g = acc[ai][0][m][n][j], uu = acc[ai][1][m][n][j]; h[4 * n + j] = g * uu * sigmoid_f(g); }
                u32x4 w; w.x = cvt_pk_bf16(h[0], h[1]); w.y = cvt_pk_bf16(h[2], h[3]); w.z = cvt_pk_bf16(h[4], h[5]); w.w = cvt_pk_bf16(h[6], h[7]);
                *(u32x4*)(H + row * FH + col) = w;
            }
    }
};
template <bool RES_BF16, bool HAS_MUL, bool OUT_BF16 = false>
struct EpiResid {
    const void* res; const bf16_t* mul; float* Y; float scale;
    __device__ __forceinline__ void operator()(const f32x4 (&acc)[2][2][4][2], const Unit& u, int wr, int wc, int fr, int fq) const {
#pragma unroll
        for (int ai = 0; ai < 2; ++ai)
#pragma unroll
            for (int m = 0; m < 4; ++m) {
                const size_t row = EPI_ROWS(ai, m);
#pragma unroll
                for (int bj = 0; bj < 2; ++bj) {
                    const size_t off = row * DM + u.pn * 256 + bj * 128 + wc * 32 + 8 * fq;
                    float r[8];
                    if (RES_BF16) { const u32x4 rv = *(const u32x4*)((const bf16_t*)res + off);
                        r[0] = bf_lo(rv.x); r[1] = bf_hi(rv.x); r[2] = bf_lo(rv.y); r[3] = bf_hi(rv.y); r[4] = bf_lo(rv.z); r[5] = bf_hi(rv.z); r[6] = bf_lo(rv.w); r[7] = bf_hi(rv.w); }
                    else { const f32x4 a = *(const f32x4*)((const float*)res + off), b = *(const f32x4*)((const float*)res + off + 4);
                        r[0] = a[0]; r[1] = a[1]; r[2] = a[2]; r[3] = a[3]; r[4] = b[0]; r[5] = b[1]; r[6] = b[2]; r[7] = b[3]; }
                    float mv[8];
                    if (HAS_MUL) { const u32x4 rv = *(const u32x4*)(mul + off);
                        mv[0] = bf_lo(rv.x); mv[1] = bf_hi(rv.x); mv[2] = bf_lo(rv.y); mv[3] = bf_hi(rv.y); mv[4] = bf_lo(rv.z); mv[5] = bf_hi(rv.z); mv[6] = bf_lo(rv.w); mv[7] = bf_hi(rv.w); }
                    f32x4 o0, o1;
#pragma unroll
                    for (int j = 0; j < 4; ++j) {
                        const float a0 = acc[ai][bj][m][0][j] * scale, a1 = acc[ai][bj][m][1][j] * scale;
                        o0[j] = ALPHA * r[j] + (HAS_MUL ? mv[j] * a0 : a0); o1[j] = ALPHA * r[4 + j] + (HAS_MUL ? mv[4 + j] * a1 : a1); }
                    if (OUT_BF16) { u32x4 w; w.x = cvt_pk_bf16(o0[0], o0[1]); w.y = cvt_pk_bf16(o0[2], o0[3]); w.z = cvt_pk_bf16(o1[0], o1[1]); w.w = cvt_pk_bf16(o1[2], o1[3]); *(u32x4*)((bf16_t*)Y + off) = w; }
                    else { *(f32x4*)(Y + off) = o0; *(f32x4*)(Y + off + 4) = o1; }
                }
            }
    }
};
struct EpiWin {
    bf16_t* proj; bf16_t* gates; float* ifg; const float* bias;
    __device__ __forceinline__ void operator()(const f32x4 (&acc)[2][2][4][2], const Unit& u, int wr, int wc, int fr, int fq) const {
        const int pn = u.pn;
        if (pn == 32) {
            if (wc == 0 && fq == 0) {
                const f32x4 bi = *(const f32x4*)(bias + 8192), bf = *(const f32x4*)(bias + 8196);
#pragma unroll
                for (int ai = 0; ai < 2; ++ai)
#pragma unroll
                    for (int m = 0; m < 4; ++m) {
                        const size_t row = EPI_ROWS(ai, m);
                        f32x4 iv = acc[ai][0][m][0] + bi, fv = acc[ai][0][m][1] + bf, lf;
#pragma unroll
                        for (int j = 0; j < 4; ++j) { const float xx = fv[j]; lf[j] = xx >= 0.f ? -log1pf(expf(-xx)) : xx - log1pf(expf(xx)); }
                        *(f32x4*)(ifg + row * 8) = iv; *(f32x4*)(ifg + row * 8 + 4) = lf;
                    }
            }
            return;
        }
        bf16_t* dst; int ld, c0; int act = 0; float sc = 1.0f;
        if (pn < 24) { const int sec = pn >> 2; dst = proj + (size_t)sec * ((size_t)MTOK * DM); ld = DM; c0 = (pn & 3) * 256; if (sec == 2) act = 1; if (sec == 3) sc = 0.08838834764831845f * LOG2E; }
        else { dst = gates; ld = 2 * DM; c0 = (pn - 24) * 256; act = 1; }
#pragma unroll
        for (int bj = 0; bj < 2; ++bj) {
            const int cl = bj * 128 + wc * 32 + 8 * fq;
            const f32x4 b0 = *(const f32x4*)(bias + pn * 256 + cl), b1 = *(const f32x4*)(bias + pn * 256 + cl + 4);
#pragma unroll
            for (int ai = 0; ai < 2; ++ai)
#pragma unroll
                for (int m = 0; m < 4; ++m) {
                    const size_t row = EPI_ROWS(ai, m);
                    f32x4 v0 = acc[ai][bj][m][0] + b0, v1 = acc[ai][bj][m][1] + b1;
                    if (act) {
#pragma unroll
                        for (int j = 0; j < 4; ++j) { v0[j] = sigmoid_f(v0[j]); v1[j] = sigmoid_f(v1[j]); } }
                    else { v0 *= sc; v1 *= sc; }
                    u32x4 w; w.x = cvt_pk_bf16(v0[0], v0[1]); w.y = cvt_pk_bf16(v0[2], v0[3]); w.z = cvt_pk_bf16(v1[0], v1[1]); w.w = cvt_pk_bf16(v1[2], v1[3]);
                    *(u32x4*)(dst + row * ld + c0 + cl) = w;
                }
        }
    }
};
template <bool ADD>
struct EpiGateMul {
    const bf16_t* gate; int goff; const bf16_t* tin; bf16_t* out;
    __device__ __forceinline__ void operator()(const f32x4 (&acc)[2][2][4][2], const Unit& u, int wr, int wc, int fr, int fq) const {
#pragma unroll
        for (int ai = 0; ai < 2; ++ai)
#pragma unroll
            for (int m = 0; m < 4; ++m) {
                const size_t row = EPI_ROWS(ai, m);
#pragma unroll
                for (int bj = 0; bj < 2; ++bj) {
                    const int c = u.pn * 256 + bj * 128 + wc * 32 + 8 * fq;
                    const u32x4 gv = *(const u32x4*)(gate + row * (2 * DM) + goff + c);
                    float gg[8] = {bf_lo(gv.x), bf_hi(gv.x), bf_lo(gv.y), bf_hi(gv.y), bf_lo(gv.z), bf_hi(gv.z), bf_lo(gv.w), bf_hi(gv.w)};
                    float tt[8] = {0.f, 0.f, 0.f, 0.f, 0.f, 0.f, 0.f, 0.f};
                    if (ADD) { const u32x4 tv = *(const u32x4*)(tin + row * DM + c);
                        tt[0] = bf_lo(tv.x); tt[1] = bf_hi(tv.x); tt[2] = bf_lo(tv.y); tt[3] = bf_hi(tv.y); tt[4] = bf_lo(tv.z); tt[5] = bf_hi(tv.z); tt[6] = bf_lo(tv.w); tt[7] = bf_hi(tv.w); }
                    float o[8];
#pragma unroll
                    for (int j = 0; j < 4; ++j) { o[j] = tt[j] + gg[j] * acc[ai][bj][m][0][j]; o[4 + j] = tt[4 + j] + gg[4 + j] * acc[ai][bj][m][1][j]; }
                    u32x4 w; w.x = cvt_pk_bf16(o[0], o[1]); w.y = cvt_pk_bf16(o[2], o[3]); w.z = cvt_pk_bf16(o[4], o[5]); w.w = cvt_pk_bf16(o[6], o[7]);
                    *(u32x4*)(out + row * DM + c) = w;
                }
            }
    }
};
struct EpiSigBias {
    const float* bias; bf16_t* out;
    __device__ __forceinline__ void operator()(const f32x4 (&acc)[2][2][4][2], const Unit& u, int wr, int wc, int fr, int fq) const {
#pragma unroll
        for (int bj = 0; bj < 2; ++bj) {
            const int c = u.pn * 256 + bj * 128 + wc * 32 + 8 * fq;
            const f32x4 b0 = *(const f32x4*)(bias + c), b1 = *(const f32x4*)(bias + c + 4);
#pragma unroll
            for (int ai = 0; ai < 2; ++ai)
#pragma unroll
                for (int m = 0; m < 4; ++m) {
                    const size_t row = EPI_ROWS(ai, m);
                    f32x4 v0 = acc[ai][bj][m][0] + b0, v1 = acc[ai][bj][m][1] + b1;
#pragma unroll
                    for (int j = 0; j < 4; ++j) { v0[j] = sigmoid_f(v0[j]); v1[j] = sigmoid_f(v1[j]); }
                    u32x4 w; w.x = cvt_pk_bf16(v0[0], v0[1]); w.y = cvt_pk_bf16(v0[2], v0[3]); w.z = cvt_pk_bf16(v1[0], v1[1]); w.w = cvt_pk_bf16(v1[2], v1[3]);
                    *(u32x4*)(out + row * DM + c) = w;
                }
        }
    }
};

struct Params {
    const float *x, *p, *ln_g, *ln_b, *wg, *wu, *wd, *w_in, *b_in, *b_forget, *conv_w, *conv_b, *mh_g, *w_a, *w_b, *w_o, *w_ple, *w_pg, *b_pg;
    float* out; unsigned char* ws;
    int ph_lo, ph_hi, coop, pad;
};

__device__ void cvt_bf16_phase(const float* src, bf16_t* dst, size_t n8) {
    const size_t stride = (size_t)gridDim.x * NTHREADS;
    size_t i = (size_t)blockIdx.x * NTHREADS + threadIdx.x;
    for (; i + 3 * stride < n8; i += 4 * stride) {
        f32x4 a[4], b[4];
#pragma unroll
        for (int u = 0; u < 4; ++u) { a[u] = *(const f32x4*)(src + (i + u * stride) * 8); b[u] = *(const f32x4*)(src + (i + u * stride) * 8 + 4); }
#pragma unroll
        for (int u = 0; u < 4; ++u) { u32x4 w; w.x = cvt_pk_bf16(a[u][0], a[u][1]); w.y = cvt_pk_bf16(a[u][2], a[u][3]); w.z = cvt_pk_bf16(b[u][0], b[u][1]); w.w = cvt_pk_bf16(b[u][2], b[u][3]);
            *(u32x4*)(dst + (i + u * stride) * 8) = w; }
    }
    for (; i < n8; i += stride) {
        const f32x4 a = *(const f32x4*)(src + i * 8), b = *(const f32x4*)(src + i * 8 + 4);
        u32x4 w; w.x = cvt_pk_bf16(a[0], a[1]); w.y = cvt_pk_bf16(a[2], a[3]); w.z = cvt_pk_bf16(b[0], b[1]); w.w = cvt_pk_bf16(b[2], b[3]);
        *(u32x4*)(dst + i * 8) = w;
    }
}
template <int MODE>
__device__ __forceinline__ f32x4 tsrc_val4(const float* w0, const float* w1, int ldn, int k, int n) {
    if (MODE == 0) return *(const f32x4*)(w0 + (size_t)k * ldn + n);
    if (MODE == 1) { const int pn = n >> 8, sel = (n >> 7) & 1, i = n & 127; const float* w = sel ? w1 : w0; return *(const f32x4*)(w + (size_t)k * ldn + pn * 128 + i); }
    int col; if (n < 3072) col = n; else if (n < 8192) col = n + 8; else if (n < 8200) col = 3072 + (n - 8192); else return (f32x4){0.f, 0.f, 0.f, 0.f};
    return *(const f32x4*)(w0 + (size_t)k * ldn + col);
}
template <int MODE>
__device__ __forceinline__ void transpose_mat(LAS float* tile, const float* w0, const float* w1, int ldn, bf16_t* dst, int NP, int K, int& base) {
    const int tid = threadIdx.x;
    const int tn = NP / 128, tk = K / 128, nt = tn * tk;
    int first = ((int)blockIdx.x - base) % (int)gridDim.x; if (first < 0) first += gridDim.x;
    for (int t = first; t < nt; t += gridDim.x) {
        const int n0 = (t / tk) * 128, k0 = (t % tk) * 128;
#pragma unroll
        for (int e = 0; e < 8; ++e) { const int idx = e * NTHREADS + tid, kk = idx >> 5, n4 = (idx & 31) * 4; const f32x4 v = tsrc_val4<MODE>(w0, w1, ldn, k0 + kk, n0 + n4);
            tile[kk * 129 + n4] = v[0]; tile[kk * 129 + n4 + 1] = v[1]; tile[kk * 129 + n4 + 2] = v[2]; tile[kk * 129 + n4 + 3] = v[3]; }
        __syncthreads();
#pragma unroll 8
        for (int e = 0; e < 16; ++e) { const int idx = e * NTHREADS + tid, nn = idx >> 6, kk = (idx & 63) * 2;
            *(unsigned*)(dst + (size_t)(n0 + nn) * K + k0 + kk) = cvt_pk_bf16(tile[kk * 129 + nn], tile[(kk + 1) * 129 + nn]); }
        __syncthreads();
    }
    base += nt;
}
__device__ void prep_phase(const Params& P, LAS unsigned char* lds) {
    unsigned char* ws = P.ws;
    cvt_bf16_phase(P.x, (bf16_t*)(ws + WS_X), (size_t)MTOK * DM / 8);
    if (blockIdx.x == 0 && threadIdx.x < 64) ((unsigned*)(ws + MISC_CNT))[threadIdx.x] = 0u;
    for (int n = blockIdx.x * NTHREADS + threadIdx.x; n < NIN_PAD; n += gridDim.x * NTHREADS) {
        float b;
        if (n < 3072) b = P.b_in[n]; else if (n < 8192) b = P.b_in[n + 8]; else if (n < 8196) b = P.b_in[3072 + n - 8192];
        else if (n < 8200) b = P.b_in[3072 + n - 8192] + P.b_forget[n - 8196]; else b = 0.f;
        ((float*)(ws + W_BIAS))[n] = b;
    }
    LAS float* tile = (LAS float*)lds;
    int base = 0;
    transpose_mat<1>(tile, P.wg, P.wu, FH, (bf16_t*)(ws + W_GU1), 5632, 1024, base);
    transpose_mat<0>(tile, P.wd, nullptr, DM, (bf16_t*)(ws + W_D1), 1024, FH, base);
    transpose_mat<1>(tile, P.wg + (size_t)DM * FH, P.wu + (size_t)DM * FH, FH, (bf16_t*)(ws + W_GU2), 5632, 1024, base);
    transpose_mat<0>(tile, P.wd + (size_t)DM * FH, nullptr, DM, (bf16_t*)(ws + W_D2), 1024, FH, base);
    transpose_mat<2>(tile, P.w_in, nullptr, 8200, (bf16_t*)(ws + W_IN), NIN_PAD, 1024, base);
    transpose_mat<0>(tile, P.w_a, nullptr, DM, (bf16_t*)(ws + W_A), 1024, 1024, base);
    transpose_mat<0>(tile, P.w_b, nullptr, DM, (bf16_t*)(ws + W_B), 1024, 1024, base);
    transpose_mat<0>(tile, P.w_o, nullptr, DM, (bf16_t*)(ws + W_O), 1024, 1024, base);
    transpose_mat<0>(tile, P.w_pg, nullptr, DM, (bf16_t*)(ws + W_PG), 1024, 1024, base);
    transpose_mat<0>(tile, P.w_ple, nullptr, DM, (bf16_t*)(ws + W_P), 1024, 256, base);
}
template <bool OUT_BF16, bool IN_BF16 = false>
__device__ void ln_phase(const float* Y, const float* g, const float* b, void* out) {
    const int wid = threadIdx.x >> 6, lane = threadIdx.x & 63;
    f32x4 gv[4], bv[4];
#pragma unroll
    for (int i = 0; i < 4; ++i) { gv[i] = *(const f32x4*)(g + i * 256 + lane * 4); bv[i] = *(const f32x4*)(b + i * 256 + lane * 4); }
    for (int row0 = (blockIdx.x * 8 + wid) * 2; row0 < MTOK; row0 += gridDim.x * 16) {
        f32x4 v[2][4]; float s[2] = {0.f, 0.f};
#pragma unroll
        for (int r = 0; r < 2; ++r)
#pragma unroll
            for (int i = 0; i < 4; ++i) {
                if (IN_BF16) { const u32x2 t = *(const u32x2*)((const bf16_t*)Y + (size_t)(row0 + r) * DM + i * 256 + lane * 4); v[r][i] = (f32x4){bf_lo(t.x), bf_hi(t.x), bf_lo(t.y), bf_hi(t.y)}; }
                else v[r][i] = *(const f32x4*)(Y + (size_t)(row0 + r) * DM + i * 256 + lane * 4); }
#pragma unroll
        for (int r = 0; r < 2; ++r) {
#pragma unroll
            for (int i = 0; i < 4; ++i) s[r] += (v[r][i][0] + v[r][i][1]) + (v[r][i][2] + v[r][i][3]);
            const float mean = wave_sum(s[r]) * (1.0f / DM);
            float q = 0.f;
#pragma unroll
            for (int i = 0; i < 4; ++i) { const f32x4 d = v[r][i] - mean; q += (d[0] * d[0] + d[1] * d[1]) + (d[2] * d[2] + d[3] * d[3]); }
            const float rstd = rsqrtf(wave_sum(q) * (1.0f / DM) + LN_EPS);
#pragma unroll
            for (int i = 0; i < 4; ++i) {
                const f32x4 o = (v[r][i] - mean) * rstd * gv[i] + bv[i];
                if (OUT_BF16) { u32x2 w; w.x = cvt_pk_bf16(o[0], o[1]); w.y = cvt_pk_bf16(o[2], o[3]); *(u32x2*)((bf16_t*)out + (size_t)(row0 + r) * DM + i * 256 + lane * 4) = w; }
                else *(f32x4*)((float*)out + (size_t)(row0 + r) * DM + i * 256 + lane * 4) = o;
            }
        }
    }
}

constexpr int L_QI = 0, L_KI = 17408, L_KT = 34816, L_VT = 53248, L_PI = 90112, L_F = 99328;
constexpr int F_N = 0, F_QN = 128, F_RS = 192, F_HS = 320, F_BL = 1344, F_GM = 1472, F_M = 1600, F_CW = 1732, F_SA = 3012, F_SB2 = 3028, F_SMU = 4052, F_SWI = 5076, F_SWN = 6100, F_SEM = 7124, F_END = 8148;
constexpr int MIX_LDS = L_F + F_END * 4;

__device__ void mlstm_prologue(const Params& P, LAS unsigned char* lds, int b, int h, int gi) {
    LAS float* F = (LAS float*)(lds + L_F);
    const float* ifg = (const float*)(P.ws + MISC_IF);
    const int tid = threadIdx.x, w = tid >> 6, lane = tid & 63;
    const int nch = 16 * (gi + 1);
    for (int c0 = w; c0 < nch; c0 += 32) {
        float ivv[4], lfv[4];
#pragma unroll
        for (int u = 0; u < 4; ++u) { const int c = c0 + 8 * u; if (c < nch) { const size_t tok = (size_t)b * SEQ + c * 64 + lane; ivv[u] = ifg[tok * 8 + h]; lfv[u] = ifg[tok * 8 + 4 + h]; } else { ivv[u] = 0.f; lfv[u] = 0.f; } }
#pragma unroll
        for (int u = 0; u < 4; ++u) { const int c = c0 + 8 * u; if (c < nch) {
            const float bc = wave_incl_sum(lfv[u], lane);
            const float bl = __shfl(bc, 63);
            const float gm = wave_max(bl - bc + ivv[u]);
            if (lane == 0) { F[F_BL + c] = bl; F[F_GM + c] = gm; } } }
    }
    for (int i = tid; i < 1280; i += NTHREADS) {
        const int j = i >> 8, ch = i & 255; const int gc = ch < 128 ? h * 128 + ch : 512 + h * 128 + (ch - 128);
        F[F_CW + i] = j < 4 ? P.conv_w[j * 1024 + gc] : P.conv_b[gc];
    }
    if (tid < 128) F[F_N + tid] = 0.f;
    __syncthreads();
    if (tid == 0) { float m = 0.f; F[F_M] = 0.f; for (int c = 0; c < nch; ++c) { m = fmaxf(F[F_BL + c] + m, F[F_GM + c]); F[F_M + c + 1] = m; } }
    __syncthreads();
    for (int lc = w; lc < 16; lc += 8) {
        const int c = gi * 16 + lc;
        const size_t tok = (size_t)b * SEQ + c * 64 + lane;
        const float iv = ifg[tok * 8 + h], lf = ifg[tok * 8 + 4 + h];
        const float bc = wave_incl_sum(lf, lane);
        const float bl = __shfl(bc, 63);
        const float mst = F[F_M + c], mnew = F[F_M + c + 1];
        const float beta = iv - bc;
        const float mu = fmaxf(mst, wave_incl_max(beta, lane));
        F[F_SB2 + lc * 64 + lane] = beta * LOG2E;
        F[F_SMU + lc * 64 + lane] = mu * LOG2E;
        F[F_SWI + lc * 64 + lane] = expf(mst - mu);
        F[F_SWN + lc * 64 + lane] = expf(bl - bc + iv - mnew);
        F[F_SEM + lc * 64 + lane] = expf(-(bc + mu));
        if (lane == 0) F[F_SA + lc] = expf(bl + mst - mnew);
    }
    __syncthreads();
}

template <bool NEED_Q>
__device__ __forceinline__ void mlstm_load(const Params& P, LAS unsigned char* lds, int b, int h, int c, int lc) {
    LAS float* F = (LAS float*)(lds + L_F);
    const bf16_t* QK = (const bf16_t*)(P.ws + WS_QK);
    const bf16_t* VA = (const bf16_t*)(P.ws + WS_VA);
    const int tid = threadIdx.x, tg = tid & 15, cg = tid >> 4;
    {
        u32x4 vr[4];
#pragma unroll
        for (int tt = 0; tt < 4; ++tt) vr[tt] = *(const u32x4*)(VA + ((size_t)b * SEQ + c * 64 + 4 * tg + tt) * DM + h * 256 + 8 * cg);
#pragma unroll
        for (int e = 0; e < 8; ++e) {
            unsigned short x0, x1, x2, x3;
            { const unsigned a0 = vr[0][e >> 1], a1 = vr[1][e >> 1], a2 = vr[2][e >> 1], a3 = vr[3][e >> 1];
              if (e & 1) { x0 = a0 >> 16; x1 = a1 >> 16; x2 = a2 >> 16; x3 = a3 >> 16; } else { x0 = a0 & 0xffff; x1 = a1 & 0xffff; x2 = a2 & 0xffff; x3 = a3 & 0xffff; } }
            u32x2 wv; wv.x = (unsigned)x0 | ((unsigned)x1 << 16); wv.y = (unsigned)x2 | ((unsigned)x3 << 16);
            *(LAS u32x2*)(lds + L_VT + (8 * cg + e) * 144 + 8 * tg) = wv;
        }
    }
    __builtin_amdgcn_sched_barrier(0);
    if (NEED_Q || cg >= 16) {
        const int gc = cg < 16 ? h * 128 + 8 * cg : 512 + h * 128 + 8 * (cg - 16);
        u32x4 raw[7];
#pragma unroll
        for (int i = 0; i < 7; ++i) {
            const int pos = c * 64 + 4 * tg - 3 + i;
            raw[i] = pos >= 0 ? *(const u32x4*)(QK + ((size_t)b * SEQ + pos) * DM + gc) : (u32x4){0u, 0u, 0u, 0u};
        }
        float o[4][8];
#pragma unroll
        for (int e = 0; e < 8; ++e) {
            float rv[7];
#pragma unroll
            for (int i = 0; i < 7; ++i) rv[i] = (e & 1) ? bf_hi(raw[i][e >> 1]) : bf_lo(raw[i][e >> 1]);
            const float w0 = F[F_CW + 0 * 256 + 8 * cg + e], w1 = F[F_CW + 1 * 256 + 8 * cg + e], w2 = F[F_CW + 2 * 256 + 8 * cg + e], w3 = F[F_CW + 3 * 256 + 8 * cg + e], cb = F[F_CW + 4 * 256 + 8 * cg + e];
#pragma unroll
            for (int tt = 0; tt < 4; ++tt) { const float v = cb + w0 * rv[tt] + w1 * rv[tt + 1] + w2 * rv[tt + 2] + w3 * rv[tt + 3]; o[tt][e] = v * sigmoid_f(v); }
            __builtin_amdgcn_sched_barrier(0);
        }
        if (cg < 16) {
#pragma unroll
            for (int tt = 0; tt < 4; ++tt) { u32x4 wv; wv.x = cvt_pk_bf16(o[tt][0], o[tt][1]); wv.y = cvt_pk_bf16(o[tt][2], o[tt][3]); wv.z = cvt_pk_bf16(o[tt][4], o[tt][5]); wv.w = cvt_pk_bf16(o[tt][6], o[tt][7]);
                *(LAS u32x4*)(lds + L_QI + (4 * tg + tt) * 272 + 16 * cg) = wv; }
        } else {
            const int kc = cg - 16;
            const f32x4 wn = *(const LAS f32x4*)(F + F_SWN + lc * 64 + 4 * tg);
#pragma unroll
            for (int tt = 0; tt < 4; ++tt) {
#pragma unroll
                for (int e = 0; e < 8; ++e) o[tt][e] *= 0.08838834764831845f;
                u32x4 wv; wv.x = cvt_pk_bf16(o[tt][0], o[tt][1]); wv.y = cvt_pk_bf16(o[tt][2], o[tt][3]); wv.z = cvt_pk_bf16(o[tt][4], o[tt][5]); wv.w = cvt_pk_bf16(o[tt][6], o[tt][7]);
                *(LAS u32x4*)(lds + L_KI + (4 * tg + tt) * 272 + 16 * kc) = wv; }
#pragma unroll
            for (int e = 0; e < 8; ++e) { u32x2 wv; wv.x = cvt_pk_bf16(o[0][e] * wn[0], o[1][e] * wn[1]); wv.y = cvt_pk_bf16(o[2][e] * wn[2], o[3][e] * wn[3]);
                *(LAS u32x2*)(lds + L_KT + (8 * kc + e) * 144 + 8 * tg) = wv; }
        }
    }
}

__device__ __forceinline__ void mlstm_update(LAS unsigned char* lds, f32x4 (&C)[2][8], int lc, int w, int r, int g) {
    LAS float* F = (LAS float*)(lds + L_F);
    const float a = F[F_SA + lc];
    const LAS unsigned char* vp = lds + (L_VT + (32 * w + r) * 144 + 16 * g);
    const LAS unsigned char* kp = lds + (L_KT + r * 144 + 16 * g);
#pragma unroll
    for (int dvb = 0; dvb < 2; ++dvb)
#pragma unroll
        for (int dkb = 0; dkb < 8; ++dkb) C[dvb][dkb] *= a;
#pragma unroll
    for (int ks = 0; ks < 2; ++ks) {
        bf16x8 vf[2];
#pragma unroll
        for (int dvb = 0; dvb < 2; ++dvb) vf[dvb] = *(const LAS bf16x8*)(vp + (16 * dvb * 144 + 64 * ks));
#pragma unroll
        for (int dkb = 0; dkb < 8; ++dkb) {
            const bf16x8 kf = *(const LAS bf16x8*)(kp + (16 * dkb * 144 + 64 * ks));
#pragma unroll
            for (int dvb = 0; dvb < 2; ++dvb) C[dvb][dkb] = mfma16(kf, vf[dvb], C[dvb][dkb]);
        }
        __builtin_amdgcn_sched_barrier(0);
    }
    const int tid = threadIdx.x, dk = tid >> 2, part = tid & 3;
    const u32x4 k0 = *(const LAS u32x4*)(lds + L_KT + dk * 144 + 32 * part), k1 = *(const LAS u32x4*)(lds + L_KT + dk * 144 + 32 * part + 16);
    float s = 0.f;
#pragma unroll
    for (int i = 0; i < 4; ++i) s += bf_lo(k0[i]) + bf_hi(k0[i]) + bf_lo(k1[i]) + bf_hi(k1[i]);
    s += __shfl_xor(s, 1); s += __shfl_xor(s, 2);
    if (part == 0) F[F_N + dk] = a * F[F_N + dk] + s;
}

__device__ void mlstm_phase1(const Params& P, LAS unsigned char* lds) {
    const int tid = threadIdx.x, w = tid >> 6, lane = tid & 63, r = lane & 15, g = lane >> 4;
    LAS float* F = (LAS float*)(lds + L_F);
    for (int task = blockIdx.x; task < 256; task += gridDim.x) {
        const int gi = task & 7, st = task >> 3, b = st >> 2, h = st & 3;
        if (gi == 7) continue;
        mlstm_prologue(P, lds, b, h, gi);
        f32x4 C[2][8];
#pragma unroll
        for (int i = 0; i < 2; ++i)
#pragma unroll
            for (int j = 0; j < 8; ++j) C[i][j] = (f32x4){0.f, 0.f, 0.f, 0.f};
        for (int lc = 0; lc < 16; ++lc) {
            mlstm_load<false>(P, lds, b, h, gi * 16 + lc, lc);
            __syncthreads();
            mlstm_update(lds, C, lc, w, r, g);
            __syncthreads();
        }
        float* slot = (float*)(P.ws + WS_PB) + (size_t)(st * 7 + gi) * STATE_FLOATS;
#pragma unroll
        for (int dvb = 0; dvb < 2; ++dvb)
#pragma unroll
            for (int dkb = 0; dkb < 8; ++dkb) *(f32x4*)(slot + (((w * 2 + dvb) * 8 + dkb) * 64 + lane) * 4) = C[dvb][dkb];
        if (tid < 128) slot[32768 + tid] = F[F_N + tid];
        __syncthreads();
    }
}

__device__ void mlstm_phase2(const Params& P, LAS unsigned char* lds) {
    const int tid = threadIdx.x, w = tid >> 6, lane = tid & 63, r = lane & 15, g = lane >> 4;
    LAS float* F = (LAS float*)(lds + L_F);
    const bf16_t* OA = (const bf16_t*)(P.ws + WS_OA);
    bf16_t* VA = (bf16_t*)(P.ws + WS_VA);
    for (int task = blockIdx.x; task < 256; task += gridDim.x) {
        const int gi = task & 7, st = task >> 3, b = st >> 2, h = st & 3;
        mlstm_prologue(P, lds, b, h, gi);
        f32x4 C[2][8];
#pragma unroll
        for (int i = 0; i < 2; ++i)
#pragma unroll
            for (int j = 0; j < 8; ++j) C[i][j] = (f32x4){0.f, 0.f, 0.f, 0.f};
        float nreg = 0.f;
        for (int j = 0; j < gi; ++j) {
            float Bj = 0.f;
            for (int c = 0; c < 16; ++c) Bj += F[F_BL + j * 16 + c];
            const float Aj = expf(Bj + F[F_M + 16 * j] - F[F_M + 16 * j + 16]);
            const float* slot = (const float*)(P.ws + WS_PB) + (size_t)(st * 7 + j) * STATE_FLOATS;
#pragma unroll
            for (int dvb = 0; dvb < 2; ++dvb)
#pragma unroll
                for (int dkb = 0; dkb < 8; ++dkb) C[dvb][dkb] = C[dvb][dkb] * Aj + *(const f32x4*)(slot + (((w * 2 + dvb) * 8 + dkb) * 64 + lane) * 4);
            if (tid < 128) nreg = nreg * Aj + slot[32768 + tid];
        }
        if (tid < 128) F[F_N + tid] = nreg;
        __syncthreads();
        for (int lc = 0; lc < 16; ++lc) {
            const int c = gi * 16 + lc;
            mlstm_load<true>(P, lds, b, h, c, lc);
            __syncthreads();
            {
                const int tb = w >> 1, par = w & 1;
                const LAS unsigned char* qpS = lds + (L_QI + (16 * tb + r) * 272 + 16 * g);
                const LAS unsigned char* kpS = lds + (L_KI + (16 * par + r) * 272 + 16 * g);
                LAS unsigned char* ppS = lds + (L_PI + (16 * tb + r) * 144 + 32 * par + 8 * g);
                bf16x8 qf[4];
#pragma unroll
                for (int kd = 0; kd < 4; ++kd) qf[kd] = *(const LAS bf16x8*)(qpS + 64 * kd);
                const float mu2 = F[F_SMU + lc * 64 + 16 * tb + r];
                float rs = 0.f;
#pragma unroll
                for (int sbi = 0; sbi < 2; ++sbi) {
                    const int sb = par + 2 * sbi;
                    u32x2 pw = (u32x2){0u, 0u};
                    if (sb <= tb) {
                        f32x4 acc = (f32x4){0.f, 0.f, 0.f, 0.f};
#pragma unroll
                        for (int kd = 0; kd < 4; ++kd) { const bf16x8 kf = *(const LAS bf16x8*)(kpS + (32 * sbi * 272 + 64 * kd)); acc = mfma16(kf, qf[kd], acc); }
                        const f32x4 b2 = *(const LAS f32x4*)(F + F_SB2 + lc * 64 + 16 * sb + 4 * g);
                        float pv[4];
#pragma unroll
                        for (int j = 0; j < 4; ++j) { const int s = 16 * sb + 4 * g + j, t = 16 * tb + r; pv[j] = (s <= t) ? acc[j] * fast_exp2(b2[j] - mu2) : 0.f; }
                        pw.x = cvt_pk_bf16(pv[0], pv[1]); pw.y = cvt_pk_bf16(pv[2], pv[3]);
                        rs += bf_lo(pw.x) + bf_hi(pw.x) + bf_lo(pw.y) + bf_hi(pw.y);
                    }
                    *(LAS u32x2*)(ppS + 64 * sbi) = pw;
                }
                rs += __shfl_xor(rs, 16); rs += __shfl_xor(rs, 32);
                if (g == 0) F[F_RS + par * 64 + 16 * tb + r] = rs;
            }
            __builtin_amdgcn_sched_barrier(0);
            const LAS unsigned char* q8p = lds + (L_QI + r * 272 + 8 * g);
            f32x4 num[2][4];
#pragma unroll
            for (int i = 0; i < 2; ++i)
#pragma unroll
                for (int j = 0; j < 4; ++j) num[i][j] = (f32x4){0.f, 0.f, 0.f, 0.f};
#pragma unroll
            for (int kk = 0; kk < 4; ++kk) {
                bf16x8 af[2];
#pragma unroll
                for (int dvb = 0; dvb < 2; ++dvb) {
                    u32x2 lo, hi; lo.x = cvt_pk_bf16(C[dvb][2 * kk][0], C[dvb][2 * kk][1]); lo.y = cvt_pk_bf16(C[dvb][2 * kk][2], C[dvb][2 * kk][3]);
                    hi.x = cvt_pk_bf16(C[dvb][2 * kk + 1][0], C[dvb][2 * kk + 1][1]); hi.y = cvt_pk_bf16(C[dvb][2 * kk + 1][2], C[dvb][2 * kk + 1][3]);
                    af[dvb] = mk8(lo, hi);
                }
#pragma unroll
                for (int tb = 0; tb < 4; ++tb) {
                    const u32x2 q0 = *(const LAS u32x2*)(q8p + (16 * tb * 272 + 64 * kk)), q1 = *(const LAS u32x2*)(q8p + (16 * tb * 272 + 64 * kk + 32));
                    const bf16x8 bq = mk8(q0, q1);
#pragma unroll
                    for (int dvb = 0; dvb < 2; ++dvb) num[dvb][tb] = mfma16(af[dvb], bq, num[dvb][tb]);
                }
                __builtin_amdgcn_sched_barrier(0);
            }
#pragma unroll
            for (int tb = 0; tb < 4; ++tb) { const float wi = F[F_SWI + lc * 64 + 16 * tb + r];
#pragma unroll
                for (int dvb = 0; dvb < 2; ++dvb) num[dvb][tb] *= wi; }
            {
                const int t = tid >> 3, part = tid & 7;
                const u32x4 q0 = *(const LAS u32x4*)(lds + L_QI + t * 272 + 32 * part), q1 = *(const LAS u32x4*)(lds + L_QI + t * 272 + 32 * part + 16);
                float s = 0.f;
#pragma unroll
                for (int i = 0; i < 4; ++i) {
                    s += bf_lo(q0[i]) * F[F_N + 16 * part + 2 * i] + bf_hi(q0[i]) * F[F_N + 16 * part + 2 * i + 1];
                    s += bf_lo(q1[i]) * F[F_N + 16 * part + 8 + 2 * i] + bf_hi(q1[i]) * F[F_N + 16 * part + 8 + 2 * i + 1];
                }
                s += __shfl_xor(s, 1); s += __shfl_xor(s, 2); s += __shfl_xor(s, 4);
                if (part == 0) F[F_QN + t] = s;
            }
            __builtin_amdgcn_sched_barrier(0);
            __syncthreads();
            const LAS unsigned char* vpC = lds + (L_VT + (32 * w + r) * 144 + 16 * g);
            const LAS unsigned char* ppC = lds + (L_PI + r * 144 + 16 * g);
#pragma unroll
            for (int ks = 0; ks < 2; ++ks) {
                bf16x8 vf[2];
#pragma unroll
                for (int dvb = 0; dvb < 2; ++dvb) vf[dvb] = *(const LAS bf16x8*)(vpC + (16 * dvb * 144 + 64 * ks));
#pragma unroll
                for (int tb = 0; tb < 4; ++tb) {
                    if (ks == 0 || tb >= 2) {
                        const bf16x8 pb = *(const LAS bf16x8*)(ppC + (16 * tb * 144 + 64 * ks));
#pragma unroll
                        for (int dvb = 0; dvb < 2; ++dvb) num[dvb][tb] = mfma16(vf[dvb], pb, num[dvb][tb]);
                    }
                }
                __builtin_amdgcn_sched_barrier(0);
            }
#pragma unroll
            for (int tb = 0; tb < 4; ++tb) {
                const int t = 16 * tb + r;
                const float den = F[F_SWI + lc * 64 + t] * F[F_QN + t] + F[F_RS + t] + F[F_RS + 64 + t];
                const float inv = 1.0f / fmaxf(fabsf(den), F[F_SEM + lc * 64 + t]);
                float s1 = 0.f, s2 = 0.f;
#pragma unroll
                for (int dvb = 0; dvb < 2; ++dvb) { num[dvb][tb] *= inv;
#pragma unroll
                    for (int j = 0; j < 4; ++j) { const float v = num[dvb][tb][j]; s1 += v; s2 += v * v; } }
                s1 += __shfl_xor(s1, 16); s1 += __shfl_xor(s1, 32); s2 += __shfl_xor(s2, 16); s2 += __shfl_xor(s2, 32);
                if (g == 0) { F[F_HS + (w * 64 + t) * 2] = s1; F[F_HS + (w * 64 + t) * 2 + 1] = s2; }
                __builtin_amdgcn_sched_barrier(0);
            }
            mlstm_update(lds, C, lc, w, r, g);
            __builtin_amdgcn_sched_barrier(0);
            __syncthreads();
#pragma unroll
            for (int tb = 0; tb < 4; ++tb) {
                const int t = 16 * tb + r;
                float s1 = 0.f, s2 = 0.f;
#pragma unroll
                for (int ww = 0; ww < 8; ++ww) { s1 += F[F_HS + (ww * 64 + t) * 2]; s2 += F[F_HS + (ww * 64 + t) * 2 + 1]; }
                const float mean = s1 * (1.0f / 256.0f), var = fmaxf(s2 * (1.0f / 256.0f) - mean * mean, 0.f), rstd = rsqrtf(var + LN_EPS);
                const size_t tok = (size_t)b * SEQ + c * 64 + t;
#pragma unroll
                for (int dvb = 0; dvb < 2; ++dvb) {
                    const int dv0 = 32 * w + 16 * dvb + 4 * g;
                    const f32x4 gn = *(const f32x4*)(P.mh_g + h * 256 + dv0);
                    const u32x2 og = *(const u32x2*)(OA + tok * DM + h * 256 + dv0);
                    const float y0 = (num[dvb][tb][0] - mean) * rstd * gn[0] * bf_lo(og.x), y1 = (num[dvb][tb][1] - mean) * rstd * gn[1] * bf_hi(og.x);
                    const float y2 = (num[dvb][tb][2] - mean) * rstd * gn[2] * bf_lo(og.y), y3 = (num[dvb][tb][3] - mean) * rstd * gn[3] * bf_hi(og.y);
                    u32x2 wv; wv.x = cvt_pk_bf16(y0, y1); wv.y = cvt_pk_bf16(y2, y3);
                    *(u32x2*)(VA + tok * DM + h * 256 + dv0) = wv;
                }
            }
        }
        __syncthreads();
    }
}

constexpr int A_KI = 0, A_VT = 17408, A_FL = 35840;
constexpr float SB_DONE_LOG2 = -40.0f;

__device__ void attn_phase(const Params& P, LAS unsigned char* lds) {
    const int tid = threadIdx.x, w = tid >> 6, lane = tid & 63, r = lane & 15, g = lane >> 4;
    bf16_t* QB = (bf16_t*)(P.ws + WS_QB);
    const bf16_t* KB = (const bf16_t*)(P.ws + WS_KB);
    const bf16_t* VB = (const bf16_t*)(P.ws + WS_VB);
    unsigned* cnt = (unsigned*)(P.ws + MISC_CNT);
    LAS int* FL = (LAS int*)(lds + A_FL);
    for (;;) {
        if (tid == 0) FL[32] = (int)atomicAdd(cnt, 1u);
        __syncthreads();
        const int item = FL[32];
        __syncthreads();
        if (item >= 4096) break;
        const int qb = 63 - (item >> 6), b = (item >> 3) & 7, h = item & 7;
        const int q0w = qb * 128 + 16 * w;
        const size_t qtok = (size_t)b * SEQ + q0w + r;
        bf16x8 qf[4];
#pragma unroll
        for (int kd = 0; kd < 4; ++kd) qf[kd] = *(const bf16x8*)(QB + qtok * DM + h * 128 + 32 * kd + 8 * g);
        f32x4 O[8];
#pragma unroll
        for (int i = 0; i < 8; ++i) O[i] = (f32x4){0.f, 0.f, 0.f, 0.f};
        float R = 0.f;
        int wdone = 0, it = 0;
        u32x4 pre[4];
        const int ptg = tid & 15, pcg = (tid >> 4) & 15, prow = (tid - 256) >> 2, pch = tid & 3;
        auto issue_tile = [&](int kt_) {
            if (tid < 256) {
#pragma unroll
                for (int tt = 0; tt < 4; ++tt) pre[tt] = *(const u32x4*)(VB + ((size_t)b * SEQ + kt_ * 64 + 4 * ptg + tt) * DM + h * 128 + 8 * pcg);
            } else {
                const bf16_t* src_ = KB + ((size_t)b * SEQ + kt_ * 64 + prow) * DM + h * 128 + 32 * pch;
#pragma unroll
                for (int i = 0; i < 4; ++i) pre[i] = *(const u32x4*)(src_ + 8 * i);
            }
        };
        issue_tile(2 * qb + 1);
        for (int kt = 2 * qb + 1; kt >= 0; --kt, ++it) {
            if (tid < 256) {
#pragma unroll
                for (int e = 0; e < 8; ++e) {
                    unsigned short x0, x1, x2, x3;
                    { const unsigned a0 = pre[0][e >> 1], a1 = pre[1][e >> 1], a2 = pre[2][e >> 1], a3 = pre[3][e >> 1];
                      if (e & 1) { x0 = a0 >> 16; x1 = a1 >> 16; x2 = a2 >> 16; x3 = a3 >> 16; } else { x0 = a0 & 0xffff; x1 = a1 & 0xffff; x2 = a2 & 0xffff; x3 = a3 & 0xffff; } }
                    u32x2 wv; wv.x = (unsigned)x0 | ((unsigned)x1 << 16); wv.y = (unsigned)x2 | ((unsigned)x3 << 16);
                    *(LAS u32x2*)(lds + A_VT + (8 * pcg + e) * 144 + 8 * ptg) = wv;
                }
            } else {
#pragma unroll
                for (int i = 0; i < 4; ++i) *(LAS u32x4*)(lds + A_KI + prow * 272 + 64 * pch + 16 * i) = pre[i];
            }
            __syncthreads();
            if (kt > 0) issue_tile(kt - 1);
            const int key0 = kt * 64;
            if (!wdone && key0 <= q0w + 14) {
                const int qpos = q0w + r;
                float wgt[4][4];
                float Rrun = R;
#pragma unroll
                for (int sb = 3; sb >= 0; --sb) {
                    f32x4 acc = (f32x4){0.f, 0.f, 0.f, 0.f};
#pragma unroll
                    for (int kd = 0; kd < 4; ++kd) { const bf16x8 kf = *(const LAS bf16x8*)(lds + A_KI + (16 * sb + r) * 272 + 64 * kd + 16 * g); acc = mfma16(kf, qf[kd], acc); }
                    float lk[4], z[4];
#pragma unroll
                    for (int j = 0; j < 4; ++j) {
                        const int key = key0 + 16 * sb + 4 * g + j;
                        z[j] = fminf(acc[j], 80.0f);
                        lk[j] = (key < qpos) ? -fast_log2(1.0f + fast_exp2(z[j])) : 0.f;
                    }
                    const float s3 = lk[3], s2 = s3 + lk[2], s1 = s2 + lk[1], s0 = s1 + lk[0];
                    const float t1 = __shfl_xor(s0, 16), t2 = __shfl_xor(s0, 32), t3 = __shfl_xor(t1, 32);
                    const float above = g == 0 ? (t1 + t2 + t3) : (g == 1 ? (t2 + t3) : (g == 2 ? t1 : 0.f));
                    const float base = Rrun + above;
                    const float sj[4] = {s0, s1, s2, s3};
#pragma unroll
                    for (int j = 0; j < 4; ++j) { const int key = key0 + 16 * sb + 4 * g + j; wgt[sb][j] = (key < qpos) ? fast_exp2(z[j] + base + sj[j]) : 0.f; }
                    Rrun += (s0 + t1) + (t2 + t3);
                }
                R = Rrun;
#pragma unroll
                for (int ks = 0; ks < 2; ++ks) {
                    u32x2 lo, hi; lo.x = cvt_pk_bf16(wgt[2 * ks][0], wgt[2 * ks][1]); lo.y = cvt_pk_bf16(wgt[2 * ks][2], wgt[2 * ks][3]);
                    hi.x = cvt_pk_bf16(wgt[2 * ks + 1][0], wgt[2 * ks + 1][1]); hi.y = cvt_pk_bf16(wgt[2 * ks + 1][2], wgt[2 * ks + 1][3]);
                    const bf16x8 pf = mk8(lo, hi);
#pragma unroll
                    for (int db = 0; db < 8; ++db) {
                        const u32x2 v0 = *(const LAS u32x2*)(lds + A_VT + (16 * db + r) * 144 + 64 * ks + 8 * g), v1 = *(const LAS u32x2*)(lds + A_VT + (16 * db + r) * 144 + 64 * ks + 32 + 8 * g);
                        O[db] = mfma16(mk8(v0, v1), pf, O[db]);
                    }
                }
                wdone = __all(R < SB_DONE_LOG2) ? 1 : 0;
            }
            if (lane == 0) FL[(it & 1) * 8 + w] = wdone;
            __syncthreads();
            int alld = 1;
#pragma unroll
            for (int i = 0; i < 8; ++i) alld &= FL[(it & 1) * 8 + i];
            if (alld) break;
        }
#pragma unroll
        for (int db = 0; db < 8; ++db) { u32x2 wv; wv.x = cvt_pk_bf16(O[db][0], O[db][1]); wv.y = cvt_pk_bf16(O[db][2], O[db][3]);
            *(u32x2*)(QB + qtok * DM + h * 128 + 16 * db + 4 * g) = wv; }
        __syncthreads();
    }
}


#ifdef DIAG
__device__ void diag_count_f32(const float* p, size_t n, float thr, unsigned* ctr) {
    unsigned c = 0;
    for (size_t i = (size_t)blockIdx.x * NTHREADS + threadIdx.x; i < n; i += (size_t)gridDim.x * NTHREADS) { const float v = p[i]; if (!(fabsf(v) <= thr)) ++c; }
    if (c) atomicAdd(ctr, c);
}
__device__ void diag_count_bf16(const bf16_t* p, size_t n, float thr, unsigned* ctr) {
    unsigned c = 0;
    for (size_t i = (size_t)blockIdx.x * NTHREADS + threadIdx.x; i < n; i += (size_t)gridDim.x * NTHREADS) { const float v = __uint_as_float((unsigned)p[i] << 16); if (!(fabsf(v) <= thr)) ++c; }
    if (c) atomicAdd(ctr, c);
}
#endif
#define XB_TMO      128
#define XB_XCNT(j)  (256  + 64 * (j))
#define XB_XSUB(j)  (1280 + 64 * (j))
#define XB_XGEN(j)  (2304 + 64 * (j))
#define XB_TOP      3328
#define XB_TOPGEN   3392
#define XCD_BAR_WORDS 3456
#define XB_SPIN_CAP (1u << 18)

__device__ __forceinline__ unsigned xb_ld(unsigned* p)              { return __hip_atomic_load(p, __ATOMIC_RELAXED, __HIP_MEMORY_SCOPE_AGENT); }
__device__ __forceinline__ unsigned xb_add(unsigned* p, unsigned v) { return __hip_atomic_fetch_add(p, v, __ATOMIC_RELAXED, __HIP_MEMORY_SCOPE_AGENT); }
__device__ __forceinline__ unsigned xb_xcc_id() { return (unsigned)__builtin_amdgcn_s_getreg((3 << 11) | 20) & 0xFu; }
#define XB_SPIN(cond, bar) do { unsigned _sp = 0; while (cond) { __builtin_amdgcn_s_sleep(1); \
    if ((++_sp & 255u) == 0u) { if (xb_ld(&(bar)[XB_TMO])) break; if (_sp > XB_SPIN_CAP) { atomicAdd(&(bar)[XB_TMO], 1u); break; } } } } while (0)

struct XcdBarrier {
    unsigned* bar; unsigned x;
    volatile LAS unsigned* st;
};

__device__ __forceinline__ XcdBarrier xcd_barrier_post(unsigned* bar, volatile LAS unsigned* st) {
    XcdBarrier b; b.bar = bar; b.x = xb_xcc_id(); b.st = st;
    if (threadIdx.x == 0) (void)xb_add(&bar[XB_XCNT(b.x)], 1u);
    return b;
}
__device__ __forceinline__ void xcd_barrier_complete(unsigned* bar, unsigned x, unsigned& nloc, unsigned& nx) {
    const unsigned G = gridDim.x * gridDim.y * gridDim.z;
    unsigned sum, cnt, mine, sp = 0u;
    for (;;) {
        sum = 0u; cnt = 0u; mine = 0u;
#pragma unroll
        for (unsigned j = 0; j < 16; ++j) { const unsigned c = xb_ld(&bar[XB_XCNT(j)]); sum += c; cnt += (c > 0u) ? 1u : 0u; mine = (j == x) ? c : mine; }
        if (sum == G) break;
        __builtin_amdgcn_s_sleep(1);
        if ((++sp & 255u) == 0u) { if (xb_ld(&bar[XB_TMO])) break; if (sp > XB_SPIN_CAP) { atomicAdd(&bar[XB_TMO], 1u); break; } }
    }
    nloc = mine > 0u ? mine : 1u; nx = cnt > 0u ? cnt : 1u;
}

__device__ __forceinline__ void xcd_barrier(const XcdBarrier& b) {
    asm volatile("s_waitcnt vmcnt(0)" ::: "memory");
    __syncthreads();
    if (threadIdx.x == 0) {
        unsigned* bar = b.bar;
        __builtin_amdgcn_s_waitcnt(0);
        unsigned nloc = b.st[0], nx = b.st[1];
        if (nloc == 0u) { xcd_barrier_complete(bar, b.x, nloc, nx); b.st[0] = nloc; b.st[1] = nx; }
        const unsigned old = xb_add(&bar[XB_XSUB(b.x)], 1u);
        const unsigned gen = old / nloc;
        if (old + 1u == (gen + 1u) * nloc) {
            __builtin_amdgcn_fence(__ATOMIC_RELEASE, "agent");
            asm volatile("s_waitcnt vmcnt(0)" ::: "memory");
            const unsigned og = xb_add(&bar[XB_TOP], 1u);
            const unsigned tg = og / nx;
            if (og + 1u == (tg + 1u) * nx) xb_add(&bar[XB_TOPGEN], 1u);
            else XB_SPIN(xb_ld(&bar[XB_TOPGEN]) == tg, bar);
            __builtin_amdgcn_fence(__ATOMIC_ACQUIRE, "agent");
            xb_add(&bar[XB_XGEN(b.x)], 1u);
            asm volatile("s_waitcnt vmcnt(0)" ::: "memory");
        } else {
            XB_SPIN(xb_ld(&bar[XB_XGEN(b.x)]) == gen, bar);
            __builtin_amdgcn_fence(__ATOMIC_ACQUIRE, "agent");
            asm volatile("s_waitcnt vmcnt(0)" ::: "memory");
        }
    }
    __syncthreads();
}

constexpr int LDS_BYTES = 135168;
static_assert(MIX_LDS <= LDS_BYTES && 128 * 129 * 4 <= LDS_BYTES && pg8::STAGE_BYTES <= LDS_BYTES, "LDS budget");
constexpr int NPHASE = 17;

template <class Epi>
__device__ __forceinline__ void run_gemm(LAS unsigned char* lds, const bf16_t* A, const bf16_t* Bt, int N, int K, const Epi& E) {
    pg8::Gemm g{A, Bt, MTOK, N, K};
    pg8::StaticOrder S; S.init(MTOK, N, gridDim.x, blockIdx.x);
    pg8::gemm_phase<Epi, pg8::StaticOrder, true, true>(lds, g, S, E);
}

__global__ void __launch_bounds__(NTHREADS, 2) fwd_megakernel(Params P) {
    extern __shared__ __attribute__((aligned(16))) unsigned char smem[];
    LAS unsigned char* lds = (LAS unsigned char*)smem;
    cg::grid_group grid = cg::this_grid();
    unsigned char* ws = P.ws;
    bf16_t* X = (bf16_t*)(ws + WS_X);
    bf16_t* H = (bf16_t*)(ws + WS_H);
    float* Y = P.out;
    bf16_t* gates = (bf16_t*)P.out;
#ifdef ONLYMASK
#define PHASE(k) if (((ONLYMASK >> (k)) & 1) && P.ph_lo <= (k) && (k) < P.ph_hi)
#else
#define PHASE(k) if (P.ph_lo <= (k) && (k) < P.ph_hi)
#endif
#define SYNC0() do { if (P.coop) { asm volatile("s_waitcnt vmcnt(0) lgkmcnt(0)" ::: "memory"); grid.sync(); \
        if (threadIdx.x < 64) { __builtin_amdgcn_fence(__ATOMIC_ACQUIRE, "agent"); asm volatile("s_waitcnt vmcnt(0)" ::: "memory"); } __syncthreads(); } } while (0)
#define SYNC() do { if (P.coop) xcd_barrier(xb); } while (0)
    volatile LAS unsigned* bst = (volatile LAS unsigned*)(lds + (LDS_BYTES - 16));
    XcdBarrier xb; xb.bar = (unsigned*)(ws + MISC_BAR); xb.x = 0; xb.st = bst;
    if (P.coop) { if (threadIdx.x == 0) { bst[0] = 0u; bst[1] = 0u; } xb = xcd_barrier_post((unsigned*)(ws + MISC_BAR), bst); }
    PHASE(0) prep_phase(P, lds);
    SYNC0();
    PHASE(1) run_gemm(lds, X, (const bf16_t*)(ws + W_GU1), 5632, 1024, EpiSwiglu{H});
    SYNC();
    PHASE(2) run_gemm(lds, H, (const bf16_t*)(ws + W_D1), 1024, FH, EpiResid<false, false, true>{P.x, nullptr, Y, 0.5f});
    SYNC();
    PHASE(3) ln_phase<true, true>(Y, P.ln_g, P.ln_b, X);
    SYNC();
    PHASE(4) run_gemm(lds, X, (const bf16_t*)(ws + W_IN), NIN_PAD, 1024, EpiWin{(bf16_t*)(ws + WS_QK), gates, (float*)(ws + MISC_IF), (const float*)(ws + W_BIAS)});
    SYNC();
    PHASE(5) mlstm_phase1(P, lds);
    SYNC();
    PHASE(6) {
#ifndef NO_ML2
        mlstm_phase2(P, lds);
#endif
#ifndef NO_ATT
        attn_phase(P, lds);
#endif
    }
    SYNC();
    PHASE(7) {
        run_gemm(lds, (const bf16_t*)(ws + WS_VA), (const bf16_t*)(ws + W_A), 1024, 1024, EpiGateMul<false>{gates, 0, nullptr, (bf16_t*)(ws + WS_T)});
        run_gemm(lds, (const bf16_t*)(ws + WS_QB), (const bf16_t*)(ws + W_B), 1024, 1024, EpiGateMul<true>{gates, DM, (const bf16_t*)(ws + WS_T), (bf16_t*)(ws + WS_MG)});
    }
    SYNC();
    PHASE(8) run_gemm(lds, (const bf16_t*)(ws + WS_MG), (const bf16_t*)(ws + W_O), 1024, 1024, EpiResid<true, false, true>{X, nullptr, Y, 1.0f});
    SYNC();
    PHASE(9) ln_phase<true, true>(Y, P.ln_g + DM, P.ln_b + DM, X);
    SYNC();
    PHASE(10) run_gemm(lds, X, (const bf16_t*)(ws + W_GU2), 5632, 1024, EpiSwiglu{H});
    SYNC();
    PHASE(11) run_gemm(lds, H, (const bf16_t*)(ws + W_D2), 1024, FH, EpiResid<true, false, true>{X, nullptr, Y, 0.5f});
    SYNC();
    PHASE(12) { ln_phase<true, true>(Y, P.ln_g + 2 * DM, P.ln_b + 2 * DM, X); cvt_bf16_phase(P.p, (bf16_t*)(ws + WS_PB), (size_t)MTOK * 256 / 8); }
    SYNC();
    PHASE(13) {
        run_gemm(lds, X, (const bf16_t*)(ws + W_PG), 1024, 1024, EpiSigBias{P.b_pg, (bf16_t*)(ws + WS_PG)});
        run_gemm(lds, (const bf16_t*)(ws + WS_PB), (const bf16_t*)(ws + W_P), 1024, 256, EpiResid<true, true, true>{X, (const bf16_t*)(ws + WS_PG), (float*)(ws + WS_VA), 1.0f});
    }
    SYNC();
    PHASE(14) ln_phase<false, true>((const float*)(ws + WS_VA), P.ln_g + 3 * DM, P.ln_b + 3 * DM, P.out);
#undef PHASE
#undef SYNC
#undef SYNC0
}

extern "C" void kernel_launch(void* const* d_in, const int* in_sizes, int n_in, void* d_out, int out_size, void* d_ws, size_t ws_size, hipStream_t stream) {
    static int grid_blocks = 0;
    if (grid_blocks == 0) {
        if (n_in != 19 || out_size != MTOK * DM || ws_size < WS_END) { fprintf(stderr, "kernel_launch: unexpected shapes (n_in %d, out %d, ws %zu, need %zu)\n", n_in, out_size, ws_size, (size_t)WS_END); grid_blocks = -1; return; }
        int dev = 0, cus = 0, per_cu = 0;
        hipGetDevice(&dev);
        hipDeviceGetAttribute(&cus, hipDeviceAttributeMultiprocessorCount, dev);
        if (hipFuncSetAttribute((const void*)fwd_megakernel, hipFuncAttributeMaxDynamicSharedMemorySize, LDS_BYTES) != hipSuccess) { fprintf(stderr, "kernel_launch: hipFuncSetAttribute failed\n"); grid_blocks = -1; return; }
        if (hipOccupancyMaxActiveBlocksPerMultiprocessor(&per_cu, (const void*)fwd_megakernel, NTHREADS, LDS_BYTES) != hipSuccess || per_cu < 1) { fprintf(stderr, "kernel_launch: occupancy query failed (%d)\n", per_cu); per_cu = 1; (void)hipGetLastError(); }
        grid_blocks = cus * per_cu;
    }
    if (grid_blocks < 0) return;
    Params p{};
    p.x = (const float*)d_in[0]; p.p = (const float*)d_in[1]; p.ln_g = (const float*)d_in[2]; p.ln_b = (const float*)d_in[3];
    p.wg = (const float*)d_in[4]; p.wu = (const float*)d_in[5]; p.wd = (const float*)d_in[6]; p.w_in = (const float*)d_in[7]; p.b_in = (const float*)d_in[8];
    p.b_forget = (const float*)d_in[9]; p.conv_w = (const float*)d_in[10]; p.conv_b = (const float*)d_in[11]; p.mh_g = (const float*)d_in[12];
    p.w_a = (const float*)d_in[13]; p.w_b = (const float*)d_in[14]; p.w_o = (const float*)d_in[15]; p.w_ple = (const float*)d_in[16]; p.w_pg = (const float*)d_in[17]; p.b_pg = (const float*)d_in[18];
    p.out = (float*)d_out; p.ws = (unsigned char*)d_ws; p.pad = 0;
#if ONE_LAUNCH
    if (hipMemsetAsync((char*)d_ws + MISC_BAR, 0, XCD_BAR_WORDS * 4, stream) != hipSuccess) { fprintf(stderr, "kernel_launch: memset of the barrier words failed\n"); return; }
    p.ph_lo = 0; p.ph_hi = NPHASE; p.coop = 1;
    void* args[] = {&p};
    hipError_t e = hipLaunchCooperativeKernel((const void*)fwd_megakernel, dim3(grid_blocks), dim3(NTHREADS), args, LDS_BYTES, stream);
    if (e != hipSuccess) fprintf(stderr, "cooperative launch failed: %s (grid %d)\n", hipGetErrorString(e), grid_blocks);
#else
    p.coop = 0;
    for (int ph = 0; ph < 15; ++ph) { p.ph_lo = ph; p.ph_hi = ph + 1; hipLaunchKernelGGL(fwd_megakernel, dim3(grid_blocks), dim3(NTHREADS), LDS_BYTES, stream, p); }
#endif
}
```

```cpp
#include <hip/hip_runtime.h>
#include <hip/hip_cooperative_groups.h>
#include <cstdio>
namespace cg = cooperative_groups;

#ifndef ONE_LAUNCH
#define ONE_LAUNCH 1
#endif

#define LAS __attribute__((address_space(3)))
typedef unsigned short bf16_t;
typedef short bf16x8 __attribute__((ext_vector_type(8)));
typedef float f32x4 __attribute__((ext_vector_type(4)));
typedef float f32x2 __attribute__((ext_vector_type(2)));
typedef unsigned u32x4 __attribute__((ext_vector_type(4)));
typedef unsigned u32x2 __attribute__((ext_vector_type(2)));

constexpr int MTOK = 65536, DM = 1024, FH = 2816, SEQ = 8192;
constexpr int NIN_PAD = 8448;
constexpr float ALPHA = 1.189207115002721f;
constexpr float LN_EPS = 1e-5f;
constexpr float LOG2E = 1.4426950408889634f;
constexpr int NTHREADS = 512;

constexpr size_t QB_ = 33554432ull;
constexpr size_t WS_W = 0;
constexpr size_t W_GU1 = 0;
constexpr size_t W_D1 = W_GU1 + 5632ull * 1024 * 2;
constexpr size_t W_GU2 = W_D1 + 1024ull * 2816 * 2;
constexpr size_t W_D2 = W_GU2 + 5632ull * 1024 * 2;
constexpr size_t W_IN = W_D2 + 1024ull * 2816 * 2;
constexpr size_t W_A = W_IN + 8448ull * 1024 * 2;
constexpr size_t W_B = W_A + 1024ull * 1024 * 2;
constexpr size_t W_O = W_B + 1024ull * 1024 * 2;
constexpr size_t W_PG = W_O + 1024ull * 1024 * 2;
constexpr size_t W_P = W_PG + 1024ull * 1024 * 2;
constexpr size_t W_BIAS = W_P + 1024ull * 256 * 2;
static_assert(W_BIAS + 8448 * 4 <= 2 * QB_, "weights overflow");
constexpr size_t WS_PB = 2 * QB_;
constexpr size_t WS_MISC = 3 * QB_;
constexpr size_t MISC_IF = WS_MISC;
constexpr size_t MISC_CNT = WS_MISC + 2097152ull;
constexpr size_t MISC_BAR = MISC_CNT + 4096;
constexpr size_t WS_X = 4 * QB_;
constexpr size_t WS_H = 8 * QB_;
constexpr size_t WS_QK = 8 * QB_, WS_VA = 12 * QB_, WS_OA = 16 * QB_, WS_QB = 20 * QB_, WS_KB = 24 * QB_, WS_VB = 28 * QB_;
constexpr size_t WS_T = WS_QK, WS_MG = WS_KB, WS_PG = 8 * QB_;
constexpr size_t WS_END = 32 * QB_;
constexpr int STATE_FLOATS = 32768 + 128;

typedef __bf16 bf16x2_t __attribute__((ext_vector_type(2)));
__device__ __forceinline__ unsigned cvt_pk_bf16(float lo, float hi) { f32x2 v = {lo, hi}; bf16x2_t r = __builtin_convertvector(v, bf16x2_t); return __builtin_bit_cast(unsigned, r); }
__device__ __forceinline__ float bf_lo(unsigned u) { return __uint_as_float(u << 16); }
__device__ __forceinline__ float bf_hi(unsigned u) { return __uint_as_float(u & 0xffff0000u); }
__device__ __forceinline__ float fast_exp2(float x) { return __builtin_amdgcn_exp2f(x); }
__device__ __forceinline__ float fast_log2(float x) { return __builtin_amdgcn_logf(x); }
__device__ __forceinline__ float fast_rcp(float x) { return __builtin_amdgcn_rcpf(x); }
__device__ __forceinline__ float sigmoid_f(float x) { return fast_rcp(1.0f + fast_exp2(-x * LOG2E)); }
__device__ __forceinline__ f32x4 mfma16(bf16x8 a, bf16x8 b, f32x4 c) { return __builtin_amdgcn_mfma_f32_16x16x32_bf16(a, b, c, 0, 0, 0); }
__device__ __forceinline__ bf16x8 mk8(u32x2 lo, u32x2 hi) { u32x4 v; v.x = lo.x; v.y = lo.y; v.z = hi.x; v.w = hi.y; return __builtin_bit_cast(bf16x8, v); }
__device__ __forceinline__ float wave_sum(float v) {
#pragma unroll
    for (int o = 32; o > 0; o >>= 1) v += __shfl_xor(v, o);
    return v;
}
__device__ __forceinline__ float wave_max(float v) {
#pragma unroll
    for (int o = 32; o > 0; o >>= 1) v = fmaxf(v, __shfl_xor(v, o));
    return v;
}
__device__ __forceinline__ float wave_incl_sum(float v, int lane) {
#pragma unroll
    for (int o = 1; o < 64; o <<= 1) { float t = __shfl_up(v, o); if (lane >= o) v += t; }
    return v;
}
__device__ __forceinline__ float wave_incl_max(float v, int lane) {
#pragma unroll
    for (int o = 1; o < 64; o <<= 1) { float t = __shfl_up(v, o); if (lane >= o) v = fmaxf(v, t); }
    return v;
}

namespace pg8 {
constexpr int BM = 256, BK = 64, HALF = 128, HTB = HALF * BK * 2, STAGE_BYTES = 8 * HTB, NXCD = 8, WGM = 8;
__host__ __device__ __forceinline__ int lds_byte(int r, int c) { const int st = (r >> 4) * 2 + (c >> 5), rr = r & 15, cc = c & 31, ob = rr * 64 + cc * 2; return st * 1024 + (ob ^ (((ob >> 9) & 1) << 5)); }
__host__ __device__ __forceinline__ void stage_rc(int b, int& R, int& C) { const int st = b / 1024, sb = b % 1024, swz = sb ^ (((sb >> 9) & 1) << 5); R = (st >> 1) * 16 + swz / 64; C = (st & 1) * 32 + (swz % 64) / 2; }
__host__ __device__ __forceinline__ int perm32(int rho) { const int n = rho >> 4, i = rho & 15; return 8 * (i >> 2) + 4 * n + (i & 3); }
struct Unit { int pm, pn; };
struct Gemm { const bf16_t* A; const bf16_t* Bt; int M, N, K; };
struct StaticOrder {
    int nM, nN, nwg, G, c;
    __device__ void init(int M, int N, int G_, int c_) { nM = M / BM; nN = N / BM; nwg = nM * nN; G = G_; c = c_; }
    __device__ bool next(int i, Unit& u) const {
        const long L = (long)i * G + c; if (L >= nwg) return false;
        int wgid = (int)L; { const int q = nwg / NXCD, r = nwg % NXCD, xcd = wgid % NXCD, off = wgid / NXCD; wgid = (xcd < r ? xcd * (q + 1) : r * (q + 1) + (xcd - r) * q) + off; }
        const int nig = WGM * nN, gid = wgid / nig, fm = gid * WGM, gsz = (nM - fm) < WGM ? (nM - fm) : WGM;
        u.pm = fm + ((wgid % nig) % gsz); u.pn = (wgid % nig) / gsz; return true;
    }
};
template <class Epi, class Sched, bool ALIGN_EPI = false, bool SP2 = false>
__device__ __forceinline__ void gemm_phase(LAS unsigned char* lds, const Gemm g, const Sched& S, const Epi& E) {
    const int tid = threadIdx.x, wid = __builtin_amdgcn_readfirstlane(tid >> 6), lane = tid & 63, wr = wid >> 2, wc = wid & 3, fr = lane & 15, fq = lane >> 4;
    const int K = g.K, nt = K / BK;
    unsigned voffA[2], voffB[2];
#pragma unroll
    for (int i = 0; i < 2; ++i) { int R, C; stage_rc(tid * 16 + i * 8192, R, C); const int Rb = ((R & ~31) + perm32(R & 31));
        voffA[i] = (unsigned)(R * K + C) * 2u; voffB[i] = (unsigned)(Rb * K + C) * 2u; }
    const size_t kstep = (size_t)(BK * 2);
    const size_t hstep = (size_t)HALF * K * 2;
    const size_t tstep = 2 * hstep;
    const unsigned ldsw = (unsigned)wid * 1024u;
    const int aoff = lds_byte(wr * 64 + fr, fq * 8), boff = lds_byte(wc * 32 + fr, fq * 8);
#define PG8_SA(b, h) (((b) * 2 + (h)) * HTB)
#define PG8_SB(b, h) ((4 + (b) * 2 + (h)) * HTB)
#define PG8_STAGE(bufoff, gbase, voff) do { _Pragma("unroll") for (int _i = 0; _i < 2; ++_i) \
        __builtin_amdgcn_global_load_lds((const unsigned*)((const char*)(gbase) + (voff)[_i]), (LAS unsigned*)(lds + (bufoff) + ldsw + _i * 8192), 16, 0, 0); } while (0)
#define PG8_LDA(dst, b, h) do { _Pragma("unroll") for (int m = 0; m < 4; ++m) _Pragma("unroll") for (int k = 0; k < 2; ++k) dst[m][k] = *(const LAS bf16x8*)(lds + PG8_SA(b, h) + aoff + m * 2048 + k * 1024); } while (0)
#define PG8_LDB(dst, b, h) do { _Pragma("unroll") for (int n = 0; n < 2; ++n) _Pragma("unroll") for (int k = 0; k < 2; ++k) dst[n][k] = *(const LAS bf16x8*)(lds + PG8_SB(b, h) + boff + n * 2048 + k * 1024); } while (0)
#define PG8_MMA(ai, bj, At, Bt) do { __builtin_amdgcn_s_setprio(1); _Pragma("unroll") for (int m = 0; m < 4; ++m) _Pragma("unroll") for (int n = 0; n < 2; ++n) _Pragma("unroll") for (int k = 0; k < 2; ++k) \
        acc[ai][bj][m][n] = __builtin_amdgcn_mfma_f32_16x16x32_bf16(Bt[n][k], At[m][k], acc[ai][bj][m][n], 0, 0, 0); __builtin_amdgcn_s_setprio(0); } while (0)
#define PG8_WAIT_V(n) asm volatile("s_waitcnt vmcnt(" #n ")" ::: "memory")
#define PG8_WAIT_L(n) asm volatile("s_waitcnt lgkmcnt(" #n ")" ::: "memory")
#define PG8_BAR __builtin_amdgcn_s_barrier()
#define PG8_SCHED __builtin_amdgcn_sched_barrier(0)
    Unit cur, nxt; int ui = 0;
    if (!S.next(0, cur)) return;
    f32x4 acc[2][2][4][2];
#pragma unroll
    for (int a = 0; a < 2; ++a)
#pragma unroll
        for (int b = 0; b < 2; ++b)
#pragma unroll
            for (int m = 0; m < 4; ++m)
#pragma unroll
                for (int n = 0; n < 2; ++n) acc[a][b][m][n] = (f32x4){0.f, 0.f, 0.f, 0.f};
    bf16x8 At[4][2], B0[2][2], B1[2][2];
    const char* cA = (const char*)g.A + (size_t)cur.pm * tstep; const char* cB = (const char*)g.Bt + (size_t)cur.pn * tstep;

    if constexpr (SP2) {
        PG8_STAGE(PG8_SB(0, 0), cB, voffB); PG8_STAGE(PG8_SB(0, 1), cB + hstep, voffB); PG8_STAGE(PG8_SA(0, 0), cA, voffA); PG8_STAGE(PG8_SA(0, 1), cA + hstep, voffA);
        if (wr == 1) PG8_BAR;
        PG8_WAIT_V(2); PG8_BAR;
        PG8_STAGE(PG8_SB(1, 0), cB + kstep, voffB); PG8_STAGE(PG8_SA(1, 0), cA + kstep, voffA); PG8_STAGE(PG8_SB(1, 1), cB + hstep + kstep, voffB);
        PG8_WAIT_V(6); PG8_BAR;
    } else {
        PG8_STAGE(PG8_SB(0, 0), cB, voffB); PG8_STAGE(PG8_SA(0, 0), cA, voffA); PG8_STAGE(PG8_SB(0, 1), cB + hstep, voffB); PG8_STAGE(PG8_SA(0, 1), cA + hstep, voffA);
        if (wr == 1) PG8_BAR;
        PG8_WAIT_V(4); PG8_BAR;
        PG8_STAGE(PG8_SB(1, 0), cB + kstep, voffB); PG8_STAGE(PG8_SA(1, 0), cA + kstep, voffA); PG8_STAGE(PG8_SB(1, 1), cB + hstep + kstep, voffB);
        PG8_WAIT_V(6); PG8_BAR;
    }
    for (;;) {
        const bool has_next = S.next(ui + 1, nxt);
        const char* nA = has_next ? (const char*)g.A + (size_t)nxt.pm * tstep : cA; const char* nB = has_next ? (const char*)g.Bt + (size_t)nxt.pn * tstep : cB;
        for (int t = 0; t < nt; t += 2) {
            const bool last = (t == nt - 2);
            const char* a1 = cA + (size_t)(t + 1) * kstep;
            const char* a2 = last ? nA : cA + (size_t)(t + 2) * kstep; const char* b2 = last ? nB : cB + (size_t)(t + 2) * kstep;
            const char* a3 = a2 + kstep; const char* b3 = b2 + kstep;

            if constexpr (SP2) {
            PG8_LDB(B0, 0, 0); PG8_LDB(B1, 0, 1); PG8_SCHED; PG8_LDA(At, 0, 0); PG8_STAGE(PG8_SA(1, 1), a1 + hstep, voffA);
            PG8_WAIT_V(8); PG8_WAIT_L(0); PG8_BAR; PG8_MMA(0, 0, At, B0); PG8_MMA(0, 1, At, B1); PG8_BAR; PG8_SCHED;
            PG8_LDA(At, 0, 1); PG8_STAGE(PG8_SB(0, 0), b2, voffB); PG8_STAGE(PG8_SB(0, 1), b2 + hstep, voffB); PG8_STAGE(PG8_SA(0, 0), a2, voffA);
            PG8_WAIT_V(8); PG8_WAIT_L(0); PG8_BAR; PG8_MMA(1, 0, At, B0); PG8_MMA(1, 1, At, B1); PG8_BAR; PG8_SCHED;
            PG8_LDB(B0, 1, 0); PG8_LDB(B1, 1, 1); PG8_SCHED; PG8_LDA(At, 1, 0); PG8_STAGE(PG8_SA(0, 1), a2 + hstep, voffA);
            PG8_WAIT_V(8); PG8_WAIT_L(0); PG8_BAR; PG8_MMA(0, 0, At, B0); PG8_MMA(0, 1, At, B1); PG8_BAR; PG8_SCHED;
            PG8_LDA(At, 1, 1); PG8_STAGE(PG8_SB(1, 0), b3, voffB); PG8_STAGE(PG8_SB(1, 1), b3 + hstep, voffB); PG8_STAGE(PG8_SA(1, 0), a3, voffA);
            PG8_WAIT_V(8); PG8_WAIT_L(0); PG8_BAR; PG8_MMA(1, 0, At, B0); PG8_MMA(1, 1, At, B1); PG8_BAR; PG8_SCHED;
            } else {
            PG8_LDB(B0, 0, 0); PG8_SCHED; PG8_LDA(At, 0, 0); PG8_STAGE(PG8_SA(1, 1), a1 + hstep, voffA);
            PG8_WAIT_L(8); PG8_BAR; PG8_WAIT_L(0); PG8_MMA(0, 0, At, B0); PG8_BAR; PG8_SCHED;
            PG8_LDB(B1, 0, 1); PG8_STAGE(PG8_SB(0, 0), b2, voffB);
            PG8_BAR; PG8_WAIT_L(0); PG8_MMA(0, 1, At, B1); PG8_BAR;
            PG8_LDA(At, 0, 1); PG8_STAGE(PG8_SA(0, 0), a2, voffA);
            PG8_BAR; PG8_WAIT_L(0); PG8_MMA(1, 0, At, B0); PG8_BAR; PG8_SCHED;
            PG8_STAGE(PG8_SB(0, 1), b2 + hstep, voffB);
            PG8_WAIT_V(6); PG8_BAR; PG8_MMA(1, 1, At, B1); PG8_BAR;
            PG8_LDB(B0, 1, 0); PG8_SCHED; PG8_LDA(At, 1, 0); PG8_STAGE(PG8_SA(0, 1), a2 + hstep, voffA);
            PG8_WAIT_L(8); PG8_BAR; PG8_WAIT_L(0); PG8_MMA(0, 0, At, B0); PG8_BAR; PG8_SCHED;
            PG8_LDB(B1, 1, 1); PG8_STAGE(PG8_SB(1, 0), b3, voffB);
            PG8_BAR; PG8_WAIT_L(0); PG8_MMA(0, 1, At, B1); PG8_BAR;
            PG8_LDA(At, 1, 1); PG8_STAGE(PG8_SA(1, 0), a3, voffA);
            PG8_BAR; PG8_WAIT_L(0); PG8_MMA(1, 0, At, B0); PG8_BAR; PG8_SCHED;
            PG8_STAGE(PG8_SB(1, 1), b3 + hstep, voffB);
            PG8_WAIT_V(6); PG8_BAR; PG8_MMA(1, 1, At, B1); PG8_BAR;
            }
        }
        if constexpr (ALIGN_EPI) { if (wr == 0) PG8_BAR; }
        E(acc, cur, wr, wc, fr, fq);
        if (!has_next) break;
#pragma unroll
        for (int a = 0; a < 2; ++a)
#pragma unroll
            for (int b = 0; b < 2; ++b)
#pragma unroll
                for (int m = 0; m < 4; ++m)
#pragma unroll
                    for (int n = 0; n < 2; ++n) acc[a][b][m][n] = (f32x4){0.f, 0.f, 0.f, 0.f};
        cur = nxt; cA = nA; cB = nB; ++ui;
        if constexpr (ALIGN_EPI) { if (wr == 1) PG8_BAR; }
    }
    PG8_WAIT_V(0);
    if constexpr (!ALIGN_EPI) { if (wr == 0) PG8_BAR; }
    PG8_BAR;
#undef PG8_SA
#undef PG8_SB
#undef PG8_STAGE
#undef PG8_LDA
#undef PG8_LDB
#undef PG8_MMA
#undef PG8_WAIT_V
#undef PG8_WAIT_L
#undef PG8_BAR
#undef PG8_SCHED
}
}
using pg8::Unit;

#define EPI_ROWS(ai, m) (u.pm * 256 + (ai) * 128 + wr * 64 + (m) * 16 + fr)
struct EpiSwiglu {
    bf16_t* H;
    __device__ __forceinline__ void operator()(const f32x4 (&acc)[2][2][4][2], const Unit& u, int wr, int wc, int fr, int fq) const {
        const int col = u.pn * 128 + wc * 32 + 8 * fq;
#pragma unroll
        for (int ai = 0; ai < 2; ++ai)
#pragma unroll
            for (int m = 0; m < 4; ++m) {
                const size_t row = EPI_ROWS(ai, m);
                float h[8];
#pragma unroll
                for (int n = 0; n < 2; ++n)
#pragma unroll
                    for (int j = 0; j < 4; ++j) { const float g = acc[ai][0][m][n][j], uu = acc[ai][1][m][n][j]; h[4 * n + j] = g * uu * sigmoid_f(g); }
                u32x4 w; w.x = cvt_pk_bf16(h[0], h[1]); w.y = cvt_pk_bf16(h[2], h[3]); w.z = cvt_pk_bf16(h[4], h[5]); w.w = cvt_pk_bf16(h[6], h[7]);
                *(u32x4*)(H + row * FH + col) = w;
            }
    }
};
template <bool RES_BF16, bool HAS_MUL, bool OUT_BF16 = false>
struct EpiResid {
    const void* res; const bf16_t* mul; float* Y; float scale;
    __device__ __forceinline__ void operator()(const f32x4 (&acc)[2][2][4][2], const Unit& u, int wr, int wc, int fr, int fq) const {
#pragma unroll
        for (int ai = 0; ai < 2; ++ai)
#pragma unroll
            for (int m = 0; m < 4; ++m) {
                const size_t row = EPI_ROWS(ai, m);
#pragma unroll
                for (int bj = 0; bj < 2; ++bj) {
                    const size_t off = row * DM + u.pn * 256 + bj * 128 + wc * 32 + 8 * fq;
                    float r[8];
                    if (RES_BF16) { const u32x4 rv = *(const u32x4*)((const bf16_t*)res + off);
                        r[0] = bf_lo(rv.x); r[1] = bf_hi(rv.x); r[2] = bf_lo(rv.y); r[3] = bf_hi(rv.y); r[4] = bf_lo(rv.z); r[5] = bf_hi(rv.z); r[6] = bf_lo(rv.w); r[7] = bf_hi(rv.w); }
                    else { const f32x4 a = *(const f32x4*)((const float*)res + off), b = *(const f32x4*)((const float*)res + off + 4);
                        r[0] = a[0]; r[1] = a[1]; r[2] = a[2]; r[3] = a[3]; r[4] = b[0]; r[5] = b[1]; r[6] = b[2]; r[7] = b[3]; }
                    float mv[8];
                    if (HAS_MUL) { const u32x4 rv = *(const u32x4*)(mul + off);
                        mv[0] = bf_lo(rv.x); mv[1] = bf_hi(rv.x); mv[2] = bf_lo(rv.y); mv[3] = bf_hi(rv.y); mv[4] = bf_lo(rv.z); mv[5] = bf_hi(rv.z); mv[6] = bf_lo(rv.w); mv[7] = bf_hi(rv.w); }
                    f32x4 o0, o1;
#pragma unroll
                    for (int j = 0; j < 4; ++j) {
                        const float a0 = acc[ai][bj][m][0][j] * scale, a1 = acc[ai][bj][m][1][j] * scale;
                        o0[j] = ALPHA * r[j] + (HAS_MUL ? mv[j] * a0 : a0); o1[j] = ALPHA * r[4 + j] + (HAS_MUL ? mv[4 + j] * a1 : a1); }
                    if (OUT_BF16) { u32x4 w; w.x = cvt_pk_bf16(o0[0], o0[1]); w.y = cvt_pk_bf16(o0[2], o0[3]); w.z = cvt_pk_bf16(o1[0], o1[1]); w.w = cvt_pk_bf16(o1[2], o1[3]); *(u32x4*)((bf16_t*)Y + off) = w; }
                    else { *(f32x4*)(Y + off) = o0; *(f32x4*)(Y + off + 4) = o1; }
                }
            }
    }
};
struct EpiWin {
    bf16_t* proj; bf16_t* gates; float* ifg; const float* bias;
    __device__ __forceinline__ void operator()(const f32x4 (&acc)[2][2][4][2], const Unit& u, int wr, int wc, int fr, int fq) const {
        const int pn = u.pn;
        if (pn == 32) {
            if (wc == 0 && fq == 0) {
                const f32x4 bi = *(const f32x4*)(bias + 8192), bf = *(const f32x4*)(bias + 8196);
#pragma unroll
                for (int ai = 0; ai < 2; ++ai)
#pragma unroll
                    for (int m = 0; m < 4; ++m) {
                        const size_t row = EPI_ROWS(ai, m);
                        f32x4 iv = acc[ai][0][m][0] + bi, fv = acc[ai][0][m][1] + bf, lf;
#pragma unroll
                        for (int j = 0; j < 4; ++j) { const float xx = fv[j]; lf[j] = xx >= 0.f ? -log1pf(expf(-xx)) : xx - log1pf(expf(xx)); }
                        *(f32x4*)(ifg + row * 8) = iv; *(f32x4*)(ifg + row * 8 + 4) = lf;
                    }
            }
            return;
        }
        bf16_t* dst; int ld, c0; int act = 0; float sc = 1.0f;
        if (pn < 24) { const int sec = pn >> 2; dst = proj + (size_t)sec * ((size_t)MTOK * DM); ld = DM; c0 = (pn & 3) * 256; if (sec == 2) act = 1; if (sec == 3) sc = 0.08838834764831845f * LOG2E; }
        else { dst = gates; ld = 2 * DM; c0 = (pn - 24) * 256; act = 1; }
#pragma unroll
        for (int bj = 0; bj < 2; ++bj) {
            const int cl = bj * 128 + wc * 32 + 8 * fq;
            const f32x4 b0 = *(const f32x4*)(bias + pn * 256 + cl), b1 = *(const f32x4*)(bias + pn * 256 + cl + 4);
#pragma unroll
            for (int ai = 0; ai < 2; ++ai)
#pragma unroll
                for (int m = 0; m < 4; ++m) {
                    const size_t row = EPI_ROWS(ai, m);
                    f32x4 v0 = acc[ai][bj][m][0] + b0, v1 = acc[ai][bj][m][1] + b1;
                    if (act) {
#pragma unroll
                        for (int j = 0; j < 4; ++j) { v0[j] = sigmoid_f(v0[j]); v1[j] = sigmoid_f(v1[j]); } }
                    else { v0 *= sc; v1 *= sc; }
                    u32x4 w; w.x = cvt_pk_bf16(v0[0], v0[1]); w.y = cvt_pk_bf16(v0[2], v0[3]); w.z = cvt_pk_bf16(v1[0], v1[1]); w.w = cvt_pk_bf16(v1[2], v1[3]);
                    *(u32x4*)(dst + row * ld + c0 + cl) = w;
                }
        }
    }
};
template <bool ADD>
struct EpiGateMul {
    const bf16_t* gate; int goff; const bf16_t* tin; bf16_t* out;
    __device__ __forceinline__ void operator()(const f32x4 (&acc)[2][2][4][2], const Unit& u, int wr, int wc, int fr, int fq) const {
#pragma unroll
        for (int ai = 0; ai < 2; ++ai)
#pragma unroll
            for (int m = 0; m < 4; ++m) {
                const size_t row = EPI_ROWS(ai, m);
#pragma unroll
                for (int bj = 0; bj < 2; ++bj) {
                    const int c = u.pn * 256 + bj * 128 + wc * 32 + 8 * fq;
                    const u32x4 gv = *(const u32x4*)(gate + row * (2 * DM) + goff + c);
                    float gg[8] = {bf_lo(gv.x), bf_hi(gv.x), bf_lo(gv.y), bf_hi(gv.y), bf_lo(gv.z), bf_hi(gv.z), bf_lo(gv.w), bf_hi(gv.w)};
                    float tt[8] = {0.f, 0.f, 0.f, 0.f, 0.f, 0.f, 0.f, 0.f};
                    if (ADD) { const u32x4 tv = *(const u32x4*)(tin + row * DM + c);
                        tt[0] = bf_lo(tv.x); tt[1] = bf_hi(tv.x); tt[2] = bf_lo(tv.y); tt[3] = bf_hi(tv.y); tt[4] = bf_lo(tv.z); tt[5] = bf_hi(tv.z); tt[6] = bf_lo(tv.w); tt[7] = bf_hi(tv.w); }
                    float o[8];
#pragma unroll
                    for (int j = 0; j < 4; ++j) { o[j] = tt[j] + gg[j] * acc[ai][bj][m][0][j]; o[4 + j] = tt[4 + j] + gg[4 + j] * acc[ai][bj][m][1][j]; }
                    u32x4 w; w.x = cvt_pk_bf16(o[0], o[1]); w.y = cvt_pk_bf16(o[2], o[3]); w.z = cvt_pk_bf16(o[4], o[5]); w.w = cvt_pk_bf16(o[6], o[7]);
                    *(u32x4*)(out + row * DM + c) = w;
                }
            }
    }
};
struct EpiSigBias {
    const float* bias; bf16_t* out;
    __device__ __forceinline__ void operator()(const f32x4 (&acc)[2][2][4][2], const Unit& u, int wr, int wc, int fr, int fq) const {
#pragma unroll
        for (int bj = 0; bj < 2; ++bj) {
            const int c = u.pn * 256 + bj * 128 + wc * 32 + 8 * fq;
            const f32x4 b0 = *(const f32x4*)(bias + c), b1 = *(const f32x4*)(bias + c + 4);
#pragma unroll
            for (int ai = 0; ai < 2; ++ai)
#pragma unroll
                for (int m = 0; m < 4; ++m) {
                    const size_t row = EPI_ROWS(ai, m);
                    f32x4 v0 = acc[ai][bj][m][0] + b0, v1 = acc[ai][bj][m][1] + b1;
#pragma unroll
                    for (int j = 0; j < 4; ++j) { v0[j] = sigmoid_f(v0[j]); v1[j] = sigmoid_f(v1[j]); }
                    u32x4 w; w.x = cvt_pk_bf16(v0[0], v0[1]); w.y = cvt_pk_bf16(v0[2], v0[3]); w.z = cvt_pk_bf16(v1[0], v1[1]); w.w = cvt_pk_bf16(v1[2], v1[3]);
                    *(u32x4*)(out + row * DM + c) = w;
                }
        }
    }
};

struct Params {
    const float *x, *p, *ln_g, *ln_b, *wg, *wu, *wd, *w_in, *b_in, *b_forget, *conv_w, *conv_b, *mh_g, *w_a, *w_b, *w_o, *w_ple, *w_pg, *b_pg;
    float* out; unsigned char* ws;
    int ph_lo, ph_hi, coop, pad;
};

__device__ void cvt_bf16_phase(const float* src, bf16_t* dst, size_t n8) {
    const size_t stride = (size_t)gridDim.x * NTHREADS;
    size_t i = (size_t)blockIdx.x * NTHREADS + threadIdx.x;
    for (; i + 3 * stride < n8; i += 4 * stride) {
        f32x4 a[4], b[4];
#pragma unroll
        for (int u = 0; u < 4; ++u) { a[u] = *(const f32x4*)(src + (i + u * stride) * 8); b[u] = *(const f32x4*)(src + (i + u * stride) * 8 + 4); }
#pragma unroll
        for (int u = 0; u < 4; ++u) { u32x4 w; w.x = cvt_pk_bf16(a[u][0], a[u][1]); w.y = cvt_pk_bf16(a[u][2], a[u][3]); w.z = cvt_pk_bf16(b[u][0], b[u][1]); w.w = cvt_pk_bf16(b[u][2], b[u][3]);
            *(u32x4*)(dst + (i + u * stride) * 8) = w; }
    }
    for (; i < n8; i += stride) {
        const f32x4 a = *(const f32x4*)(src + i * 8), b = *(const f32x4*)(src + i * 8 + 4);
        u32x4 w; w.x = cvt_pk_bf16(a[0], a[1]); w.y = cvt_pk_bf16(a[2], a[3]); w.z = cvt_pk_bf16(b[0], b[1]); w.w = cvt_pk_bf16(b[2], b[3]);
        *(u32x4*)(dst + i * 8) = w;
    }
}
template <int MODE>
__device__ __forceinline__ f32x4 tsrc_val4(const float* w0, const float* w1, int ldn, int k, int n) {
    if (MODE == 0) return *(const f32x4*)(w0 + (size_t)k * ldn + n);
    if (MODE == 1) { const int pn = n >> 8, sel = (n >> 7) & 1, i = n & 127; const float* w = sel ? w1 : w0; return *(const f32x4*)(w + (size_t)k * ldn + pn * 128 + i); }
    int col; if (n < 3072) col = n; else if (n < 8192) col = n + 8; else if (n < 8200) col = 3072 + (n - 8192); else return (f32x4){0.f, 0.f, 0.f, 0.f};
    return *(const f32x4*)(w0 + (size_t)k * ldn + col);
}
template <int MODE>
__device__ __forceinline__ void transpose_mat(LAS float* tile, const float* w0, const float* w1, int ldn, bf16_t* dst, int NP, int K, int& base) {
    const int tid = threadIdx.x;
    const int tn = NP / 128, tk = K / 128, nt = tn * tk;
    int first = ((int)blockIdx.x - base) % (int)gridDim.x; if (first < 0) first += gridDim.x;
    for (int t = first; t < nt; t += gridDim.x) {
        const int n0 = (t / tk) * 128, k0 = (t % tk) * 128;
#pragma unroll
        for (int e = 0; e < 8; ++e) { const int idx = e * NTHREADS + tid, kk = idx >> 5, n4 = (idx & 31) * 4; const f32x4 v = tsrc_val4<MODE>(w0, w1, ldn, k0 + kk, n0 + n4);
            tile[kk * 129 + n4] = v[0]; tile[kk * 129 + n4 + 1] = v[1]; tile[kk * 129 + n4 + 2] = v[2]; tile[kk * 129 + n4 + 3] = v[3]; }
        __syncthreads();
#pragma unroll 8
        for (int e = 0; e < 16; ++e) { const int idx = e * NTHREADS + tid, nn = idx >> 6, kk = (idx & 63) * 2;
            *(unsigned*)(dst + (size_t)(n0 + nn) * K + k0 + kk) = cvt_pk_bf16(tile[kk * 129 + nn], tile[(kk + 1) * 129 + nn]); }
        __syncthreads();
    }
    base += nt;
}
__device__ void prep_phase(const Params& P, LAS unsigned char* lds) {
    unsigned char* ws = P.ws;
    cvt_bf16_phase(P.x, (bf16_t*)(ws + WS_X), (size_t)MTOK * DM / 8);
    if (blockIdx.x == 0 && threadIdx.x < 64) ((unsigned*)(ws + MISC_CNT))[threadIdx.x] = 0u;
    for (int n = blockIdx.x * NTHREADS + threadIdx.x; n < NIN_PAD; n += gridDim.x * NTHREADS) {
        float b;
        if (n < 3072) b = P.b_in[n]; else if (n < 8192) b = P.b_in[n + 8]; else if (n < 8196) b = P.b_in[3072 + n - 8192];
        else if (n < 8200) b = P.b_in[3072 + n - 8192] + P.b_forget[n - 8196]; else b = 0.f;
        ((float*)(ws + W_BIAS))[n] = b;
    }
    LAS float* tile = (LAS float*)lds;
    int base = 0;
    transpose_mat<1>(tile, P.wg, P.wu, FH, (bf16_t*)(ws + W_GU1), 5632, 1024, base);
    transpose_mat<0>(tile, P.wd, nullptr, DM, (bf16_t*)(ws + W_D1), 1024, FH, base);
    transpose_mat<1>(tile, P.wg + (size_t)DM * FH, P.wu + (size_t)DM * FH, FH, (bf16_t*)(ws + W_GU2), 5632, 1024, base);
    transpose_mat<0>(tile, P.wd + (size_t)DM * FH, nullptr, DM, (bf16_t*)(ws + W_D2), 1024, FH, base);
    transpose_mat<2>(tile, P.w_in, nullptr, 8200, (bf16_t*)(ws + W_IN), NIN_PAD, 1024, base);
    transpose_mat<0>(tile, P.w_a, nullptr, DM, (bf16_t*)(ws + W_A), 1024, 1024, base);
    transpose_mat<0>(tile, P.w_b, nullptr, DM, (bf16_t*)(ws + W_B), 1024, 1024, base);
    transpose_mat<0>(tile, P.w_o, nullptr, DM, (bf16_t*)(ws + W_O), 1024, 1024, base);
    transpose_mat<0>(tile, P.w_pg, nullptr, DM, (bf16_t*)(ws + W_PG), 1024, 1024, base);
    transpose_mat<0>(tile, P.w_ple, nullptr, DM, (bf16_t*)(ws + W_P), 1024, 256, base);
}
template <bool OUT_BF16, bool IN_BF16 = false>
__device__ void ln_phase(const float* Y, const float* g, const float* b, void* out) {
    const int wid = threadIdx.x >> 6, lane = threadIdx.x & 63;
    f32x4 gv[4], bv[4];
#pragma unroll
    for (int i = 0; i < 4; ++i) { gv[i] = *(const f32x4*)(g + i * 256 + lane * 4); bv[i] = *(const f32x4*)(b + i * 256 + lane * 4); }
    for (int row0 = (blockIdx.x * 8 + wid) * 2; row0 < MTOK; row0 += gridDim.x * 16) {
        f32x4 v[2][4]; float s[2] = {0.f, 0.f};
#pragma unroll
        for (int r = 0; r < 2; ++r)
#pragma unroll
            for (int i = 0; i < 4; ++i) {
                if (IN_BF16) { const u32x2 t = *(const u32x2*)((const bf16_t*)Y + (size_t)(row0 + r) * DM + i * 256 + lane * 4); v[r][i] = (f32x4){bf_lo(t.x), bf_hi(t.x), bf_lo(t.y), bf_hi(t.y)}; }
                else v[r][i] = *(const f32x4*)(Y + (size_t)(row0 + r) * DM + i * 256 + lane * 4); }
#pragma unroll
        for (int r = 0; r < 2; ++r) {
#pragma unroll
            for (int i = 0; i < 4; ++i) s[r] += (v[r][i][0] + v[r][i][1]) + (v[r][i][2] + v[r][i][3]);
            const float mean = wave_sum(s[r]) * (1.0f / DM);
            float q = 0.f;
#pragma unroll
            for (int i = 0; i < 4; ++i) { const f32x4 d = v[r][i] - mean; q += (d[0] * d[0] + d[1] * d[1]) + (d[2] * d[2] + d[3] * d[3]); }
            const float rstd = rsqrtf(wave_sum(q) * (1.0f / DM) + LN_EPS);
#pragma unroll
            for (int i = 0; i < 4; ++i) {
                const f32x4 o = (v[r][i] - mean) * rstd * gv[i] + bv[i];
                if (OUT_BF16) { u32x2 w; w.x = cvt_pk_bf16(o[0], o[1]); w.y = cvt_pk_bf16(o[2], o[3]); *(u32x2*)((bf16_t*)out + (size_t)(row0 + r) * DM + i * 256 + lane * 4) = w; }
                else *(f32x4*)((float*)out + (size_t)(row0 + r) * DM + i * 256 + lane * 4) = o;
            }
        }
    }
}

constexpr int L_QI = 0, L_KI = 17408, L_KT = 34816, L_VT = 53248, L_PI = 90112, L_F = 99328;
constexpr int F_N = 0, F_QN = 128, F_RS = 192, F_HS = 320, F_BL = 1344, F_GM = 1472, F_M = 1600, F_CW = 1732, F_SA = 3012, F_SB2 = 3028, F_SMU = 4052, F_SWI = 5076, F_SWN = 6100, F_SEM = 7124, F_END = 8148;
constexpr int MIX_LDS = L_F + F_END * 4;

__device__ void mlstm_prologue(const Params& P, LAS unsigned char* lds, int b, int h, int gi) {
    LAS float* F = (LAS float*)(lds + L_F);
    const float* ifg = (const float*)(P.ws + MISC_IF);
    const int tid = threadIdx.x, w = tid >> 6, lane = tid & 63;
    const int nch = 16 * (gi + 1);
    for (int c0 = w; c0 < nch; c0 += 32) {
        float ivv[4], lfv[4];
#pragma unroll
        for (int u = 0; u < 4; ++u) { const int c = c0 + 8 * u; if (c < nch) { const size_t tok = (size_t)b * SEQ + c * 64 + lane; ivv[u] = ifg[tok * 8 + h]; lfv[u] = ifg[tok * 8 + 4 + h]; } else { ivv[u] = 0.f; lfv[u] = 0.f; } }
#pragma unroll
        for (int u = 0; u < 4; ++u) { const int c = c0 + 8 * u; if (c < nch) {
            const float bc = wave_incl_sum(lfv[u], lane);
            const float bl = __shfl(bc, 63);
            const float gm = wave_max(bl - bc + ivv[u]);
            if (lane == 0) { F[F_BL + c] = bl; F[F_GM + c] = gm; } } }
    }
    for (int i = tid; i < 1280; i += NTHREADS) {
        const int j = i >> 8, ch = i & 255; const int gc = ch < 128 ? h * 128 + ch : 512 + h * 128 + (ch - 128);
        F[F_CW + i] = j < 4 ? P.conv_w[j * 1024 + gc] : P.conv_b[gc];
    }
    if (tid < 128) F[F_N + tid] = 0.f;
    __syncthreads();
    if (tid == 0) { float m = 0.f; F[F_M] = 0.f; for (int c = 0; c < nch; ++c) { m = fmaxf(F[F_BL + c] + m, F[F_GM + c]); F[F_M + c + 1] = m; } }
    __syncthreads();
    for (int lc = w; lc < 16; lc += 8) {
        const int c = gi * 16 + lc;
        const size_t tok = (size_t)b * SEQ + c * 64 + lane;
        const float iv = ifg[tok * 8 + h], lf = ifg[tok * 8 + 4 + h];
        const float bc = wave_incl_sum(lf, lane);
        const float bl = __shfl(bc, 63);
        const float mst = F[F_M + c], mnew = F[F_M + c + 1];
        const float beta = iv - bc;
        const float mu = fmaxf(mst, wave_incl_max(beta, lane));
        F[F_SB2 + lc * 64 + lane] = beta * LOG2E;
        F[F_SMU + lc * 64 + lane] = mu * LOG2E;
        F[F_SWI + lc * 64 + lane] = expf(mst - mu);
        F[F_SWN + lc * 64 + lane] = expf(bl - bc + iv - mnew);
        F[F_SEM + lc * 64 + lane] = expf(-(bc + mu));
        if (lane == 0) F[F_SA + lc] = expf(bl + mst - mnew);
    }
    __syncthreads();
}

struct MlRaw { u32x4 vr[4]; u32x4 raw[7]; };
template <bool NEED_Q>
__device__ __forceinline__ void mlstm_issue(const Params& P, int b, int h, int c, MlRaw& R) {
    const bf16_t* QK = (const bf16_t*)(P.ws + WS_QK);
    const bf16_t* VA = (const bf16_t*)(P.ws + WS_VA);
    const int tid = threadIdx.x, tg = tid & 15, cg = tid >> 4;
#pragma unroll
    for (int tt = 0; tt < 4; ++tt) R.vr[tt] = *(const u32x4*)(VA + ((size_t)b * SEQ + c * 64 + 4 * tg + tt) * DM + h * 256 + 8 * cg);
    if (NEED_Q || cg >= 16) {
        const int gc = cg < 16 ? h * 128 + 8 * cg : 512 + h * 128 + 8 * (cg - 16);
#pragma unroll
        for (int i = 0; i < 7; ++i) {
            const int pos = c * 64 + 4 * tg - 3 + i;
            R.raw[i] = pos >= 0 ? *(const u32x4*)(QK + ((size_t)b * SEQ + pos) * DM + gc) : (u32x4){0u, 0u, 0u, 0u};
        }
    }
}
template <bool NEED_Q>
__device__ __forceinline__ void mlstm_load(LAS unsigned char* lds, const MlRaw& R, int lc) {
    LAS float* F = (LAS float*)(lds + L_F);
    const int tid = threadIdx.x, tg = tid & 15, cg = tid >> 4;
    {
        const u32x4 (&vr)[4] = R.vr;
#pragma unroll
        for (int e = 0; e < 8; ++e) {
            unsigned short x0, x1, x2, x3;
            { const unsigned a0 = vr[0][e >> 1], a1 = vr[1][e >> 1], a2 = vr[2][e >> 1], a3 = vr[3][e >> 1];
              if (e & 1) { x0 = a0 >> 16; x1 = a1 >> 16; x2 = a2 >> 16; x3 = a3 >> 16; } else { x0 = a0 & 0xffff; x1 = a1 & 0xffff; x2 = a2 & 0xffff; x3 = a3 & 0xffff; } }
            u32x2 wv; wv.x = (unsigned)x0 | ((unsigned)x1 << 16); wv.y = (unsigned)x2 | ((unsigned)x3 << 16);
            *(LAS u32x2*)(lds + L_VT + (8 * cg + e) * 144 + 8 * tg) = wv;
        }
    }
    __builtin_amdgcn_sched_barrier(0);
    if (NEED_Q || cg >= 16) {
        const u32x4 (&raw)[7] = R.raw;
        float o[4][8];
#pragma unroll
        for (int e = 0; e < 8; ++e) {
            float rv[7];
#pragma unroll
            for (int i = 0; i < 7; ++i) rv[i] = (e & 1) ? bf_hi(raw[i][e >> 1]) : bf_lo(raw[i][e >> 1]);
            const float w0 = F[F_CW + 0 * 256 + 8 * cg + e], w1 = F[F_CW + 1 * 256 + 8 * cg + e], w2 = F[F_CW + 2 * 256 + 8 * cg + e], w3 = F[F_CW + 3 * 256 + 8 * cg + e], cb = F[F_CW + 4 * 256 + 8 * cg + e];
#pragma unroll
            for (int tt = 0; tt < 4; ++tt) { const float v = cb + w0 * rv[tt] + w1 * rv[tt + 1] + w2 * rv[tt + 2] + w3 * rv[tt + 3]; o[tt][e] = v * sigmoid_f(v); }
            __builtin_amdgcn_sched_barrier(0);
        }
        if (cg < 16) {
#pragma unroll
            for (int tt = 0; tt < 4; ++tt) { u32x4 wv; wv.x = cvt_pk_bf16(o[tt][0], o[tt][1]); wv.y = cvt_pk_bf16(o[tt][2], o[tt][3]); wv.z = cvt_pk_bf16(o[tt][4], o[tt][5]); wv.w = cvt_pk_bf16(o[tt][6], o[tt][7]);
                *(LAS u32x4*)(lds + L_QI + (4 * tg + tt) * 272 + 16 * cg) = wv; }
        } else {
            const int kc = cg - 16;
            const f32x4 wn = *(const LAS f32x4*)(F + F_SWN + lc * 64 + 4 * tg);
#pragma unroll
            for (int tt = 0; tt < 4; ++tt) {
#pragma unroll
                for (int e = 0; e < 8; ++e) o[tt][e] *= 0.08838834764831845f;
                u32x4 wv; wv.x = cvt_pk_bf16(o[tt][0], o[tt][1]); wv.y = cvt_pk_bf16(o[tt][2], o[tt][3]); wv.z = cvt_pk_bf16(o[tt][4], o[tt][5]); wv.w = cvt_pk_bf16(o[tt][6], o[tt][7]);
                *(LAS u32x4*)(lds + L_KI + (4 * tg + tt) * 272 + 16 * kc) = wv; }
#pragma unroll
            for (int e = 0; e < 8; ++e) { u32x2 wv; wv.x = cvt_pk_bf16(o[0][e] * wn[0], o[1][e] * wn[1]); wv.y = cvt_pk_bf16(o[2][e] * wn[2], o[3][e] * wn[3]);
                *(LAS u32x2*)(lds + L_KT + (8 * kc + e) * 144 + 8 * tg) = wv; }
        }
    }
}

__device__ __forceinline__ void mlstm_update(LAS unsigned char* lds, f32x4 (&C)[2][8], int lc, int w, int r, int g) {
    LAS float* F = (LAS float*)(lds + L_F);
    const float a = F[F_SA + lc];
    const LAS unsigned char* vp = lds + (L_VT + (32 * w + r) * 144 + 16 * g);
    const LAS unsigned char* kp = lds + (L_KT + r * 144 + 16 * g);
#pragma unroll
    for (int dvb = 0; dvb < 2; ++dvb)
#pragma unroll
        for (int dkb = 0; dkb < 8; ++dkb) C[dvb][dkb] *= a;
#pragma unroll
    for (int ks = 0; ks < 2; ++ks) {
        bf16x8 vf[2];
#pragma unroll
        for (int dvb = 0; dvb < 2; ++dvb) vf[dvb] = *(const LAS bf16x8*)(vp + (16 * dvb * 144 + 64 * ks));
#pragma unroll
        for (int dkb = 0; dkb < 8; ++dkb) {
            const bf16x8 kf = *(const LAS bf16x8*)(kp + (16 * dkb * 144 + 64 * ks));
#pragma unroll
            for (int dvb = 0; dvb < 2; ++dvb) C[dvb][dkb] = mfma16(kf, vf[dvb], C[dvb][dkb]);
        }
        __builtin_amdgcn_sched_barrier(0);
    }
    const int tid = threadIdx.x, dk = tid >> 2, part = tid & 3;
    const u32x4 k0 = *(const LAS u32x4*)(lds + L_KT + dk * 144 + 32 * part), k1 = *(const LAS u32x4*)(lds + L_KT + dk * 144 + 32 * part + 16);
    float s = 0.f;
#pragma unroll
    for (int i = 0; i < 4; ++i) s += bf_lo(k0[i]) + bf_hi(k0[i]) + bf_lo(k1[i]) + bf_hi(k1[i]);
    s += __shfl_xor(s, 1); s += __shfl_xor(s, 2);
    if (part == 0) F[F_N + dk] = a * F[F_N + dk] + s;
}

__device__ void mlstm_phase1(const Params& P, LAS unsigned char* lds) {
    const int tid = threadIdx.x, w = tid >> 6, lane = tid & 63, r = lane & 15, g = lane >> 4;
    LAS float* F = (LAS float*)(lds + L_F);
    for (int task = blockIdx.x; task < 256; task += gridDim.x) {
        const int gi = task & 7, st = task >> 3, b = st >> 2, h = st & 3;
        if (gi == 7) continue;
        mlstm_prologue(P, lds, b, h, gi);
        f32x4 C[2][8];
#pragma unroll
        for (int i = 0; i < 2; ++i)
#pragma unroll
            for (int j = 0; j < 8; ++j) C[i][j] = (f32x4){0.f, 0.f, 0.f, 0.f};
        MlRaw R;
        mlstm_issue<false>(P, b, h, gi * 16, R);
        for (int lc = 0; lc < 16; ++lc) {
            mlstm_load<false>(lds, R, lc);
            __syncthreads();
            if (lc < 15) mlstm_issue<false>(P, b, h, gi * 16 + lc + 1, R);
            mlstm_update(lds, C, lc, w, r, g);
            __syncthreads();
        }
        float* slot = (float*)(P.ws + WS_PB) + (size_t)(st * 7 + gi) * STATE_FLOATS;
#pragma unroll
        for (int dvb = 0; dvb < 2; ++dvb)
#pragma unroll
            for (int dkb = 0; dkb < 8; ++dkb) *(f32x4*)(slot + (((w * 2 + dvb) * 8 + dkb) * 64 + lane) * 4) = C[dvb][dkb];
        if (tid < 128) slot[32768 + tid] = F[F_N + tid];
        __syncthreads();
    }
}

__device__ void mlstm_phase2(const Params& P, LAS unsigned char* lds) {
    const int tid = threadIdx.x, w = tid >> 6, lane = tid & 63, r = lane & 15, g = lane >> 4;
    LAS float* F = (LAS float*)(lds + L_F);
    const bf16_t* OA = (const bf16_t*)(P.ws + WS_OA);
    bf16_t* VA = (bf16_t*)(P.ws + WS_VA);
    for (int task = blockIdx.x; task < 256; task += gridDim.x) {
        const int gi = task & 7, st = task >> 3, b = st >> 2, h = st & 3;
        mlstm_prologue(P, lds, b, h, gi);
        f32x4 C[2][8];
#pragma unroll
        for (int i = 0; i < 2; ++i)
#pragma unroll
            for (int j = 0; j < 8; ++j) C[i][j] = (f32x4){0.f, 0.f, 0.f, 0.f};
        float nreg = 0.f;
        for (int j = 0; j < gi; ++j) {
            float Bj = 0.f;
            for (int c = 0; c < 16; ++c) Bj += F[F_BL + j * 16 + c];
            const float Aj = expf(Bj + F[F_M + 16 * j] - F[F_M + 16 * j + 16]);
            const float* slot = (const float*)(P.ws + WS_PB) + (size_t)(st * 7 + j) * STATE_FLOATS;
#pragma unroll
            for (int dvb = 0; dvb < 2; ++dvb)
#pragma unroll
                for (int dkb = 0; dkb < 8; ++dkb) C[dvb][dkb] = C[dvb][dkb] * Aj + *(const f32x4*)(slot + (((w * 2 + dvb) * 8 + dkb) * 64 + lane) * 4);
            if (tid < 128) nreg = nreg * Aj + slot[32768 + tid];
        }
        if (tid < 128) F[F_N + tid] = nreg;
        __syncthreads();
        for (int lc = 0; lc < 16; ++lc) {
            const int c = gi * 16 + lc;
            MlRaw R;
            mlstm_issue<true>(P, b, h, c, R);
            mlstm_load<true>(lds, R, lc);
            __syncthreads();
            {
                const int tb = w >> 1, par = w & 1;
                const LAS unsigned char* qpS = lds + (L_QI + (16 * tb + r) * 272 + 16 * g);
                const LAS unsigned char* kpS = lds + (L_KI + (16 * par + r) * 272 + 16 * g);
                LAS unsigned char* ppS = lds + (L_PI + (16 * tb + r) * 144 + 32 * par + 8 * g);
                bf16x8 qf[4];
#pragma unroll
                for (int kd = 0; kd < 4; ++kd) qf[kd] = *(const LAS bf16x8*)(qpS + 64 * kd);
                const float mu2 = F[F_SMU + lc * 64 + 16 * tb + r];
                float rs = 0.f;
#pragma unroll
                for (int sbi = 0; sbi < 2; ++sbi) {
                    const int sb = par + 2 * sbi;
                    u32x2 pw = (u32x2){0u, 0u};
                    if (sb <= tb) {
                        f32x4 acc = (f32x4){0.f, 0.f, 0.f, 0.f};
#pragma unroll
                        for (int kd = 0; kd < 4; ++kd) { const bf16x8 kf = *(const LAS bf16x8*)(kpS + (32 * sbi * 272 + 64 * kd)); acc = mfma16(kf, qf[kd], acc); }
                        const f32x4 b2 = *(const LAS f32x4*)(F + F_SB2 + lc * 64 + 16 * sb + 4 * g);
                        float pv[4];
#pragma unroll
                        for (int j = 0; j < 4; ++j) { const int s = 16 * sb + 4 * g + j, t = 16 * tb + r; pv[j] = (s <= t) ? acc[j] * fast_exp2(b2[j] - mu2) : 0.f; }
                        pw.x = cvt_pk_bf16(pv[0], pv[1]); pw.y = cvt_pk_bf16(pv[2], pv[3]);
                        rs += bf_lo(pw.x) + bf_hi(pw.x) + bf_lo(pw.y) + bf_hi(pw.y);
                    }
                    *(LAS u32x2*)(ppS + 64 * sbi) = pw;
                }
                rs += __shfl_xor(rs, 16); rs += __shfl_xor(rs, 32);
                if (g == 0) F[F_RS + par * 64 + 16 * tb + r] = rs;
            }
            __builtin_amdgcn_sched_barrier(0);
            const LAS unsigned char* q8p = lds + (L_QI + r * 272 + 8 * g);
            f32x4 num[2][4];
#pragma unroll
            for (int i = 0; i < 2; ++i)
#pragma unroll
                for (int j = 0; j < 4; ++j) num[i][j] = (f32x4){0.f, 0.f, 0.f, 0.f};
#pragma unroll
            for (int kk = 0; kk < 4; ++kk) {
                bf16x8 af[2];
#pragma unroll
                for (int dvb = 0; dvb < 2; ++dvb) {
                    u32x2 lo, hi; lo.x = cvt_pk_bf16(C[dvb][2 * kk][0], C[dvb][2 * kk][1]); lo.y = cvt_pk_bf16(C[dvb][2 * kk][2], C[dvb][2 * kk][3]);
                    hi.x = cvt_pk_bf16(C[dvb][2 * kk + 1][0], C[dvb][2 * kk + 1][1]); hi.y = cvt_pk_bf16(C[dvb][2 * kk + 1][2], C[dvb][2 * kk + 1][3]);
                    af[dvb] = mk8(lo, hi);
                }
#pragma unroll
                for (int tb = 0; tb < 4; ++tb) {
                    const u32x2 q0 = *(const LAS u32x2*)(q8p + (16 * tb * 272 + 64 * kk)), q1 = *(const LAS u32x2*)(q8p + (16 * tb * 272 + 64 * kk + 32));
                    const bf16x8 bq = mk8(q0, q1);
#pragma unroll
                    for (int dvb = 0; dvb < 2; ++dvb) num[dvb][tb] = mfma16(af[dvb], bq, num[dvb][tb]);
                }
                __builtin_amdgcn_sched_barrier(0);
            }
#pragma unroll
            for (int tb = 0; tb < 4; ++tb) { const float wi = F[F_SWI + lc * 64 + 16 * tb + r];
#pragma unroll
                for (int dvb = 0; dvb < 2; ++dvb) num[dvb][tb] *= wi; }
            {
                const int t = tid >> 3, part = tid & 7;
                const u32x4 q0 = *(const LAS u32x4*)(lds + L_QI + t * 272 + 32 * part), q1 = *(const LAS u32x4*)(lds + L_QI + t * 272 + 32 * part + 16);
                float s = 0.f;
#pragma unroll
                for (int i = 0; i < 4; ++i) {
                    s += bf_lo(q0[i]) * F[F_N + 16 * part + 2 * i] + bf_hi(q0[i]) * F[F_N + 16 * part + 2 * i + 1];
                    s += bf_lo(q1[i]) * F[F_N + 16 * part + 8 + 2 * i] + bf_hi(q1[i]) * F[F_N + 16 * part + 8 + 2 * i + 1];
                }
                s += __shfl_xor(s, 1); s += __shfl_xor(s, 2); s += __shfl_xor(s, 4);
                if (part == 0) F[F_QN + t] = s;
            }
            __builtin_amdgcn_sched_barrier(0);
            __syncthreads();
            const LAS unsigned char* vpC = lds + (L_VT + (32 * w + r) * 144 + 16 * g);
            const LAS unsigned char* ppC = lds + (L_PI + r * 144 + 16 * g);
#pragma unroll
            for (int ks = 0; ks < 2; ++ks) {
                bf16x8 vf[2];
#pragma unroll
                for (int dvb = 0; dvb < 2; ++dvb) vf[dvb] = *(const LAS bf16x8*)(vpC + (16 * dvb * 144 + 64 * ks));
#pragma unroll
                for (int tb = 0; tb < 4; ++tb) {
                    if (ks == 0 || tb >= 2) {
                        const bf16x8 pb = *(const LAS bf16x8*)(ppC + (16 * tb * 144 + 64 * ks));
#pragma unroll
                        for (int dvb = 0; dvb < 2; ++dvb) num[dvb][tb] = mfma16(vf[dvb], pb, num[dvb][tb]);
                    }
                }
                __builtin_amdgcn_sched_barrier(0);
            }
#pragma unroll
            for (int tb = 0; tb < 4; ++tb) {
                const int t = 16 * tb + r;
                const float den = F[F_SWI + lc * 64 + t] * F[F_QN + t] + F[F_RS + t] + F[F_RS + 64 + t];
                const float inv = 1.0f / fmaxf(fabsf(den), F[F_SEM + lc * 64 + t]);
                float s1 = 0.f, s2 = 0.f;
#pragma unroll
                for (int dvb = 0; dvb < 2; ++dvb) { num[dvb][tb] *= inv;
#pragma unroll
                    for (int j = 0; j < 4; ++j) { const float v = num[dvb][tb][j]; s1 += v; s2 += v * v; } }
                s1 += __shfl_xor(s1, 16); s1 += __shfl_xor(s1, 32); s2 += __shfl_xor(s2, 16); s2 += __shfl_xor(s2, 32);
                if (g == 0) { F[F_HS + (w * 64 + t) * 2] = s1; F[F_HS + (w * 64 + t) * 2 + 1] = s2; }
                __builtin_amdgcn_sched_barrier(0);
            }
            mlstm_update(lds, C, lc, w, r, g);
            __builtin_amdgcn_sched_barrier(0);
            __syncthreads();
#pragma unroll
            for (int tb = 0; tb < 4; ++tb) {
                const int t = 16 * tb + r;
                float s1 = 0.f, s2 = 0.f;
#pragma unroll
                for (int ww = 0; ww < 8; ++ww) { s1 += F[F_HS + (ww * 64 + t) * 2]; s2 += F[F_HS + (ww * 64 + t) * 2 + 1]; }
                const float mean = s1 * (1.0f / 256.0f), var = fmaxf(s2 * (1.0f / 256.0f) - mean * mean, 0.f), rstd = rsqrtf(var + LN_EPS);
                const size_t tok = (size_t)b * SEQ + c * 64 + t;
#pragma unroll
                for (int dvb = 0; dvb < 2; ++dvb) {
                    const int dv0 = 32 * w + 16 * dvb + 4 * g;
                    const f32x4 gn = *(const f32x4*)(P.mh_g + h * 256 + dv0);
                    const u32x2 og = *(const u32x2*)(OA + tok * DM + h * 256 + dv0);
                    const float y0 = (num[dvb][tb][0] - mean) * rstd * gn[0] * bf_lo(og.x), y1 = (num[dvb][tb][1] - mean) * rstd * gn[1] * bf_hi(og.x);
                    const float y2 = (num[dvb][tb][2] - mean) * rstd * gn[2] * bf_lo(og.y), y3 = (num[dvb][tb][3] - mean) * rstd * gn[3] * bf_hi(og.y);
                    u32x2 wv; wv.x = cvt_pk_bf16(y0, y1); wv.y = cvt_pk_bf16(y2, y3);
                    *(u32x2*)(VA + tok * DM + h * 256 + dv0) = wv;
                }
            }
        }
        __syncthreads();
    }
}

constexpr int A_KI = 0, A_VT = 17408, A_FL = 35840;
constexpr float SB_DONE_LOG2 = -40.0f;

__device__ void attn_phase(const Params& P, LAS unsigned char* lds) {
    const int tid = threadIdx.x, w = tid >> 6, lane = tid & 63, r = lane & 15, g = lane >> 4;
    bf16_t* QB = (bf16_t*)(P.ws + WS_QB);
    const bf16_t* KB = (const bf16_t*)(P.ws + WS_KB);
    const bf16_t* VB = (const bf16_t*)(P.ws + WS_VB);
    unsigned* cnt = (unsigned*)(P.ws + MISC_CNT);
    LAS int* FL = (LAS int*)(lds + A_FL);
    for (;;) {
        if (tid == 0) FL[32] = (int)atomicAdd(cnt, 1u);
        __syncthreads();
        const int item = FL[32];
        __syncthreads();
        if (item >= 4096) break;
        const int qb = 63 - (item >> 6), b = (item >> 3) & 7, h = item & 7;
        const int q0w = qb * 128 + 16 * w;
        const size_t qtok = (size_t)b * SEQ + q0w + r;
        bf16x8 qf[4];
#pragma unroll
        for (int kd = 0; kd < 4; ++kd) qf[kd] = *(const bf16x8*)(QB + qtok * DM + h * 128 + 32 * kd + 8 * g);
        f32x4 O[8];
#pragma unroll
        for (int i = 0; i < 8; ++i) O[i] = (f32x4){0.f, 0.f, 0.f, 0.f};
        float R = 0.f;
        int wdone = 0, it = 0;
        u32x4 pre[4];
        const int ptg = tid & 15, pcg = (tid >> 4) & 15, prow = (tid - 256) >> 2, pch = tid & 3;
        auto issue_tile = [&](int kt_) {
            if (tid < 256) {
#pragma unroll
                for (int tt = 0; tt < 4; ++tt) pre[tt] = *(const u32x4*)(VB + ((size_t)b * SEQ + kt_ * 64 + 4 * ptg + tt) * DM + h * 128 + 8 * pcg);
            } else {
                const bf16_t* src_ = KB + ((size_t)b * SEQ + kt_ * 64 + prow) * DM + h * 128 + 32 * pch;
#pragma unroll
                for (int i = 0; i < 4; ++i) pre[i] = *(const u32x4*)(src_ + 8 * i);
            }
        };
        issue_tile(2 * qb + 1);
        for (int kt = 2 * qb + 1; kt >= 0; --kt, ++it) {
            if (tid < 256) {
#pragma unroll
                for (int e = 0; e < 8; ++e) {
                    unsigned short x0, x1, x2, x3;
                    { const unsigned a0 = pre[0][e >> 1], a1 = pre[1][e >> 1], a2 = pre[2][e >> 1], a3 = pre[3][e >> 1];
                      if (e & 1) { x0 = a0 >> 16; x1 = a1 >> 16; x2 = a2 >> 16; x3 = a3 >> 16; } else { x0 = a0 & 0xffff; x1 = a1 & 0xffff; x2 = a2 & 0xffff; x3 = a3 & 0xffff; } }
                    u32x2 wv; wv.x = (unsigned)x0 | ((unsigned)x1 << 16); wv.y = (unsigned)x2 | ((unsigned)x3 << 16);
                    *(LAS u32x2*)(lds + A_VT + (8 * pcg + e) * 144 + 8 * ptg) = wv;
                }
            } else {
#pragma unroll
                for (int i = 0; i < 4; ++i) *(LAS u32x4*)(lds + A_KI + prow * 272 + 64 * pch + 16 * i) = pre[i];
            }
            __syncthreads();
            if (kt > 0) issue_tile(kt - 1);
            const int key0 = kt * 64;
            if (!wdone && key0 <= q0w + 14) {
                const int qpos = q0w + r;
                float wgt[4][4];
                float Rrun = R;
#pragma unroll
                for (int sb = 3; sb >= 0; --sb) {
                    f32x4 acc = (f32x4){0.f, 0.f, 0.f, 0.f};
#pragma unroll
                    for (int kd = 0; kd < 4; ++kd) { const bf16x8 kf = *(const LAS bf16x8*)(lds + A_KI + (16 * sb + r) * 272 + 64 * kd + 16 * g); acc = mfma16(kf, qf[kd], acc); }
                    float lk[4], z[4];
#pragma unroll
                    for (int j = 0; j < 4; ++j) {
                        const int key = key0 + 16 * sb + 4 * g + j;
                        z[j] = fminf(acc[j], 80.0f);
                        lk[j] = (key < qpos) ? -fast_log2(1.0f + fast_exp2(z[j])) : 0.f;
                    }
                    const float s3 = lk[3], s2 = s3 + lk[2], s1 = s2 + lk[1], s0 = s1 + lk[0];
                    const float t1 = __shfl_xor(s0, 16), t2 = __shfl_xor(s0, 32), t3 = __shfl_xor(t1, 32);
                    const float above = g == 0 ? (t1 + t2 + t3) : (g == 1 ? (t2 + t3) : (g == 2 ? t1 : 0.f));
                    const float base = Rrun + above;
                    const float sj[4] = {s0, s1, s2, s3};
#pragma unroll
                    for (int j = 0; j < 4; ++j) { const int key = key0 + 16 * sb + 4 * g + j; wgt[sb][j] = (key < qpos) ? fast_exp2(z[j] + base + sj[j]) : 0.f; }
                    Rrun += (s0 + t1) + (t2 + t3);
                }
                R = Rrun;
#pragma unroll
                for (int ks = 0; ks < 2; ++ks) {
                    u32x2 lo, hi; lo.x = cvt_pk_bf16(wgt[2 * ks][0], wgt[2 * ks][1]); lo.y = cvt_pk_bf16(wgt[2 * ks][2], wgt[2 * ks][3]);
                    hi.x = cvt_pk_bf16(wgt[2 * ks + 1][0], wgt[2 * ks + 1][1]); hi.y = cvt_pk_bf16(wgt[2 * ks + 1][2], wgt[2 * ks + 1][3]);
                    const bf16x8 pf = mk8(lo, hi);
#pragma unroll
                    for (int db = 0; db < 8; ++db) {
                        const u32x2 v0 = *(const LAS u32x2*)(lds + A_VT + (16 * db + r) * 144 + 64 * ks + 8 * g), v1 = *(const LAS u32x2*)(lds + A_VT + (16 * db + r) * 144 + 64 * ks + 32 + 8 * g);
                        O[db] = mfma16(mk8(v0, v1), pf, O[db]);
                    }
                }
                wdone = __all(R < SB_DONE_LOG2) ? 1 : 0;
            }
            if (lane == 0) FL[(it & 1) * 8 + w] = wdone;
            __syncthreads();
            int alld = 1;
#pragma unroll
            for (int i = 0; i < 8; ++i) alld &= FL[(it & 1) * 8 + i];
            if (alld) break;
        }
#pragma unroll
        for (int db = 0; db < 8; ++db) { u32x2 wv; wv.x = cvt_pk_bf16(O[db][0], O[db][1]); wv.y = cvt_pk_bf16(O[db][2], O[db][3]);
            *(u32x2*)(QB + qtok * DM + h * 128 + 16 * db + 4 * g) = wv; }
        __syncthreads();
    }
}


#ifdef DIAG
__device__ void diag_count_f32(const float* p, size_t n, float thr, unsigned* ctr) {
    unsigned c = 0;
    for (size_t i = (size_t)blockIdx.x * NTHREADS + threadIdx.x; i < n; i += (size_t)gridDim.x * NTHREADS) { const float v = p[i]; if (!(fabsf(v) <= thr)) ++c; }
    if (c) atomicAdd(ctr, c);
}
__device__ void diag_count_bf16(const bf16_t* p, size_t n, float thr, unsigned* ctr) {
    unsigned c = 0;
    for (size_t i = (size_t)blockIdx.x * NTHREADS + threadIdx.x; i < n; i += (size_t)gridDim.x * NTHREADS) { const float v = __uint_as_float((unsigned)p[i] << 16); if (!(fabsf(v) <= thr)) ++c; }
    if (c) atomicAdd(ctr, c);
}
#endif
#define XB_TMO      128
#define XB_XCNT(j)  (256  + 64 * (j))
#define XB_XSUB(j)  (1280 + 64 * (j))
#define XB_XGEN(j)  (2304 + 64 * (j))
#define XB_TOP      3328
#define XB_TOPGEN   3392
#define XCD_BAR_WORDS 3456
#define XB_SPIN_CAP (1u << 18)

__device__ __forceinline__ unsigned xb_ld(unsigned* p)              { return __hip_atomic_load(p, __ATOMIC_RELAXED, __HIP_MEMORY_SCOPE_AGENT); }
__device__ __forceinline__ unsigned xb_add(unsigned* p, unsigned v) { return __hip_atomic_fetch_add(p, v, __ATOMIC_RELAXED, __HIP_MEMORY_SCOPE_AGENT); }
__device__ __forceinline__ unsigned xb_xcc_id() { return (unsigned)__builtin_amdgcn_s_getreg((3 << 11) | 20) & 0xFu; }
#define XB_SPIN(cond, bar) do { unsigned _sp = 0; while (cond) { __builtin_amdgcn_s_sleep(1); \
    if ((++_sp & 255u) == 0u) { if (xb_ld(&(bar)[XB_TMO])) break; if (_sp > XB_SPIN_CAP) { atomicAdd(&(bar)[XB_TMO], 1u); break; } } } } while (0)

struct XcdBarrier {
    unsigned* bar; unsigned x;
    volatile LAS unsigned* st;
};

__device__ __forceinline__ XcdBarrier xcd_barrier_post(unsigned* bar, volatile LAS unsigned* st) {
    XcdBarrier b; b.bar = bar; b.x = xb_xcc_id(); b.st = st;
    if (threadIdx.x == 0) (void)xb_add(&bar[XB_XCNT(b.x)], 1u);
    return b;
}
__device__ __forceinline__ void xcd_barrier_complete(unsigned* bar, unsigned x, unsigned& nloc, unsigned& nx) {
    const unsigned G = gridDim.x * gridDim.y * gridDim.z;
    unsigned sum, cnt, mine, sp = 0u;
    for (;;) {
        sum = 0u; cnt = 0u; mine = 0u;
#pragma unroll
        for (unsigned j = 0; j < 16; ++j) { const unsigned c = xb_ld(&bar[XB_XCNT(j)]); sum += c; cnt += (c > 0u) ? 1u : 0u; mine = (j == x) ? c : mine; }
        if (sum == G) break;
        __builtin_amdgcn_s_sleep(1);
        if ((++sp & 255u) == 0u) { if (xb_ld(&bar[XB_TMO])) break; if (sp > XB_SPIN_CAP) { atomicAdd(&bar[XB_TMO], 1u); break; } }
    }
    nloc = mine > 0u ? mine : 1u; nx = cnt > 0u ? cnt : 1u;
}

__device__ __forceinline__ void xcd_barrier(const XcdBarrier& b) {
    asm volatile("s_waitcnt vmcnt(0)" ::: "memory");
    __syncthreads();
    if (threadIdx.x == 0) {
        unsigned* bar = b.bar;
        __builtin_amdgcn_s_waitcnt(0);
        unsigned nloc = b.st[0], nx = b.st[1];
        if (nloc == 0u) { xcd_barrier_complete(bar, b.x, nloc, nx); b.st[0] = nloc; b.st[1] = nx; }
        const unsigned old = xb_add(&bar[XB_XSUB(b.x)], 1u);
        const unsigned gen = old / nloc;
        if (old + 1u == (gen + 1u) * nloc) {
            __builtin_amdgcn_fence(__ATOMIC_RELEASE, "agent");
            asm volatile("s_waitcnt vmcnt(0)" ::: "memory");
            const unsigned og = xb_add(&bar[XB_TOP], 1u);
            const unsigned tg = og / nx;
            if (og + 1u == (tg + 1u) * nx) xb_add(&bar[XB_TOPGEN], 1u);
            else XB_SPIN(xb_ld(&bar[XB_TOPGEN]) == tg, bar);
            __builtin_amdgcn_fence(__ATOMIC_ACQUIRE, "agent");
            xb_add(&bar[XB_XGEN(b.x)], 1u);
            asm volatile("s_waitcnt vmcnt(0)" ::: "memory");
        } else {
            XB_SPIN(xb_ld(&bar[XB_XGEN(b.x)]) == gen, bar);
            __builtin_amdgcn_fence(__ATOMIC_ACQUIRE, "agent");
            asm volatile("s_waitcnt vmcnt(0)" ::: "memory");
        }
    }
    __syncthreads();
}

constexpr int LDS_BYTES = 135168;
static_assert(MIX_LDS <= LDS_BYTES && 128 * 129 * 4 <= LDS_BYTES && pg8::STAGE_BYTES <= LDS_BYTES, "LDS budget");
constexpr int NPHASE = 17;

template <class Epi>
__device__ __forceinline__ void run_gemm(LAS unsigned char* lds, const bf16_t* A, const bf16_t* Bt, int N, int K, const Epi& E) {
    pg8::Gemm g{A, Bt, MTOK, N, K};
    pg8::StaticOrder S; S.init(MTOK, N, gridDim.x, blockIdx.x);
    pg8::gemm_phase<Epi, pg8::StaticOrder, true, true>(lds, g, S, E);
}

__global__ void __launch_bounds__(NTHREADS, 2) fwd_megakernel(Params P) {
    extern __shared__ __attribute__((aligned(16))) unsigned char smem[];
    LAS unsigned char* lds = (LAS unsigned char*)smem;
    cg::grid_group grid = cg::this_grid();
    unsigned char* ws = P.ws;
    bf16_t* X = (bf16_t*)(ws + WS_X);
    bf16_t* H = (bf16_t*)(ws + WS_H);
    float* Y = P.out;
    bf16_t* gates = (bf16_t*)P.out;
#ifdef ONLYMASK
#define PHASE(k) if (((ONLYMASK >> (k)) & 1) && P.ph_lo <= (k) && (k) < P.ph_hi)
#else
#define PHASE(k) if (P.ph_lo <= (k) && (k) < P.ph_hi)
#endif
#define SYNC0() do { if (P.coop) { asm volatile("s_waitcnt vmcnt(0) lgkmcnt(0)" ::: "memory"); grid.sync(); \
        if (threadIdx.x < 64) { __builtin_amdgcn_fence(__ATOMIC_ACQUIRE, "agent"); asm volatile("s_waitcnt vmcnt(0)" ::: "memory"); } __syncthreads(); } } while (0)
#define SYNC() do { if (P.coop) xcd_barrier(xb); } while (0)
    volatile LAS unsigned* bst = (volatile LAS unsigned*)(lds + (LDS_BYTES - 16));
    XcdBarrier xb; xb.bar = (unsigned*)(ws + MISC_BAR); xb.x = 0; xb.st = bst;
    if (P.coop) { if (threadIdx.x == 0) { bst[0] = 0u; bst[1] = 0u; } xb = xcd_barrier_post((unsigned*)(ws + MISC_BAR), bst); }
    PHASE(0) prep_phase(P, lds);
    SYNC0();
    PHASE(1) run_gemm(lds, X, (const bf16_t*)(ws + W_GU1), 5632, 1024, EpiSwiglu{H});
    SYNC();
    PHASE(2) run_gemm(lds, H, (const bf16_t*)(ws + W_D1), 1024, FH, EpiResid<false, false, true>{P.x, nullptr, Y, 0.5f});
    SYNC();
    PHASE(3) ln_phase<true, true>(Y, P.ln_g, P.ln_b, X);
    SYNC();
    PHASE(4) run_gemm(lds, X, (const bf16_t*)(ws + W_IN), NIN_PAD, 1024, EpiWin{(bf16_t*)(ws + WS_QK), gates, (float*)(ws + MISC_IF), (const float*)(ws + W_BIAS)});
    SYNC();
    PHASE(5) mlstm_phase1(P, lds);
    SYNC();
    PHASE(6) {
#ifndef NO_ML2
        mlstm_phase2(P, lds);
#endif
#ifndef NO_ATT
        attn_phase(P, lds);
#endif
    }
    SYNC();
    PHASE(7) {
        run_gemm(lds, (const bf16_t*)(ws + WS_VA), (const bf16_t*)(ws + W_A), 1024, 1024, EpiGateMul<false>{gates, 0, nullptr, (bf16_t*)(ws + WS_T)});
        run_gemm(lds, (const bf16_t*)(ws + WS_QB), (const bf16_t*)(ws + W_B), 1024, 1024, EpiGateMul<true>{gates, DM, (const bf16_t*)(ws + WS_T), (bf16_t*)(ws + WS_MG)});
    }
    SYNC();
    PHASE(8) run_gemm(lds, (const bf16_t*)(ws + WS_MG), (const bf16_t*)(ws + W_O), 1024, 1024, EpiResid<true, false, true>{X, nullptr, Y, 1.0f});
    SYNC();
    PHASE(9) ln_phase<true, true>(Y, P.ln_g + DM, P.ln_b + DM, X);
    SYNC();
    PHASE(10) run_gemm(lds, X, (const bf16_t*)(ws + W_GU2), 5632, 1024, EpiSwiglu{H});
    SYNC();
    PHASE(11) run_gemm(lds, H, (const bf16_t*)(ws + W_D2), 1024, FH, EpiResid<true, false, true>{X, nullptr, Y, 0.5f});
    SYNC();
    PHASE(12) { ln_phase<true, true>(Y, P.ln_g + 2 * DM, P.ln_b + 2 * DM, X); cvt_bf16_phase(P.p, (bf16_t*)(ws + WS_PB), (size_t)MTOK * 256 / 8); }
    SYNC();
    PHASE(13) {
        run_gemm(lds, X, (const bf16_t*)(ws + W_PG), 1024, 1024, EpiSigBias{P.b_pg, (bf16_t*)(ws + WS_PG)});
        run_gemm(lds, (const bf16_t*)(ws + WS_PB), (const bf16_t*)(ws + W_P), 1024, 256, EpiResid<true, true, true>{X, (const bf16_t*)(ws + WS_PG), (float*)(ws + WS_VA), 1.0f});
    }
    SYNC();
    PHASE(14) ln_phase<false, true>((const float*)(ws + WS_VA), P.ln_g + 3 * DM, P.ln_b + 3 * DM, P.out);
#undef PHASE
#undef SYNC
#undef SYNC0
}

extern "C" void kernel_launch(void* const* d_in, const int* in_sizes, int n_in, void* d_out, int out_size, void* d_ws, size_t ws_size, hipStream_t stream) {
    static int grid_blocks = 0;
    if (grid_blocks == 0) {
        if (n_in != 19 || out_size != MTOK * DM || ws_size < WS_END) { fprintf(stderr, "kernel_launch: unexpected shapes (n_in %d, out %d, ws %zu, need %zu)\n", n_in, out_size, ws_size, (size_t)WS_END); grid_blocks = -1; return; }
        int dev = 0, cus = 0, per_cu = 0;
        hipGetDevice(&dev);
        hipDeviceGetAttribute(&cus, hipDeviceAttributeMultiprocessorCount, dev);
        if (hipFuncSetAttribute((const void*)fwd_megakernel, hipFuncAttributeMaxDynamicSharedMemorySize, LDS_BYTES) != hipSuccess) { fprintf(stderr, "kernel_launch: hipFuncSetAttribute failed\n"); grid_blocks = -1; return; }
        if (hipOccupancyMaxActiveBlocksPerMultiprocessor(&per_cu, (const void*)fwd_megakernel, NTHREADS, LDS_BYTES) != hipSuccess || per_cu < 1) { fprintf(stderr, "kernel_launch: occupancy query failed (%d)\n", per_cu); per_cu = 1; (void)hipGetLastError(); }
        grid_blocks = cus * per_cu;
    }
    if (grid_blocks < 0) return;
    Params p{};
    p.x = (const float*)d_in[0]; p.p = (const float*)d_in[1]; p.ln_g = (const float*)d_in[2]; p.ln_b = (const float*)d_in[3];
    p.wg = (const float*)d_in[4]; p.wu = (const float*)d_in[5]; p.wd = (const float*)d_in[6]; p.w_in = (const float*)d_in[7]; p.b_in = (const float*)d_in[8];
    p.b_forget = (const float*)d_in[9]; p.conv_w = (const float*)d_in[10]; p.conv_b = (const float*)d_in[11]; p.mh_g = (const float*)d_in[12];
    p.w_a = (const float*)d_in[13]; p.w_b = (const float*)d_in[14]; p.w_o = (const float*)d_in[15]; p.w_ple = (const float*)d_in[16]; p.w_pg = (const float*)d_in[17]; p.b_pg = (const float*)d_in[18];
    p.out = (float*)d_out; p.ws = (unsigned char*)d_ws; p.pad = 0;
#if ONE_LAUNCH
    if (hipMemsetAsync((char*)d_ws + MISC_BAR, 0, XCD_BAR_WORDS * 4, stream) != hipSuccess) { fprintf(stderr, "kernel_launch: memset of the barrier words failed\n"); return; }
    p.ph_lo = 0; p.ph_hi = NPHASE; p.coop = 1;
    void* args[] = {&p};
    hipError_t e = hipLaunchCooperativeKernel((const void*)fwd_megakernel, dim3(grid_blocks), dim3(NTHREADS), args, LDS_BYTES, stream);
    if (e != hipSuccess) fprintf(stderr, "cooperative launch failed: %s (grid %d)\n", hipGetErrorString(e), grid_blocks);
#else
    p.coop = 0;
    for (int ph = 0; ph < 15; ++ph) { p.ph_lo = ph; p.ph_hi = ph + 1; hipLaunchKernelGGL(fwd_megakernel, dim3(grid_blocks), dim3(NTHREADS), LDS_BYTES, stream, p); }
#endif
}
```

```cpp
#include <hip/hip_runtime.h>
#include <hip/hip_cooperative_groups.h>
#include <cstdio>
namespace cg = cooperative_groups;

#ifndef ONE_LAUNCH
#define ONE_LAUNCH 1
#endif

#define LAS __attribute__((address_space(3)))
typedef unsigned short bf16_t;
typedef short bf16x8 __attribute__((ext_vector_type(8)));
typedef float f32x4 __attribute__((ext_vector_type(4)));
typedef float f32x2 __attribute__((ext_vector_type(2)));
typedef unsigned u32x4 __attribute__((ext_vector_type(4)));
typedef unsigned u32x2 __attribute__((ext_vector_type(2)));

constexpr int MTOK = 65536, DM = 1024, FH = 2816, SEQ = 8192;
constexpr int NIN_PAD = 8448;
constexpr float ALPHA = 1.189207115002721f;
constexpr float LN_EPS = 1e-5f;
constexpr float LOG2E = 1.4426950408889634f;
constexpr int NTHREADS = 512;

constexpr size_t QB_ = 33554432ull;
constexpr size_t WS_W = 0;
constexpr size_t W_GU1 = 0;
constexpr size_t W_D1 = W_GU1 + 5632ull * 1024 * 2;
constexpr size_t W_GU2 = W_D1 + 1024ull * 2816 * 2;
constexpr size_t W_D2 = W_GU2 + 5632ull * 1024 * 2;
constexpr size_t W_IN = W_D2 + 1024ull * 2816 * 2;
constexpr size_t W_A = W_IN + 8448ull * 1024 * 2;
constexpr size_t W_B = W_A + 1024ull * 1024 * 2;
constexpr size_t W_O = W_B + 1024ull * 1024 * 2;
constexpr size_t W_PG = W_O + 1024ull * 1024 * 2;
constexpr size_t W_P = W_PG + 1024ull * 1024 * 2;
constexpr size_t W_BIAS = W_P + 1024ull * 256 * 2;
static_assert(W_BIAS + 8448 * 4 <= 2 * QB_, "weights overflow");
constexpr size_t WS_PB = 2 * QB_;
constexpr size_t WS_MISC = 3 * QB_;
constexpr size_t MISC_IF = WS_MISC;
constexpr size_t MISC_CNT = WS_MISC + 2097152ull;
constexpr size_t MISC_BAR = MISC_CNT + 4096;
constexpr size_t WS_X = 4 * QB_;
constexpr size_t WS_H = 8 * QB_;
constexpr size_t WS_QK = 8 * QB_, WS_VA = 12 * QB_, WS_OA = 16 * QB_, WS_QB = 20 * QB_, WS_KB = 24 * QB_, WS_VB = 28 * QB_;
constexpr size_t WS_T = WS_QK, WS_MG = WS_KB, WS_PG = 8 * QB_;
constexpr size_t WS_END = 32 * QB_;
constexpr int STATE_FLOATS = 32768 + 128;

typedef __bf16 bf16x2_t __attribute__((ext_vector_type(2)));
__device__ __forceinline__ unsigned cvt_pk_bf16(float lo, float hi) { f32x2 v = {lo, hi}; bf16x2_t r = __builtin_convertvector(v, bf16x2_t); return __builtin_bit_cast(unsigned, r); }
__device__ __forceinline__ float bf_lo(unsigned u) { return __uint_as_float(u << 16); }
__device__ __forceinline__ float bf_hi(unsigned u) { return __uint_as_float(u & 0xffff0000u); }
__device__ __forceinline__ float fast_exp2(float x) { return __builtin_amdgcn_exp2f(x); }
__device__ __forceinline__ float fast_log2(float x) { return __builtin_amdgcn_logf(x); }
__device__ __forceinline__ float fast_rcp(float x) { return __builtin_amdgcn_rcpf(x); }
__device__ __forceinline__ float sigmoid_f(float x) { return fast_rcp(1.0f + fast_exp2(-x * LOG2E)); }
__device__ __forceinline__ f32x4 mfma16(bf16x8 a, bf16x8 b, f32x4 c) { return __builtin_amdgcn_mfma_f32_16x16x32_bf16(a, b, c, 0, 0, 0); }
__device__ __forceinline__ bf16x8 mk8(u32x2 lo, u32x2 hi) { u32x4 v; v.x = lo.x; v.y = lo.y; v.z = hi.x; v.w = hi.y; return __builtin_bit_cast(bf16x8, v); }
__device__ __forceinline__ float wave_sum(float v) {
#pragma unroll
    for (int o = 32; o > 0; o >>= 1) v += __shfl_xor(v, o);
    return v;
}
__device__ __forceinline__ float wave_max(float v) {
#pragma unroll
    for (int o = 32; o > 0; o >>= 1) v = fmaxf(v, __shfl_xor(v, o));
    return v;
}
__device__ __forceinline__ float wave_incl_sum(float v, int lane) {
#pragma unroll
    for (int o = 1; o < 64; o <<= 1) { float t = __shfl_up(v, o); if (lane >= o) v += t; }
    return v;
}
__device__ __forceinline__ float wave_incl_max(float v, int lane) {
#pragma unroll
    for (int o = 1; o < 64; o <<= 1) { float t = __shfl_up(v, o); if (lane >= o) v = fmaxf(v, t); }
    return v;
}

namespace pg8 {
constexpr int BM = 256, BK = 64, HALF = 128, HTB = HALF * BK * 2, STAGE_BYTES = 8 * HTB, NXCD = 8, WGM = 8;
__host__ __device__ __forceinline__ int lds_byte(int r, int c) { const int st = (r >> 4) * 2 + (c >> 5), rr = r & 15, cc = c & 31, ob = rr * 64 + cc * 2; return st * 1024 + (ob ^ (((ob >> 9) & 1) << 5)); }
__host__ __device__ __forceinline__ void stage_rc(int b, int& R, int& C) { const int st = b / 1024, sb = b % 1024, swz = sb ^ (((sb >> 9) & 1) << 5); R = (st >> 1) * 16 + swz / 64; C = (st & 1) * 32 + (swz % 64) / 2; }
__host__ __device__ __forceinline__ int perm32(int rho) { const int n = rho >> 4, i = rho & 15; return 8 * (i >> 2) + 4 * n + (i & 3); }
struct Unit { int pm, pn; };
struct Gemm { const bf16_t* A; const bf16_t* Bt; int M, N, K; };
struct StaticOrder {
    int nM, nN, nwg, G, c;
    __device__ void init(int M, int N, int G_, int c_) { nM = M / BM; nN = N / BM; nwg = nM * nN; G = G_; c = c_; }
    __device__ bool next(int i, Unit& u) const {
        const long L = (long)i * G + c; if (L >= nwg) return false;
        int wgid = (int)L; { const int q = nwg / NXCD, r = nwg % NXCD, xcd = wgid % NXCD, off = wgid / NXCD; wgid = (xcd < r ? xcd * (q + 1) : r * (q + 1) + (xcd - r) * q) + off; }
        const int nig = WGM * nN, gid = wgid / nig, fm = gid * WGM, gsz = (nM - fm) < WGM ? (nM - fm) : WGM;
        u.pm = fm + ((wgid % nig) % gsz); u.pn = (wgid % nig) / gsz; return true;
    }
};
template <class Epi, class Sched, bool ALIGN_EPI = false, bool SP2 = false>
__device__ __forceinline__ void gemm_phase(LAS unsigned char* lds, const Gemm g, const Sched& S, const Epi& E) {
    const int tid = threadIdx.x, wid = __builtin_amdgcn_readfirstlane(tid >> 6), lane = tid & 63, wr = wid >> 2, wc = wid & 3, fr = lane & 15, fq = lane >> 4;
    const int K = g.K, nt = K / BK;
    unsigned voffA[2], voffB[2];
#pragma unroll
    for (int i = 0; i < 2; ++i) { int R, C; stage_rc(tid * 16 + i * 8192, R, C); const int Rb = ((R & ~31) + perm32(R & 31));
        voffA[i] = (unsigned)(R * K + C) * 2u; voffB[i] = (unsigned)(Rb * K + C) * 2u; }
    const size_t kstep = (size_t)(BK * 2);
    const size_t hstep = (size_t)HALF * K * 2;
    const size_t tstep = 2 * hstep;
    const unsigned ldsw = (unsigned)wid * 1024u;
    const int aoff = lds_byte(wr * 64 + fr, fq * 8), boff = lds_byte(wc * 32 + fr, fq * 8);
#define PG8_SA(b, h) (((b) * 2 + (h)) * HTB)
#define PG8_SB(b, h) ((4 + (b) * 2 + (h)) * HTB)
#define PG8_STAGE(bufoff, gbase, voff) do { _Pragma("unroll") for (int _i = 0; _i < 2; ++_i) \
        __builtin_amdgcn_global_load_lds((const unsigned*)((const char*)(gbase) + (voff)[_i]), (LAS unsigned*)(lds + (bufoff) + ldsw + _i * 8192), 16, 0, 0); } while (0)
#define PG8_LDA(dst, b, h) do { _Pragma("unroll") for (int m = 0; m < 4; ++m) _Pragma("unroll") for (int k = 0; k < 2; ++k) dst[m][k] = *(const LAS bf16x8*)(lds + PG8_SA(b, h) + aoff + m * 2048 + k * 1024); } while (0)
#define PG8_LDB(dst, b, h) do { _Pragma("unroll") for (int n = 0; n < 2; ++n) _Pragma("unroll") for (int k = 0; k < 2; ++k) dst[n][k] = *(const LAS bf16x8*)(lds + PG8_SB(b, h) + boff + n * 2048 + k * 1024); } while (0)
#define PG8_MMA(ai, bj, At, Bt) do { __builtin_amdgcn_s_setprio(1); _Pragma("unroll") for (int m = 0; m < 4; ++m) _Pragma("unroll") for (int n = 0; n < 2; ++n) _Pragma("unroll") for (int k = 0; k < 2; ++k) \
        acc[ai][bj][m][n] = __builtin_amdgcn_mfma_f32_16x16x32_bf16(Bt[n][k], At[m][k], acc[ai][bj][m][n], 0, 0, 0); __builtin_amdgcn_s_setprio(0); } while (0)
#define PG8_WAIT_V(n) asm volatile("s_waitcnt vmcnt(" #n ")" ::: "memory")
#define PG8_WAIT_L(n) asm volatile("s_waitcnt lgkmcnt(" #n ")" ::: "memory")
#define PG8_BAR __builtin_amdgcn_s_barrier()
#define PG8_SCHED __builtin_amdgcn_sched_barrier(0)
    Unit cur, nxt; int ui = 0;
    if (!S.next(0, cur)) return;
    f32x4 acc[2][2][4][2];
#pragma unroll
    for (int a = 0; a < 2; ++a)
#pragma unroll
        for (int b = 0; b < 2; ++b)
#pragma unroll
            for (int m = 0; m < 4; ++m)
#pragma unroll
                for (int n = 0; n < 2; ++n) acc[a][b][m][n] = (f32x4){0.f, 0.f, 0.f, 0.f};
    bf16x8 At[4][2], B0[2][2], B1[2][2];
    const char* cA = (const char*)g.A + (size_t)cur.pm * tstep; const char* cB = (const char*)g.Bt + (size_t)cur.pn * tstep;

    if constexpr (SP2) {
        PG8_STAGE(PG8_SB(0, 0), cB, voffB); PG8_STAGE(PG8_SB(0, 1), cB + hstep, voffB); PG8_STAGE(PG8_SA(0, 0), cA, voffA); PG8_STAGE(PG8_SA(0, 1), cA + hstep, voffA);
        if (wr == 1) PG8_BAR;
        PG8_WAIT_V(2); PG8_BAR;
        PG8_STAGE(PG8_SB(1, 0), cB + kstep, voffB); PG8_STAGE(PG8_SA(1, 0), cA + kstep, voffA); PG8_STAGE(PG8_SB(1, 1), cB + hstep + kstep, voffB);
        PG8_WAIT_V(6); PG8_BAR;
    } else {
        PG8_STAGE(PG8_SB(0, 0), cB, voffB); PG8_STAGE(PG8_SA(0, 0), cA, voffA); PG8_STAGE(PG8_SB(0, 1), cB + hstep, voffB); PG8_STAGE(PG8_SA(0, 1), cA + hstep, voffA);
        if (wr == 1) PG8_BAR;
        PG8_WAIT_V(4); PG8_BAR;
        PG8_STAGE(PG8_SB(1, 0), cB + kstep, voffB); PG8_STAGE(PG8_SA(1, 0), cA + kstep, voffA); PG8_STAGE(PG8_SB(1, 1), cB + hstep + kstep, voffB);
        PG8_WAIT_V(6); PG8_BAR;
    }
    for (;;) {
        const bool has_next = S.next(ui + 1, nxt);
        const char* nA = has_next ? (const char*)g.A + (size_t)nxt.pm * tstep : cA; const char* nB = has_next ? (const char*)g.Bt + (size_t)nxt.pn * tstep : cB;
        for (int t = 0; t < nt; t += 2) {
            const bool last = (t == nt - 2);
            const char* a1 = cA + (size_t)(t + 1) * kstep;
            const char* a2 = last ? nA : cA + (size_t)(t + 2) * kstep; const char* b2 = last ? nB : cB + (size_t)(t + 2) * kstep;
            const char* a3 = a2 + kstep; const char* b3 = b2 + kstep;

            if constexpr (SP2) {
            PG8_LDB(B0, 0, 0); PG8_LDB(B1, 0, 1); PG8_SCHED; PG8_LDA(At, 0, 0); PG8_STAGE(PG8_SA(1, 1), a1 + hstep, voffA);
            PG8_WAIT_V(8); PG8_WAIT_L(0); PG8_BAR; PG8_MMA(0, 0, At, B0); PG8_MMA(0, 1, At, B1); PG8_BAR; PG8_SCHED;
            PG8_LDA(At, 0, 1); PG8_STAGE(PG8_SB(0, 0), b2, voffB); PG8_STAGE(PG8_SB(0, 1), b2 + hstep, voffB); PG8_STAGE(PG8_SA(0, 0), a2, voffA);
            PG8_WAIT_V(8); PG8_WAIT_L(0); PG8_BAR; PG8_MMA(1, 0, At, B0); PG8_MMA(1, 1, At, B1); PG8_BAR; PG8_SCHED;
            PG8_LDB(B0, 1, 0); PG8_LDB(B1, 1, 1); PG8_SCHED; PG8_LDA(At, 1, 0); PG8_STAGE(PG8_SA(0, 1), a2 + hstep, voffA);
            PG8_WAIT_V(8); PG8_WAIT_L(0); PG8_BAR; PG8_MMA(0, 0, At, B0); PG8_MMA(0, 1, At, B1); PG8_BAR; PG8_SCHED;
            PG8_LDA(At, 1, 1); PG8_STAGE(PG8_SB(1, 0), b3, voffB); PG8_STAGE(PG8_SB(1, 1), b3 + hstep, voffB); PG8_STAGE(PG8_SA(1, 0), a3, voffA);
            PG8_WAIT_V(8); PG8_WAIT_L(0); PG8_BAR; PG8_MMA(1, 0, At, B0); PG8_MMA(1, 1, At, B1); PG8_BAR; PG8_SCHED;
            } else {
            PG8_LDB(B0, 0, 0); PG8_SCHED; PG8_LDA(At, 0, 0); PG8_STAGE(PG8_SA(1, 1), a1 + hstep, voffA);
            PG8_WAIT_L(8); PG8_BAR; PG8_WAIT_L(0); PG8_MMA(0, 0, At, B0); PG8_BAR; PG8_SCHED;
            PG8_LDB(B1, 0, 1); PG8_STAGE(PG8_SB(0, 0), b2, voffB);
            PG8_BAR; PG8_WAIT_L(0); PG8_MMA(0, 1, At, B1); PG8_BAR;
            PG8_LDA(At, 0, 1); PG8_STAGE(PG8_SA(0, 0), a2, voffA);
            PG8_BAR; PG8_WAIT_L(0); PG8_MMA(1, 0, At, B0); PG8_BAR; PG8_SCHED;
            PG8_STAGE(PG8_SB(0, 1), b2 + hstep, voffB);
            PG8_WAIT_V(6); PG8_BAR; PG8_MMA(1, 1, At, B1); PG8_BAR;
            PG8_LDB(B0, 1, 0); PG8_SCHED; PG8_LDA(At, 1, 0); PG8_STAGE(PG8_SA(0, 1), a2 + hstep, voffA);
            PG8_WAIT_L(8); PG8_BAR; PG8_WAIT_L(0); PG8_MMA(0, 0, At, B0); PG8_BAR; PG8_SCHED;
            PG8_LDB(B1, 1, 1); PG8_STAGE(PG8_SB(1, 0), b3, voffB);
            PG8_BAR; PG8_WAIT_L(0); PG8_MMA(0, 1, At, B1); PG8_BAR;
            PG8_LDA(At, 1, 1); PG8_STAGE(PG8_SA(1, 0), a3, voffA);
            PG8_BAR; PG8_WAIT_L(0); PG8_MMA(1, 0, At, B0); PG8_BAR; PG8_SCHED;
            PG8_STAGE(PG8_SB(1, 1), b3 + hstep, voffB);
            PG8_WAIT_V(6); PG8_BAR; PG8_MMA(1, 1, At, B1); PG8_BAR;
            }
        }
        if constexpr (ALIGN_EPI) { if (wr == 0) PG8_BAR; }
        E(acc, cur, wr, wc, fr, fq);
        if (!has_next) break;
#pragma unroll
        for (int a = 0; a < 2; ++a)
#pragma unroll
            for (int b = 0; b < 2; ++b)
#pragma unroll
                for (int m = 0; m < 4; ++m)
#pragma unroll
                    for (int n = 0; n < 2; ++n) acc[a][b][m][n] = (f32x4){0.f, 0.f, 0.f, 0.f};
        cur = nxt; cA = nA; cB = nB; ++ui;
        if constexpr (ALIGN_EPI) { if (wr == 1) PG8_BAR; }
    }
    PG8_WAIT_V(0);
    if constexpr (!ALIGN_EPI) { if (wr == 0) PG8_BAR; }
    PG8_BAR;
#undef PG8_SA
#undef PG8_SB
#undef PG8_STAGE
#undef PG8_LDA
#undef PG8_LDB
#undef PG8_MMA
#undef PG8_WAIT_V
#undef PG8_WAIT_L
#undef PG8_BAR
#undef PG8_SCHED
}
}
using pg8::Unit;

#define EPI_ROWS(ai, m) (u.pm * 256 + (ai) * 128 + wr * 64 + (m) * 16 + fr)
struct EpiSwiglu {
    bf16_t* H;
    __device__ __forceinline__ void operator()(const f32x4 (&acc)[2][2][4][2], const Unit& u, int wr, int wc, int fr, int fq) const {
        const int col = u.pn * 128 + wc * 32 + 8 * fq;
#pragma unroll
        for (int ai = 0; ai < 2; ++ai)
#pragma unroll
            for (int m = 0; m < 4; ++m) {
                const size_t row = EPI_ROWS(ai, m);
                float h[8];
#pragma unroll
                for (int n = 0; n < 2; ++n)
#pragma unroll
                    for (int j = 0; j < 4; ++j) { const float g = acc[ai][0][m][n][j], uu = acc[ai][1][m][n][j]; h[4 * n + j] = g * uu * sigmoid_f(g); }
                u32x4 w; w.x = cvt_pk_bf16(h[0], h[1]); w.y = cvt_pk_bf16(h[2], h[3]); w.z = cvt_pk_bf16(h[4], h[5]); w.w = cvt_pk_bf16(h[6], h[7]);
                *(u32x4*)(H + row * FH + col) = w;
            }
    }
};
template <bool RES_BF16, bool HAS_MUL, bool OUT_BF16 = false>
struct EpiResid {
    const void* res; const bf16_t* mul; float* Y; float scale;
    __device__ __forceinline__ void operator()(const f32x4 (&acc)[2][2][4][2], const Unit& u, int wr, int wc, int fr, int fq) const {
#pragma unroll
        for (int ai = 0; ai < 2; ++ai)
#pragma unroll
            for (int m = 0; m < 4; ++m) {
                const size_t row = EPI_ROWS(ai, m);
#pragma unroll
                for (int bj = 0; bj < 2; ++bj) {
                    const size_t off = row * DM + u.pn * 256 + bj * 128 + wc * 32 + 8 * fq;
                    float r[8];
                    if (RES_BF16) { const u32x4 rv = *(const u32x4*)((const bf16_t*)res + off);
                        r[0] = bf_lo(rv.x); r[1] = bf_hi(rv.x); r[2] = bf_lo(rv.y); r[3] = bf_hi(rv.y); r[4] = bf_lo(rv.z); r[5] = bf_hi(rv.z); r[6] = bf_lo(rv.w); r[7] = bf_hi(rv.w); }
                    else { const f32x4 a = *(const f32x4*)((const float*)res + off), b = *(const f32x4*)((const float*)res + off + 4);
                        r[0] = a[0]; r[1] = a[1]; r[2] = a[2]; r[3] = a[3]; r[4] = b[0]; r[5] = b[1]; r[6] = b[2]; r[7] = b[3]; }
                    float mv[8];
                    if (HAS_MUL) { const u32x4 rv = *(const u32x4*)(mul + off);
                        mv[0] = bf_lo(rv.x); mv[1] = bf_hi(rv.x); mv[2] = bf_lo(rv.y); mv[3] = bf_hi(rv.y); mv[4] = bf_lo(rv.z); mv[5] = bf_hi(rv.z); mv[6] = bf_lo(rv.w); mv[7] = bf_hi(rv.w); }
                    f32x4 o0, o1;
#pragma unroll
                    for (int j = 0; j < 4; ++j) {
                        const float a0 = acc[ai][bj][m][0][j] * scale, a1 = acc[ai][bj][m][1][j] * scale;
                        o0[j] = ALPHA * r[j] + (HAS_MUL ? mv[j] * a0 : a0); o1[j] = ALPHA * r[4 + j] + (HAS_MUL ? mv[4 + j] * a1 : a1); }
                    if (OUT_BF16) { u32x4 w; w.x = cvt_pk_bf16(o0[0], o0[1]); w.y = cvt_pk_bf16(o0[2], o0[3]); w.z = cvt_pk_bf16(o1[0], o1[1]); w.w = cvt_pk_bf16(o1[2], o1[3]); *(u32x4*)((bf16_t*)Y + off) = w; }
                    else { *(f32x4*)(Y + off) = o0; *(f32x4*)(Y + off + 4) = o1; }
                }
            }
    }
};
struct EpiWin {
    bf16_t* proj; bf16_t* gates; float* ifg; const float* bias;
    __device__ __forceinline__ void operator()(const f32x4 (&acc)[2][2][4][2], const Unit& u, int wr, int wc, int fr, int fq) const {
        const int pn = u.pn;
        if (pn == 32) {
            if (wc == 0 && fq == 0) {
                const f32x4 bi = *(const f32x4*)(bias + 8192), bf = *(const f32x4*)(bias + 8196);
#pragma unroll
                for (int ai = 0; ai < 2; ++ai)
#pragma unroll
                    for (int m = 0; m < 4; ++m) {
                        const size_t row = EPI_ROWS(ai, m);
                        f32x4 iv = acc[ai][0][m][0] + bi, fv = acc[ai][0][m][1] + bf, lf;
#pragma unroll
                        for (int j = 0; j < 4; ++j) { const float xx = fv[j]; lf[j] = xx >= 0.f ? -log1pf(expf(-xx)) : xx - log1pf(expf(xx)); }
                        *(f32x4*)(ifg + row * 8) = iv; *(f32x4*)(ifg + row * 8 + 4) = lf;
                    }
            }
            return;
        }
        bf16_t* dst; int ld, c0; int act = 0; float sc = 1.0f;
        if (pn < 24) { const int sec = pn >> 2; dst = proj + (size_t)sec * ((size_t)MTOK * DM); ld = DM; c0 = (pn & 3) * 256; if (sec == 2) act = 1; if (sec == 3) sc = 0.08838834764831845f * LOG2E; }
        else { dst = gates; ld = 2 * DM; c0 = (pn - 24) * 256; act = 1; }
#pragma unroll
        for (int bj = 0; bj < 2; ++bj) {
            const int cl = bj * 128 + wc * 32 + 8 * fq;
            const f32x4 b0 = *(const f32x4*)(bias + pn * 256 + cl), b1 = *(const f32x4*)(bias + pn * 256 + cl + 4);
#pragma unroll
            for (int ai = 0; ai < 2; ++ai)
#pragma unroll
                for (int m = 0; m < 4; ++m) {
                    const size_t row = EPI_ROWS(ai, m);
                    f32x4 v0 = acc[ai][bj][m][0] + b0, v1 = acc[ai][bj][m][1] + b1;
                    if (act) {
#pragma unroll
                        for (int j = 0; j < 4; ++j) { v0[j] = sigmoid_f(v0[j]); v1[j] = sigmoid_f(v1[j]); } }
                    else { v0 *= sc; v1 *= sc; }
                    u32x4 w; w.x = cvt_pk_bf16(v0[0], v0[1]); w.y = cvt_pk_bf16(v0[2], v0[3]); w.z = cvt_pk_bf16(v1[0], v1[1]); w.w = cvt_pk_bf16(v1[2], v1[3]);
                    *(u32x4*)(dst + row * ld + c0 + cl) = w;
                }
        }
    }
};
template <bool ADD>
struct EpiGateMul {
    const bf16_t* gate; int goff; const bf16_t* tin; bf16_t* out;
    __device__ __forceinline__ void operator()(const f32x4 (&acc)[2][2][4][2], const Unit& u, int wr, int wc, int fr, int fq) const {
#pragma unroll
        for (int ai = 0; ai < 2; ++ai)
#pragma unroll
            for (int m = 0; m < 4; ++m) {
                const size_t row = EPI_ROWS(ai, m);
#pragma unroll
                for (int bj = 0; bj < 2; ++bj) {
                    const int c = u.pn * 256 + bj * 128 + wc * 32 + 8 * fq;
                    const u32x4 gv = *(const u32x4*)(gate + row * (2 * DM) + goff + c);
                    float gg[8] = {bf_lo(gv.x), bf_hi(gv.x), bf_lo(gv.y), bf_hi(gv.y), bf_lo(gv.z), bf_hi(gv.z), bf_lo(gv.w), bf_hi(gv.w)};
                    float tt[8] = {0.f, 0.f, 0.f, 0.f, 0.f, 0.f, 0.f, 0.f};
                    if (ADD) { const u32x4 tv = *(const u32x4*)(tin + row * DM + c);
                        tt[0] = bf_lo(tv.x); tt[1] = bf_hi(tv.x); tt[2] = bf_lo(tv.y); tt[3] = bf_hi(tv.y); tt[4] = bf_lo(tv.z); tt[5] = bf_hi(tv.z); tt[6] = bf_lo(tv.w); tt[7] = bf_hi(tv.w); }
                    float o[8];
#pragma unroll
                    for (int j = 0; j < 4; ++j) { o[j] = tt[j] + gg[j] * acc[ai][bj][m][0][j]; o[4 + j] = tt[4 + j] + gg[4 + j] * acc[ai][bj][m][1][j]; }
                    u32x4 w; w.x = cvt_pk_bf16(o[0], o[1]); w.y = cvt_pk_bf16(o[2], o[3]); w.z = cvt_pk_bf16(o[4], o[5]); w.w = cvt_pk_bf16(o[6], o[7]);
                    *(u32x4*)(out + row * DM + c) = w;
                }
            }
    }
};
struct EpiSigBias {
    const float* bias; bf16_t* out;
    __device__ __forceinline__ void operator()(const f32x4 (&acc)[2][2][4][2], const Unit& u, int wr, int wc, int fr, int fq) const {
#pragma unroll
        for (int bj = 0; bj < 2; ++bj) {
            const int c = u.pn * 256 + bj * 128 + wc * 32 + 8 * fq;
            const f32x4 b0 = *(const f32x4*)(bias + c), b1 = *(const f32x4*)(bias + c + 4);
#pragma unroll
            for (int ai = 0; ai < 2; ++ai)
#pragma unroll
                for (int m = 0; m < 4; ++m) {
                    const size_t row = EPI_ROWS(ai, m);
                    f32x4 v0 = acc[ai][bj][m][0] + b0, v1 = acc[ai][bj][m][1] + b1;
#pragma unroll
                    for (int j = 0; j < 4; ++j) { v0[j] = sigmoid_f(v0[j]); v1[j] = sigmoid_f(v1[j]); }
                    u32x4 w; w.x = cvt_pk_bf16(v0[0], v0[1]); w.y = cvt_pk_bf16(v0[2], v0[3]); w.z = cvt_pk_bf16(v1[0], v1[1]); w.w = cvt_pk_bf16(v1[2], v1[3]);
                    *(u32x4*)(out + row * DM + c) = w;
                }
        }
    }
};

struct Params {
    const float *x, *p, *ln_g, *ln_b, *wg, *wu, *wd, *w_in, *b_in, *b_forget, *conv_w, *conv_b, *mh_g, *w_a, *w_b, *w_o, *w_ple, *w_pg, *b_pg;
    float* out; unsigned char* ws;
    int ph_lo, ph_hi, coop, pad;
};

__device__ void cvt_bf16_phase(const float* src, bf16_t* dst, size_t n8) {
    const size_t stride = (size_t)gridDim.x * NTHREADS;
    size_t i = (size_t)blockIdx.x * NTHREADS + threadIdx.x;
    for (; i + 3 * stride < n8; i += 4 * stride) {
        f32x4 a[4], b[4];
#pragma unroll
        for (int u = 0; u < 4; ++u) { a[u] = *(const f32x4*)(src + (i + u * stride) * 8); b[u] = *(const f32x4*)(src + (i + u * stride) * 8 + 4); }
#pragma unroll
        for (int u = 0; u < 4; ++u) { u32x4 w; w.x = cvt_pk_bf16(a[u][0], a[u][1]); w.y = cvt_pk_bf16(a[u][2], a[u][3]); w.z = cvt_pk_bf16(b[u][0], b[u][1]); w.w = cvt_pk_bf16(b[u][2], b[u][3]);
            *(u32x4*)(dst + (i + u * stride) * 8) = w; }
    }
    for (; i < n8; i += stride) {
        const f32x4 a = *(const f32x4*)(src + i * 8), b = *(const f32x4*)(src + i * 8 + 4);
        u32x4 w; w.x = cvt_pk_bf16(a[0], a[1]); w.y = cvt_pk_bf16(a[2], a[3]); w.z = cvt_pk_bf16(b[0], b[1]); w.w = cvt_pk_bf16(b[2], b[3]);
        *(u32x4*)(dst + i * 8) = w;
    }
}
template <int MODE>
__device__ __forceinline__ f32x4 tsrc_val4(const float* w0, const float* w1, int ldn, int k, int n) {
    if (MODE == 0) return *(const f32x4*)(w0 + (size_t)k * ldn + n);
    if (MODE == 1) { const int pn = n >> 8, sel = (n >> 7) & 1, i = n & 127; const float* w = sel ? w1 : w0; return *(const f32x4*)(w + (size_t)k * ldn + pn * 128 + i); }
    int col; if (n < 3072) col = n; else if (n < 8192) col = n + 8; else if (n < 8200) col = 3072 + (n - 8192); else return (f32x4){0.f, 0.f, 0.f, 0.f};
    return *(const f32x4*)(w0 + (size_t)k * ldn + col);
}
template <int MODE>
__device__ __forceinline__ void transpose_mat(LAS float* tile, const float* w0, const float* w1, int ldn, bf16_t* dst, int NP, int K, int& base) {
    const int tid = threadIdx.x;
    const int tn = NP / 128, tk = K / 128, nt = tn * tk;
    int first = ((int)blockIdx.x - base) % (int)gridDim.x; if (first < 0) first += gridDim.x;
    for (int t = first; t < nt; t += gridDim.x) {
        const int n0 = (t / tk) * 128, k0 = (t % tk) * 128;
#pragma unroll
        for (int e = 0; e < 8; ++e) { const int idx = e * NTHREADS + tid, kk = idx >> 5, n4 = (idx & 31) * 4; const f32x4 v = tsrc_val4<MODE>(w0, w1, ldn, k0 + kk, n0 + n4);
            tile[kk * 129 + n4] = v[0]; tile[kk * 129 + n4 + 1] = v[1]; tile[kk * 129 + n4 + 2] = v[2]; tile[kk * 129 + n4 + 3] = v[3]; }
        __syncthreads();
#pragma unroll 8
        for (int e = 0; e < 16; ++e) { const int idx = e * NTHREADS + tid, nn = idx >> 6, kk = (idx & 63) * 2;
            *(unsigned*)(dst + (size_t)(n0 + nn) * K + k0 + kk) = cvt_pk_bf16(tile[kk * 129 + nn], tile[(kk + 1) * 129 + nn]); }
        __syncthreads();
    }
    base += nt;
}
__device__ void prep_phase(const Params& P, LAS unsigned char* lds) {
    unsigned char* ws = P.ws;
    cvt_bf16_phase(P.x, (bf16_t*)(ws + WS_X), (size_t)MTOK * DM / 8);
    if (blockIdx.x == 0 && threadIdx.x < 64) ((unsigned*)(ws + MISC_CNT))[threadIdx.x] = 0u;
    for (int n = blockIdx.x * NTHREADS + threadIdx.x; n < NIN_PAD; n += gridDim.x * NTHREADS) {
        float b;
        if (n < 3072) b = P.b_in[n]; else if (n < 8192) b = P.b_in[n + 8]; else if (n < 8196) b = P.b_in[3072 + n - 8192];
        else if (n < 8200) b = P.b_in[3072 + n - 8192] + P.b_forget[n - 8196]; else b = 0.f;
        ((float*)(ws + W_BIAS))[n] = b;
    }
    LAS float* tile = (LAS float*)lds;
    int base = 0;
    transpose_mat<1>(tile, P.wg, P.wu, FH, (bf16_t*)(ws + W_GU1), 5632, 1024, base);
    transpose_mat<0>(tile, P.wd, nullptr, DM, (bf16_t*)(ws + W_D1), 1024, FH, base);
    transpose_mat<1>(tile, P.wg + (size_t)DM * FH, P.wu + (size_t)DM * FH, FH, (bf16_t*)(ws + W_GU2), 5632, 1024, base);
    transpose_mat<0>(tile, P.wd + (size_t)DM * FH, nullptr, DM, (bf16_t*)(ws + W_D2), 1024, FH, base);
    transpose_mat<2>(tile, P.w_in, nullptr, 8200, (bf16_t*)(ws + W_IN), NIN_PAD, 1024, base);
    transpose_mat<0>(tile, P.w_a, nullptr, DM, (bf16_t*)(ws + W_A), 1024, 1024, base);
    transpose_mat<0>(tile, P.w_b, nullptr, DM, (bf16_t*)(ws + W_B), 1024, 1024, base);
    transpose_mat<0>(tile, P.w_o, nullptr, DM, (bf16_t*)(ws + W_O), 1024, 1024, base);
    transpose_mat<0>(tile, P.w_pg, nullptr, DM, (bf16_t*)(ws + W_PG), 1024, 1024, base);
    transpose_mat<0>(tile, P.w_ple, nullptr, DM, (bf16_t*)(ws + W_P), 1024, 256, base);
}
template <bool OUT_BF16, bool IN_BF16 = false>
__device__ void ln_phase(const float* Y, const float* g, const float* b, void* out) {
    const int wid = threadIdx.x >> 6, lane = threadIdx.x & 63;
    f32x4 gv[4], bv[4];
#pragma unroll
    for (int i = 0; i < 4; ++i) { gv[i] = *(const f32x4*)(g + i * 256 + lane * 4); bv[i] = *(const f32x4*)(b + i * 256 + lane * 4); }
    for (int row0 = (blockIdx.x * 8 + wid) * 2; row0 < MTOK; row0 += gridDim.x * 16) {
        f32x4 v[2][4]; float s[2] = {0.f, 0.f};
#pragma unroll
        for (int r = 0; r < 2; ++r)
#pragma unroll
            for (int i = 0; i < 4; ++i) {
                if (IN_BF16) { const u32x2 t = *(const u32x2*)((const bf16_t*)Y + (size_t)(row0 + r) * DM + i * 256 + lane * 4); v[r][i] = (f32x4){bf_lo(t.x), bf_hi(t.x), bf_lo(t.y), bf_hi(t.y)}; }
                else v[r][i] = *(const f32x4*)(Y + (size_t)(row0 + r) * DM + i * 256 + lane * 4); }
#pragma unroll
        for (int r = 0; r < 2; ++r) {
#pragma unroll
            for (int i = 0; i < 4; ++i) s[r] += (v[r][i][0] + v[r][i][1]) + (v[r][i][2] + v[r][i][3]);
            const float mean = wave_sum(s[r]) * (1.0f / DM);
            float q = 0.f;
#pragma unroll
            for (int i = 0; i < 4; ++i) { const f32x4 d = v[r][i] - mean; q += (d[0] * d[0] + d[1] * d[1]) + (d[2] * d[2] + d[3] * d[3]); }
            const float rstd = rsqrtf(wave_sum(q) * (1.0f / DM) + LN_EPS);
#pragma unroll
            for (int i = 0; i < 4; ++i) {
                const f32x4 o = (v[r][i] - mean) * rstd * gv[i] + bv[i];
                if (OUT_BF16) { u32x2 w; w.x = cvt_pk_bf16(o[0], o[1]); w.y = cvt_pk_bf16(o[2], o[3]); *(u32x2*)((bf16_t*)out + (size_t)(row0 + r) * DM + i * 256 + lane * 4) = w; }
                else *(f32x4*)((float*)out + (size_t)(row0 + r) * DM + i * 256 + lane * 4) = o;
            }
        }
    }
}

constexpr int L_QI = 0, L_KI = 17408, L_KT = 34816, L_VT = 53248, L_PI = 90112, L_F = 99328;
constexpr int F_N = 0, F_QN = 128, F_RS = 192, F_HS = 320, F_BL = 1344, F_GM = 1472, F_M = 1600, F_CW = 1732, F_SA = 3012, F_SB2 = 3028, F_SMU = 4052, F_SWI = 5076, F_SWN = 6100, F_SEM = 7124, F_END = 8148;
constexpr int MIX_LDS = L_F + F_END * 4;

__device__ void mlstm_prologue(const Params& P, LAS unsigned char* lds, int b, int h, int gi) {
    LAS float* F = (LAS float*)(lds + L_F);
    const float* ifg = (const float*)(P.ws + MISC_IF);
    const int tid = threadIdx.x, w = tid >> 6, lane = tid & 63;
    const int nch = 16 * (gi + 1);
    for (int c0 = w; c0 < nch; c0 += 32) {
        float ivv[4], lfv[4];
#pragma unroll
        for (int u = 0; u < 4; ++u) { const int c = c0 + 8 * u; if (c < nch) { const size_t tok = (size_t)b * SEQ + c * 64 + lane; ivv[u] = ifg[tok * 8 + h]; lfv[u] = ifg[tok * 8 + 4 + h]; } else { ivv[u] = 0.f; lfv[u] = 0.f; } }
#pragma unroll
        for (int u = 0; u < 4; ++u) { const int c = c0 + 8 * u; if (c < nch) {
            const float bc = wave_incl_sum(lfv[u], lane);
            const float bl = __shfl(bc, 63);
            const float gm = wave_max(bl - bc + ivv[u]);
            if (lane == 0) { F[F_BL + c] = bl; F[F_GM + c] = gm; } } }
    }
    for (int i = tid; i < 1280; i += NTHREADS) {
        const int j = i >> 8, ch = i & 255; const int gc = ch < 128 ? h * 128 + ch : 512 + h * 128 + (ch - 128);
        F[F_CW + i] = j < 4 ? P.conv_w[j * 1024 + gc] : P.conv_b[gc];
    }
    if (tid < 128) F[F_N + tid] = 0.f;
    __syncthreads();
    if (tid == 0) { float m = 0.f; F[F_M] = 0.f; for (int c = 0; c < nch; ++c) { m = fmaxf(F[F_BL + c] + m, F[F_GM + c]); F[F_M + c + 1] = m; } }
    __syncthreads();
    for (int lc = w; lc < 16; lc += 8) {
        const int c = gi * 16 + lc;
        const size_t tok = (size_t)b * SEQ + c * 64 + lane;
        const float iv = ifg[tok * 8 + h], lf = ifg[tok * 8 + 4 + h];
        const float bc = wave_incl_sum(lf, lane);
        const float bl = __shfl(bc, 63);
        const float mst = F[F_M + c], mnew = F[F_M + c + 1];
        const float beta = iv - bc;
        const float mu = fmaxf(mst, wave_incl_max(beta, lane));
        F[F_SB2 + lc * 64 + lane] = beta * LOG2E;
        F[F_SMU + lc * 64 + lane] = mu * LOG2E;
        F[F_SWI + lc * 64 + lane] = expf(mst - mu);
        F[F_SWN + lc * 64 + lane] = expf(bl - bc + iv - mnew);
        F[F_SEM + lc * 64 + lane] = expf(-(bc + mu));
        if (lane == 0) F[F_SA + lc] = expf(bl + mst - mnew);
    }
    __syncthreads();
}

struct MlRaw { u32x4 vr[4]; u32x4 raw[7]; };
template <bool NEED_Q>
__device__ __forceinline__ void mlstm_issue(const Params& P, int b, int h, int c, MlRaw& R) {
    const bf16_t* QK = (const bf16_t*)(P.ws + WS_QK);
    const bf16_t* VA = (const bf16_t*)(P.ws + WS_VA);
    const int tid = threadIdx.x, tg = tid & 15, cg = tid >> 4;
#pragma unroll
    for (int tt = 0; tt < 4; ++tt) R.vr[tt] = *(const u32x4*)(VA + ((size_t)b * SEQ + c * 64 + 4 * tg + tt) * DM + h * 256 + 8 * cg);
    if (NEED_Q || cg >= 16) {
        const int gc = cg < 16 ? h * 128 + 8 * cg : 512 + h * 128 + 8 * (cg - 16);
#pragma unroll
        for (int i = 0; i < 7; ++i) {
            const int pos = c * 64 + 4 * tg - 3 + i;
            R.raw[i] = pos >= 0 ? *(const u32x4*)(QK + ((size_t)b * SEQ + pos) * DM + gc) : (u32x4){0u, 0u, 0u, 0u};
        }
    }
}
template <bool NEED_Q>
__device__ __forceinline__ void mlstm_load(LAS unsigned char* lds, const MlRaw& R, int lc) {
    LAS float* F = (LAS float*)(lds + L_F);
    const int tid = threadIdx.x, tg = tid & 15, cg = tid >> 4;
    {
        const u32x4 (&vr)[4] = R.vr;
#pragma unroll
        for (int e = 0; e < 8; ++e) {
            unsigned short x0, x1, x2, x3;
            { const unsigned a0 = vr[0][e >> 1], a1 = vr[1][e >> 1], a2 = vr[2][e >> 1], a3 = vr[3][e >> 1];
              if (e & 1) { x0 = a0 >> 16; x1 = a1 >> 16; x2 = a2 >> 16; x3 = a3 >> 16; } else { x0 = a0 & 0xffff; x1 = a1 & 0xffff; x2 = a2 & 0xffff; x3 = a3 & 0xffff; } }
            u32x2 wv; wv.x = (unsigned)x0 | ((unsigned)x1 << 16); wv.y = (unsigned)x2 | ((unsigned)x3 << 16);
            *(LAS u32x2*)(lds + L_VT + (8 * cg + e) * 144 + 8 * tg) = wv;
        }
    }
    __builtin_amdgcn_sched_barrier(0);
    if (NEED_Q || cg >= 16) {
        const u32x4 (&raw)[7] = R.raw;
        float o[4][8];
#pragma unroll
        for (int e = 0; e < 8; ++e) {
            float rv[7];
#pragma unroll
            for (int i = 0; i < 7; ++i) rv[i] = (e & 1) ? bf_hi(raw[i][e >> 1]) : bf_lo(raw[i][e >> 1]);
            const float w0 = F[F_CW + 0 * 256 + 8 * cg + e], w1 = F[F_CW + 1 * 256 + 8 * cg + e], w2 = F[F_CW + 2 * 256 + 8 * cg + e], w3 = F[F_CW + 3 * 256 + 8 * cg + e], cb = F[F_CW + 4 * 256 + 8 * cg + e];
#pragma unroll
            for (int tt = 0; tt < 4; ++tt) { const float v = cb + w0 * rv[tt] + w1 * rv[tt + 1] + w2 * rv[tt + 2] + w3 * rv[tt + 3]; o[tt][e] = v * sigmoid_f(v); }
            __builtin_amdgcn_sched_barrier(0);
        }
        if (cg < 16) {
#pragma unroll
            for (int tt = 0; tt < 4; ++tt) { u32x4 wv; wv.x = cvt_pk_bf16(o[tt][0], o[tt][1]); wv.y = cvt_pk_bf16(o[tt][2], o[tt][3]); wv.z = cvt_pk_bf16(o[tt][4], o[tt][5]); wv.w = cvt_pk_bf16(o[tt][6], o[tt][7]);
                *(LAS u32x4*)(lds + L_QI + (4 * tg + tt) * 272 + 16 * cg) = wv; }
        } else {
            const int kc = cg - 16;
            const f32x4 wn = *(const LAS f32x4*)(F + F_SWN + lc * 64 + 4 * tg);
#pragma unroll
            for (int tt = 0; tt < 4; ++tt) {
#pragma unroll
                for (int e = 0; e < 8; ++e) o[tt][e] *= 0.08838834764831845f;
                u32x4 wv; wv.x = cvt_pk_bf16(o[tt][0], o[tt][1]); wv.y = cvt_pk_bf16(o[tt][2], o[tt][3]); wv.z = cvt_pk_bf16(o[tt][4], o[tt][5]); wv.w = cvt_pk_bf16(o[tt][6], o[tt][7]);
                *(LAS u32x4*)(lds + L_KI + (4 * tg + tt) * 272 + 16 * kc) = wv; }
#pragma unroll
            for (int e = 0; e < 8; ++e) { u32x2 wv; wv.x = cvt_pk_bf16(o[0][e] * wn[0], o[1][e] * wn[1]); wv.y = cvt_pk_bf16(o[2][e] * wn[2], o[3][e] * wn[3]);
                *(LAS u32x2*)(lds + L_KT + (8 * kc + e) * 144 + 8 * tg) = wv; }
        }
    }
}

__device__ __forceinline__ void mlstm_update(LAS unsigned char* lds, f32x4 (&C)[2][8], int lc, int w, int r, int g) {
    LAS float* F = (LAS float*)(lds + L_F);
    const float a = F[F_SA + lc];
    const LAS unsigned char* vp = lds + (L_VT + (32 * w + r) * 144 + 16 * g);
    const LAS unsigned char* kp = lds + (L_KT + r * 144 + 16 * g);
#pragma unroll
    for (int dvb = 0; dvb < 2; ++dvb)
#pragma unroll
        for (int dkb = 0; dkb < 8; ++dkb) C[dvb][dkb] *= a;
#pragma unroll
    for (int ks = 0; ks < 2; ++ks) {
        bf16x8 vf[2];
#pragma unroll
        for (int dvb = 0; dvb < 2; ++dvb) vf[dvb] = *(const LAS bf16x8*)(vp + (16 * dvb * 144 + 64 * ks));
#pragma unroll
        for (int dkb = 0; dkb < 8; ++dkb) {
            const bf16x8 kf = *(const LAS bf16x8*)(kp + (16 * dkb * 144 + 64 * ks));
#pragma unroll
            for (int dvb = 0; dvb < 2; ++dvb) C[dvb][dkb] = mfma16(kf, vf[dvb], C[dvb][dkb]);
        }
        __builtin_amdgcn_sched_barrier(0);
    }
    const int tid = threadIdx.x, dk = tid >> 2, part = tid & 3;
    const u32x4 k0 = *(const LAS u32x4*)(lds + L_KT + dk * 144 + 32 * part), k1 = *(const LAS u32x4*)(lds + L_KT + dk * 144 + 32 * part + 16);
    float s = 0.f;
#pragma unroll
    for (int i = 0; i < 4; ++i) s += bf_lo(k0[i]) + bf_hi(k0[i]) + bf_lo(k1[i]) + bf_hi(k1[i]);
    s += __shfl_xor(s, 1); s += __shfl_xor(s, 2);
    if (part == 0) F[F_N + dk] = a * F[F_N + dk] + s;
}

__device__ void mlstm_phase1(const Params& P, LAS unsigned char* lds) {
    const int tid = threadIdx.x, w = tid >> 6, lane = tid & 63, r = lane & 15, g = lane >> 4;
    LAS float* F = (LAS float*)(lds + L_F);
    for (int task = blockIdx.x; task < 256; task += gridDim.x) {
        const int gi = task & 7, st = task >> 3, b = st >> 2, h = st & 3;
        if (gi == 7) continue;
        mlstm_prologue(P, lds, b, h, gi);
        f32x4 C[2][8];
#pragma unroll
        for (int i = 0; i < 2; ++i)
#pragma unroll
            for (int j = 0; j < 8; ++j) C[i][j] = (f32x4){0.f, 0.f, 0.f, 0.f};
        MlRaw R;
        mlstm_issue<false>(P, b, h, gi * 16, R);
        for (int lc = 0; lc < 16; ++lc) {
            mlstm_load<false>(lds, R, lc);
            __syncthreads();
            if (lc < 15) mlstm_issue<false>(P, b, h, gi * 16 + lc + 1, R);
            mlstm_update(lds, C, lc, w, r, g);
            __syncthreads();
        }
        float* slot = (float*)(P.ws + WS_PB) + (size_t)(st * 7 + gi) * STATE_FLOATS;
#pragma unroll
        for (int dvb = 0; dvb < 2; ++dvb)
#pragma unroll
            for (int dkb = 0; dkb < 8; ++dkb) *(f32x4*)(slot + (((w * 2 + dvb) * 8 + dkb) * 64 + lane) * 4) = C[dvb][dkb];
        if (tid < 128) slot[32768 + tid] = F[F_N + tid];
        __syncthreads();
    }
}

__device__ void mlstm_phase2(const Params& P, LAS unsigned char* lds) {
    const int tid = threadIdx.x, w = tid >> 6, lane = tid & 63, r = lane & 15, g = lane >> 4;
    LAS float* F = (LAS float*)(lds + L_F);
    const bf16_t* OA = (const bf16_t*)(P.ws + WS_OA);
    bf16_t* VA = (bf16_t*)(P.ws + WS_VA);
    for (int task = blockIdx.x; task < 256; task += gridDim.x) {
        const int gi = task & 7, st = task >> 3, b = st >> 2, h = st & 3;
#if !ONE_LAUNCH
        mlstm_prologue(P, lds, b, h, gi);
#endif
        f32x4 C[2][8];
#pragma unroll
        for (int i = 0; i < 2; ++i)
#pragma unroll
            for (int j = 0; j < 8; ++j) C[i][j] = (f32x4){0.f, 0.f, 0.f, 0.f};
        float nreg = 0.f;
        for (int j = 0; j < gi; ++j) {
            float Bj = 0.f;
            for (int c = 0; c < 16; ++c) Bj += F[F_BL + j * 16 + c];
            const float Aj = expf(Bj + F[F_M + 16 * j] - F[F_M + 16 * j + 16]);
            const float* slot = (const float*)(P.ws + WS_PB) + (size_t)(st * 7 + j) * STATE_FLOATS;
#pragma unroll
            for (int dvb = 0; dvb < 2; ++dvb)
#pragma unroll
                for (int dkb = 0; dkb < 8; ++dkb) C[dvb][dkb] = C[dvb][dkb] * Aj + *(const f32x4*)(slot + (((w * 2 + dvb) * 8 + dkb) * 64 + lane) * 4);
            if (tid < 128) nreg = nreg * Aj + slot[32768 + tid];
        }
        if (tid < 128) F[F_N + tid] = nreg;
        __syncthreads();
        for (int lc = 0; lc < 16; ++lc) {
            const int c = gi * 16 + lc;
            MlRaw R;
            mlstm_issue<true>(P, b, h, c, R);
            mlstm_load<true>(lds, R, lc);
            __syncthreads();
            {
                const int tb = w >> 1, par = w & 1;
                const LAS unsigned char* qpS = lds + (L_QI + (16 * tb + r) * 272 + 16 * g);
                const LAS unsigned char* kpS = lds + (L_KI + (16 * par + r) * 272 + 16 * g);
                LAS unsigned char* ppS = lds + (L_PI + (16 * tb + r) * 144 + 32 * par + 8 * g);
                bf16x8 qf[4];
#pragma unroll
                for (int kd = 0; kd < 4; ++kd) qf[kd] = *(const LAS bf16x8*)(qpS + 64 * kd);
                const float mu2 = F[F_SMU + lc * 64 + 16 * tb + r];
                float rs = 0.f;
#pragma unroll
                for (int sbi = 0; sbi < 2; ++sbi) {
                    const int sb = par + 2 * sbi;
                    u32x2 pw = (u32x2){0u, 0u};
                    if (sb <= tb) {
                        f32x4 acc = (f32x4){0.f, 0.f, 0.f, 0.f};
#pragma unroll
                        for (int kd = 0; kd < 4; ++kd) { const bf16x8 kf = *(const LAS bf16x8*)(kpS + (32 * sbi * 272 + 64 * kd)); acc = mfma16(kf, qf[kd], acc); }
                        const f32x4 b2 = *(const LAS f32x4*)(F + F_SB2 + lc * 64 + 16 * sb + 4 * g);
                        float pv[4];
#pragma unroll
                        for (int j = 0; j < 4; ++j) { const int s = 16 * sb + 4 * g + j, t = 16 * tb + r; pv[j] = (s <= t) ? acc[j] * fast_exp2(b2[j] - mu2) : 0.f; }
                        pw.x = cvt_pk_bf16(pv[0], pv[1]); pw.y = cvt_pk_bf16(pv[2], pv[3]);
                        rs += bf_lo(pw.x) + bf_hi(pw.x) + bf_lo(pw.y) + bf_hi(pw.y);
                    }
                    *(LAS u32x2*)(ppS + 64 * sbi) = pw;
                }
                rs += __shfl_xor(rs, 16); rs += __shfl_xor(rs, 32);
                if (g == 0) F[F_RS + par * 64 + 16 * tb + r] = rs;
            }
            __builtin_amdgcn_sched_barrier(0);
            const LAS unsigned char* q8p = lds + (L_QI + r * 272 + 8 * g);
            f32x4 num[2][4];
#pragma unroll
            for (int i = 0; i < 2; ++i)
#pragma unroll
                for (int j = 0; j < 4; ++j) num[i][j] = (f32x4){0.f, 0.f, 0.f, 0.f};
#pragma unroll
            for (int kk = 0; kk < 4; ++kk) {
                bf16x8 af[2];
#pragma unroll
                for (int dvb = 0; dvb < 2; ++dvb) {
                    u32x2 lo, hi; lo.x = cvt_pk_bf16(C[dvb][2 * kk][0], C[dvb][2 * kk][1]); lo.y = cvt_pk_bf16(C[dvb][2 * kk][2], C[dvb][2 * kk][3]);
                    hi.x = cvt_pk_bf16(C[dvb][2 * kk + 1][0], C[dvb][2 * kk + 1][1]); hi.y = cvt_pk_bf16(C[dvb][2 * kk + 1][2], C[dvb][2 * kk + 1][3]);
                    af[dvb] = mk8(lo, hi);
                }
#pragma unroll
                for (int tb = 0; tb < 4; ++tb) {
                    const u32x2 q0 = *(const LAS u32x2*)(q8p + (16 * tb * 272 + 64 * kk)), q1 = *(const LAS u32x2*)(q8p + (16 * tb * 272 + 64 * kk + 32));
                    const bf16x8 bq = mk8(q0, q1);
#pragma unroll
                    for (int dvb = 0; dvb < 2; ++dvb) num[dvb][tb] = mfma16(af[dvb], bq, num[dvb][tb]);
                }
                __builtin_amdgcn_sched_barrier(0);
            }
#pragma unroll
            for (int tb = 0; tb < 4; ++tb) { const float wi = F[F_SWI + lc * 64 + 16 * tb + r];
#pragma unroll
                for (int dvb = 0; dvb < 2; ++dvb) num[dvb][tb] *= wi; }
            {
                const int t = tid >> 3, part = tid & 7;
                const u32x4 q0 = *(const LAS u32x4*)(lds + L_QI + t * 272 + 32 * part), q1 = *(const LAS u32x4*)(lds + L_QI + t * 272 + 32 * part + 16);
                float s = 0.f;
#pragma unroll
                for (int i = 0; i < 4; ++i) {
                    s += bf_lo(q0[i]) * F[F_N + 16 * part + 2 * i] + bf_hi(q0[i]) * F[F_N + 16 * part + 2 * i + 1];
                    s += bf_lo(q1[i]) * F[F_N + 16 * part + 8 + 2 * i] + bf_hi(q1[i]) * F[F_N + 16 * part + 8 + 2 * i + 1];
                }
                s += __shfl_xor(s, 1); s += __shfl_xor(s, 2); s += __shfl_xor(s, 4);
                if (part == 0) F[F_QN + t] = s;
            }
            __builtin_amdgcn_sched_barrier(0);
            __syncthreads();
            const LAS unsigned char* vpC = lds + (L_VT + (32 * w + r) * 144 + 16 * g);
            const LAS unsigned char* ppC = lds + (L_PI + r * 144 + 16 * g);
#pragma unroll
            for (int ks = 0; ks < 2; ++ks) {
                bf16x8 vf[2];
#pragma unroll
                for (int dvb = 0; dvb < 2; ++dvb) vf[dvb] = *(const LAS bf16x8*)(vpC + (16 * dvb * 144 + 64 * ks));
#pragma unroll
                for (int tb = 0; tb < 4; ++tb) {
                    if (ks == 0 || tb >= 2) {
                        const bf16x8 pb = *(const LAS bf16x8*)(ppC + (16 * tb * 144 + 64 * ks));
#pragma unroll
                        for (int dvb = 0; dvb < 2; ++dvb) num[dvb][tb] = mfma16(vf[dvb], pb, num[dvb][tb]);
                    }
                }
                __builtin_amdgcn_sched_barrier(0);
            }
#pragma unroll
            for (int tb = 0; tb < 4; ++tb) {
                const int t = 16 * tb + r;
                const float den = F[F_SWI + lc * 64 + t] * F[F_QN + t] + F[F_RS + t] + F[F_RS + 64 + t];
                const float inv = 1.0f / fmaxf(fabsf(den), F[F_SEM + lc * 64 + t]);
                float s1 = 0.f, s2 = 0.f;
#pragma unroll
                for (int dvb = 0; dvb < 2; ++dvb) { num[dvb][tb] *= inv;
#pragma unroll
                    for (int j = 0; j < 4; ++j) { const float v = num[dvb][tb][j]; s1 += v; s2 += v * v; } }
                s1 += __shfl_xor(s1, 16); s1 += __shfl_xor(s1, 32); s2 += __shfl_xor(s2, 16); s2 += __shfl_xor(s2, 32);
                if (g == 0) { F[F_HS + (w * 64 + t) * 2] = s1; F[F_HS + (w * 64 + t) * 2 + 1] = s2; }
                __builtin_amdgcn_sched_barrier(0);
            }
            mlstm_update(lds, C, lc, w, r, g);
            __builtin_amdgcn_sched_barrier(0);
            __syncthreads();
#pragma unroll
            for (int tb = 0; tb < 4; ++tb) {
                const int t = 16 * tb + r;
                float s1 = 0.f, s2 = 0.f;
#pragma unroll
                for (int ww = 0; ww < 8; ++ww) { s1 += F[F_HS + (ww * 64 + t) * 2]; s2 += F[F_HS + (ww * 64 + t) * 2 + 1]; }
                const float mean = s1 * (1.0f / 256.0f), var = fmaxf(s2 * (1.0f / 256.0f) - mean * mean, 0.f), rstd = rsqrtf(var + LN_EPS);
                const size_t tok = (size_t)b * SEQ + c * 64 + t;
#pragma unroll
                for (int dvb = 0; dvb < 2; ++dvb) {
                    const int dv0 = 32 * w + 16 * dvb + 4 * g;
                    const f32x4 gn = *(const f32x4*)(P.mh_g + h * 256 + dv0);
                    const u32x2 og = *(const u32x2*)(OA + tok * DM + h * 256 + dv0);
                    const float y0 = (num[dvb][tb][0] - mean) * rstd * gn[0] * bf_lo(og.x), y1 = (num[dvb][tb][1] - mean) * rstd * gn[1] * bf_hi(og.x);
                    const float y2 = (num[dvb][tb][2] - mean) * rstd * gn[2] * bf_lo(og.y), y3 = (num[dvb][tb][3] - mean) * rstd * gn[3] * bf_hi(og.y);
                    u32x2 wv; wv.x = cvt_pk_bf16(y0, y1); wv.y = cvt_pk_bf16(y2, y3);
                    *(u32x2*)(VA + tok * DM + h * 256 + dv0) = wv;
                }
            }
        }
        __syncthreads();
    }
}

constexpr int A_KI = 0, A_VT = 17408, A_FL = 35840;
constexpr float SB_DONE_LOG2 = -40.0f;

__device__ void attn_phase(const Params& P, LAS unsigned char* lds) {
    const int tid = threadIdx.x, w = tid >> 6, lane = tid & 63, r = lane & 15, g = lane >> 4;
    bf16_t* QB = (bf16_t*)(P.ws + WS_QB);
    const bf16_t* KB = (const bf16_t*)(P.ws + WS_KB);
    const bf16_t* VB = (const bf16_t*)(P.ws + WS_VB);
    unsigned* cnt = (unsigned*)(P.ws + MISC_CNT);
    LAS int* FL = (LAS int*)(lds + A_FL);
    for (;;) {
        if (tid == 0) FL[32] = (int)atomicAdd(cnt, 1u);
        __syncthreads();
        const int item = FL[32];
        __syncthreads();
        if (item >= 4096) break;
        const int qb = 63 - (item >> 6), b = (item >> 3) & 7, h = item & 7;
        const int q0w = qb * 128 + 16 * w;
        const size_t qtok = (size_t)b * SEQ + q0w + r;
        bf16x8 qf[4];
#pragma unroll
        for (int kd = 0; kd < 4; ++kd) qf[kd] = *(const bf16x8*)(QB + qtok * DM + h * 128 + 32 * kd + 8 * g);
        f32x4 O[8];
#pragma unroll
        for (int i = 0; i < 8; ++i) O[i] = (f32x4){0.f, 0.f, 0.f, 0.f};
        float R = 0.f;
        int wdone = 0, it = 0;
        u32x4 pre[4];
        const int ptg = tid & 15, pcg = (tid >> 4) & 15, prow = (tid - 256) >> 2, pch = tid & 3;
        auto issue_tile = [&](int kt_) {
            if (tid < 256) {
#pragma unroll
                for (int tt = 0; tt < 4; ++tt) pre[tt] = *(const u32x4*)(VB + ((size_t)b * SEQ + kt_ * 64 + 4 * ptg + tt) * DM + h * 128 + 8 * pcg);
            } else {
                const bf16_t* src_ = KB + ((size_t)b * SEQ + kt_ * 64 + prow) * DM + h * 128 + 32 * pch;
#pragma unroll
                for (int i = 0; i < 4; ++i) pre[i] = *(const u32x4*)(src_ + 8 * i);
            }
        };
        issue_tile(2 * qb + 1);
        for (int kt = 2 * qb + 1; kt >= 0; --kt, ++it) {
            if (tid < 256) {
#pragma unroll
                for (int e = 0; e < 8; ++e) {
                    unsigned short x0, x1, x2, x3;
                    { const unsigned a0 = pre[0][e >> 1], a1 = pre[1][e >> 1], a2 = pre[2][e >> 1], a3 = pre[3][e >> 1];
                      if (e & 1) { x0 = a0 >> 16; x1 = a1 >> 16; x2 = a2 >> 16; x3 = a3 >> 16; } else { x0 = a0 & 0xffff; x1 = a1 & 0xffff; x2 = a2 & 0xffff; x3 = a3 & 0xffff; } }
                    u32x2 wv; wv.x = (unsigned)x0 | ((unsigned)x1 << 16); wv.y = (unsigned)x2 | ((unsigned)x3 << 16);
                    *(LAS u32x2*)(lds + A_VT + (8 * pcg + e) * 144 + 8 * ptg) = wv;
                }
            } else {
#pragma unroll
                for (int i = 0; i < 4; ++i) *(LAS u32x4*)(lds + A_KI + prow * 272 + 64 * pch + 16 * i) = pre[i];
            }
            __syncthreads();
            if (kt > 0) issue_tile(kt - 1);
            const int key0 = kt * 64;
            if (!wdone && key0 <= q0w + 14) {
                const int qpos = q0w + r;
                float wgt[4][4];
                float Rrun = R;
#pragma unroll
                for (int sb = 3; sb >= 0; --sb) {
                    f32x4 acc = (f32x4){0.f, 0.f, 0.f, 0.f};
#pragma unroll
                    for (int kd = 0; kd < 4; ++kd) { const bf16x8 kf = *(const LAS bf16x8*)(lds + A_KI + (16 * sb + r) * 272 + 64 * kd + 16 * g); acc = mfma16(kf, qf[kd], acc); }
                    float lk[4], z[4];
#pragma unroll
                    for (int j = 0; j < 4; ++j) {
                        const int key = key0 + 16 * sb + 4 * g + j;
                        z[j] = fminf(acc[j], 80.0f);
                        lk[j] = (key < qpos) ? -fast_log2(1.0f + fast_exp2(z[j])) : 0.f;
                    }
                    const float s3 = lk[3], s2 = s3 + lk[2], s1 = s2 + lk[1], s0 = s1 + lk[0];
                    const float t1 = __shfl_xor(s0, 16), t2 = __shfl_xor(s0, 32), t3 = __shfl_xor(t1, 32);
                    const float above = g == 0 ? (t1 + t2 + t3) : (g == 1 ? (t2 + t3) : (g == 2 ? t1 : 0.f));
                    const float base = Rrun + above;
                    const float sj[4] = {s0, s1, s2, s3};
#pragma unroll
                    for (int j = 0; j < 4; ++j) { const int key = key0 + 16 * sb + 4 * g + j; wgt[sb][j] = (key < qpos) ? fast_exp2(z[j] + base + sj[j]) : 0.f; }
                    Rrun += (s0 + t1) + (t2 + t3);
                }
                R = Rrun;
#pragma unroll
                for (int ks = 0; ks < 2; ++ks) {
                    u32x2 lo, hi; lo.x = cvt_pk_bf16(wgt[2 * ks][0], wgt[2 * ks][1]); lo.y = cvt_pk_bf16(wgt[2 * ks][2], wgt[2 * ks][3]);
                    hi.x = cvt_pk_bf16(wgt[2 * ks + 1][0], wgt[2 * ks + 1][1]); hi.y = cvt_pk_bf16(wgt[2 * ks + 1][2], wgt[2 * ks + 1][3]);
                    const bf16x8 pf = mk8(lo, hi);
#pragma unroll
                    for (int db = 0; db < 8; ++db) {
                        const u32x2 v0 = *(const LAS u32x2*)(lds + A_VT + (16 * db + r) * 144 + 64 * ks + 8 * g), v1 = *(const LAS u32x2*)(lds + A_VT + (16 * db + r) * 144 + 64 * ks + 32 + 8 * g);
                        O[db] = mfma16(mk8(v0, v1), pf, O[db]);
                    }
                }
                wdone = __all(R < SB_DONE_LOG2) ? 1 : 0;
            }
            if (lane == 0) FL[(it & 1) * 8 + w] = wdone;
            __syncthreads();
            int alld = 1;
#pragma unroll
            for (int i = 0; i < 8; ++i) alld &= FL[(it & 1) * 8 + i];
            if (alld) break;
        }
#pragma unroll
        for (int db = 0; db < 8; ++db) { u32x2 wv; wv.x = cvt_pk_bf16(O[db][0], O[db][1]); wv.y = cvt_pk_bf16(O[db][2], O[db][3]);
            *(u32x2*)(QB + qtok * DM + h * 128 + 16 * db + 4 * g) = wv; }
        __syncthreads();
    }
}


#ifdef DIAG
__device__ void diag_count_f32(const float* p, size_t n, float thr, unsigned* ctr) {
    unsigned c = 0;
    for (size_t i = (size_t)blockIdx.x * NTHREADS + threadIdx.x; i < n; i += (size_t)gridDim.x * NTHREADS) { const float v = p[i]; if (!(fabsf(v) <= thr)) ++c; }
    if (c) atomicAdd(ctr, c);
}
__device__ void diag_count_bf16(const bf16_t* p, size_t n, float thr, unsigned* ctr) {
    unsigned c = 0;
    for (size_t i = (size_t)blockIdx.x * NTHREADS + threadIdx.x; i < n; i += (size_t)gridDim.x * NTHREADS) { const float v = __uint_as_float((unsigned)p[i] << 16); if (!(fabsf(v) <= thr)) ++c; }
    if (c) atomicAdd(ctr, c);
}
#endif
#define XB_TMO      128
#define XB_XCNT(j)  (256  + 64 * (j))
#define XB_XSUB(j)  (1280 + 64 * (j))
#define XB_XGEN(j)  (2304 + 64 * (j))
#define XB_TOP      3328
#define XB_TOPGEN   3392
#define XCD_BAR_WORDS 3456
#define XB_SPIN_CAP (1u << 18)

__device__ __forceinline__ unsigned xb_ld(unsigned* p)              { return __hip_atomic_load(p, __ATOMIC_RELAXED, __HIP_MEMORY_SCOPE_AGENT); }
__device__ __forceinline__ unsigned xb_add(unsigned* p, unsigned v) { return __hip_atomic_fetch_add(p, v, __ATOMIC_RELAXED, __HIP_MEMORY_SCOPE_AGENT); }
__device__ __forceinline__ unsigned xb_xcc_id() { return (unsigned)__builtin_amdgcn_s_getreg((3 << 11) | 20) & 0xFu; }
#define XB_SPIN(cond, bar) do { unsigned _sp = 0; while (cond) { __builtin_amdgcn_s_sleep(1); \
    if ((++_sp & 255u) == 0u) { if (xb_ld(&(bar)[XB_TMO])) break; if (_sp > XB_SPIN_CAP) { atomicAdd(&(bar)[XB_TMO], 1u); break; } } } } while (0)

struct XcdBarrier {
    unsigned* bar; unsigned x;
    volatile LAS unsigned* st;
};

__device__ __forceinline__ XcdBarrier xcd_barrier_post(unsigned* bar, volatile LAS unsigned* st) {
    XcdBarrier b; b.bar = bar; b.x = xb_xcc_id(); b.st = st;
    if (threadIdx.x == 0) (void)xb_add(&bar[XB_XCNT(b.x)], 1u);
    return b;
}
__device__ __forceinline__ void xcd_barrier_complete(unsigned* bar, unsigned x, unsigned& nloc, unsigned& nx) {
    const unsigned G = gridDim.x * gridDim.y * gridDim.z;
    unsigned sum, cnt, mine, sp = 0u;
    for (;;) {
        sum = 0u; cnt = 0u; mine = 0u;
#pragma unroll
        for (unsigned j = 0; j < 16; ++j) { const unsigned c = xb_ld(&bar[XB_XCNT(j)]); sum += c; cnt += (c > 0u) ? 1u : 0u; mine = (j == x) ? c : mine; }
        if (sum == G) break;
        __builtin_amdgcn_s_sleep(1);
        if ((++sp & 255u) == 0u) { if (xb_ld(&bar[XB_TMO])) break; if (sp > XB_SPIN_CAP) { atomicAdd(&bar[XB_TMO], 1u); break; } }
    }
    nloc = mine > 0u ? mine : 1u; nx = cnt > 0u ? cnt : 1u;
}

__device__ __forceinline__ void xcd_barrier(const XcdBarrier& b) {
    asm volatile("s_waitcnt vmcnt(0)" ::: "memory");
    __syncthreads();
    if (threadIdx.x == 0) {
        unsigned* bar = b.bar;
        __builtin_amdgcn_s_waitcnt(0);
        unsigned nloc = b.st[0], nx = b.st[1];
        if (nloc == 0u) { xcd_barrier_complete(bar, b.x, nloc, nx); b.st[0] = nloc; b.st[1] = nx; }
        const unsigned old = xb_add(&bar[XB_XSUB(b.x)], 1u);
        const unsigned gen = old / nloc;
        if (old + 1u == (gen + 1u) * nloc) {
            __builtin_amdgcn_fence(__ATOMIC_RELEASE, "agent");
            asm volatile("s_waitcnt vmcnt(0)" ::: "memory");
            const unsigned og = xb_add(&bar[XB_TOP], 1u);
            const unsigned tg = og / nx;
            if (og + 1u == (tg + 1u) * nx) xb_add(&bar[XB_TOPGEN], 1u);
            else XB_SPIN(xb_ld(&bar[XB_TOPGEN]) == tg, bar);
            __builtin_amdgcn_fence(__ATOMIC_ACQUIRE, "agent");
            xb_add(&bar[XB_XGEN(b.x)], 1u);
            asm volatile("s_waitcnt vmcnt(0)" ::: "memory");
        } else {
            XB_SPIN(xb_ld(&bar[XB_XGEN(b.x)]) == gen, bar);
            __builtin_amdgcn_fence(__ATOMIC_ACQUIRE, "agent");
            asm volatile("s_waitcnt vmcnt(0)" ::: "memory");
        }
    }
    __syncthreads();
}

constexpr int LDS_BYTES = 135168;
static_assert(MIX_LDS <= LDS_BYTES && 128 * 129 * 4 <= LDS_BYTES && pg8::STAGE_BYTES <= LDS_BYTES, "LDS budget");
constexpr int NPHASE = 17;

template <class Epi>
__device__ __forceinline__ void run_gemm(LAS unsigned char* lds, const bf16_t* A, const bf16_t* Bt, int N, int K, const Epi& E) {
    pg8::Gemm g{A, Bt, MTOK, N, K};
    pg8::StaticOrder S; S.init(MTOK, N, gridDim.x, blockIdx.x);
    pg8::gemm_phase<Epi, pg8::StaticOrder, true, true>(lds, g, S, E);
}

__global__ void __launch_bounds__(NTHREADS, 2) fwd_megakernel(Params P) {
    extern __shared__ __attribute__((aligned(16))) unsigned char smem[];
    LAS unsigned char* lds = (LAS unsigned char*)smem;
    cg::grid_group grid = cg::this_grid();
    unsigned char* ws = P.ws;
    bf16_t* X = (bf16_t*)(ws + WS_X);
    bf16_t* H = (bf16_t*)(ws + WS_H);
    float* Y = P.out;
    bf16_t* gates = (bf16_t*)P.out;
#ifdef ONLYMASK
#define PHASE(k) if (((ONLYMASK >> (k)) & 1) && P.ph_lo <= (k) && (k) < P.ph_hi)
#else
#define PHASE(k) if (P.ph_lo <= (k) && (k) < P.ph_hi)
#endif
#define SYNC0() do { if (P.coop) { asm volatile("s_waitcnt vmcnt(0) lgkmcnt(0)" ::: "memory"); grid.sync(); \
        if (threadIdx.x < 64) { __builtin_amdgcn_fence(__ATOMIC_ACQUIRE, "agent"); asm volatile("s_waitcnt vmcnt(0)" ::: "memory"); } __syncthreads(); } } while (0)
#define SYNC() do { if (P.coop) xcd_barrier(xb); } while (0)
    volatile LAS unsigned* bst = (volatile LAS unsigned*)(lds + (LDS_BYTES - 16));
    XcdBarrier xb; xb.bar = (unsigned*)(ws + MISC_BAR); xb.x = 0; xb.st = bst;
    if (P.coop) { if (threadIdx.x == 0) { bst[0] = 0u; bst[1] = 0u; } xb = xcd_barrier_post((unsigned*)(ws + MISC_BAR), bst); }
    PHASE(0) prep_phase(P, lds);
    SYNC0();
    PHASE(1) run_gemm(lds, X, (const bf16_t*)(ws + W_GU1), 5632, 1024, EpiSwiglu{H});
    SYNC();
    PHASE(2) run_gemm(lds, H, (const bf16_t*)(ws + W_D1), 1024, FH, EpiResid<false, false, true>{P.x, nullptr, Y, 0.5f});
    SYNC();
    PHASE(3) ln_phase<true, true>(Y, P.ln_g, P.ln_b, X);
    SYNC();
    PHASE(4) run_gemm(lds, X, (const bf16_t*)(ws + W_IN), NIN_PAD, 1024, EpiWin{(bf16_t*)(ws + WS_QK), gates, (float*)(ws + MISC_IF), (const float*)(ws + W_BIAS)});
    SYNC();
    PHASE(5) {
        mlstm_phase1(P, lds);
#if ONE_LAUNCH
        if ((blockIdx.x & 7) == 7 && blockIdx.x < 256) { const int st_ = blockIdx.x >> 3; mlstm_prologue(P, lds, st_ >> 2, st_ & 3, 7); }
#endif
    }
    SYNC();
    PHASE(6) {
#ifndef NO_ML2
        mlstm_phase2(P, lds);
#endif
#ifndef NO_ATT
        attn_phase(P, lds);
#endif
    }
    SYNC();
    PHASE(7) {
        run_gemm(lds, (const bf16_t*)(ws + WS_VA), (const bf16_t*)(ws + W_A), 1024, 1024, EpiGateMul<false>{gates, 0, nullptr, (bf16_t*)(ws + WS_T)});
        run_gemm(lds, (const bf16_t*)(ws + WS_QB), (const bf16_t*)(ws + W_B), 1024, 1024, EpiGateMul<true>{gates, DM, (const bf16_t*)(ws + WS_T), (bf16_t*)(ws + WS_MG)});
    }
    SYNC();
    PHASE(8) run_gemm(lds, (const bf16_t*)(ws + WS_MG), (const bf16_t*)(ws + W_O), 1024, 1024, EpiResid<true, false, true>{X, nullptr, Y, 1.0f});
    SYNC();
    PHASE(9) ln_phase<true, true>(Y, P.ln_g + DM, P.ln_b + DM, X);
    SYNC();
    PHASE(10) run_gemm(lds, X, (const bf16_t*)(ws + W_GU2), 5632, 1024, EpiSwiglu{H});
    SYNC();
    PHASE(11) run_gemm(lds, H, (const bf16_t*)(ws + W_D2), 1024, FH, EpiResid<true, false, true>{X, nullptr, Y, 0.5f});
    SYNC();
    PHASE(12) { ln_phase<true, true>(Y, P.ln_g + 2 * DM, P.ln_b + 2 * DM, X); cvt_bf16_phase(P.p, (bf16_t*)(ws + WS_PB), (size_t)MTOK * 256 / 8); }
    SYNC();
    PHASE(13) {
        run_gemm(lds, X, (const bf16_t*)(ws + W_PG), 1024, 1024, EpiSigBias{P.b_pg, (bf16_t*)(ws + WS_PG)});
        run_gemm(lds, (const bf16_t*)(ws + WS_PB), (const bf16_t*)(ws + W_P), 1024, 256, EpiResid<true, true, true>{X, (const bf16_t*)(ws + WS_PG), (float*)(ws + WS_VA), 1.0f});
    }
    SYNC();
    PHASE(14) ln_phase<false, true>((const float*)(ws + WS_VA), P.ln_g + 3 * DM, P.ln_b + 3 * DM, P.out);
#undef PHASE
#undef SYNC
#undef SYNC0
}

extern "C" void kernel_launch(void* const* d_in, const int* in_sizes, int n_in, void* d_out, int out_size, void* d_ws, size_t ws_size, hipStream_t stream) {
    static int grid_blocks = 0;
    if (grid_blocks == 0) {
        if (n_in != 19 || out_size != MTOK * DM || ws_size < WS_END) { fprintf(stderr, "kernel_launch: unexpected shapes (n_in %d, out %d, ws %zu, need %zu)\n", n_in, out_size, ws_size, (size_t)WS_END); grid_blocks = -1; return; }
        int dev = 0, cus = 0, per_cu = 0;
        hipGetDevice(&dev);
        hipDeviceGetAttribute(&cus, hipDeviceAttributeMultiprocessorCount, dev);
        if (hipFuncSetAttribute((const void*)fwd_megakernel, hipFuncAttributeMaxDynamicSharedMemorySize, LDS_BYTES) != hipSuccess) { fprintf(stderr, "kernel_launch: hipFuncSetAttribute failed\n"); grid_blocks = -1; return; }
        if (hipOccupancyMaxActiveBlocksPerMultiprocessor(&per_cu, (const void*)fwd_megakernel, NTHREADS, LDS_BYTES) != hipSuccess || per_cu < 1) { fprintf(stderr, "kernel_launch: occupancy query failed (%d)\n", per_cu); per_cu = 1; (void)hipGetLastError(); }
        grid_blocks = cus * per_cu;
#if ONE_LAUNCH
        if (grid_blocks != 256) { fprintf(stderr, "kernel_launch: this build needs exactly 256 resident workgroups (got %d)\n", grid_blocks); grid_blocks = -1; return; }
#endif
    }
    if (grid_blocks < 0) return;
    Params p{};
    p.x = (const float*)d_in[0]; p.p = (const float*)d_in[1]; p.ln_g = (const float*)d_in[2]; p.ln_b = (const float*)d_in[3];
    p.wg = (const float*)d_in[4]; p.wu = (const float*)d_in[5]; p.wd = (const float*)d_in[6]; p.w_in = (const float*)d_in[7]; p.b_in = (const float*)d_in[8];
    p.b_forget = (const float*)d_in[9]; p.conv_w = (const float*)d_in[10]; p.conv_b = (const float*)d_in[11]; p.mh_g = (const float*)d_in[12];
    p.w_a = (const float*)d_in[13]; p.w_b = (const float*)d_in[14]; p.w_o = (const float*)d_in[15]; p.w_ple = (const float*)d_in[16]; p.w_pg = (const float*)d_in[17]; p.b_pg = (const float*)d_in[18];
    p.out = (float*)d_out; p.ws = (unsigned char*)d_ws; p.pad = 0;
#if ONE_LAUNCH
    if (hipMemsetAsync((char*)d_ws + MISC_BAR, 0, XCD_BAR_WORDS * 4, stream) != hipSuccess) { fprintf(stderr, "kernel_launch: memset of the barrier words failed\n"); return; }
    p.ph_lo = 0; p.ph_hi = NPHASE; p.coop = 1;
    void* args[] = {&p};
    hipError_t e = hipLaunchCooperativeKernel((const void*)fwd_megakernel, dim3(grid_blocks), dim3(NTHREADS), args, LDS_BYTES, stream);
    if (e != hipSuccess) fprintf(stderr, "cooperative launch failed: %s (grid %d)\n", hipGetErrorString(e), grid_blocks);
#else
    p.coop = 0;
    for (int ph = 0; ph < 15; ++ph) { p.ph_lo = ph; p.ph_hi = ph + 1; hipLaunchKernelGGL(fwd_megakernel, dim3(grid_blocks), dim3(NTHREADS), LDS_BYTES, stream, p); }
#endif
}
```

```cpp
#include <hip/hip_runtime.h>
#include <hip/hip_cooperative_groups.h>
#include <cstdio>
namespace cg = cooperative_groups;

#ifndef ONE_LAUNCH
#define ONE_LAUNCH 1
#endif

#define LAS __attribute__((address_space(3)))
typedef unsigned short bf16_t;
typedef short bf16x8 __attribute__((ext_vector_type(8)));
typedef float f32x4 __attribute__((ext_vector_type(4)));
typedef float f32x2 __attribute__((ext_vector_type(2)));
typedef unsigned u32x4 __attribute__((ext_vector_type(4)));
typedef unsigned u32x2 __attribute__((ext_vector_type(2)));

constexpr int MTOK = 65536, DM = 1024, FH = 2816, SEQ = 8192;
constexpr int NIN_PAD = 8448;
constexpr float ALPHA = 1.189207115002721f;
constexpr float LN_EPS = 1e-5f;
constexpr float LOG2E = 1.4426950408889634f;
constexpr int NTHREADS = 512;

constexpr size_t QB_ = 33554432ull;
constexpr size_t WS_W = 0;
constexpr size_t W_GU1 = 0;
constexpr size_t W_D1 = W_GU1 + 5632ull * 1024 * 2;
constexpr size_t W_GU2 = W_D1 + 1024ull * 2816 * 2;
constexpr size_t W_D2 = W_GU2 + 5632ull * 1024 * 2;
constexpr size_t W_IN = W_D2 + 1024ull * 2816 * 2;
constexpr size_t W_A = W_IN + 8448ull * 1024 * 2;
constexpr size_t W_B = W_A + 1024ull * 1024 * 2;
constexpr size_t W_O = W_B + 1024ull * 1024 * 2;
constexpr size_t W_PG = W_O + 1024ull * 1024 * 2;
constexpr size_t W_P = W_PG + 1024ull * 1024 * 2;
constexpr size_t W_BIAS = W_P + 1024ull * 256 * 2;
static_assert(W_BIAS + 8448 * 4 <= 2 * QB_, "weights overflow");
constexpr size_t WS_PB = 2 * QB_;
constexpr size_t WS_MISC = 3 * QB_;
constexpr size_t MISC_IF = WS_MISC;
constexpr size_t MISC_CNT = WS_MISC + 2097152ull;
constexpr size_t MISC_BAR = MISC_CNT + 4096;
constexpr size_t WS_X = 4 * QB_;
constexpr size_t WS_H = 8 * QB_;
constexpr size_t WS_QK = 8 * QB_, WS_VA = 12 * QB_, WS_OA = 16 * QB_, WS_QB = 20 * QB_, WS_KB = 24 * QB_, WS_VB = 28 * QB_;
constexpr size_t WS_T = WS_QK, WS_MG = WS_KB, WS_PG = 8 * QB_;
constexpr size_t WS_END = 32 * QB_;
constexpr int STATE_FLOATS = 32768 + 128;

typedef __bf16 bf16x2_t __attribute__((ext_vector_type(2)));
__device__ __forceinline__ unsigned cvt_pk_bf16(float lo, float hi) { f32x2 v = {lo, hi}; bf16x2_t r = __builtin_convertvector(v, bf16x2_t); return __builtin_bit_cast(unsigned, r); }
__device__ __forceinline__ float bf_lo(unsigned u) { return __uint_as_float(u << 16); }
__device__ __forceinline__ float bf_hi(unsigned u) { return __uint_as_float(u & 0xffff0000u); }
__device__ __forceinline__ float fast_exp2(float x) { return __builtin_amdgcn_exp2f(x); }
__device__ __forceinline__ float fast_log2(float x) { return __builtin_amdgcn_logf(x); }
__device__ __forceinline__ float fast_rcp(float x) { return __builtin_amdgcn_rcpf(x); }
__device__ __forceinline__ float sigmoid_f(float x) { return fast_rcp(1.0f + fast_exp2(-x * LOG2E)); }
__device__ __forceinline__ f32x4 mfma16(bf16x8 a, bf16x8 b, f32x4 c) { return __builtin_amdgcn_mfma_f32_16x16x32_bf16(a, b, c, 0, 0, 0); }
__device__ __forceinline__ bf16x8 mk8(u32x2 lo, u32x2 hi) { u32x4 v; v.x = lo.x; v.y = lo.y; v.z = hi.x; v.w = hi.y; return __builtin_bit_cast(bf16x8, v); }
__device__ __forceinline__ float wave_sum(float v) {
#pragma unroll
    for (int o = 32; o > 0; o >>= 1) v += __shfl_xor(v, o);
    return v;
}
__device__ __forceinline__ float wave_max(float v) {
#pragma unroll
    for (int o = 32; o > 0; o >>= 1) v = fmaxf(v, __shfl_xor(v, o));
    return v;
}
__device__ __forceinline__ float wave_incl_sum(float v, int lane) {
#pragma unroll
    for (int o = 1; o < 64; o <<= 1) { float t = __shfl_up(v, o); if (lane >= o) v += t; }
    return v;
}
__device__ __forceinline__ float wave_incl_max(float v, int lane) {
#pragma unroll
    for (int o = 1; o < 64; o <<= 1) { float t = __shfl_up(v, o); if (lane >= o) v = fmaxf(v, t); }
    return v;
}

namespace pg8 {
constexpr int BM = 256, BK = 64, HALF = 128, HTB = HALF * BK * 2, STAGE_BYTES = 8 * HTB, NXCD = 8, WGM = 8;
__host__ __device__ __forceinline__ int lds_byte(int r, int c) { const int st = (r >> 4) * 2 + (c >> 5), rr = r & 15, cc = c & 31, ob = rr * 64 + cc * 2; return st * 1024 + (ob ^ (((ob >> 9) & 1) << 5)); }
__host__ __device__ __forceinline__ void stage_rc(int b, int& R, int& C) { const int st = b / 1024, sb = b % 1024, swz = sb ^ (((sb >> 9) & 1) << 5); R = (st >> 1) * 16 + swz / 64; C = (st & 1) * 32 + (swz % 64) / 2; }
__host__ __device__ __forceinline__ int perm32(int rho) { const int n = rho >> 4, i = rho & 15; return 8 * (i >> 2) + 4 * n + (i & 3); }
struct Unit { int pm, pn; };
struct Gemm { const bf16_t* A; const bf16_t* Bt; int M, N, K; };
struct StaticOrder {
    int nM, nN, nwg, G, c;
    __device__ void init(int M, int N, int G_, int c_) { nM = M / BM; nN = N / BM; nwg = nM * nN; G = G_; c = c_; }
    __device__ bool next(int i, Unit& u) const {
        const long L = (long)i * G + c; if (L >= nwg) return false;
        int wgid = (int)L; { const int q = nwg / NXCD, r = nwg % NXCD, xcd = wgid % NXCD, off = wgid / NXCD; wgid = (xcd < r ? xcd * (q + 1) : r * (q + 1) + (xcd - r) * q) + off; }
        const int nig = WGM * nN, gid = wgid / nig, fm = gid * WGM, gsz = (nM - fm) < WGM ? (nM - fm) : WGM;
        u.pm = fm + ((wgid % nig) % gsz); u.pn = (wgid % nig) / gsz; return true;
    }
};
template <class Epi, class Sched, bool ALIGN_EPI = false, bool SP2 = false>
__device__ __forceinline__ void gemm_phase(LAS unsigned char* lds, const Gemm g, const Sched& S, const Epi& E) {
    const int tid = threadIdx.x, wid = __builtin_amdgcn_readfirstlane(tid >> 6), lane = tid & 63, wr = wid >> 2, wc = wid & 3, fr = lane & 15, fq = lane >> 4;
    const int K = g.K, nt = K / BK;
    unsigned voffA[2], voffB[2];
#pragma unroll
    for (int i = 0; i < 2; ++i) { int R, C; stage_rc(tid * 16 + i * 8192, R, C); const int Rb = ((R & ~31) + perm32(R & 31));
        voffA[i] = (unsigned)(R * K + C) * 2u; voffB[i] = (unsigned)(Rb * K + C) * 2u; }
    const size_t kstep = (size_t)(BK * 2);
    const size_t hstep = (size_t)HALF * K * 2;
    const size_t tstep = 2 * hstep;
    const unsigned ldsw = (unsigned)wid * 1024u;
    const int aoff = lds_byte(wr * 64 + fr, fq * 8), boff = lds_byte(wc * 32 + fr, fq * 8);
#define PG8_SA(b, h) (((b) * 2 + (h)) * HTB)
#define PG8_SB(b, h) ((4 + (b) * 2 + (h)) * HTB)
#define PG8_STAGE(bufoff, gbase, voff) do { _Pragma("unroll") for (int _i = 0; _i < 2; ++_i) \
        __builtin_amdgcn_global_load_lds((const unsigned*)((const char*)(gbase) + (voff)[_i]), (LAS unsigned*)(lds + (bufoff) + ldsw + _i * 8192), 16, 0, 0); } while (0)
#define PG8_LDA(dst, b, h) do { _Pragma("unroll") for (int m = 0; m < 4; ++m) _Pragma("unroll") for (int k = 0; k < 2; ++k) dst[m][k] = *(const LAS bf16x8*)(lds + PG8_SA(b, h) + aoff + m * 2048 + k * 1024); } while (0)
#define PG8_LDB(dst, b, h) do { _Pragma("unroll") for (int n = 0; n < 2; ++n) _Pragma("unroll") for (int k = 0; k < 2; ++k) dst[n][k] = *(const LAS bf16x8*)(lds + PG8_SB(b, h) + boff + n * 2048 + k * 1024); } while (0)
#define PG8_MMA(ai, bj, At, Bt) do { __builtin_amdgcn_s_setprio(1); _Pragma("unroll") for (int m = 0; m < 4; ++m) _Pragma("unroll") for (int n = 0; n < 2; ++n) _Pragma("unroll") for (int k = 0; k < 2; ++k) \
        acc[ai][bj][m][n] = __builtin_amdgcn_mfma_f32_16x16x32_bf16(Bt[n][k], At[m][k], acc[ai][bj][m][n], 0, 0, 0); __builtin_amdgcn_s_setprio(0); } while (0)
#define PG8_WAIT_V(n) asm volatile("s_waitcnt vmcnt(" #n ")" ::: "memory")
#define PG8_WAIT_L(n) asm volatile("s_waitcnt lgkmcnt(" #n ")" ::: "memory")
#define PG8_BAR __builtin_amdgcn_s_barrier()
#define PG8_SCHED __builtin_amdgcn_sched_barrier(0)
    Unit cur, nxt; int ui = 0;
    if (!S.next(0, cur)) return;
    f32x4 acc[2][2][4][2];
#pragma unroll
    for (int a = 0; a < 2; ++a)
#pragma unroll
        for (int b = 0; b < 2; ++b)
#pragma unroll
            for (int m = 0; m < 4; ++m)
#pragma unroll
                for (int n = 0; n < 2; ++n) acc[a][b][m][n] = (f32x4){0.f, 0.f, 0.f, 0.f};
    bf16x8 At[4][2], B0[2][2], B1[2][2];
    const char* cA = (const char*)g.A + (size_t)cur.pm * tstep; const char* cB = (const char*)g.Bt + (size_t)cur.pn * tstep;

    if constexpr (SP2) {
        PG8_STAGE(PG8_SB(0, 0), cB, voffB); PG8_STAGE(PG8_SB(0, 1), cB + hstep, voffB); PG8_STAGE(PG8_SA(0, 0), cA, voffA); PG8_STAGE(PG8_SA(0, 1), cA + hstep, voffA);
        if (wr == 1) PG8_BAR;
        PG8_WAIT_V(2); PG8_BAR;
        PG8_STAGE(PG8_SB(1, 0), cB + kstep, voffB); PG8_STAGE(PG8_SA(1, 0), cA + kstep, voffA); PG8_STAGE(PG8_SB(1, 1), cB + hstep + kstep, voffB);
        PG8_WAIT_V(6); PG8_BAR;
    } else {
        PG8_STAGE(PG8_SB(0, 0), cB, voffB); PG8_STAGE(PG8_SA(0, 0), cA, voffA); PG8_STAGE(PG8_SB(0, 1), cB + hstep, voffB); PG8_STAGE(PG8_SA(0, 1), cA + hstep, voffA);
        if (wr == 1) PG8_BAR;
        PG8_WAIT_V(4); PG8_BAR;
        PG8_STAGE(PG8_SB(1, 0), cB + kstep, voffB); PG8_STAGE(PG8_SA(1, 0), cA + kstep, voffA); PG8_STAGE(PG8_SB(1, 1), cB + hstep + kstep, voffB);
        PG8_WAIT_V(6); PG8_BAR;
    }
    for (;;) {
        const bool has_next = S.next(ui + 1, nxt);
        const char* nA = has_next ? (const char*)g.A + (size_t)nxt.pm * tstep : cA; const char* nB = has_next ? (const char*)g.Bt + (size_t)nxt.pn * tstep : cB;
        for (int t = 0; t < nt; t += 2) {
            const bool last = (t == nt - 2);
            const char* a1 = cA + (size_t)(t + 1) * kstep;
            const char* a2 = last ? nA : cA + (size_t)(t + 2) * kstep; const char* b2 = last ? nB : cB + (size_t)(t + 2) * kstep;
            const char* a3 = a2 + kstep; const char* b3 = b2 + kstep;

            if constexpr (SP2) {
            PG8_LDB(B0, 0, 0); PG8_LDB(B1, 0, 1); PG8_SCHED; PG8_LDA(At, 0, 0); PG8_STAGE(PG8_SA(1, 1), a1 + hstep, voffA);
            PG8_WAIT_V(8); PG8_WAIT_L(0); PG8_BAR; PG8_MMA(0, 0, At, B0); PG8_MMA(0, 1, At, B1); PG8_BAR; PG8_SCHED;
            PG8_LDA(At, 0, 1); PG8_STAGE(PG8_SB(0, 0), b2, voffB); PG8_STAGE(PG8_SB(0, 1), b2 + hstep, voffB); PG8_STAGE(PG8_SA(0, 0), a2, voffA);
            PG8_WAIT_V(8); PG8_WAIT_L(0); PG8_BAR; PG8_MMA(1, 0, At, B0); PG8_MMA(1, 1, At, B1); PG8_BAR; PG8_SCHED;
            PG8_LDB(B0, 1, 0); PG8_LDB(B1, 1, 1); PG8_SCHED; PG8_LDA(At, 1, 0); PG8_STAGE(PG8_SA(0, 1), a2 + hstep, voffA);
            PG8_WAIT_V(8); PG8_WAIT_L(0); PG8_BAR; PG8_MMA(0, 0, At, B0); PG8_MMA(0, 1, At, B1); PG8_BAR; PG8_SCHED;
            PG8_LDA(At, 1, 1); PG8_STAGE(PG8_SB(1, 0), b3, voffB); PG8_STAGE(PG8_SB(1, 1), b3 + hstep, voffB); PG8_STAGE(PG8_SA(1, 0), a3, voffA);
            PG8_WAIT_V(8); PG8_WAIT_L(0); PG8_BAR; PG8_MMA(1, 0, At, B0); PG8_MMA(1, 1, At, B1); PG8_BAR; PG8_SCHED;
            } else {
            PG8_LDB(B0, 0, 0); PG8_SCHED; PG8_LDA(At, 0, 0); PG8_STAGE(PG8_SA(1, 1), a1 + hstep, voffA);
            PG8_WAIT_L(8); PG8_BAR; PG8_WAIT_L(0); PG8_MMA(0, 0, At, B0); PG8_BAR; PG8_SCHED;
            PG8_LDB(B1, 0, 1); PG8_STAGE(PG8_SB(0, 0), b2, voffB);
            PG8_BAR; PG8_WAIT_L(0); PG8_MMA(0, 1, At, B1); PG8_BAR;
            PG8_LDA(At, 0, 1); PG8_STAGE(PG8_SA(0, 0), a2, voffA);
            PG8_BAR; PG8_WAIT_L(0); PG8_MMA(1, 0, At, B0); PG8_BAR; PG8_SCHED;
            PG8_STAGE(PG8_SB(0, 1), b2 + hstep, voffB);
            PG8_WAIT_V(6); PG8_BAR; PG8_MMA(1, 1, At, B1); PG8_BAR;
            PG8_LDB(B0, 1, 0); PG8_SCHED; PG8_LDA(At, 1, 0); PG8_STAGE(PG8_SA(0, 1), a2 + hstep, voffA);
            PG8_WAIT_L(8); PG8_BAR; PG8_WAIT_L(0); PG8_MMA(0, 0, At, B0); PG8_BAR; PG8_SCHED;
            PG8_LDB(B1, 1, 1); PG8_STAGE(PG8_SB(1, 0), b3, voffB);
            PG8_BAR; PG8_WAIT_L(0); PG8_MMA(0, 1, At, B1); PG8_BAR;
            PG8_LDA(At, 1, 1); PG8_STAGE(PG8_SA(1, 0), a3, voffA);
            PG8_BAR; PG8_WAIT_L(0); PG8_MMA(1, 0, At, B0); PG8_BAR; PG8_SCHED;
            PG8_STAGE(PG8_SB(1, 1), b3 + hstep, voffB);
            PG8_WAIT_V(6); PG8_BAR; PG8_MMA(1, 1, At, B1); PG8_BAR;
            }
        }
        if constexpr (ALIGN_EPI) { if (wr == 0) PG8_BAR; }
        E(acc, cur, wr, wc, fr, fq);
        if (!has_next) break;
#pragma unroll
        for (int a = 0; a < 2; ++a)
#pragma unroll
            for (int b = 0; b < 2; ++b)
#pragma unroll
                for (int m = 0; m < 4; ++m)
#pragma unroll
                    for (int n = 0; n < 2; ++n) acc[a][b][m][n] = (f32x4){0.f, 0.f, 0.f, 0.f};
        cur = nxt; cA = nA; cB = nB; ++ui;
        if constexpr (ALIGN_EPI) { if (wr == 1) PG8_BAR; }
    }
    PG8_WAIT_V(0);
    if constexpr (!ALIGN_EPI) { if (wr == 0) PG8_BAR; }
    PG8_BAR;
#undef PG8_SA
#undef PG8_SB
#undef PG8_STAGE
#undef PG8_LDA
#undef PG8_LDB
#undef PG8_MMA
#undef PG8_WAIT_V
#undef PG8_WAIT_L
#undef PG8_BAR
#undef PG8_SCHED
}
}
using pg8::Unit;

#define EPI_ROWS(ai, m) (u.pm * 256 + (ai) * 128 + wr * 64 + (m) * 16 + fr)
struct EpiSwiglu {
    bf16_t* H;
    __device__ __forceinline__ void operator()(const f32x4 (&acc)[2][2][4][2], const Unit& u, int wr, int wc, int fr, int fq) const {
        const int col = u.pn * 128 + wc * 32 + 8 * fq;
#pragma unroll
        for (int ai = 0; ai < 2; ++ai)
#pragma unroll
            for (int m = 0; m < 4; ++m) {
                const size_t row = EPI_ROWS(ai, m);
                float h[8];
#pragma unroll
                for (int n = 0; n < 2; ++n)
#pragma unroll
                    for (int j = 0; j < 4; ++j) { const float g = acc[ai][0][m][n][j], uu = acc[ai][1][m][n][j]; h[4 * n + j] = g * uu * sigmoid_f(g); }
                u32x4 w; w.x = cvt_pk_bf16(h[0], h[1]); w.y = cvt_pk_bf16(h[2], h[3]); w.z = cvt_pk_bf16(h[4], h[5]); w.w = cvt_pk_bf16(h[6], h[7]);
                *(u32x4*)(H + row * FH + col) = w;
            }
    }
};
template <bool RES_BF16, bool HAS_MUL, bool OUT_BF16 = false>
struct EpiResid {
    const void* res; const bf16_t* mul; float* Y; float scale;
    __device__ __forceinline__ void operator()(const f32x4 (&acc)[2][2][4][2], const Unit& u, int wr, int wc, int fr, int fq) const {
#pragma unroll
        for (int ai = 0; ai < 2; ++ai)
#pragma unroll
            for (int m = 0; m < 4; ++m) {
                const size_t row = EPI_ROWS(ai, m);
#pragma unroll
                for (int bj = 0; bj < 2; ++bj) {
                    const size_t off = row * DM + u.pn * 256 + bj * 128 + wc * 32 + 8 * fq;
                    float r[8];
                    if (RES_BF16) { const u32x4 rv = *(const u32x4*)((const bf16_t*)res + off);
                        r[0] = bf_lo(rv.x); r[1] = bf_hi(rv.x); r[2] = bf_lo(rv.y); r[3] = bf_hi(rv.y); r[4] = bf_lo(rv.z); r[5] = bf_hi(rv.z); r[6] = bf_lo(rv.w); r[7] = bf_hi(rv.w); }
                    else { const f32x4 a = *(const f32x4*)((const float*)res + off), b = *(const f32x4*)((const float*)res + off + 4);
                        r[0] = a[0]; r[1] = a[1]; r[2] = a[2]; r[3] = a[3]; r[4] = b[0]; r[5] = b[1]; r[6] = b[2]; r[7] = b[3]; }
                    float mv[8];
                    if (HAS_MUL) { const u32x4 rv = *(const u32x4*)(mul + off);
                        mv[0] = bf_lo(rv.x); mv[1] = bf_hi(rv.x); mv[2] = bf_lo(rv.y); mv[3] = bf_hi(rv.y); mv[4] = bf_lo(rv.z); mv[5] = bf_hi(rv.z); mv[6] = bf_lo(rv.w); mv[7] = bf_hi(rv.w); }
                    f32x4 o0, o1;
#pragma unroll
                    for (int j = 0; j < 4; ++j) {
                        const float a0 = acc[ai][bj][m][0][j] * scale, a1 = acc[ai][bj][m][1][j] * scale;
                        o0[j] = ALPHA * r[j] + (HAS_MUL ? mv[j] * a0 : a0); o1[j] = ALPHA * r[4 + j] + (HAS_MUL ? mv[4 + j] * a1 : a1); }
                    if (OUT_BF16) { u32x4 w; w.x = cvt_pk_bf16(o0[0], o0[1]); w.y = cvt_pk_bf16(o0[2], o0[3]); w.z = cvt_pk_bf16(o1[0], o1[1]); w.w = cvt_pk_bf16(o1[2], o1[3]); *(u32x4*)((bf16_t*)Y + off) = w; }
                    else { *(f32x4*)(Y + off) = o0; *(f32x4*)(Y + off + 4) = o1; }
                }
            }
    }
};
struct EpiWin {
    bf16_t* proj; bf16_t* gates; float* ifg; const float* bias;
    __device__ __forceinline__ void operator()(const f32x4 (&acc)[2][2][4][2], const Unit& u, int wr, int wc, int fr, int fq) const {
        const int pn = u.pn;
        if (pn == 32) {
            if (wc == 0 && fq == 0) {
                const f32x4 bi = *(const f32x4*)(bias + 8192), bf = *(const f32x4*)(bias + 8196);
#pragma unroll
                for (int ai = 0; ai < 2; ++ai)
#pragma unroll
                    for (int m = 0; m < 4; ++m) {
                        const size_t row = EPI_ROWS(ai, m);
                        f32x4 iv = acc[ai][0][m][0] + bi, fv = acc[ai][0][m][1] + bf, lf;
#pragma unroll
                        for (int j = 0; j < 4; ++j) { const float xx = fv[j]; lf[j] = xx >= 0.f ? -log1pf(expf(-xx)) : xx - log1pf(expf(xx)); }
                        *(f32x4*)(ifg + row * 8) = iv; *(f32x4*)(ifg + row * 8 + 4) = lf;
                    }
            }
            return;
        }
        bf16_t* dst; int ld, c0; int act = 0; float sc = 1.0f;
        if (pn < 24) { const int sec = pn >> 2; dst = proj + (size_t)sec * ((size_t)MTOK * DM); ld = DM; c0 = (pn & 3) * 256; if (sec == 2) act = 1; if (sec == 3) sc = 0.08838834764831845f * LOG2E; }
        else { dst = gates; ld = 2 * DM; c0 = (pn - 24) * 256; act = 1; }
#pragma unroll
        for (int bj = 0; bj < 2; ++bj) {
            const int cl = bj * 128 + wc * 32 + 8 * fq;
            const f32x4 b0 = *(const f32x4*)(bias + pn * 256 + cl), b1 = *(const f32x4*)(bias + pn * 256 + cl + 4);
#pragma unroll
            for (int ai = 0; ai < 2; ++ai)
#pragma unroll
                for (int m = 0; m < 4; ++m) {
                    const size_t row = EPI_ROWS(ai, m);
                    f32x4 v0 = acc[ai][bj][m][0] + b0, v1 = acc[ai][bj][m][1] + b1;
                    if (act) {
#pragma unroll
                        for (int j = 0; j < 4; ++j) { v0[j] = sigmoid_f(v0[j]); v1[j] = sigmoid_f(v1[j]); } }
                    else { v0 *= sc; v1 *= sc; }
                    u32x4 w; w.x = cvt_pk_bf16(v0[0], v0[1]); w.y = cvt_pk_bf16(v0[2], v0[3]); w.z = cvt_pk_bf16(v1[0], v1[1]); w.w = cvt_pk_bf16(v1[2], v1[3]);
                    *(u32x4*)(dst + row * ld + c0 + cl) = w;
                }
        }
    }
};
template <bool ADD>
struct EpiGateMul {
    const bf16_t* gate; int goff; const bf16_t* tin; bf16_t* out;
    __device__ __forceinline__ void operator()(const f32x4 (&acc)[2][2][4][2], const Unit& u, int wr, int wc, int fr, int fq) const {
#pragma unroll
        for (int ai = 0; ai < 2; ++ai)
#pragma unroll
            for (int m = 0; m < 4; ++m) {
                const size_t row = EPI_ROWS(ai, m);
#pragma unroll
                for (int bj = 0; bj < 2; ++bj) {
                    const int c = u.pn * 256 + bj * 128 + wc * 32 + 8 * fq;
                    const u32x4 gv = *(const u32x4*)(gate + row * (2 * DM) + goff + c);
                    float gg[8] = {bf_lo(gv.x), bf_hi(gv.x), bf_lo(gv.y), bf_hi(gv.y), bf_lo(gv.z), bf_hi(gv.z), bf_lo(gv.w), bf_hi(gv.w)};
                    float tt[8] = {0.f, 0.f, 0.f, 0.f, 0.f, 0.f, 0.f, 0.f};
                    if (ADD) { const u32x4 tv = *(const u32x4*)(tin + row * DM + c);
                        tt[0] = bf_lo(tv.x); tt[1] = bf_hi(tv.x); tt[2] = bf_lo(tv.y); tt[3] = bf_hi(tv.y); tt[4] = bf_lo(tv.z); tt[5] = bf_hi(tv.z); tt[6] = bf_lo(tv.w); tt[7] = bf_hi(tv.w); }
                    float o[8];
#pragma unroll
                    for (int j = 0; j < 4; ++j) { o[j] = tt[j] + gg[j] * acc[ai][bj][m][0][j]; o[4 + j] = tt[4 + j] + gg[4 + j] * acc[ai][bj][m][1][j]; }
                    u32x4 w; w.x = cvt_pk_bf16(o[0], o[1]); w.y = cvt_pk_bf16(o[2], o[3]); w.z = cvt_pk_bf16(o[4], o[5]); w.w = cvt_pk_bf16(o[6], o[7]);
                    *(u32x4*)(out + row * DM + c) = w;
                }
            }
    }
};
struct EpiSigBias {
    const float* bias; bf16_t* out;
    __device__ __forceinline__ void operator()(const f32x4 (&acc)[2][2][4][2], const Unit& u, int wr, int wc, int fr, int fq) const {
#pragma unroll
        for (int bj = 0; bj < 2; ++bj) {
            const int c = u.pn * 256 + bj * 128 + wc * 32 + 8 * fq;
            const f32x4 b0 = *(const f32x4*)(bias + c), b1 = *(const f32x4*)(bias + c + 4);
#pragma unroll
            for (int ai = 0; ai < 2; ++ai)
#pragma unroll
                for (int m = 0; m < 4; ++m) {
                    const size_t row = EPI_ROWS(ai, m);
                    f32x4 v0 = acc[ai][bj][m][0] + b0, v1 = acc[ai][bj][m][1] + b1;
#pragma unroll
                    for (int j = 0; j < 4; ++j) { v0[j] = sigmoid_f(v0[j]); v1[j] = sigmoid_f(v1[j]); }
                    u32x4 w; w.x = cvt_pk_bf16(v0[0], v0[1]); w.y = cvt_pk_bf16(v0[2], v0[3]); w.z = cvt_pk_bf16(v1[0], v1[1]); w.w = cvt_pk_bf16(v1[2], v1[3]);
                    *(u32x4*)(out + row * DM + c) = w;
                }
        }
    }
};

struct Params {
    const float *x, *p, *ln_g, *ln_b, *wg, *wu, *wd, *w_in, *b_in, *b_forget, *conv_w, *conv_b, *mh_g, *w_a, *w_b, *w_o, *w_ple, *w_pg, *b_pg;
    float* out; unsigned char* ws;
    int ph_lo, ph_hi, coop, pad;
};

__device__ void cvt_bf16_phase(const float* src, bf16_t* dst, size_t n8) {
    const size_t stride = (size_t)gridDim.x * NTHREADS;
    size_t i = (size_t)blockIdx.x * NTHREADS + threadIdx.x;
    for (; i + 3 * stride < n8; i += 4 * stride) {
        f32x4 a[4], b[4];
#pragma unroll
        for (int u = 0; u < 4; ++u) { a[u] = __builtin_nontemporal_load((const f32x4*)(src + (i + u * stride) * 8)); b[u] = __builtin_nontemporal_load((const f32x4*)(src + (i + u * stride) * 8 + 4)); }
#pragma unroll
        for (int u = 0; u < 4; ++u) { u32x4 w; w.x = cvt_pk_bf16(a[u][0], a[u][1]); w.y = cvt_pk_bf16(a[u][2], a[u][3]); w.z = cvt_pk_bf16(b[u][0], b[u][1]); w.w = cvt_pk_bf16(b[u][2], b[u][3]);
            *(u32x4*)(dst + (i + u * stride) * 8) = w; }
    }
    for (; i < n8; i += stride) {
        const f32x4 a = *(const f32x4*)(src + i * 8), b = *(const f32x4*)(src + i * 8 + 4);
        u32x4 w; w.x = cvt_pk_bf16(a[0], a[1]); w.y = cvt_pk_bf16(a[2], a[3]); w.z = cvt_pk_bf16(b[0], b[1]); w.w = cvt_pk_bf16(b[2], b[3]);
        *(u32x4*)(dst + i * 8) = w;
    }
}
template <int MODE>
__device__ __forceinline__ f32x4 tsrc_val4(const float* w0, const float* w1, int ldn, int k, int n) {
    if (MODE == 0) return *(const f32x4*)(w0 + (size_t)k * ldn + n);
    if (MODE == 1) { const int pn = n >> 8, sel = (n >> 7) & 1, i = n & 127; const float* w = sel ? w1 : w0; return *(const f32x4*)(w + (size_t)k * ldn + pn * 128 + i); }
    int col; if (n < 3072) col = n; else if (n < 8192) col = n + 8; else if (n < 8200) col = 3072 + (n - 8192); else return (f32x4){0.f, 0.f, 0.f, 0.f};
    return *(const f32x4*)(w0 + (size_t)k * ldn + col);
}
template <int MODE>
__device__ __forceinline__ void transpose_mat(LAS float* tile, const float* w0, const float* w1, int ldn, bf16_t* dst, int NP, int K, int& base) {
    const int tid = threadIdx.x;
    const int tn = NP / 128, tk = K / 128, nt = tn * tk;
    int first = ((int)blockIdx.x - base) % (int)gridDim.x; if (first < 0) first += gridDim.x;
    for (int t = first; t < nt; t += gridDim.x) {
        const int n0 = (t / tk) * 128, k0 = (t % tk) * 128;
#pragma unroll
        for (int e = 0; e < 8; ++e) { const int idx = e * NTHREADS + tid, kk = idx >> 5, n4 = (idx & 31) * 4; const f32x4 v = tsrc_val4<MODE>(w0, w1, ldn, k0 + kk, n0 + n4);
            tile[kk * 129 + n4] = v[0]; tile[kk * 129 + n4 + 1] = v[1]; tile[kk * 129 + n4 + 2] = v[2]; tile[kk * 129 + n4 + 3] = v[3]; }
        __syncthreads();
#pragma unroll 8
        for (int e = 0; e < 16; ++e) { const int idx = e * NTHREADS + tid, nn = idx >> 6, kk = (idx & 63) * 2;
            *(unsigned*)(dst + (size_t)(n0 + nn) * K + k0 + kk) = cvt_pk_bf16(tile[kk * 129 + nn], tile[(kk + 1) * 129 + nn]); }
        __syncthreads();
    }
    base += nt;
}
__device__ void prep_phase(const Params& P, LAS unsigned char* lds) {
    unsigned char* ws = P.ws;
    cvt_bf16_phase(P.x, (bf16_t*)(ws + WS_X), (size_t)MTOK * DM / 8);
    if (blockIdx.x == 0 && threadIdx.x < 64) ((unsigned*)(ws + MISC_CNT))[threadIdx.x] = 0u;
    for (int n = blockIdx.x * NTHREADS + threadIdx.x; n < NIN_PAD; n += gridDim.x * NTHREADS) {
        float b;
        if (n < 3072) b = P.b_in[n]; else if (n < 8192) b = P.b_in[n + 8]; else if (n < 8196) b = P.b_in[3072 + n - 8192];
        else if (n < 8200) b = P.b_in[3072 + n - 8192] + P.b_forget[n - 8196]; else b = 0.f;
        ((float*)(ws + W_BIAS))[n] = b;
    }
    LAS float* tile = (LAS float*)lds;
    int base = 0;
    transpose_mat<1>(tile, P.wg, P.wu, FH, (bf16_t*)(ws + W_GU1), 5632, 1024, base);
    transpose_mat<0>(tile, P.wd, nullptr, DM, (bf16_t*)(ws + W_D1), 1024, FH, base);
    transpose_mat<1>(tile, P.wg + (size_t)DM * FH, P.wu + (size_t)DM * FH, FH, (bf16_t*)(ws + W_GU2), 5632, 1024, base);
    transpose_mat<0>(tile, P.wd + (size_t)DM * FH, nullptr, DM, (bf16_t*)(ws + W_D2), 1024, FH, base);
    transpose_mat<2>(tile, P.w_in, nullptr, 8200, (bf16_t*)(ws + W_IN), NIN_PAD, 1024, base);
    transpose_mat<0>(tile, P.w_a, nullptr, DM, (bf16_t*)(ws + W_A), 1024, 1024, base);
    transpose_mat<0>(tile, P.w_b, nullptr, DM, (bf16_t*)(ws + W_B), 1024, 1024, base);
    transpose_mat<0>(tile, P.w_o, nullptr, DM, (bf16_t*)(ws + W_O), 1024, 1024, base);
    transpose_mat<0>(tile, P.w_pg, nullptr, DM, (bf16_t*)(ws + W_PG), 1024, 1024, base);
    transpose_mat<0>(tile, P.w_ple, nullptr, DM, (bf16_t*)(ws + W_P), 1024, 256, base);
}
template <bool OUT_BF16, bool IN_BF16 = false>
__device__ void ln_phase(const float* Y, const float* g, const float* b, void* out) {
    const int wid = threadIdx.x >> 6, lane = threadIdx.x & 63;
    f32x4 gv[4], bv[4];
#pragma unroll
    for (int i = 0; i < 4; ++i) { gv[i] = *(const f32x4*)(g + i * 256 + lane * 4); bv[i] = *(const f32x4*)(b + i * 256 + lane * 4); }
    for (int row0 = (blockIdx.x * 8 + wid) * 2; row0 < MTOK; row0 += gridDim.x * 16) {
        f32x4 v[2][4]; float s[2] = {0.f, 0.f};
#pragma unroll
        for (int r = 0; r < 2; ++r)
#pragma unroll
            for (int i = 0; i < 4; ++i) {
                if (IN_BF16) { const u32x2 t = __builtin_nontemporal_load((const u32x2*)((const bf16_t*)Y + (size_t)(row0 + r) * DM + i * 256 + lane * 4)); v[r][i] = (f32x4){bf_lo(t.x), bf_hi(t.x), bf_lo(t.y), bf_hi(t.y)}; }
                else v[r][i] = *(const f32x4*)(Y + (size_t)(row0 + r) * DM + i * 256 + lane * 4); }
#pragma unroll
        for (int r = 0; r < 2; ++r) {
#pragma unroll
            for (int i = 0; i < 4; ++i) s[r] += (v[r][i][0] + v[r][i][1]) + (v[r][i][2] + v[r][i][3]);
            const float mean = wave_sum(s[r]) * (1.0f / DM);
            float q = 0.f;
#pragma unroll
            for (int i = 0; i < 4; ++i) { const f32x4 d = v[r][i] - mean; q += (d[0] * d[0] + d[1] * d[1]) + (d[2] * d[2] + d[3] * d[3]); }
            const float rstd = rsqrtf(wave_sum(q) * (1.0f / DM) + LN_EPS);
#pragma unroll
            for (int i = 0; i < 4; ++i) {
                const f32x4 o = (v[r][i] - mean) * rstd * gv[i] + bv[i];
                if (OUT_BF16) { u32x2 w; w.x = cvt_pk_bf16(o[0], o[1]); w.y = cvt_pk_bf16(o[2], o[3]); *(u32x2*)((bf16_t*)out + (size_t)(row0 + r) * DM + i * 256 + lane * 4) = w; }
                else *(f32x4*)((float*)out + (size_t)(row0 + r) * DM + i * 256 + lane * 4) = o;
            }
        }
    }
}

constexpr int L_QI = 0, L_KI = 17408, L_KT = 34816, L_VT = 53248, L_PI = 90112, L_F = 99328;
constexpr int F_N = 0, F_QN = 128, F_RS = 192, F_HS = 320, F_BL = 1344, F_GM = 1472, F_M = 1600, F_CW = 1732, F_SA = 3012, F_SB2 = 3028, F_SMU = 4052, F_SWI = 5076, F_SWN = 6100, F_SEM = 7124, F_END = 8148;
constexpr int MIX_LDS = L_F + F_END * 4;

__device__ void mlstm_prologue(const Params& P, LAS unsigned char* lds, int b, int h, int gi) {
    LAS float* F = (LAS float*)(lds + L_F);
    const float* ifg = (const float*)(P.ws + MISC_IF);
    const int tid = threadIdx.x, w = tid >> 6, lane = tid & 63;
    const int nch = 16 * (gi + 1);
    for (int c0 = w; c0 < nch; c0 += 32) {
        float ivv[4], lfv[4];
#pragma unroll
        for (int u = 0; u < 4; ++u) { const int c = c0 + 8 * u; if (c < nch) { const size_t tok = (size_t)b * SEQ + c * 64 + lane; ivv[u] = ifg[tok * 8 + h]; lfv[u] = ifg[tok * 8 + 4 + h]; } else { ivv[u] = 0.f; lfv[u] = 0.f; } }
#pragma unroll
        for (int u = 0; u < 4; ++u) { const int c = c0 + 8 * u; if (c < nch) {
            const float bc = wave_incl_sum(lfv[u], lane);
            const float bl = __shfl(bc, 63);
            const float gm = wave_max(bl - bc + ivv[u]);
            if (lane == 0) { F[F_BL + c] = bl; F[F_GM + c] = gm; } } }
    }
    for (int i = tid; i < 1280; i += NTHREADS) {
        const int j = i >> 8, ch = i & 255; const int gc = ch < 128 ? h * 128 + ch : 512 + h * 128 + (ch - 128);
        F[F_CW + i] = j < 4 ? P.conv_w[j * 1024 + gc] : P.conv_b[gc];
    }
    if (tid < 128) F[F_N + tid] = 0.f;
    __syncthreads();
    if (tid == 0) { float m = 0.f; F[F_M] = 0.f; for (int c = 0; c < nch; ++c) { m = fmaxf(F[F_BL + c] + m, F[F_GM + c]); F[F_M + c + 1] = m; } }
    __syncthreads();
    for (int lc = w; lc < 16; lc += 8) {
        const int c = gi * 16 + lc;
        const size_t tok = (size_t)b * SEQ + c * 64 + lane;
        const float iv = ifg[tok * 8 + h], lf = ifg[tok * 8 + 4 + h];
        const float bc = wave_incl_sum(lf, lane);
        const float bl = __shfl(bc, 63);
        const float mst = F[F_M + c], mnew = F[F_M + c + 1];
        const float beta = iv - bc;
        const float mu = fmaxf(mst, wave_incl_max(beta, lane));
        F[F_SB2 + lc * 64 + lane] = beta * LOG2E;
        F[F_SMU + lc * 64 + lane] = mu * LOG2E;
        F[F_SWI + lc * 64 + lane] = expf(mst - mu);
        F[F_SWN + lc * 64 + lane] = expf(bl - bc + iv - mnew);
        F[F_SEM + lc * 64 + lane] = expf(-(bc + mu));
        if (lane == 0) F[F_SA + lc] = expf(bl + mst - mnew);
    }
    __syncthreads();
}

struct MlRaw { u32x4 vr[4]; u32x4 raw[7]; };
template <bool NEED_Q>
__device__ __forceinline__ void mlstm_issue(const Params& P, int b, int h, int c, MlRaw& R) {
    const bf16_t* QK = (const bf16_t*)(P.ws + WS_QK);
    const bf16_t* VA = (const bf16_t*)(P.ws + WS_VA);
    const int tid = threadIdx.x, tg = tid & 15, cg = tid >> 4;
#pragma unroll
    for (int tt = 0; tt < 4; ++tt) R.vr[tt] = *(const u32x4*)(VA + ((size_t)b * SEQ + c * 64 + 4 * tg + tt) * DM + h * 256 + 8 * cg);
    if (NEED_Q || cg >= 16) {
        const int gc = cg < 16 ? h * 128 + 8 * cg : 512 + h * 128 + 8 * (cg - 16);
#pragma unroll
        for (int i = 0; i < 7; ++i) {
            const int pos = c * 64 + 4 * tg - 3 + i;
            R.raw[i] = pos >= 0 ? *(const u32x4*)(QK + ((size_t)b * SEQ + pos) * DM + gc) : (u32x4){0u, 0u, 0u, 0u};
        }
    }
}
template <bool NEED_Q>
__device__ __forceinline__ void mlstm_load(LAS unsigned char* lds, const MlRaw& R, int lc) {
    LAS float* F = (LAS float*)(lds + L_F);
    const int tid = threadIdx.x, tg = tid & 15, cg = tid >> 4;
    {
        const u32x4 (&vr)[4] = R.vr;
#pragma unroll
        for (int e = 0; e < 8; ++e) {
            unsigned short x0, x1, x2, x3;
            { const unsigned a0 = vr[0][e >> 1], a1 = vr[1][e >> 1], a2 = vr[2][e >> 1], a3 = vr[3][e >> 1];
              if (e & 1) { x0 = a0 >> 16; x1 = a1 >> 16; x2 = a2 >> 16; x3 = a3 >> 16; } else { x0 = a0 & 0xffff; x1 = a1 & 0xffff; x2 = a2 & 0xffff; x3 = a3 & 0xffff; } }
            u32x2 wv; wv.x = (unsigned)x0 | ((unsigned)x1 << 16); wv.y = (unsigned)x2 | ((unsigned)x3 << 16);
            *(LAS u32x2*)(lds + L_VT + (8 * cg + e) * 144 + 8 * tg) = wv;
        }
    }
    __builtin_amdgcn_sched_barrier(0);
    if (NEED_Q || cg >= 16) {
        const u32x4 (&raw)[7] = R.raw;
        float o[4][8];
#pragma unroll
        for (int e = 0; e < 8; ++e) {
            float rv[7];
#pragma unroll
            for (int i = 0; i < 7; ++i) rv[i] = (e & 1) ? bf_hi(raw[i][e >> 1]) : bf_lo(raw[i][e >> 1]);
            const float w0 = F[F_CW + 0 * 256 + 8 * cg + e], w1 = F[F_CW + 1 * 256 + 8 * cg + e], w2 = F[F_CW + 2 * 256 + 8 * cg + e], w3 = F[F_CW + 3 * 256 + 8 * cg + e], cb = F[F_CW + 4 * 256 + 8 * cg + e];
#pragma unroll
            for (int tt = 0; tt < 4; ++tt) { const float v = cb + w0 * rv[tt] + w1 * rv[tt + 1] + w2 * rv[tt + 2] + w3 * rv[tt + 3]; o[tt][e] = v * sigmoid_f(v); }
            __builtin_amdgcn_sched_barrier(0);
        }
        if (cg < 16) {
#pragma unroll
            for (int tt = 0; tt < 4; ++tt) { u32x4 wv; wv.x = cvt_pk_bf16(o[tt][0], o[tt][1]); wv.y = cvt_pk_bf16(o[tt][2], o[tt][3]); wv.z = cvt_pk_bf16(o[tt][4], o[tt][5]); wv.w = cvt_pk_bf16(o[tt][6], o[tt][7]);
                *(LAS u32x4*)(lds + L_QI + (4 * tg + tt) * 272 + 16 * cg) = wv; }
        } else {
            const int kc = cg - 16;
            const f32x4 wn = *(const LAS f32x4*)(F + F_SWN + lc * 64 + 4 * tg);
#pragma unroll
            for (int tt = 0; tt < 4; ++tt) {
#pragma unroll
                for (int e = 0; e < 8; ++e) o[tt][e] *= 0.08838834764831845f;
                u32x4 wv; wv.x = cvt_pk_bf16(o[tt][0], o[tt][1]); wv.y = cvt_pk_bf16(o[tt][2], o[tt][3]); wv.z = cvt_pk_bf16(o[tt][4], o[tt][5]); wv.w = cvt_pk_bf16(o[tt][6], o[tt][7]);
                *(LAS u32x4*)(lds + L_KI + (4 * tg + tt) * 272 + 16 * kc) = wv; }
#pragma unroll
            for (int e = 0; e < 8; ++e) { u32x2 wv; wv.x = cvt_pk_bf16(o[0][e] * wn[0], o[1][e] * wn[1]); wv.y = cvt_pk_bf16(o[2][e] * wn[2], o[3][e] * wn[3]);
                *(LAS u32x2*)(lds + L_KT + (8 * kc + e) * 144 + 8 * tg) = wv; }
        }
    }
}

__device__ __forceinline__ void mlstm_update(LAS unsigned char* lds, f32x4 (&C)[2][8], int lc, int w, int r, int g) {
    LAS float* F = (LAS float*)(lds + L_F);
    const float a = F[F_SA + lc];
    const LAS unsigned char* vp = lds + (L_VT + (32 * w + r) * 144 + 16 * g);
    const LAS unsigned char* kp = lds + (L_KT + r * 144 + 16 * g);
#pragma unroll
    for (int dvb = 0; dvb < 2; ++dvb)
#pragma unroll
        for (int dkb = 0; dkb < 8; ++dkb) C[dvb][dkb] *= a;
#pragma unroll
    for (int ks = 0; ks < 2; ++ks) {
        bf16x8 vf[2];
#pragma unroll
        for (int dvb = 0; dvb < 2; ++dvb) vf[dvb] = *(const LAS bf16x8*)(vp + (16 * dvb * 144 + 64 * ks));
#pragma unroll
        for (int dkb = 0; dkb < 8; ++dkb) {
            const bf16x8 kf = *(const LAS bf16x8*)(kp + (16 * dkb * 144 + 64 * ks));
#pragma unroll
            for (int dvb = 0; dvb < 2; ++dvb) C[dvb][dkb] = mfma16(kf, vf[dvb], C[dvb][dkb]);
        }
        __builtin_amdgcn_sched_barrier(0);
    }
    const int tid = threadIdx.x, dk = tid >> 2, part = tid & 3;
    const u32x4 k0 = *(const LAS u32x4*)(lds + L_KT + dk * 144 + 32 * part), k1 = *(const LAS u32x4*)(lds + L_KT + dk * 144 + 32 * part + 16);
    float s = 0.f;
#pragma unroll
    for (int i = 0; i < 4; ++i) s += bf_lo(k0[i]) + bf_hi(k0[i]) + bf_lo(k1[i]) + bf_hi(k1[i]);
    s += __shfl_xor(s, 1); s += __shfl_xor(s, 2);
    if (part == 0) F[F_N + dk] = a * F[F_N + dk] + s;
}

__device__ void mlstm_phase1(const Params& P, LAS unsigned char* lds) {
    const int tid = threadIdx.x, w = tid >> 6, lane = tid & 63, r = lane & 15, g = lane >> 4;
    LAS float* F = (LAS float*)(lds + L_F);
    for (int task = blockIdx.x; task < 256; task += gridDim.x) {
        const int gi = task & 7, st = task >> 3, b = st >> 2, h = st & 3;
        if (gi == 7) continue;
        mlstm_prologue(P, lds, b, h, gi);
        f32x4 C[2][8];
#pragma unroll
        for (int i = 0; i < 2; ++i)
#pragma unroll
            for (int j = 0; j < 8; ++j) C[i][j] = (f32x4){0.f, 0.f, 0.f, 0.f};
        MlRaw R;
        mlstm_issue<false>(P, b, h, gi * 16, R);
        for (int lc = 0; lc < 16; ++lc) {
            mlstm_load<false>(lds, R, lc);
            __syncthreads();
            if (lc < 15) mlstm_issue<false>(P, b, h, gi * 16 + lc + 1, R);
            mlstm_update(lds, C, lc, w, r, g);
            __syncthreads();
        }
        float* slot = (float*)(P.ws + WS_PB) + (size_t)(st * 7 + gi) * STATE_FLOATS;
#pragma unroll
        for (int dvb = 0; dvb < 2; ++dvb)
#pragma unroll
            for (int dkb = 0; dkb < 8; ++dkb) *(f32x4*)(slot + (((w * 2 + dvb) * 8 + dkb) * 64 + lane) * 4) = C[dvb][dkb];
        if (tid < 128) slot[32768 + tid] = F[F_N + tid];
        __syncthreads();
    }
}

__device__ void mlstm_phase2(const Params& P, LAS unsigned char* lds) {
    const int tid = threadIdx.x, w = tid >> 6, lane = tid & 63, r = lane & 15, g = lane >> 4;
    LAS float* F = (LAS float*)(lds + L_F);
    const bf16_t* OA = (const bf16_t*)(P.ws + WS_OA);
    bf16_t* VA = (bf16_t*)(P.ws + WS_VA);
    for (int task = blockIdx.x; task < 256; task += gridDim.x) {
        const int gi = task & 7, st = task >> 3, b = st >> 2, h = st & 3;
        mlstm_prologue(P, lds, b, h, gi);
        f32x4 C[2][8];
#pragma unroll
        for (int i = 0; i < 2; ++i)
#pragma unroll
            for (int j = 0; j < 8; ++j) C[i][j] = (f32x4){0.f, 0.f, 0.f, 0.f};
        float nreg = 0.f;
        for (int j = 0; j < gi; ++j) {
            float Bj = 0.f;
            for (int c = 0; c < 16; ++c) Bj += F[F_BL + j * 16 + c];
            const float Aj = expf(Bj + F[F_M + 16 * j] - F[F_M + 16 * j + 16]);
            const float* slot = (const float*)(P.ws + WS_PB) + (size_t)(st * 7 + j) * STATE_FLOATS;
#pragma unroll
            for (int dvb = 0; dvb < 2; ++dvb)
#pragma unroll
                for (int dkb = 0; dkb < 8; ++dkb) C[dvb][dkb] = C[dvb][dkb] * Aj + *(const f32x4*)(slot + (((w * 2 + dvb) * 8 + dkb) * 64 + lane) * 4);
            if (tid < 128) nreg = nreg * Aj + slot[32768 + tid];
        }
        if (tid < 128) F[F_N + tid] = nreg;
        __syncthreads();
        for (int lc = 0; lc < 16; ++lc) {
            const int c = gi * 16 + lc;
            MlRaw R;
            mlstm_issue<true>(P, b, h, c, R);
            mlstm_load<true>(lds, R, lc);
            __syncthreads();
            {
                const int tb = w >> 1, par = w & 1;
                const LAS unsigned char* qpS = lds + (L_QI + (16 * tb + r) * 272 + 16 * g);
                const LAS unsigned char* kpS = lds + (L_KI + (16 * par + r) * 272 + 16 * g);
                LAS unsigned char* ppS = lds + (L_PI + (16 * tb + r) * 144 + 32 * par + 8 * g);
                bf16x8 qf[4];
#pragma unroll
                for (int kd = 0; kd < 4; ++kd) qf[kd] = *(const LAS bf16x8*)(qpS + 64 * kd);
                const float mu2 = F[F_SMU + lc * 64 + 16 * tb + r];
                float rs = 0.f;
#pragma unroll
                for (int sbi = 0; sbi < 2; ++sbi) {
                    const int sb = par + 2 * sbi;
                    u32x2 pw = (u32x2){0u, 0u};
                    if (sb <= tb) {
                        f32x4 acc = (f32x4){0.f, 0.f, 0.f, 0.f};
#pragma unroll
                        for (int kd = 0; kd < 4; ++kd) { const bf16x8 kf = *(const LAS bf16x8*)(kpS + (32 * sbi * 272 + 64 * kd)); acc = mfma16(kf, qf[kd], acc); }
                        const f32x4 b2 = *(const LAS f32x4*)(F + F_SB2 + lc * 64 + 16 * sb + 4 * g);
                        float pv[4];
#pragma unroll
                        for (int j = 0; j < 4; ++j) { const int s = 16 * sb + 4 * g + j, t = 16 * tb + r; pv[j] = (s <= t) ? acc[j] * fast_exp2(b2[j] - mu2) : 0.f; }
                        pw.x = cvt_pk_bf16(pv[0], pv[1]); pw.y = cvt_pk_bf16(pv[2], pv[3]);
                        rs += bf_lo(pw.x) + bf_hi(pw.x) + bf_lo(pw.y) + bf_hi(pw.y);
                    }
                    *(LAS u32x2*)(ppS + 64 * sbi) = pw;
                }
                rs += __shfl_xor(rs, 16); rs += __shfl_xor(rs, 32);
                if (g == 0) F[F_RS + par * 64 + 16 * tb + r] = rs;
            }
            __builtin_amdgcn_sched_barrier(0);
            const LAS unsigned char* q8p = lds + (L_QI + r * 272 + 8 * g);
            f32x4 num[2][4];
#pragma unroll
            for (int i = 0; i < 2; ++i)
#pragma unroll
                for (int j = 0; j < 4; ++j) num[i][j] = (f32x4){0.f, 0.f, 0.f, 0.f};
#pragma unroll
            for (int kk = 0; kk < 4; ++kk) {
                bf16x8 af[2];
#pragma unroll
                for (int dvb = 0; dvb < 2; ++dvb) {
                    u32x2 lo, hi; lo.x = cvt_pk_bf16(C[dvb][2 * kk][0], C[dvb][2 * kk][1]); lo.y = cvt_pk_bf16(C[dvb][2 * kk][2], C[dvb][2 * kk][3]);
                    hi.x = cvt_pk_bf16(C[dvb][2 * kk + 1][0], C[dvb][2 * kk + 1][1]); hi.y = cvt_pk_bf16(C[dvb][2 * kk + 1][2], C[dvb][2 * kk + 1][3]);
                    af[dvb] = mk8(lo, hi);
                }
#pragma unroll
                for (int tb = 0; tb < 4; ++tb) {
                    const u32x2 q0 = *(const LAS u32x2*)(q8p + (16 * tb * 272 + 64 * kk)), q1 = *(const LAS u32x2*)(q8p + (16 * tb * 272 + 64 * kk + 32));
                    const bf16x8 bq = mk8(q0, q1);
#pragma unroll
                    for (int dvb = 0; dvb < 2; ++dvb) num[dvb][tb] = mfma16(af[dvb], bq, num[dvb][tb]);
                }
                __builtin_amdgcn_sched_barrier(0);
            }
#pragma unroll
            for (int tb = 0; tb < 4; ++tb) { const float wi = F[F_SWI + lc * 64 + 16 * tb + r];
#pragma unroll
                for (int dvb = 0; dvb < 2; ++dvb) num[dvb][tb] *= wi; }
            {
                const int t = tid >> 3, part = tid & 7;
                const u32x4 q0 = *(const LAS u32x4*)(lds + L_QI + t * 272 + 32 * part), q1 = *(const LAS u32x4*)(lds + L_QI + t * 272 + 32 * part + 16);
                float s = 0.f;
#pragma unroll
                for (int i = 0; i < 4; ++i) {
                    s += bf_lo(q0[i]) * F[F_N + 16 * part + 2 * i] + bf_hi(q0[i]) * F[F_N + 16 * part + 2 * i + 1];
                    s += bf_lo(q1[i]) * F[F_N + 16 * part + 8 + 2 * i] + bf_hi(q1[i]) * F[F_N + 16 * part + 8 + 2 * i + 1];
                }
                s += __shfl_xor(s, 1); s += __shfl_xor(s, 2); s += __shfl_xor(s, 4);
                if (part == 0) F[F_QN + t] = s;
            }
            __builtin_amdgcn_sched_barrier(0);
            __syncthreads();
            const LAS unsigned char* vpC = lds + (L_VT + (32 * w + r) * 144 + 16 * g);
            const LAS unsigned char* ppC = lds + (L_PI + r * 144 + 16 * g);
#pragma unroll
            for (int ks = 0; ks < 2; ++ks) {
                bf16x8 vf[2];
#pragma unroll
                for (int dvb = 0; dvb < 2; ++dvb) vf[dvb] = *(const LAS bf16x8*)(vpC + (16 * dvb * 144 + 64 * ks));
#pragma unroll
                for (int tb = 0; tb < 4; ++tb) {
                    if (ks == 0 || tb >= 2) {
                        const bf16x8 pb = *(const LAS bf16x8*)(ppC + (16 * tb * 144 + 64 * ks));
#pragma unroll
                        for (int dvb = 0; dvb < 2; ++dvb) num[dvb][tb] = mfma16(vf[dvb], pb, num[dvb][tb]);
                    }
                }
                __builtin_amdgcn_sched_barrier(0);
            }
#pragma unroll
            for (int tb = 0; tb < 4; ++tb) {
                const int t = 16 * tb + r;
                const float den = F[F_SWI + lc * 64 + t] * F[F_QN + t] + F[F_RS + t] + F[F_RS + 64 + t];
                const float inv = 1.0f / fmaxf(fabsf(den), F[F_SEM + lc * 64 + t]);
                float s1 = 0.f, s2 = 0.f;
#pragma unroll
                for (int dvb = 0; dvb < 2; ++dvb) { num[dvb][tb] *= inv;
#pragma unroll
                    for (int j = 0; j < 4; ++j) { const float v = num[dvb][tb][j]; s1 += v; s2 += v * v; } }
                s1 += __shfl_xor(s1, 16); s1 += __shfl_xor(s1, 32); s2 += __shfl_xor(s2, 16); s2 += __shfl_xor(s2, 32);
                if (g == 0) { F[F_HS + (w * 64 + t) * 2] = s1; F[F_HS + (w * 64 + t) * 2 + 1] = s2; }
                __builtin_amdgcn_sched_barrier(0);
            }
            mlstm_update(lds, C, lc, w, r, g);
            __builtin_amdgcn_sched_barrier(0);
            __syncthreads();
#pragma unroll
            for (int tb = 0; tb < 4; ++tb) {
                const int t = 16 * tb + r;
                float s1 = 0.f, s2 = 0.f;
#pragma unroll
                for (int ww = 0; ww < 8; ++ww) { s1 += F[F_HS + (ww * 64 + t) * 2]; s2 += F[F_HS + (ww * 64 + t) * 2 + 1]; }
                const float mean = s1 * (1.0f / 256.0f), var = fmaxf(s2 * (1.0f / 256.0f) - mean * mean, 0.f), rstd = rsqrtf(var + LN_EPS);
                const size_t tok = (size_t)b * SEQ + c * 64 + t;
#pragma unroll
                for (int dvb = 0; dvb < 2; ++dvb) {
                    const int dv0 = 32 * w + 16 * dvb + 4 * g;
                    const f32x4 gn = *(const f32x4*)(P.mh_g + h * 256 + dv0);
                    const u32x2 og = *(const u32x2*)(OA + tok * DM + h * 256 + dv0);
                    const float y0 = (num[dvb][tb][0] - mean) * rstd * gn[0] * bf_lo(og.x), y1 = (num[dvb][tb][1] - mean) * rstd * gn[1] * bf_hi(og.x);
                    const float y2 = (num[dvb][tb][2] - mean) * rstd * gn[2] * bf_lo(og.y), y3 = (num[dvb][tb][3] - mean) * rstd * gn[3] * bf_hi(og.y);
                    u32x2 wv; wv.x = cvt_pk_bf16(y0, y1); wv.y = cvt_pk_bf16(y2, y3);
                    *(u32x2*)(VA + tok * DM + h * 256 + dv0) = wv;
                }
            }
        }
        __syncthreads();
    }
}

constexpr int A_KI = 0, A_VT = 17408, A_FL = 35840;
constexpr float SB_DONE_LOG2 = -40.0f;

__device__ void attn_phase(const Params& P, LAS unsigned char* lds) {
    const int tid = threadIdx.x, w = tid >> 6, lane = tid & 63, r = lane & 15, g = lane >> 4;
    bf16_t* QB = (bf16_t*)(P.ws + WS_QB);
    const bf16_t* KB = (const bf16_t*)(P.ws + WS_KB);
    const bf16_t* VB = (const bf16_t*)(P.ws + WS_VB);
    unsigned* cnt = (unsigned*)(P.ws + MISC_CNT);
    LAS int* FL = (LAS int*)(lds + A_FL);
    for (;;) {
        if (tid == 0) FL[32] = (int)atomicAdd(cnt, 1u);
        __syncthreads();
        const int item = FL[32];
        __syncthreads();
        if (item >= 4096) break;
        const int qb = 63 - (item >> 6), b = (item >> 3) & 7, h = item & 7;
        const int q0w = qb * 128 + 16 * w;
        const size_t qtok = (size_t)b * SEQ + q0w + r;
        bf16x8 qf[4];
#pragma unroll
        for (int kd = 0; kd < 4; ++kd) qf[kd] = *(const bf16x8*)(QB + qtok * DM + h * 128 + 32 * kd + 8 * g);
        f32x4 O[8];
#pragma unroll
        for (int i = 0; i < 8; ++i) O[i] = (f32x4){0.f, 0.f, 0.f, 0.f};
        float R = 0.f;
        int wdone = 0, it = 0;
        u32x4 pre[4];
        const int ptg = tid & 15, pcg = (tid >> 4) & 15, prow = (tid - 256) >> 2, pch = tid & 3;
        auto issue_tile = [&](int kt_) {
            if (tid < 256) {
#pragma unroll
                for (int tt = 0; tt < 4; ++tt) pre[tt] = *(const u32x4*)(VB + ((size_t)b * SEQ + kt_ * 64 + 4 * ptg + tt) * DM + h * 128 + 8 * pcg);
            } else {
                const bf16_t* src_ = KB + ((size_t)b * SEQ + kt_ * 64 + prow) * DM + h * 128 + 32 * pch;
#pragma unroll
                for (int i = 0; i < 4; ++i) pre[i] = *(const u32x4*)(src_ + 8 * i);
            }
        };
        issue_tile(2 * qb + 1);
        for (int kt = 2 * qb + 1; kt >= 0; --kt, ++it) {
            if (tid < 256) {
#pragma unroll
                for (int e = 0; e < 8; ++e) {
                    unsigned short x0, x1, x2, x3;
                    { const unsigned a0 = pre[0][e >> 1], a1 = pre[1][e >> 1], a2 = pre[2][e >> 1], a3 = pre[3][e >> 1];
                      if (e & 1) { x0 = a0 >> 16; x1 = a1 >> 16; x2 = a2 >> 16; x3 = a3 >> 16; } else { x0 = a0 & 0xffff; x1 = a1 & 0xffff; x2 = a2 & 0xffff; x3 = a3 & 0xffff; } }
                    u32x2 wv; wv.x = (unsigned)x0 | ((unsigned)x1 << 16); wv.y = (unsigned)x2 | ((unsigned)x3 << 16);
                    *(LAS u32x2*)(lds + A_VT + (8 * pcg + e) * 144 + 8 * ptg) = wv;
                }
            } else {
#pragma unroll
                for (int i = 0; i < 4; ++i) *(LAS u32x4*)(lds + A_KI + prow * 272 + 64 * pch + 16 * i) = pre[i];
            }
            __syncthreads();
            if (kt > 0) issue_tile(kt - 1);
            const int key0 = kt * 64;
            if (!wdone && key0 <= q0w + 14) {
                const int qpos = q0w + r;
                float wgt[4][4];
                float Rrun = R;
#pragma unroll
                for (int sb = 3; sb >= 0; --sb) {
                    f32x4 acc = (f32x4){0.f, 0.f, 0.f, 0.f};
#pragma unroll
                    for (int kd = 0; kd < 4; ++kd) { const bf16x8 kf = *(const LAS bf16x8*)(lds + A_KI + (16 * sb + r) * 272 + 64 * kd + 16 * g); acc = mfma16(kf, qf[kd], acc); }
                    float lk[4], z[4];
#pragma unroll
                    for (int j = 0; j < 4; ++j) {
                        const int key = key0 + 16 * sb + 4 * g + j;
                        z[j] = fminf(acc[j], 80.0f);
                        lk[j] = (key < qpos) ? -fast_log2(1.0f + fast_exp2(z[j])) : 0.f;
                    }
                    const float s3 = lk[3], s2 = s3 + lk[2], s1 = s2 + lk[1], s0 = s1 + lk[0];
                    const float t1 = __shfl_xor(s0, 16), t2 = __shfl_xor(s0, 32), t3 = __shfl_xor(t1, 32);
                    const float above = g == 0 ? (t1 + t2 + t3) : (g == 1 ? (t2 + t3) : (g == 2 ? t1 : 0.f));
                    const float base = Rrun + above;
                    const float sj[4] = {s0, s1, s2, s3};
#pragma unroll
                    for (int j = 0; j < 4; ++j) { const int key = key0 + 16 * sb + 4 * g + j; wgt[sb][j] = (key < qpos) ? fast_exp2(z[j] + base + sj[j]) : 0.f; }
                    Rrun += (s0 + t1) + (t2 + t3);
                }
                R = Rrun;
#pragma unroll
                for (int ks = 0; ks < 2; ++ks) {
                    u32x2 lo, hi; lo.x = cvt_pk_bf16(wgt[2 * ks][0], wgt[2 * ks][1]); lo.y = cvt_pk_bf16(wgt[2 * ks][2], wgt[2 * ks][3]);
                    hi.x = cvt_pk_bf16(wgt[2 * ks + 1][0], wgt[2 * ks + 1][1]); hi.y = cvt_pk_bf16(wgt[2 * ks + 1][2], wgt[2 * ks + 1][3]);
                    const bf16x8 pf = mk8(lo, hi);
#pragma unroll
                    for (int db = 0; db < 8; ++db) {
                        const u32x2 v0 = *(const LAS u32x2*)(lds + A_VT + (16 * db + r) * 144 + 64 * ks + 8 * g), v1 = *(const LAS u32x2*)(lds + A_VT + (16 * db + r) * 144 + 64 * ks + 32 + 8 * g);
                        O[db] = mfma16(mk8(v0, v1), pf, O[db]);
                    }
                }
                wdone = __all(R < SB_DONE_LOG2) ? 1 : 0;
            }
            if (lane == 0) FL[(it & 1) * 8 + w] = wdone;
            __syncthreads();
            int alld = 1;
#pragma unroll
            for (int i = 0; i < 8; ++i) alld &= FL[(it & 1) * 8 + i];
            if (alld) break;
        }
#pragma unroll
        for (int db = 0; db < 8; ++db) { u32x2 wv; wv.x = cvt_pk_bf16(O[db][0], O[db][1]); wv.y = cvt_pk_bf16(O[db][2], O[db][3]);
            *(u32x2*)(QB + qtok * DM + h * 128 + 16 * db + 4 * g) = wv; }
        __syncthreads();
    }
}


#ifdef DIAG
__device__ void diag_count_f32(const float* p, size_t n, float thr, unsigned* ctr) {
    unsigned c = 0;
    for (size_t i = (size_t)blockIdx.x * NTHREADS + threadIdx.x; i < n; i += (size_t)gridDim.x * NTHREADS) { const float v = p[i]; if (!(fabsf(v) <= thr)) ++c; }
    if (c) atomicAdd(ctr, c);
}
__device__ void diag_count_bf16(const bf16_t* p, size_t n, float thr, unsigned* ctr) {
    unsigned c = 0;
    for (size_t i = (size_t)blockIdx.x * NTHREADS + threadIdx.x; i < n; i += (size_t)gridDim.x * NTHREADS) { const float v = __uint_as_float((unsigned)p[i] << 16); if (!(fabsf(v) <= thr)) ++c; }
    if (c) atomicAdd(ctr, c);
}
#endif
#define XB_TMO      128
#define XB_XCNT(j)  (256  + 64 * (j))
#define XB_XSUB(j)  (1280 + 64 * (j))
#define XB_XGEN(j)  (2304 + 64 * (j))
#define XB_TOP      3328
#define XB_TOPGEN   3392
#define XCD_BAR_WORDS 3456
#define XB_SPIN_CAP (1u << 18)

__device__ __forceinline__ unsigned xb_ld(unsigned* p)              { return __hip_atomic_load(p, __ATOMIC_RELAXED, __HIP_MEMORY_SCOPE_AGENT); }
__device__ __forceinline__ unsigned xb_add(unsigned* p, unsigned v) { return __hip_atomic_fetch_add(p, v, __ATOMIC_RELAXED, __HIP_MEMORY_SCOPE_AGENT); }
__device__ __forceinline__ unsigned xb_xcc_id() { return (unsigned)__builtin_amdgcn_s_getreg((3 << 11) | 20) & 0xFu; }
#define XB_SPIN(cond, bar) do { unsigned _sp = 0; while (cond) { __builtin_amdgcn_s_sleep(1); \
    if ((++_sp & 255u) == 0u) { if (xb_ld(&(bar)[XB_TMO])) break; if (_sp > XB_SPIN_CAP) { atomicAdd(&(bar)[XB_TMO], 1u); break; } } } } while (0)

struct XcdBarrier {
    unsigned* bar; unsigned x;
    volatile LAS unsigned* st;
};

__device__ __forceinline__ XcdBarrier xcd_barrier_post(unsigned* bar, volatile LAS unsigned* st) {
    XcdBarrier b; b.bar = bar; b.x = xb_xcc_id(); b.st = st;
    if (threadIdx.x == 0) (void)xb_add(&bar[XB_XCNT(b.x)], 1u);
    return b;
}
__device__ __forceinline__ void xcd_barrier_complete(unsigned* bar, unsigned x, unsigned& nloc, unsigned& nx) {
    const unsigned G = gridDim.x * gridDim.y * gridDim.z;
    unsigned sum, cnt, mine, sp = 0u;
    for (;;) {
        sum = 0u; cnt = 0u; mine = 0u;
#pragma unroll
        for (unsigned j = 0; j < 16; ++j) { const unsigned c = xb_ld(&bar[XB_XCNT(j)]); sum += c; cnt += (c > 0u) ? 1u : 0u; mine = (j == x) ? c : mine; }
        if (sum == G) break;
        __builtin_amdgcn_s_sleep(1);
        if ((++sp & 255u) == 0u) { if (xb_ld(&bar[XB_TMO])) break; if (sp > XB_SPIN_CAP) { atomicAdd(&bar[XB_TMO], 1u); break; } }
    }
    nloc = mine > 0u ? mine : 1u; nx = cnt > 0u ? cnt : 1u;
}

__device__ __forceinline__ void xcd_barrier(const XcdBarrier& b) {
    asm volatile("s_waitcnt vmcnt(0)" ::: "memory");
    __syncthreads();
    if (threadIdx.x == 0) {
        unsigned* bar = b.bar;
        __builtin_amdgcn_s_waitcnt(0);
        unsigned nloc = b.st[0], nx = b.st[1];
        if (nloc == 0u) { xcd_barrier_complete(bar, b.x, nloc, nx); b.st[0] = nloc; b.st[1] = nx; }
        const unsigned old = xb_add(&bar[XB_XSUB(b.x)], 1u);
        const unsigned gen = old / nloc;
        if (old + 1u == (gen + 1u) * nloc) {
            __builtin_amdgcn_fence(__ATOMIC_RELEASE, "agent");
            asm volatile("s_waitcnt vmcnt(0)" ::: "memory");
            const unsigned og = xb_add(&bar[XB_TOP], 1u);
            const unsigned tg = og / nx;
            if (og + 1u == (tg + 1u) * nx) xb_add(&bar[XB_TOPGEN], 1u);
            else XB_SPIN(xb_ld(&bar[XB_TOPGEN]) == tg, bar);
            __builtin_amdgcn_fence(__ATOMIC_ACQUIRE, "agent");
            xb_add(&bar[XB_XGEN(b.x)], 1u);
            asm volatile("s_waitcnt vmcnt(0)" ::: "memory");
        } else {
            XB_SPIN(xb_ld(&bar[XB_XGEN(b.x)]) == gen, bar);
            __builtin_amdgcn_fence(__ATOMIC_ACQUIRE, "agent");
            asm volatile("s_waitcnt vmcnt(0)" ::: "memory");
        }
    }
    __syncthreads();
}

constexpr int LDS_BYTES = 135168;
static_assert(MIX_LDS <= LDS_BYTES && 128 * 129 * 4 <= LDS_BYTES && pg8::STAGE_BYTES <= LDS_BYTES, "LDS budget");
constexpr int NPHASE = 17;

template <class Epi>
__device__ __forceinline__ void run_gemm(LAS unsigned char* lds, const bf16_t* A, const bf16_t* Bt, int N, int K, const Epi& E) {
    pg8::Gemm g{A, Bt, MTOK, N, K};
    pg8::StaticOrder S; S.init(MTOK, N, gridDim.x, blockIdx.x);
    pg8::gemm_phase<Epi, pg8::StaticOrder, true, true>(lds, g, S, E);
}

__global__ void __launch_bounds__(NTHREADS, 2) fwd_megakernel(Params P) {
    extern __shared__ __attribute__((aligned(16))) unsigned char smem[];
    LAS unsigned char* lds = (LAS unsigned char*)smem;
    cg::grid_group grid = cg::this_grid();
    unsigned char* ws = P.ws;
    bf16_t* X = (bf16_t*)(ws + WS_X);
    bf16_t* H = (bf16_t*)(ws + WS_H);
    float* Y = P.out;
    bf16_t* gates = (bf16_t*)P.out;
#ifdef ONLYMASK
#define PHASE(k) if (((ONLYMASK >> (k)) & 1) && P.ph_lo <= (k) && (k) < P.ph_hi)
#else
#define PHASE(k) if (P.ph_lo <= (k) && (k) < P.ph_hi)
#endif
#define SYNC0() do { if (P.coop) { asm volatile("s_waitcnt vmcnt(0) lgkmcnt(0)" ::: "memory"); grid.sync(); \
        if (threadIdx.x < 64) { __builtin_amdgcn_fence(__ATOMIC_ACQUIRE, "agent"); asm volatile("s_waitcnt vmcnt(0)" ::: "memory"); } __syncthreads(); } } while (0)
#define SYNC() do { if (P.coop) xcd_barrier(xb); } while (0)
    volatile LAS unsigned* bst = (volatile LAS unsigned*)(lds + (LDS_BYTES - 16));
    XcdBarrier xb; xb.bar = (unsigned*)(ws + MISC_BAR); xb.x = 0; xb.st = bst;
    if (P.coop) { if (threadIdx.x == 0) { bst[0] = 0u; bst[1] = 0u; } xb = xcd_barrier_post((unsigned*)(ws + MISC_BAR), bst); }
    PHASE(0) prep_phase(P, lds);
    SYNC0();
    PHASE(1) run_gemm(lds, X, (const bf16_t*)(ws + W_GU1), 5632, 1024, EpiSwiglu{H});
    SYNC();
    PHASE(2) run_gemm(lds, H, (const bf16_t*)(ws + W_D1), 1024, FH, EpiResid<false, false, true>{P.x, nullptr, Y, 0.5f});
    SYNC();
    PHASE(3) ln_phase<true, true>(Y, P.ln_g, P.ln_b, X);
    SYNC();
    PHASE(4) run_gemm(lds, X, (const bf16_t*)(ws + W_IN), NIN_PAD, 1024, EpiWin{(bf16_t*)(ws + WS_QK), gates, (float*)(ws + MISC_IF), (const float*)(ws + W_BIAS)});
    SYNC();
    PHASE(5) mlstm_phase1(P, lds);
    SYNC();
    PHASE(6) {
#ifndef NO_ML2
        mlstm_phase2(P, lds);
#endif
#ifndef NO_ATT
        attn_phase(P, lds);
#endif
    }
    SYNC();
    PHASE(7) {
        run_gemm(lds, (const bf16_t*)(ws + WS_VA), (const bf16_t*)(ws + W_A), 1024, 1024, EpiGateMul<false>{gates, 0, nullptr, (bf16_t*)(ws + WS_T)});
        run_gemm(lds, (const bf16_t*)(ws + WS_QB), (const bf16_t*)(ws + W_B), 1024, 1024, EpiGateMul<true>{gates, DM, (const bf16_t*)(ws + WS_T), (bf16_t*)(ws + WS_MG)});
    }
    SYNC();
    PHASE(8) run_gemm(lds, (const bf16_t*)(ws + WS_MG), (const bf16_t*)(ws + W_O), 1024, 1024, EpiResid<true, false, true>{X, nullptr, Y, 1.0f});
    SYNC();
    PHASE(9) ln_phase<true, true>(Y, P.ln_g + DM, P.ln_b + DM, X);
    SYNC();
    PHASE(10) run_gemm(lds, X, (const bf16_t*)(ws + W_GU2), 5632, 1024, EpiSwiglu{H});
    SYNC();
    PHASE(11) run_gemm(lds, H, (const bf16_t*)(ws + W_D2), 1024, FH, EpiResid<true, false, true>{X, nullptr, Y, 0.5f});
    SYNC();
    PHASE(12) { ln_phase<true, true>(Y, P.ln_g + 2 * DM, P.ln_b + 2 * DM, X); cvt_bf16_phase(P.p, (bf16_t*)(ws + WS_PB), (size_t)MTOK * 256 / 8); }
    SYNC();
    PHASE(13) {
        run_gemm(lds, X, (const bf16_t*)(ws + W_PG), 1024, 1024, EpiSigBias{P.b_pg, (bf16_t*)(ws + WS_PG)});
        run_gemm(lds, (const bf16_t*)(ws + WS_PB), (const bf16_t*)(ws + W_P), 1024, 256, EpiResid<true, true, true>{X, (const bf16_t*)(ws + WS_PG), (float*)(ws + WS_VA), 1.0f});
    }
    SYNC();
    PHASE(14) ln_phase<false, true>((const float*)(ws + WS_VA), P.ln_g + 3 * DM, P.ln_b + 3 * DM, P.out);
#undef PHASE
#undef SYNC
#undef SYNC0
}

extern "C" void kernel_launch(void* const* d_in, const int* in_sizes, int n_in, void* d_out, int out_size, void* d_ws, size_t ws_size, hipStream_t stream) {
    static int grid_blocks = 0;
    if (grid_blocks == 0) {
        if (n_in != 19 || out_size != MTOK * DM || ws_size < WS_END) { fprintf(stderr, "kernel_launch: unexpected shapes (n_in %d, out %d, ws %zu, need %zu)\n", n_in, out_size, ws_size, (size_t)WS_END); grid_blocks = -1; return; }
        int dev = 0, cus = 0, per_cu = 0;
        hipGetDevice(&dev);
        hipDeviceGetAttribute(&cus, hipDeviceAttributeMultiprocessorCount, dev);
        if (hipFuncSetAttribute((const void*)fwd_megakernel, hipFuncAttributeMaxDynamicSharedMemorySize, LDS_BYTES) != hipSuccess) { fprintf(stderr, "kernel_launch: hipFuncSetAttribute failed\n"); grid_blocks = -1; return; }
        if (hipOccupancyMaxActiveBlocksPerMultiprocessor(&per_cu, (const void*)fwd_megakernel, NTHREADS, LDS_BYTES) != hipSuccess || per_cu < 1) { fprintf(stderr, "kernel_launch: occupancy query failed (%d)\n", per_cu); per_cu = 1; (void)hipGetLastError(); }
        grid_blocks = cus * per_cu;
    }
    if (grid_blocks < 0) return;
    Params p{};
    p.x = (const float*)d_in[0]; p.p = (const float*)d_in[1]; p.ln_g = (const float*)d_in[2]; p.ln_b = (const float*)d_in[3];
    p.wg = (const float*)d_in[4]; p.wu = (const float*)d_in[5]; p.wd = (const float*)d_in[6]; p.w_in = (const float*)d_in[7]; p.b_in = (const float*)d_in[8];
    p.b_forget = (const float*)d_in[9]; p.conv_w = (const float*)d_in[10]; p.conv_b = (const float*)d_in[11]; p.mh_g = (const float*)d_in[12];
    p.w_a = (const float*)d_in[13]; p.w_b = (const float*)d_in[14]; p.w_o = (const float*)d_in[15]; p.w_ple = (const float*)d_in[16]; p.w_pg = (const float*)d_in[17]; p.b_pg = (const float*)d_in[18];
    p.out = (float*)d_out; p.ws = (unsigned char*)d_ws; p.pad = 0;
#if ONE_LAUNCH
    if (hipMemsetAsync((char*)d_ws + MISC_BAR, 0, XCD_BAR_WORDS * 4, stream) != hipSuccess) { fprintf(stderr, "kernel_launch: memset of the barrier words failed\n"); return; }
    p.ph_lo = 0; p.ph_hi = NPHASE; p.coop = 1;
    void* args[] = {&p};
    hipError_t e = hipLaunchCooperativeKernel((const void*)fwd_megakernel, dim3(grid_blocks), dim3(NTHREADS), args, LDS_BYTES, stream);
    if (e != hipSuccess) fprintf(stderr, "cooperative launch failed: %s (grid %d)\n", hipGetErrorString(e), grid_blocks);
#else
    p.coop = 0;
    for (int ph = 0; ph < 15; ++ph) { p.ph_lo = ph; p.ph_hi = ph + 1; hipLaunchKernelGGL(fwd_megakernel, dim3(grid_blocks), dim3(NTHREADS), LDS_BYTES, stream, p); }
#endif
}
```

```cpp
#include <hip/hip_runtime.h>
#include <hip/hip_cooperative_groups.h>
#include <cstdio>
namespace cg = cooperative_groups;

#ifndef ONE_LAUNCH
#define ONE_LAUNCH 1
#endif

#define LAS __attribute__((address_space(3)))
typedef unsigned short bf16_t;
typedef short bf16x8 __attribute__((ext_vector_type(8)));
typedef float f32x4 __attribute__((ext_vector_type(4)));
typedef float f32x2 __attribute__((ext_vector_type(2)));
typedef unsigned u32x4 __attribute__((ext_vector_type(4)));
typedef unsigned u32x2 __attribute__((ext_vector_type(2)));

constexpr int MTOK = 65536, DM = 1024, FH = 2816, SEQ = 8192;
constexpr int NIN_PAD = 8448;
constexpr float ALPHA = 1.189207115002721f;
constexpr float LN_EPS = 1e-5f;
constexpr float LOG2E = 1.4426950408889634f;
constexpr int NTHREADS = 512;

constexpr size_t QB_ = 33554432ull;
constexpr size_t WS_W = 0;
constexpr size_t W_GU1 = 0;
constexpr size_t W_D1 = W_GU1 + 5632ull * 1024 * 2;
constexpr size_t W_GU2 = W_D1 + 1024ull * 2816 * 2;
constexpr size_t W_D2 = W_GU2 + 5632ull * 1024 * 2;
constexpr size_t W_IN = W_D2 + 1024ull * 2816 * 2;
constexpr size_t W_A = W_IN + 8448ull * 1024 * 2;
constexpr size_t W_B = W_A + 1024ull * 1024 * 2;
constexpr size_t W_O = W_B + 1024ull * 1024 * 2;
constexpr size_t W_PG = W_O + 1024ull * 1024 * 2;
constexpr size_t W_P = W_PG + 1024ull * 1024 * 2;
constexpr size_t W_BIAS = W_P + 1024ull * 256 * 2;
static_assert(W_BIAS + 8448 * 4 <= 2 * QB_, "weights overflow");
constexpr size_t WS_PB = 2 * QB_;
constexpr size_t WS_MISC = 3 * QB_;
constexpr size_t MISC_IF = WS_MISC;
constexpr size_t MISC_CNT = WS_MISC + 2097152ull;
constexpr size_t MISC_BAR = MISC_CNT + 4096;
constexpr size_t WS_X = 4 * QB_;
constexpr size_t WS_H = 8 * QB_;
constexpr size_t WS_QK = 8 * QB_, WS_VA = 12 * QB_, WS_OA = 16 * QB_, WS_QB = 20 * QB_, WS_KB = 24 * QB_, WS_VB = 28 * QB_;
constexpr size_t WS_T = WS_QK, WS_MG = WS_KB, WS_PG = 8 * QB_;
constexpr size_t WS_END = 32 * QB_;
constexpr int STATE_FLOATS = 32768 + 128;

typedef __bf16 bf16x2_t __attribute__((ext_vector_type(2)));
__device__ __forceinline__ unsigned cvt_pk_bf16(float lo, float hi) { f32x2 v = {lo, hi}; bf16x2_t r = __builtin_convertvector(v, bf16x2_t); return __builtin_bit_cast(unsigned, r); }
__device__ __forceinline__ float bf_lo(unsigned u) { return __uint_as_float(u << 16); }
__device__ __forceinline__ float bf_hi(unsigned u) { return __uint_as_float(u & 0xffff0000u); }
__device__ __forceinline__ float fast_exp2(float x) { return __builtin_amdgcn_exp2f(x); }
__device__ __forceinline__ float fast_log2(float x) { return __builtin_amdgcn_logf(x); }
__device__ __forceinline__ float fast_rcp(float x) { return __builtin_amdgcn_rcpf(x); }
__device__ __forceinline__ float sigmoid_f(float x) { return fast_rcp(1.0f + fast_exp2(-x * LOG2E)); }
__device__ __forceinline__ f32x4 mfma16(bf16x8 a, bf16x8 b, f32x4 c) { return __builtin_amdgcn_mfma_f32_16x16x32_bf16(a, b, c, 0, 0, 0); }
__device__ __forceinline__ bf16x8 mk8(u32x2 lo, u32x2 hi) { u32x4 v; v.x = lo.x; v.y = lo.y; v.z = hi.x; v.w = hi.y; return __builtin_bit_cast(bf16x8, v); }
__device__ __forceinline__ float wave_sum(float v) {
#pragma unroll
    for (int o = 32; o > 0; o >>= 1) v += __shfl_xor(v, o);
    return v;
}
__device__ __forceinline__ float wave_max(float v) {
#pragma unroll
    for (int o = 32; o > 0; o >>= 1) v = fmaxf(v, __shfl_xor(v, o));
    return v;
}
__device__ __forceinline__ float wave_incl_sum(float v, int lane) {
#pragma unroll
    for (int o = 1; o < 64; o <<= 1) { float t = __shfl_up(v, o); if (lane >= o) v += t; }
    return v;
}
__device__ __forceinline__ float wave_incl_max(float v, int lane) {
#pragma unroll
    for (int o = 1; o < 64; o <<= 1) { float t = __shfl_up(v, o); if (lane >= o) v = fmaxf(v, t); }
    return v;
}

namespace pg8 {
constexpr int BM = 256, BK = 64, HALF = 128, HTB = HALF * BK * 2, STAGE_BYTES = 8 * HTB, NXCD = 8, WGM = 8;
__host__ __device__ __forceinline__ int lds_byte(int r, int c) { const int st = (r >> 4) * 2 + (c >> 5), rr = r & 15, cc = c & 31, ob = rr * 64 + cc * 2; return st * 1024 + (ob ^ (((ob >> 9) & 1) << 5)); }
__host__ __device__ __forceinline__ void stage_rc(int b, int& R, int& C) { const int st = b / 1024, sb = b % 1024, swz = sb ^ (((sb >> 9) & 1) << 5); R = (st >> 1) * 16 + swz / 64; C = (st & 1) * 32 + (swz % 64) / 2; }
__host__ __device__ __forceinline__ int perm32(int rho) { const int n = rho >> 4, i = rho & 15; return 8 * (i >> 2) + 4 * n + (i & 3); }
struct Unit { int pm, pn; };
struct Gemm { const bf16_t* A; const bf16_t* Bt; int M, N, K; };
struct StaticOrder {
    int nM, nN, nwg, G, c;
    __device__ void init(int M, int N, int G_, int c_) { nM = M / BM; nN = N / BM; nwg = nM * nN; G = G_; c = c_; }
    __device__ bool next(int i, Unit& u) const {
        const long L = (long)i * G + c; if (L >= nwg) return false;
        int wgid = (int)L; { const int q = nwg / NXCD, r = nwg % NXCD, xcd = wgid % NXCD, off = wgid / NXCD; wgid = (xcd < r ? xcd * (q + 1) : r * (q + 1) + (xcd - r) * q) + off; }
        const int nig = WGM * nN, gid = wgid / nig, fm = gid * WGM, gsz = (nM - fm) < WGM ? (nM - fm) : WGM;
        u.pm = fm + ((wgid % nig) % gsz); u.pn = (wgid % nig) / gsz; return true;
    }
};
template <class Epi, class Sched, bool ALIGN_EPI = false, bool SP2 = false>
__device__ __forceinline__ void gemm_phase(LAS unsigned char* lds, const Gemm g, const Sched& S, const Epi& E) {
    const int tid = threadIdx.x, wid = __builtin_amdgcn_readfirstlane(tid >> 6), lane = tid & 63, wr = wid >> 2, wc = wid & 3, fr = lane & 15, fq = lane >> 4;
    const int K = g.K, nt = K / BK;
    unsigned voffA[2], voffB[2];
#pragma unroll
    for (int i = 0; i < 2; ++i) { int R, C; stage_rc(tid * 16 + i * 8192, R, C); const int Rb = ((R & ~31) + perm32(R & 31));
        voffA[i] = (unsigned)(R * K + C) * 2u; voffB[i] = (unsigned)(Rb * K + C) * 2u; }
    const size_t kstep = (size_t)(BK * 2);
    const size_t hstep = (size_t)HALF * K * 2;
    const size_t tstep = 2 * hstep;
    const unsigned ldsw = (unsigned)wid * 1024u;
    const int aoff = lds_byte(wr * 64 + fr, fq * 8), boff = lds_byte(wc * 32 + fr, fq * 8);
#define PG8_SA(b, h) (((b) * 2 + (h)) * HTB)
#define PG8_SB(b, h) ((4 + (b) * 2 + (h)) * HTB)
#define PG8_STAGE(bufoff, gbase, voff) do { _Pragma("unroll") for (int _i = 0; _i < 2; ++_i) \
        __builtin_amdgcn_global_load_lds((const unsigned*)((const char*)(gbase) + (voff)[_i]), (LAS unsigned*)(lds + (bufoff) + ldsw + _i * 8192), 16, 0, 0); } while (0)
#define PG8_LDA(dst, b, h) do { _Pragma("unroll") for (int m = 0; m < 4; ++m) _Pragma("unroll") for (int k = 0; k < 2; ++k) dst[m][k] = *(const LAS bf16x8*)(lds + PG8_SA(b, h) + aoff + m * 2048 + k * 1024); } while (0)
#define PG8_LDB(dst, b, h) do { _Pragma("unroll") for (int n = 0; n < 2; ++n) _Pragma("unroll") for (int k = 0; k < 2; ++k) dst[n][k] = *(const LAS bf16x8*)(lds + PG8_SB(b, h) + boff + n * 2048 + k * 1024); } while (0)
#define PG8_MMA(ai, bj, At, Bt) do { __builtin_amdgcn_s_setprio(1); _Pragma("unroll") for (int m = 0; m < 4; ++m) _Pragma("unroll") for (int n = 0; n < 2; ++n) _Pragma("unroll") for (int k = 0; k < 2; ++k) \
        acc[ai][bj][m][n] = __builtin_amdgcn_mfma_f32_16x16x32_bf16(Bt[n][k], At[m][k], acc[ai][bj][m][n], 0, 0, 0); __builtin_amdgcn_s_setprio(0); } while (0)
#define PG8_WAIT_V(n) asm volatile("s_waitcnt vmcnt(" #n ")" ::: "memory")
#define PG8_WAIT_L(n) asm volatile("s_waitcnt lgkmcnt(" #n ")" ::: "memory")
#define PG8_BAR __builtin_amdgcn_s_barrier()
#define PG8_SCHED __builtin_amdgcn_sched_barrier(0)
    Unit cur, nxt; int ui = 0;
    if (!S.next(0, cur)) return;
    f32x4 acc[2][2][4][2];
#pragma unroll
    for (int a = 0; a < 2; ++a)
#pragma unroll
        for (int b = 0; b < 2; ++b)
#pragma unroll
            for (int m = 0; m < 4; ++m)
#pragma unroll
                for (int n = 0; n < 2; ++n) acc[a][b][m][n] = (f32x4){0.f, 0.f, 0.f, 0.f};
    bf16x8 At[4][2], B0[2][2], B1[2][2];
    const char* cA = (const char*)g.A + (size_t)cur.pm * tstep; const char* cB = (const char*)g.Bt + (size_t)cur.pn * tstep;

    if constexpr (SP2) {
        PG8_STAGE(PG8_SB(0, 0), cB, voffB); PG8_STAGE(PG8_SB(0, 1), cB + hstep, voffB); PG8_STAGE(PG8_SA(0, 0), cA, voffA); PG8_STAGE(PG8_SA(0, 1), cA + hstep, voffA);
        if (wr == 1) PG8_BAR;
        PG8_WAIT_V(2); PG8_BAR;
        PG8_STAGE(PG8_SB(1, 0), cB + kstep, voffB); PG8_STAGE(PG8_SA(1, 0), cA + kstep, voffA); PG8_STAGE(PG8_SB(1, 1), cB + hstep + kstep, voffB);
        PG8_WAIT_V(6); PG8_BAR;
    } else {
        PG8_STAGE(PG8_SB(0, 0), cB, voffB); PG8_STAGE(PG8_SA(0, 0), cA, voffA); PG8_STAGE(PG8_SB(0, 1), cB + hstep, voffB); PG8_STAGE(PG8_SA(0, 1), cA + hstep, voffA);
        if (wr == 1) PG8_BAR;
        PG8_WAIT_V(4); PG8_BAR;
        PG8_STAGE(PG8_SB(1, 0), cB + kstep, voffB); PG8_STAGE(PG8_SA(1, 0), cA + kstep, voffA); PG8_STAGE(PG8_SB(1, 1), cB + hstep + kstep, voffB);
        PG8_WAIT_V(6); PG8_BAR;
    }
    for (;;) {
        const bool has_next = S.next(ui + 1, nxt);
        const char* nA = has_next ? (const char*)g.A + (size_t)nxt.pm * tstep : cA; const char* nB = has_next ? (const char*)g.Bt + (size_t)nxt.pn * tstep : cB;
        for (int t = 0; t < nt; t += 2) {
            const bool last = (t == nt - 2);
            const char* a1 = cA + (size_t)(t + 1) * kstep;
            const char* a2 = last ? nA : cA + (size_t)(t + 2) * kstep; const char* b2 = last ? nB : cB + (size_t)(t + 2) * kstep;
            const char* a3 = a2 + kstep; const char* b3 = b2 + kstep;

            if constexpr (SP2) {
            PG8_LDB(B0, 0, 0); PG8_LDB(B1, 0, 1); PG8_SCHED; PG8_LDA(At, 0, 0); PG8_STAGE(PG8_SA(1, 1), a1 + hstep, voffA);
            PG8_WAIT_V(8); PG8_WAIT_L(0); PG8_BAR; PG8_MMA(0, 0, At, B0); PG8_MMA(0, 1, At, B1); PG8_BAR; PG8_SCHED;
            PG8_LDA(At, 0, 1); PG8_STAGE(PG8_SB(0, 0), b2, voffB); PG8_STAGE(PG8_SB(0, 1), b2 + hstep, voffB); PG8_STAGE(PG8_SA(0, 0), a2, voffA);
            PG8_WAIT_V(8); PG8_WAIT_L(0); PG8_BAR; PG8_MMA(1, 0, At, B0); PG8_MMA(1, 1, At, B1); PG8_BAR; PG8_SCHED;
            PG8_LDB(B0, 1, 0); PG8_LDB(B1, 1, 1); PG8_SCHED; PG8_LDA(At, 1, 0); PG8_STAGE(PG8_SA(0, 1), a2 + hstep, voffA);
            PG8_WAIT_V(8); PG8_WAIT_L(0); PG8_BAR; PG8_MMA(0, 0, At, B0); PG8_MMA(0, 1, At, B1); PG8_BAR; PG8_SCHED;
            PG8_LDA(At, 1, 1); PG8_STAGE(PG8_SB(1, 0), b3, voffB); PG8_STAGE(PG8_SB(1, 1), b3 + hstep, voffB); PG8_STAGE(PG8_SA(1, 0), a3, voffA);
            PG8_WAIT_V(8); PG8_WAIT_L(0); PG8_BAR; PG8_MMA(1, 0, At, B0); PG8_MMA(1, 1, At, B1); PG8_BAR; PG8_SCHED;
            } else {
            PG8_LDB(B0, 0, 0); PG8_SCHED; PG8_LDA(At, 0, 0); PG8_STAGE(PG8_SA(1, 1), a1 + hstep, voffA);
            PG8_WAIT_L(8); PG8_BAR; PG8_WAIT_L(0); PG8_MMA(0, 0, At, B0); PG8_BAR; PG8_SCHED;
            PG8_LDB(B1, 0, 1); PG8_STAGE(PG8_SB(0, 0), b2, voffB);
            PG8_BAR; PG8_WAIT_L(0); PG8_MMA(0, 1, At, B1); PG8_BAR;
            PG8_LDA(At, 0, 1); PG8_STAGE(PG8_SA(0, 0), a2, voffA);
            PG8_BAR; PG8_WAIT_L(0); PG8_MMA(1, 0, At, B0); PG8_BAR; PG8_SCHED;
            PG8_STAGE(PG8_SB(0, 1), b2 + hstep, voffB);
            PG8_WAIT_V(6); PG8_BAR; PG8_MMA(1, 1, At, B1); PG8_BAR;
            PG8_LDB(B0, 1, 0); PG8_SCHED; PG8_LDA(At, 1, 0); PG8_STAGE(PG8_SA(0, 1), a2 + hstep, voffA);
            PG8_WAIT_L(8); PG8_BAR; PG8_WAIT_L(0); PG8_MMA(0, 0, At, B0); PG8_BAR; PG8_SCHED;
            PG8_LDB(B1, 1, 1); PG8_STAGE(PG8_SB(1, 0), b3, voffB);
            PG8_BAR; PG8_WAIT_L(0); PG8_MMA(0, 1, At, B1); PG8_BAR;
            PG8_LDA(At, 1, 1); PG8_STAGE(PG8_SA(1, 0), a3, voffA);
            PG8_BAR; PG8_WAIT_L(0); PG8_MMA(1, 0, At, B0); PG8_BAR; PG8_SCHED;
            PG8_STAGE(PG8_SB(1, 1), b3 + hstep, voffB);
            PG8_WAIT_V(6); PG8_BAR; PG8_MMA(1, 1, At, B1); PG8_BAR;
            }
        }
        if constexpr (ALIGN_EPI) { if (wr == 0) PG8_BAR; }
        E(acc, cur, wr, wc, fr, fq);
        if (!has_next) break;
#pragma unroll
        for (int a = 0; a < 2; ++a)
#pragma unroll
            for (int b = 0; b < 2; ++b)
#pragma unroll
                for (int m = 0; m < 4; ++m)
#pragma unroll
                    for (int n = 0; n < 2; ++n) acc[a][b][m][n] = (f32x4){0.f, 0.f, 0.f, 0.f};
        cur = nxt; cA = nA; cB = nB; ++ui;
        if constexpr (ALIGN_EPI) { if (wr == 1) PG8_BAR; }
    }
    PG8_WAIT_V(0);
    if constexpr (!ALIGN_EPI) { if (wr == 0) PG8_BAR; }
    PG8_BAR;
#undef PG8_SA
#undef PG8_SB
#undef PG8_STAGE
#undef PG8_LDA
#undef PG8_LDB
#undef PG8_MMA
#undef PG8_WAIT_V
#undef PG8_WAIT_L
#undef PG8_BAR
#undef PG8_SCHED
}
}
using pg8::Unit;

#define EPI_ROWS(ai, m) (u.pm * 256 + (ai) * 128 + wr * 64 + (m) * 16 + fr)
struct EpiSwiglu {
    bf16_t* H;
    __device__ __forceinline__ void operator()(const f32x4 (&acc)[2][2][4][2], const Unit& u, int wr, int wc, int fr, int fq) const {
        const int col = u.pn * 128 + wc * 32 + 8 * fq;
#pragma unroll
        for (int ai = 0; ai < 2; ++ai)
#pragma unroll
            for (int m = 0; m < 4; ++m) {
                const size_t row = EPI_ROWS(ai, m);
                float h[8];
#pragma unroll
                for (int n = 0; n < 2; ++n)
#pragma unroll
                    for (int j = 0; j < 4; ++j) { const float g = acc[ai][0][m][n][j], uu = acc[ai][1][m][n][j]; h[4 * n + j] = g * uu * sigmoid_f(g); }
                u32x4 w; w.x = cvt_pk_bf16(h[0], h[1]); w.y = cvt_pk_bf16(h[2], h[3]); w.z = cvt_pk_bf16(h[4], h[5]); w.w = cvt_pk_bf16(h[6], h[7]);
                *(u32x4*)(H + row * FH + col) = w;
            }
    }
};
template <bool RES_BF16, bool HAS_MUL, bool OUT_BF16 = false>
struct EpiResid {
    const void* res; const bf16_t* mul; float* Y; float scale;
    __device__ __forceinline__ void operator()(const f32x4 (&acc)[2][2][4][2], const Unit& u, int wr, int wc, int fr, int fq) const {
#pragma unroll
        for (int ai = 0; ai < 2; ++ai)
#pragma unroll
            for (int m = 0; m < 4; ++m) {
                const size_t row = EPI_ROWS(ai, m);
#pragma unroll
                for (int bj = 0; bj < 2; ++bj) {
                    const size_t off = row * DM + u.pn * 256 + bj * 128 + wc * 32 + 8 * fq;
                    float r[8];
                    if (RES_BF16) { const u32x4 rv = *(const u32x4*)((const bf16_t*)res + off);
                        r[0] = bf_lo(rv.x); r[1] = bf_hi(rv.x); r[2] = bf_lo(rv.y); r[3] = bf_hi(rv.y); r[4] = bf_lo(rv.z); r[5] = bf_hi(rv.z); r[6] = bf_lo(rv.w); r[7] = bf_hi(rv.w); }
                    else { const f32x4 a = *(const f32x4*)((const float*)res + off), b = *(const f32x4*)((const float*)res + off + 4);
                        r[0] = a[0]; r[1] = a[1]; r[2] = a[2]; r[3] = a[3]; r[4] = b[0]; r[5] = b[1]; r[6] = b[2]; r[7] = b[3]; }
                    float mv[8];
                    if (HAS_MUL) { const u32x4 rv = *(const u32x4*)(mul + off);
                        mv[0] = bf_lo(rv.x); mv[1] = bf_hi(rv.x); mv[2] = bf_lo(rv.y); mv[3] = bf_hi(rv.y); mv[4] = bf_lo(rv.z); mv[5] = bf_hi(rv.z); mv[6] = bf_lo(rv.w); mv[7] = bf_hi(rv.w); }
                    f32x4 o0, o1;
#pragma unroll
                    for (int j = 0; j < 4; ++j) {
                        const float a0 = acc[ai][bj][m][0][j] * scale, a1 = acc[ai][bj][m][1][j] * scale;
                        o0[j] = ALPHA * r[j] + (HAS_MUL ? mv[j] * a0 : a0); o1[j] = ALPHA * r[4 + j] + (HAS_MUL ? mv[4 + j] * a1 : a1); }
                    if (OUT_BF16) { u32x4 w; w.x = cvt_pk_bf16(o0[0], o0[1]); w.y = cvt_pk_bf16(o0[2], o0[3]); w.z = cvt_pk_bf16(o1[0], o1[1]); w.w = cvt_pk_bf16(o1[2], o1[3]); *(u32x4*)((bf16_t*)Y + off) = w; }
                    else { *(f32x4*)(Y + off) = o0; *(f32x4*)(Y + off + 4) = o1; }
                }
            }
    }
};
struct EpiWin {
    bf16_t* proj; bf16_t* gates; float* ifg; const float* bias;
    __device__ __forceinline__ void operator()(const f32x4 (&acc)[2][2][4][2], const Unit& u, int wr, int wc, int fr, int fq) const {
        const int pn = u.pn;
        if (pn == 32) {
            if (wc == 0 && fq == 0) {
                const f32x4 bi = *(const f32x4*)(bias + 8192), bf = *(const f32x4*)(bias + 8196);
#pragma unroll
                for (int ai = 0; ai < 2; ++ai)
#pragma unroll
                    for (int m = 0; m < 4; ++m) {
                        const size_t row = EPI_ROWS(ai, m);
                        f32x4 iv = acc[ai][0][m][0] + bi, fv = acc[ai][0][m][1] + bf, lf;
#pragma unroll
                        for (int j = 0; j < 4; ++j) { const float xx = fv[j]; lf[j] = xx >= 0.f ? -log1pf(expf(-xx)) : xx - log1pf(expf(xx)); }
                        *(f32x4*)(ifg + row * 8) = iv; *(f32x4*)(ifg + row * 8 + 4) = lf;
                    }
            }
            return;
        }
        bf16_t* dst; int ld, c0; int act = 0; float sc = 1.0f;
        if (pn < 24) { const int sec = pn >> 2; dst = proj + (size_t)sec * ((size_t)MTOK * DM); ld = DM; c0 = (pn & 3) * 256; if (sec == 2) act = 1; if (sec == 3) sc = 0.08838834764831845f * LOG2E; }
        else { dst = gates; ld = 2 * DM; c0 = (pn - 24) * 256; act = 1; }
#pragma unroll
        for (int bj = 0; bj < 2; ++bj) {
            const int cl = bj * 128 + wc * 32 + 8 * fq;
            const f32x4 b0 = *(const f32x4*)(bias + pn * 256 + cl), b1 = *(const f32x4*)(bias + pn * 256 + cl + 4);
#pragma unroll
            for (int ai = 0; ai < 2; ++ai)
#pragma unroll
                for (int m = 0; m < 4; ++m) {
                    const size_t row = EPI_ROWS(ai, m);
                    f32x4 v0 = acc[ai][bj][m][0] + b0, v1 = acc[ai][bj][m][1] + b1;
                    if (act) {
#pragma unroll
                        for (int j = 0; j < 4; ++j) { v0[j] = sigmoid_f(v0[j]); v1[j] = sigmoid_f(v1[j]); } }
                    else { v0 *= sc; v1 *= sc; }
                    u32x4 w; w.x = cvt_pk_bf16(v0[0], v0[1]); w.y = cvt_pk_bf16(v0[2], v0[3]); w.z = cvt_pk_bf16(v1[0], v1[1]); w.w = cvt_pk_bf16(v1[2], v1[3]);
                    *(u32x4*)(dst + row * ld + c0 + cl) = w;
                }
        }
    }
};
template <bool ADD>
struct EpiGateMul {
    const bf16_t* gate; int goff; const bf16_t* tin; bf16_t* out;
    __device__ __forceinline__ void operator()(const f32x4 (&acc)[2][2][4][2], const Unit& u, int wr, int wc, int fr, int fq) const {
#pragma unroll
        for (int ai = 0; ai < 2; ++ai)
#pragma unroll
            for (int m = 0; m < 4; ++m) {
                const size_t row = EPI_ROWS(ai, m);
#pragma unroll
                for (int bj = 0; bj < 2; ++bj) {
                    const int c = u.pn * 256 + bj * 128 + wc * 32 + 8 * fq;
                    const u32x4 gv = *(const u32x4*)(gate + row * (2 * DM) + goff + c);
                    float gg[8] = {bf_lo(gv.x), bf_hi(gv.x), bf_lo(gv.y), bf_hi(gv.y), bf_lo(gv.z), bf_hi(gv.z), bf_lo(gv.w), bf_hi(gv.w)};
                    float tt[8] = {0.f, 0.f, 0.f, 0.f, 0.f, 0.f, 0.f, 0.f};
                    if (ADD) { const u32x4 tv = *(const u32x4*)(tin + row * DM + c);
                        tt[0] = bf_lo(tv.x); tt[1] = bf_hi(tv.x); tt[2] = bf_lo(tv.y); tt[3] = bf_hi(tv.y); tt[4] = bf_lo(tv.z); tt[5] = bf_hi(tv.z); tt[6] = bf_lo(tv.w); tt[7] = bf_hi(tv.w); }
                    float o[8];
#pragma unroll
                    for (int j = 0; j < 4; ++j) { o[j] = tt[j] + gg[j] * acc[ai][bj][m][0][j]; o[4 + j] = tt[4 + j] + gg[4 + j] * acc[ai][bj][m][1][j]; }
                    u32x4 w; w.x = cvt_pk_bf16(o[0], o[1]); w.y = cvt_pk_bf16(o[2], o[3]); w.z = cvt_pk_bf16(o[4], o[5]); w.w = cvt_pk_bf16(o[6], o[7]);
                    *(u32x4*)(out + row * DM + c) = w;
                }
            }
    }
};
struct EpiSigBias {
    const float* bias; bf16_t* out;
    __device__ __forceinline__ void operator()(const f32x4 (&acc)[2][2][4][2], const Unit& u, int wr, int wc, int fr, int fq) const {
#pragma unroll
        for (int bj = 0; bj < 2; ++bj) {
            const int c = u.pn * 256 + bj * 128 + wc * 32 + 8 * fq;
            const f32x4 b0 = *(const f32x4*)(bias + c), b1 = *(const f32x4*)(bias + c + 4);
#pragma unroll
            for (int ai = 0; ai < 2; ++ai)
#pragma unroll
                for (int m = 0; m < 4; ++m) {
                    const size_t row = EPI_ROWS(ai, m);
                    f32x4 v0 = acc[ai][bj][m][0] + b0, v1 = acc[ai][bj][m][1] + b1;
#pragma unroll
                    for (int j = 0; j < 4; ++j) { v0[j] = sigmoid_f(v0[j]); v1[j] = sigmoid_f(v1[j]); }
                    u32x4 w; w.x = cvt_pk_bf16(v0[0], v0[1]); w.y = cvt_pk_bf16(v0[2], v0[3]); w.z = cvt_pk_bf16(v1[0], v1[1]); w.w = cvt_pk_bf16(v1[2], v1[3]);
                    *(u32x4*)(out + row * DM + c) = w;
                }
        }
    }
};

struct Params {
    const float *x, *p, *ln_g, *ln_b, *wg, *wu, *wd, *w_in, *b_in, *b_forget, *conv_w, *conv_b, *mh_g, *w_a, *w_b, *w_o, *w_ple, *w_pg, *b_pg;
    float* out; unsigned char* ws;
    int ph_lo, ph_hi, coop, pad;
};

__device__ void cvt_bf16_phase(const float* src, bf16_t* dst, size_t n8) {
    const size_t stride = (size_t)gridDim.x * NTHREADS;
    size_t i = (size_t)blockIdx.x * NTHREADS + threadIdx.x;
    for (; i + 3 * stride < n8; i += 4 * stride) {
        f32x4 a[4], b[4];
#pragma unroll
        for (int u = 0; u < 4; ++u) { a[u] = __builtin_nontemporal_load((const f32x4*)(src + (i + u * stride) * 8)); b[u] = __builtin_nontemporal_load((const f32x4*)(src + (i + u * stride) * 8 + 4)); }
#pragma unroll
        for (int u = 0; u < 4; ++u) { u32x4 w; w.x = cvt_pk_bf16(a[u][0], a[u][1]); w.y = cvt_pk_bf16(a[u][2], a[u][3]); w.z = cvt_pk_bf16(b[u][0], b[u][1]); w.w = cvt_pk_bf16(b[u][2], b[u][3]);
            *(u32x4*)(dst + (i + u * stride) * 8) = w; }
    }
    for (; i < n8; i += stride) {
        const f32x4 a = *(const f32x4*)(src + i * 8), b = *(const f32x4*)(src + i * 8 + 4);
        u32x4 w; w.x = cvt_pk_bf16(a[0], a[1]); w.y = cvt_pk_bf16(a[2], a[3]); w.z = cvt_pk_bf16(b[0], b[1]); w.w = cvt_pk_bf16(b[2], b[3]);
        *(u32x4*)(dst + i * 8) = w;
    }
}
template <int MODE>
__device__ __forceinline__ f32x4 tsrc_val4(const float* w0, const float* w1, int ldn, int k, int n) {
    if (MODE == 0) return *(const f32x4*)(w0 + (size_t)k * ldn + n);
    if (MODE == 1) { const int pn = n >> 8, sel = (n >> 7) & 1, i = n & 127; const float* w = sel ? w1 : w0; return *(const f32x4*)(w + (size_t)k * ldn + pn * 128 + i); }
    int col; if (n < 3072) col = n; else if (n < 8192) col = n + 8; else if (n < 8200) col = 3072 + (n - 8192); else return (f32x4){0.f, 0.f, 0.f, 0.f};
    return *(const f32x4*)(w0 + (size_t)k * ldn + col);
}
template <int MODE>
__device__ __forceinline__ void transpose_mat(LAS float* tile, const float* w0, const float* w1, int ldn, bf16_t* dst, int NP, int K, int& base) {
    const int tid = threadIdx.x;
    const int tn = NP / 128, tk = K / 128, nt = tn * tk;
    int first = ((int)blockIdx.x - base) % (int)gridDim.x; if (first < 0) first += gridDim.x;
    for (int t = first; t < nt; t += gridDim.x) {
        const int n0 = (t / tk) * 128, k0 = (t % tk) * 128;
#pragma unroll
        for (int e = 0; e < 8; ++e) { const int idx = e * NTHREADS + tid, kk = idx >> 5, n4 = (idx & 31) * 4; const f32x4 v = tsrc_val4<MODE>(w0, w1, ldn, k0 + kk, n0 + n4);
            tile[kk * 129 + n4] = v[0]; tile[kk * 129 + n4 + 1] = v[1]; tile[kk * 129 + n4 + 2] = v[2]; tile[kk * 129 + n4 + 3] = v[3]; }
        __syncthreads();
#pragma unroll 8
        for (int e = 0; e < 16; ++e) { const int idx = e * NTHREADS + tid, nn = idx >> 6, kk = (idx & 63) * 2;
            *(unsigned*)(dst + (size_t)(n0 + nn) * K + k0 + kk) = cvt_pk_bf16(tile[kk * 129 + nn], tile[(kk + 1) * 129 + nn]); }
        __syncthreads();
    }
    base += nt;
}
__device__ void prep_phase(const Params& P, LAS unsigned char* lds) {
    unsigned char* ws = P.ws;
    cvt_bf16_phase(P.x, (bf16_t*)(ws + WS_X), (size_t)MTOK * DM / 8);
    if (blockIdx.x == 0 && threadIdx.x < 64) ((unsigned*)(ws + MISC_CNT))[threadIdx.x] = 0u;
    for (int n = blockIdx.x * NTHREADS + threadIdx.x; n < NIN_PAD; n += gridDim.x * NTHREADS) {
        float b;
        if (n < 3072) b = P.b_in[n]; else if (n < 8192) b = P.b_in[n + 8]; else if (n < 8196) b = P.b_in[3072 + n - 8192];
        else if (n < 8200) b = P.b_in[3072 + n - 8192] + P.b_forget[n - 8196]; else b = 0.f;
        ((float*)(ws + W_BIAS))[n] = b;
    }
    LAS float* tile = (LAS float*)lds;
    int base = 0;
    transpose_mat<1>(tile, P.wg, P.wu, FH, (bf16_t*)(ws + W_GU1), 5632, 1024, base);
    transpose_mat<0>(tile, P.wd, nullptr, DM, (bf16_t*)(ws + W_D1), 1024, FH, base);
    transpose_mat<1>(tile, P.wg + (size_t)DM * FH, P.wu + (size_t)DM * FH, FH, (bf16_t*)(ws + W_GU2), 5632, 1024, base);
    transpose_mat<0>(tile, P.wd + (size_t)DM * FH, nullptr, DM, (bf16_t*)(ws + W_D2), 1024, FH, base);
    transpose_mat<2>(tile, P.w_in, nullptr, 8200, (bf16_t*)(ws + W_IN), NIN_PAD, 1024, base);
    transpose_mat<0>(tile, P.w_a, nullptr, DM, (bf16_t*)(ws + W_A), 1024, 1024, base);
    transpose_mat<0>(tile, P.w_b, nullptr, DM, (bf16_t*)(ws + W_B), 1024, 1024, base);
    transpose_mat<0>(tile, P.w_o, nullptr, DM, (bf16_t*)(ws + W_O), 1024, 1024, base);
    transpose_mat<0>(tile, P.w_pg, nullptr, DM, (bf16_t*)(ws + W_PG), 1024, 1024, base);
    transpose_mat<0>(tile, P.w_ple, nullptr, DM, (bf16_t*)(ws + W_P), 1024, 256, base);
}
template <bool OUT_BF16, bool IN_BF16 = false>
__device__ void ln_phase(const float* Y, const float* g, const float* b, void* out) {
    const int wid = threadIdx.x >> 6, lane = threadIdx.x & 63;
    f32x4 gv[4], bv[4];
#pragma unroll
    for (int i = 0; i < 4; ++i) { gv[i] = *(const f32x4*)(g + i * 256 + lane * 4); bv[i] = *(const f32x4*)(b + i * 256 + lane * 4); }
    for (int row0 = (blockIdx.x * 8 + wid) * 2; row0 < MTOK; row0 += gridDim.x * 16) {
        f32x4 v[2][4]; float s[2] = {0.f, 0.f};
#pragma unroll
        for (int r = 0; r < 2; ++r)
#pragma unroll
            for (int i = 0; i < 4; ++i) {
                if (IN_BF16) { const u32x2 t = __builtin_nontemporal_load((const u32x2*)((const bf16_t*)Y + (size_t)(row0 + r) * DM + i * 256 + lane * 4)); v[r][i] = (f32x4){bf_lo(t.x), bf_hi(t.x), bf_lo(t.y), bf_hi(t.y)}; }
                else v[r][i] = *(const f32x4*)(Y + (size_t)(row0 + r) * DM + i * 256 + lane * 4); }
#pragma unroll
        for (int r = 0; r < 2; ++r) {
#pragma unroll
            for (int i = 0; i < 4; ++i) s[r] += (v[r][i][0] + v[r][i][1]) + (v[r][i][2] + v[r][i][3]);
            const float mean = wave_sum(s[r]) * (1.0f / DM);
            float q = 0.f;
#pragma unroll
            for (int i = 0; i < 4; ++i) { const f32x4 d = v[r][i] - mean; q += (d[0] * d[0] + d[1] * d[1]) + (d[2] * d[2] + d[3] * d[3]); }
            const float rstd = rsqrtf(wave_sum(q) * (1.0f / DM) + LN_EPS);
#pragma unroll
            for (int i = 0; i < 4; ++i) {
                const f32x4 o = (v[r][i] - mean) * rstd * gv[i] + bv[i];
                if (OUT_BF16) { u32x2 w; w.x = cvt_pk_bf16(o[0], o[1]); w.y = cvt_pk_bf16(o[2], o[3]); *(u32x2*)((bf16_t*)out + (size_t)(row0 + r) * DM + i * 256 + lane * 4) = w; }
                else __builtin_nontemporal_store(o, (f32x4*)((float*)out + (size_t)(row0 + r) * DM + i * 256 + lane * 4));
            }
        }
    }
}

constexpr int L_QI = 0, L_KI = 17408, L_KT = 34816, L_VT = 53248, L_PI = 90112, L_F = 99328;
constexpr int F_N = 0, F_QN = 128, F_RS = 192, F_HS = 320, F_BL = 1344, F_GM = 1472, F_M = 1600, F_CW = 1732, F_SA = 3012, F_SB2 = 3028, F_SMU = 4052, F_SWI = 5076, F_SWN = 6100, F_SEM = 7124, F_END = 8148;
constexpr int MIX_LDS = L_F + F_END * 4;

__device__ void mlstm_prologue(const Params& P, LAS unsigned char* lds, int b, int h, int gi) {
    LAS float* F = (LAS float*)(lds + L_F);
    const float* ifg = (const float*)(P.ws + MISC_IF);
    const int tid = threadIdx.x, w = tid >> 6, lane = tid & 63;
    const int nch = 16 * (gi + 1);
    for (int c0 = w; c0 < nch; c0 += 32) {
        float ivv[4], lfv[4];
#pragma unroll
        for (int u = 0; u < 4; ++u) { const int c = c0 + 8 * u; if (c < nch) { const size_t tok = (size_t)b * SEQ + c * 64 + lane; ivv[u] = ifg[tok * 8 + h]; lfv[u] = ifg[tok * 8 + 4 + h]; } else { ivv[u] = 0.f; lfv[u] = 0.f; } }
#pragma unroll
        for (int u = 0; u < 4; ++u) { const int c = c0 + 8 * u; if (c < nch) {
            const float bc = wave_incl_sum(lfv[u], lane);
            const float bl = __shfl(bc, 63);
            const float gm = wave_max(bl - bc + ivv[u]);
            if (lane == 0) { F[F_BL + c] = bl; F[F_GM + c] = gm; } } }
    }
    for (int i = tid; i < 1280; i += NTHREADS) {
        const int j = i >> 8, ch = i & 255; const int gc = ch < 128 ? h * 128 + ch : 512 + h * 128 + (ch - 128);
        F[F_CW + i] = j < 4 ? P.conv_w[j * 1024 + gc] : P.conv_b[gc];
    }
    if (tid < 128) F[F_N + tid] = 0.f;
    __syncthreads();
    if (tid == 0) { float m = 0.f; F[F_M] = 0.f; for (int c = 0; c < nch; ++c) { m = fmaxf(F[F_BL + c] + m, F[F_GM + c]); F[F_M + c + 1] = m; } }
    __syncthreads();
    for (int lc = w; lc < 16; lc += 8) {
        const int c = gi * 16 + lc;
        const size_t tok = (size_t)b * SEQ + c * 64 + lane;
        const float iv = ifg[tok * 8 + h], lf = ifg[tok * 8 + 4 + h];
        const float bc = wave_incl_sum(lf, lane);
        const float bl = __shfl(bc, 63);
        const float mst = F[F_M + c], mnew = F[F_M + c + 1];
        const float beta = iv - bc;
        const float mu = fmaxf(mst, wave_incl_max(beta, lane));
        F[F_SB2 + lc * 64 + lane] = beta * LOG2E;
        F[F_SMU + lc * 64 + lane] = mu * LOG2E;
        F[F_SWI + lc * 64 + lane] = expf(mst - mu);
        F[F_SWN + lc * 64 + lane] = expf(bl - bc + iv - mnew);
        F[F_SEM + lc * 64 + lane] = expf(-(bc + mu));
        if (lane == 0) F[F_SA + lc] = expf(bl + mst - mnew);
    }
    __syncthreads();
}

struct MlRaw { u32x4 vr[4]; u32x4 raw[7]; };
template <bool NEED_Q>
__device__ __forceinline__ void mlstm_issue(const Params& P, int b, int h, int c, MlRaw& R) {
    const bf16_t* QK = (const bf16_t*)(P.ws + WS_QK);
    const bf16_t* VA = (const bf16_t*)(P.ws + WS_VA);
    const int tid = threadIdx.x, tg = tid & 15, cg = tid >> 4;
#pragma unroll
    for (int tt = 0; tt < 4; ++tt) R.vr[tt] = *(const u32x4*)(VA + ((size_t)b * SEQ + c * 64 + 4 * tg + tt) * DM + h * 256 + 8 * cg);
    if (NEED_Q || cg >= 16) {
        const int gc = cg < 16 ? h * 128 + 8 * cg : 512 + h * 128 + 8 * (cg - 16);
#pragma unroll
        for (int i = 0; i < 7; ++i) {
            const int pos = c * 64 + 4 * tg - 3 + i;
            R.raw[i] = pos >= 0 ? *(const u32x4*)(QK + ((size_t)b * SEQ + pos) * DM + gc) : (u32x4){0u, 0u, 0u, 0u};
        }
    }
}
template <bool NEED_Q>
__device__ __forceinline__ void mlstm_load(LAS unsigned char* lds, const MlRaw& R, int lc) {
    LAS float* F = (LAS float*)(lds + L_F);
    const int tid = threadIdx.x, tg = tid & 15, cg = tid >> 4;
    {
        const u32x4 (&vr)[4] = R.vr;
#pragma unroll
        for (int e = 0; e < 8; ++e) {
            unsigned short x0, x1, x2, x3;
            { const unsigned a0 = vr[0][e >> 1], a1 = vr[1][e >> 1], a2 = vr[2][e >> 1], a3 = vr[3][e >> 1];
              if (e & 1) { x0 = a0 >> 16; x1 = a1 >> 16; x2 = a2 >> 16; x3 = a3 >> 16; } else { x0 = a0 & 0xffff; x1 = a1 & 0xffff; x2 = a2 & 0xffff; x3 = a3 & 0xffff; } }
            u32x2 wv; wv.x = (unsigned)x0 | ((unsigned)x1 << 16); wv.y = (unsigned)x2 | ((unsigned)x3 << 16);
            *(LAS u32x2*)(lds + L_VT + (8 * cg + e) * 144 + 8 * tg) = wv;
        }
    }
    __builtin_amdgcn_sched_barrier(0);
    if (NEED_Q || cg >= 16) {
        const u32x4 (&raw)[7] = R.raw;
        float o[4][8];
#pragma unroll
        for (int e = 0; e < 8; ++e) {
            float rv[7];
#pragma unroll
            for (int i = 0; i < 7; ++i) rv[i] = (e & 1) ? bf_hi(raw[i][e >> 1]) : bf_lo(raw[i][e >> 1]);
            const float w0 = F[F_CW + 0 * 256 + 8 * cg + e], w1 = F[F_CW + 1 * 256 + 8 * cg + e], w2 = F[F_CW + 2 * 256 + 8 * cg + e], w3 = F[F_CW + 3 * 256 + 8 * cg + e], cb = F[F_CW + 4 * 256 + 8 * cg + e];
#pragma unroll
            for (int tt = 0; tt < 4; ++tt) { const float v = cb + w0 * rv[tt] + w1 * rv[tt + 1] + w2 * rv[tt + 2] + w3 * rv[tt + 3]; o[tt][e] = v * sigmoid_f(v); }
            __builtin_amdgcn_sched_barrier(0);
        }
        if (cg < 16) {
#pragma unroll
            for (int tt = 0; tt < 4; ++tt) { u32x4 wv; wv.x = cvt_pk_bf16(o[tt][0], o[tt][1]); wv.y = cvt_pk_bf16(o[tt][2], o[tt][3]); wv.z = cvt_pk_bf16(o[tt][4], o[tt][5]); wv.w = cvt_pk_bf16(o[tt][6], o[tt][7]);
                *(LAS u32x4*)(lds + L_QI + (4 * tg + tt) * 272 + 16 * cg) = wv; }
        } else {
            const int kc = cg - 16;
            const f32x4 wn = *(const LAS f32x4*)(F + F_SWN + lc * 64 + 4 * tg);
#pragma unroll
            for (int tt = 0; tt < 4; ++tt) {
#pragma unroll
                for (int e = 0; e < 8; ++e) o[tt][e] *= 0.08838834764831845f;
                u32x4 wv; wv.x = cvt_pk_bf16(o[tt][0], o[tt][1]); wv.y = cvt_pk_bf16(o[tt][2], o[tt][3]); wv.z = cvt_pk_bf16(o[tt][4], o[tt][5]); wv.w = cvt_pk_bf16(o[tt][6], o[tt][7]);
                *(LAS u32x4*)(lds + L_KI + (4 * tg + tt) * 272 + 16 * kc) = wv; }
#pragma unroll
            for (int e = 0; e < 8; ++e) { u32x2 wv; wv.x = cvt_pk_bf16(o[0][e] * wn[0], o[1][e] * wn[1]); wv.y = cvt_pk_bf16(o[2][e] * wn[2], o[3][e] * wn[3]);
                *(LAS u32x2*)(lds + L_KT + (8 * kc + e) * 144 + 8 * tg) = wv; }
        }
    }
}

__device__ __forceinline__ void mlstm_update(LAS unsigned char* lds, f32x4 (&C)[2][8], int lc, int w, int r, int g) {
    LAS float* F = (LAS float*)(lds + L_F);
    const float a = F[F_SA + lc];
    const LAS unsigned char* vp = lds + (L_VT + (32 * w + r) * 144 + 16 * g);
    const LAS unsigned char* kp = lds + (L_KT + r * 144 + 16 * g);
#pragma unroll
    for (int dvb = 0; dvb < 2; ++dvb)
#pragma unroll
        for (int dkb = 0; dkb < 8; ++dkb) C[dvb][dkb] *= a;
#pragma unroll
    for (int ks = 0; ks < 2; ++ks) {
        bf16x8 vf[2];
#pragma unroll
        for (int dvb = 0; dvb < 2; ++dvb) vf[dvb] = *(const LAS bf16x8*)(vp + (16 * dvb * 144 + 64 * ks));
#pragma unroll
        for (int dkb = 0; dkb < 8; ++dkb) {
            const bf16x8 kf = *(const LAS bf16x8*)(kp + (16 * dkb * 144 + 64 * ks));
#pragma unroll
            for (int dvb = 0; dvb < 2; ++dvb) C[dvb][dkb] = mfma16(kf, vf[dvb], C[dvb][dkb]);
        }
        __builtin_amdgcn_sched_barrier(0);
    }
    const int tid = threadIdx.x, dk = tid >> 2, part = tid & 3;
    const u32x4 k0 = *(const LAS u32x4*)(lds + L_KT + dk * 144 + 32 * part), k1 = *(const LAS u32x4*)(lds + L_KT + dk * 144 + 32 * part + 16);
    float s = 0.f;
#pragma unroll
    for (int i = 0; i < 4; ++i) s += bf_lo(k0[i]) + bf_hi(k0[i]) + bf_lo(k1[i]) + bf_hi(k1[i]);
    s += __shfl_xor(s, 1); s += __shfl_xor(s, 2);
    if (part == 0) F[F_N + dk] = a * F[F_N + dk] + s;
}

__device__ void mlstm_phase1(const Params& P, LAS unsigned char* lds) {
    const int tid = threadIdx.x, w = tid >> 6, lane = tid & 63, r = lane & 15, g = lane >> 4;
    LAS float* F = (LAS float*)(lds + L_F);
    for (int task = blockIdx.x; task < 256; task += gridDim.x) {
        const int gi = task & 7, st = task >> 3, b = st >> 2, h = st & 3;
        if (gi == 7) continue;
        mlstm_prologue(P, lds, b, h, gi);
        f32x4 C[2][8];
#pragma unroll
        for (int i = 0; i < 2; ++i)
#pragma unroll
            for (int j = 0; j < 8; ++j) C[i][j] = (f32x4){0.f, 0.f, 0.f, 0.f};
        MlRaw R;
        mlstm_issue<false>(P, b, h, gi * 16, R);
        for (int lc = 0; lc < 16; ++lc) {
            mlstm_load<false>(lds, R, lc);
            __syncthreads();
            if (lc < 15) mlstm_issue<false>(P, b, h, gi * 16 + lc + 1, R);
            mlstm_update(lds, C, lc, w, r, g);
            __syncthreads();
        }
        float* slot = (float*)(P.ws + WS_PB) + (size_t)(st * 7 + gi) * STATE_FLOATS;
#pragma unroll
        for (int dvb = 0; dvb < 2; ++dvb)
#pragma unroll
            for (int dkb = 0; dkb < 8; ++dkb) *(f32x4*)(slot + (((w * 2 + dvb) * 8 + dkb) * 64 + lane) * 4) = C[dvb][dkb];
        if (tid < 128) slot[32768 + tid] = F[F_N + tid];
        __syncthreads();
    }
}

__device__ void mlstm_phase2(const Params& P, LAS unsigned char* lds) {
    const int tid = threadIdx.x, w = tid >> 6, lane = tid & 63, r = lane & 15, g = lane >> 4;
    LAS float* F = (LAS float*)(lds + L_F);
    const bf16_t* OA = (const bf16_t*)(P.ws + WS_OA);
    bf16_t* VA = (bf16_t*)(P.ws + WS_VA);
    for (int task = blockIdx.x; task < 256; task += gridDim.x) {
        const int gi = task & 7, st = task >> 3, b = st >> 2, h = st & 3;
        mlstm_prologue(P, lds, b, h, gi);
        f32x4 C[2][8];
#pragma unroll
        for (int i = 0; i < 2; ++i)
#pragma unroll
            for (int j = 0; j < 8; ++j) C[i][j] = (f32x4){0.f, 0.f, 0.f, 0.f};
        float nreg = 0.f;
        for (int j = 0; j < gi; ++j) {
            float Bj = 0.f;
            for (int c = 0; c < 16; ++c) Bj += F[F_BL + j * 16 + c];
            const float Aj = expf(Bj + F[F_M + 16 * j] - F[F_M + 16 * j + 16]);
            const float* slot = (const float*)(P.ws + WS_PB) + (size_t)(st * 7 + j) * STATE_FLOATS;
#pragma unroll
            for (int dvb = 0; dvb < 2; ++dvb)
#pragma unroll
                for (int dkb = 0; dkb < 8; ++dkb) C[dvb][dkb] = C[dvb][dkb] * Aj + *(const f32x4*)(slot + (((w * 2 + dvb) * 8 + dkb) * 64 + lane) * 4);
            if (tid < 128) nreg = nreg * Aj + slot[32768 + tid];
        }
        if (tid < 128) F[F_N + tid] = nreg;
        __syncthreads();
        for (int lc = 0; lc < 16; ++lc) {
            const int c = gi * 16 + lc;
            MlRaw R;
            mlstm_issue<true>(P, b, h, c, R);
            mlstm_load<true>(lds, R, lc);
            __syncthreads();
            {
                const int tb = w >> 1, par = w & 1;
                const LAS unsigned char* qpS = lds + (L_QI + (16 * tb + r) * 272 + 16 * g);
                const LAS unsigned char* kpS = lds + (L_KI + (16 * par + r) * 272 + 16 * g);
                LAS unsigned char* ppS = lds + (L_PI + (16 * tb + r) * 144 + 32 * par + 8 * g);
                bf16x8 qf[4];
#pragma unroll
                for (int kd = 0; kd < 4; ++kd) qf[kd] = *(const LAS bf16x8*)(qpS + 64 * kd);
                const float mu2 = F[F_SMU + lc * 64 + 16 * tb + r];
                float rs = 0.f;
#pragma unroll
                for (int sbi = 0; sbi < 2; ++sbi) {
                    const int sb = par + 2 * sbi;
                    u32x2 pw = (u32x2){0u, 0u};
                    if (sb <= tb) {
                        f32x4 acc = (f32x4){0.f, 0.f, 0.f, 0.f};
#pragma unroll
                        for (int kd = 0; kd < 4; ++kd) { const bf16x8 kf = *(const LAS bf16x8*)(kpS + (32 * sbi * 272 + 64 * kd)); acc = mfma16(kf, qf[kd], acc); }
                        const f32x4 b2 = *(const LAS f32x4*)(F + F_SB2 + lc * 64 + 16 * sb + 4 * g);
                        float pv[4];
#pragma unroll
                        for (int j = 0; j < 4; ++j) { const int s = 16 * sb + 4 * g + j, t = 16 * tb + r; pv[j] = (s <= t) ? acc[j] * fast_exp2(b2[j] - mu2) : 0.f; }
                        pw.x = cvt_pk_bf16(pv[0], pv[1]); pw.y = cvt_pk_bf16(pv[2], pv[3]);
                        rs += bf_lo(pw.x) + bf_hi(pw.x) + bf_lo(pw.y) + bf_hi(pw.y);
                    }
                    *(LAS u32x2*)(ppS + 64 * sbi) = pw;
                }
                rs += __shfl_xor(rs, 16); rs += __shfl_xor(rs, 32);
                if (g == 0) F[F_RS + par * 64 + 16 * tb + r] = rs;
            }
            __builtin_amdgcn_sched_barrier(0);
            const LAS unsigned char* q8p = lds + (L_QI + r * 272 + 8 * g);
            f32x4 num[2][4];
#pragma unroll
            for (int i = 0; i < 2; ++i)
#pragma unroll
                for (int j = 0; j < 4; ++j) num[i][j] = (f32x4){0.f, 0.f, 0.f, 0.f};
#pragma unroll
            for (int kk = 0; kk < 4; ++kk) {
                bf16x8 af[2];
#pragma unroll
                for (int dvb = 0; dvb < 2; ++dvb) {
                    u32x2 lo, hi; lo.x = cvt_pk_bf16(C[dvb][2 * kk][0], C[dvb][2 * kk][1]); lo.y = cvt_pk_bf16(C[dvb][2 * kk][2], C[dvb][2 * kk][3]);
                    hi.x = cvt_pk_bf16(C[dvb][2 * kk + 1][0], C[dvb][2 * kk + 1][1]); hi.y = cvt_pk_bf16(C[dvb][2 * kk + 1][2], C[dvb][2 * kk + 1][3]);
                    af[dvb] = mk8(lo, hi);
                }
#pragma unroll
                for (int tb = 0; tb < 4; ++tb) {
                    const u32x2 q0 = *(const LAS u32x2*)(q8p + (16 * tb * 272 + 64 * kk)), q1 = *(const LAS u32x2*)(q8p + (16 * tb * 272 + 64 * kk + 32));
                    const bf16x8 bq = mk8(q0, q1);
#pragma unroll
                    for (int dvb = 0; dvb < 2; ++dvb) num[dvb][tb] = mfma16(af[dvb], bq, num[dvb][tb]);
                }
                __builtin_amdgcn_sched_barrier(0);
            }
#pragma unroll
            for (int tb = 0; tb < 4; ++tb) { const float wi = F[F_SWI + lc * 64 + 16 * tb + r];
#pragma unroll
                for (int dvb = 0; dvb < 2; ++dvb) num[dvb][tb] *= wi; }
            {
                const int t = tid >> 3, part = tid & 7;
                const u32x4 q0 = *(const LAS u32x4*)(lds + L_QI + t * 272 + 32 * part), q1 = *(const LAS u32x4*)(lds + L_QI + t * 272 + 32 * part + 16);
                float s = 0.f;
#pragma unroll
                for (int i = 0; i < 4; ++i) {
                    s += bf_lo(q0[i]) * F[F_N + 16 * part + 2 * i] + bf_hi(q0[i]) * F[F_N + 16 * part + 2 * i + 1];
                    s += bf_lo(q1[i]) * F[F_N + 16 * part + 8 + 2 * i] + bf_hi(q1[i]) * F[F_N + 16 * part + 8 + 2 * i + 1];
                }
                s += __shfl_xor(s, 1); s += __shfl_xor(s, 2); s += __shfl_xor(s, 4);
                if (part == 0) F[F_QN + t] = s;
            }
            __builtin_amdgcn_sched_barrier(0);
            __syncthreads();
            const LAS unsigned char* vpC = lds + (L_VT + (32 * w + r) * 144 + 16 * g);
            const LAS unsigned char* ppC = lds + (L_PI + r * 144 + 16 * g);
#pragma unroll
            for (int ks = 0; ks < 2; ++ks) {
                bf16x8 vf[2];
#pragma unroll
                for (int dvb = 0; dvb < 2; ++dvb) vf[dvb] = *(const LAS bf16x8*)(vpC + (16 * dvb * 144 + 64 * ks));
#pragma unroll
                for (int tb = 0; tb < 4; ++tb) {
                    if (ks == 0 || tb >= 2) {
                        const bf16x8 pb = *(const LAS bf16x8*)(ppC + (16 * tb * 144 + 64 * ks));
#pragma unroll
                        for (int dvb = 0; dvb < 2; ++dvb) num[dvb][tb] = mfma16(vf[dvb], pb, num[dvb][tb]);
                    }
                }
                __builtin_amdgcn_sched_barrier(0);
            }
#pragma unroll
            for (int tb = 0; tb < 4; ++tb) {
                const int t = 16 * tb + r;
                const float den = F[F_SWI + lc * 64 + t] * F[F_QN + t] + F[F_RS + t] + F[F_RS + 64 + t];
                const float inv = 1.0f / fmaxf(fabsf(den), F[F_SEM + lc * 64 + t]);
                float s1 = 0.f, s2 = 0.f;
#pragma unroll
                for (int dvb = 0; dvb < 2; ++dvb) { num[dvb][tb] *= inv;
#pragma unroll
                    for (int j = 0; j < 4; ++j) { const float v = num[dvb][tb][j]; s1 += v; s2 += v * v; } }
                s1 += __shfl_xor(s1, 16); s1 += __shfl_xor(s1, 32); s2 += __shfl_xor(s2, 16); s2 += __shfl_xor(s2, 32);
                if (g == 0) { F[F_HS + (w * 64 + t) * 2] = s1; F[F_HS + (w * 64 + t) * 2 + 1] = s2; }
                __builtin_amdgcn_sched_barrier(0);
            }
            mlstm_update(lds, C, lc, w, r, g);
            __builtin_amdgcn_sched_barrier(0);
            __syncthreads();
#pragma unroll
            for (int tb = 0; tb < 4; ++tb) {
                const int t = 16 * tb + r;
                float s1 = 0.f, s2 = 0.f;
#pragma unroll
                for (int ww = 0; ww < 8; ++ww) { s1 += F[F_HS + (ww * 64 + t) * 2]; s2 += F[F_HS + (ww * 64 + t) * 2 + 1]; }
                const float mean = s1 * (1.0f / 256.0f), var = fmaxf(s2 * (1.0f / 256.0f) - mean * mean, 0.f), rstd = rsqrtf(var + LN_EPS);
                const size_t tok = (size_t)b * SEQ + c * 64 + t;
#pragma unroll
                for (int dvb = 0; dvb < 2; ++dvb) {
                    const int dv0 = 32 * w + 16 * dvb + 4 * g;
                    const f32x4 gn = *(const f32x4*)(P.mh_g + h * 256 + dv0);
                    const u32x2 og = *(const u32x2*)(OA + tok * DM + h * 256 + dv0);
                    const float y0 = (num[dvb][tb][0] - mean) * rstd * gn[0] * bf_lo(og.x), y1 = (num[dvb][tb][1] - mean) * rstd * gn[1] * bf_hi(og.x);
                    const float y2 = (num[dvb][tb][2] - mean) * rstd * gn[2] * bf_lo(og.y), y3 = (num[dvb][tb][3] - mean) * rstd * gn[3] * bf_hi(og.y);
                    u32x2 wv; wv.x = cvt_pk_bf16(y0, y1); wv.y = cvt_pk_bf16(y2, y3);
                    *(u32x2*)(VA + tok * DM + h * 256 + dv0) = wv;
                }
            }
        }
        __syncthreads();
    }
}

constexpr int A_KI = 0, A_VT = 17408, A_FL = 35840;
constexpr float SB_DONE_LOG2 = -40.0f;

__device__ void attn_phase(const Params& P, LAS unsigned char* lds) {
    const int tid = threadIdx.x, w = tid >> 6, lane = tid & 63, r = lane & 15, g = lane >> 4;
    bf16_t* QB = (bf16_t*)(P.ws + WS_QB);
    const bf16_t* KB = (const bf16_t*)(P.ws + WS_KB);
    const bf16_t* VB = (const bf16_t*)(P.ws + WS_VB);
    unsigned* cnt = (unsigned*)(P.ws + MISC_CNT);
    LAS int* FL = (LAS int*)(lds + A_FL);
    for (;;) {
        if (tid == 0) FL[32] = (int)atomicAdd(cnt, 1u);
        __syncthreads();
        const int item = FL[32];
        __syncthreads();
        if (item >= 4096) break;
        const int qb = 63 - (item >> 6), b = (item >> 3) & 7, h = item & 7;
        const int q0w = qb * 128 + 16 * w;
        const size_t qtok = (size_t)b * SEQ + q0w + r;
        bf16x8 qf[4];
#pragma unroll
        for (int kd = 0; kd < 4; ++kd) qf[kd] = *(const bf16x8*)(QB + qtok * DM + h * 128 + 32 * kd + 8 * g);
        f32x4 O[8];
#pragma unroll
        for (int i = 0; i < 8; ++i) O[i] = (f32x4){0.f, 0.f, 0.f, 0.f};
        float R = 0.f;
        int wdone = 0, it = 0;
        u32x4 pre[4];
        const int ptg = tid & 15, pcg = (tid >> 4) & 15, prow = (tid - 256) >> 2, pch = tid & 3;
        auto issue_tile = [&](int kt_) {
            if (tid < 256) {
#pragma unroll
                for (int tt = 0; tt < 4; ++tt) pre[tt] = *(const u32x4*)(VB + ((size_t)b * SEQ + kt_ * 64 + 4 * ptg + tt) * DM + h * 128 + 8 * pcg);
            } else {
                const bf16_t* src_ = KB + ((size_t)b * SEQ + kt_ * 64 + prow) * DM + h * 128 + 32 * pch;
#pragma unroll
                for (int i = 0; i < 4; ++i) pre[i] = *(const u32x4*)(src_ + 8 * i);
            }
        };
        issue_tile(2 * qb + 1);
        for (int kt = 2 * qb + 1; kt >= 0; --kt, ++it) {
            if (tid < 256) {
#pragma unroll
                for (int e = 0; e < 8; ++e) {
                    unsigned short x0, x1, x2, x3;
                    { const unsigned a0 = pre[0][e >> 1], a1 = pre[1][e >> 1], a2 = pre[2][e >> 1], a3 = pre[3][e >> 1];
                      if (e & 1) { x0 = a0 >> 16; x1 = a1 >> 16; x2 = a2 >> 16; x3 = a3 >> 16; } else { x0 = a0 & 0xffff; x1 = a1 & 0xffff; x2 = a2 & 0xffff; x3 = a3 & 0xffff; } }
                    u32x2 wv; wv.x = (unsigned)x0 | ((unsigned)x1 << 16); wv.y = (unsigned)x2 | ((unsigned)x3 << 16);
                    *(LAS u32x2*)(lds + A_VT + (8 * pcg + e) * 144 + 8 * ptg) = wv;
                }
            } else {
#pragma unroll
                for (int i = 0; i < 4; ++i) *(LAS u32x4*)(lds + A_KI + prow * 272 + 64 * pch + 16 * i) = pre[i];
            }
            __syncthreads();
            if (kt > 0) issue_tile(kt - 1);
            const int key0 = kt * 64;
            if (!wdone && key0 <= q0w + 14) {
                const int qpos = q0w + r;
                float wgt[4][4];
                float Rrun = R;
#pragma unroll
                for (int sb = 3; sb >= 0; --sb) {
                    f32x4 acc = (f32x4){0.f, 0.f, 0.f, 0.f};
#pragma unroll
                    for (int kd = 0; kd < 4; ++kd) { const bf16x8 kf = *(const LAS bf16x8*)(lds + A_KI + (16 * sb + r) * 272 + 64 * kd + 16 * g); acc = mfma16(kf, qf[kd], acc); }
                    float lk[4], z[4];
#pragma unroll
                    for (int j = 0; j < 4; ++j) {
                        const int key = key0 + 16 * sb + 4 * g + j;
                        z[j] = fminf(acc[j], 80.0f);
                        lk[j] = (key < qpos) ? -fast_log2(1.0f + fast_exp2(z[j])) : 0.f;
                    }
                    const float s3 = lk[3], s2 = s3 + lk[2], s1 = s2 + lk[1], s0 = s1 + lk[0];
                    const float t1 = __shfl_xor(s0, 16), t2 = __shfl_xor(s0, 32), t3 = __shfl_xor(t1, 32);
                    const float above = g == 0 ? (t1 + t2 + t3) : (g == 1 ? (t2 + t3) : (g == 2 ? t1 : 0.f));
                    const float base = Rrun + above;
                    const float sj[4] = {s0, s1, s2, s3};
#pragma unroll
                    for (int j = 0; j < 4; ++j) { const int key = key0 + 16 * sb + 4 * g + j; wgt[sb][j] = (key < qpos) ? fast_exp2(z[j] + base + sj[j]) : 0.f; }
                    Rrun += (s0 + t1) + (t2 + t3);
                }
                R = Rrun;
#pragma unroll
                for (int ks = 0; ks < 2; ++ks) {
                    u32x2 lo, hi; lo.x = cvt_pk_bf16(wgt[2 * ks][0], wgt[2 * ks][1]); lo.y = cvt_pk_bf16(wgt[2 * ks][2], wgt[2 * ks][3]);
                    hi.x = cvt_pk_bf16(wgt[2 * ks + 1][0], wgt[2 * ks + 1][1]); hi.y = cvt_pk_bf16(wgt[2 * ks + 1][2], wgt[2 * ks + 1][3]);
                    const bf16x8 pf = mk8(lo, hi);
#pragma unroll
                    for (int db = 0; db < 8; ++db) {
                        const u32x2 v0 = *(const LAS u32x2*)(lds + A_VT + (16 * db + r) * 144 + 64 * ks + 8 * g), v1 = *(const LAS u32x2*)(lds + A_VT + (16 * db + r) * 144 + 64 * ks + 32 + 8 * g);
                        O[db] = mfma16(mk8(v0, v1), pf, O[db]);
                    }
                }
                wdone = __all(R < SB_DONE_LOG2) ? 1 : 0;
            }
            if (lane == 0) FL[(it & 1) * 8 + w] = wdone;
            __syncthreads();
            int alld = 1;
#pragma unroll
            for (int i = 0; i < 8; ++i) alld &= FL[(it & 1) * 8 + i];
            if (alld) break;
        }
#pragma unroll
        for (int db = 0; db < 8; ++db) { u32x2 wv; wv.x = cvt_pk_bf16(O[db][0], O[db][1]); wv.y = cvt_pk_bf16(O[db][2], O[db][3]);
            *(u32x2*)(QB + qtok * DM + h * 128 + 16 * db + 4 * g) = wv; }
        __syncthreads();
    }
}


#ifdef DIAG
__device__ void diag_count_f32(const float* p, size_t n, float thr, unsigned* ctr) {
    unsigned c = 0;
    for (size_t i = (size_t)blockIdx.x * NTHREADS + threadIdx.x; i < n; i += (size_t)gridDim.x * NTHREADS) { const float v = p[i]; if (!(fabsf(v) <= thr)) ++c; }
    if (c) atomicAdd(ctr, c);
}
__device__ void diag_count_bf16(const bf16_t* p, size_t n, float thr, unsigned* ctr) {
    unsigned c = 0;
    for (size_t i = (size_t)blockIdx.x * NTHREADS + threadIdx.x; i < n; i += (size_t)gridDim.x * NTHREADS) { const float v = __uint_as_float((unsigned)p[i] << 16); if (!(fabsf(v) <= thr)) ++c; }
    if (c) atomicAdd(ctr, c);
}
#endif
#define XB_TMO      128
#define XB_XCNT(j)  (256  + 64 * (j))
#define XB_XSUB(j)  (1280 + 64 * (j))
#define XB_XGEN(j)  (2304 + 64 * (j))
#define XB_TOP      3328
#define XB_TOPGEN   3392
#define XCD_BAR_WORDS 3456
#define XB_SPIN_CAP (1u << 18)

__device__ __forceinline__ unsigned xb_ld(unsigned* p)              { return __hip_atomic_load(p, __ATOMIC_RELAXED, __HIP_MEMORY_SCOPE_AGENT); }
__device__ __forceinline__ unsigned xb_add(unsigned* p, unsigned v) { return __hip_atomic_fetch_add(p, v, __ATOMIC_RELAXED, __HIP_MEMORY_SCOPE_AGENT); }
__device__ __forceinline__ unsigned xb_xcc_id() { return (unsigned)__builtin_amdgcn_s_getreg((3 << 11) | 20) & 0xFu; }
#define XB_SPIN(cond, bar) do { unsigned _sp = 0; while (cond) { __builtin_amdgcn_s_sleep(1); \
    if ((++_sp & 255u) == 0u) { if (xb_ld(&(bar)[XB_TMO])) break; if (_sp > XB_SPIN_CAP) { atomicAdd(&(bar)[XB_TMO], 1u); break; } } } } while (0)

struct XcdBarrier {
    unsigned* bar; unsigned x;
    volatile LAS unsigned* st;
};

__device__ __forceinline__ XcdBarrier xcd_barrier_post(unsigned* bar, volatile LAS unsigned* st) {
    XcdBarrier b; b.bar = bar; b.x = xb_xcc_id(); b.st = st;
    if (threadIdx.x == 0) (void)xb_add(&bar[XB_XCNT(b.x)], 1u);
    return b;
}
__device__ __forceinline__ void xcd_barrier_complete(unsigned* bar, unsigned x, unsigned& nloc, unsigned& nx) {
    const unsigned G = gridDim.x * gridDim.y * gridDim.z;
    unsigned sum, cnt, mine, sp = 0u;
    for (;;) {
        sum = 0u; cnt = 0u; mine = 0u;
#pragma unroll
        for (unsigned j = 0; j < 16; ++j) { const unsigned c = xb_ld(&bar[XB_XCNT(j)]); sum += c; cnt += (c > 0u) ? 1u : 0u; mine = (j == x) ? c : mine; }
        if (sum == G) break;
        __builtin_amdgcn_s_sleep(1);
        if ((++sp & 255u) == 0u) { if (xb_ld(&bar[XB_TMO])) break; if (sp > XB_SPIN_CAP) { atomicAdd(&bar[XB_TMO], 1u); break; } }
    }
    nloc = mine > 0u ? mine : 1u; nx = cnt > 0u ? cnt : 1u;
}

__device__ __forceinline__ void xcd_barrier(const XcdBarrier& b) {
    asm volatile("s_waitcnt vmcnt(0)" ::: "memory");
    __syncthreads();
    if (threadIdx.x == 0) {
        unsigned* bar = b.bar;
        __builtin_amdgcn_s_waitcnt(0);
        unsigned nloc = b.st[0], nx = b.st[1];
        if (nloc == 0u) { xcd_barrier_complete(bar, b.x, nloc, nx); b.st[0] = nloc; b.st[1] = nx; }
        const unsigned old = xb_add(&bar[XB_XSUB(b.x)], 1u);
        const unsigned gen = old / nloc;
        if (old + 1u == (gen + 1u) * nloc) {
            __builtin_amdgcn_fence(__ATOMIC_RELEASE, "agent");
            asm volatile("s_waitcnt vmcnt(0)" ::: "memory");
            const unsigned og = xb_add(&bar[XB_TOP], 1u);
            const unsigned tg = og / nx;
            if (og + 1u == (tg + 1u) * nx) xb_add(&bar[XB_TOPGEN], 1u);
            else XB_SPIN(xb_ld(&bar[XB_TOPGEN]) == tg, bar);
            __builtin_amdgcn_fence(__ATOMIC_ACQUIRE, "agent");
            xb_add(&bar[XB_XGEN(b.x)], 1u);
            asm volatile("s_waitcnt vmcnt(0)" ::: "memory");
        } else {
            XB_SPIN(xb_ld(&bar[XB_XGEN(b.x)]) == gen, bar);
            __builtin_amdgcn_fence(__ATOMIC_ACQUIRE, "agent");
            asm volatile("s_waitcnt vmcnt(0)" ::: "memory");
        }
    }
    __syncthreads();
}

constexpr int LDS_BYTES = 135168;
static_assert(MIX_LDS <= LDS_BYTES && 128 * 129 * 4 <= LDS_BYTES && pg8::STAGE_BYTES <= LDS_BYTES, "LDS budget");
constexpr int NPHASE = 17;

template <class Epi>
__device__ __forceinline__ void run_gemm(LAS unsigned char* lds, const bf16_t* A, const bf16_t* Bt, int N, int K, const Epi& E) {
    pg8::Gemm g{A, Bt, MTOK, N, K};
    pg8::StaticOrder S; S.init(MTOK, N, gridDim.x, blockIdx.x);
    pg8::gemm_phase<Epi, pg8::StaticOrder, true, true>(lds, g, S, E);
}

__global__ void __launch_bounds__(NTHREADS, 2) fwd_megakernel(Params P) {
    extern __shared__ __attribute__((aligned(16))) unsigned char smem[];
    LAS unsigned char* lds = (LAS unsigned char*)smem;
    cg::grid_group grid = cg::this_grid();
    unsigned char* ws = P.ws;
    bf16_t* X = (bf16_t*)(ws + WS_X);
    bf16_t* H = (bf16_t*)(ws + WS_H);
    float* Y = P.out;
    bf16_t* gates = (bf16_t*)P.out;
#ifdef ONLYMASK
#define PHASE(k) if (((ONLYMASK >> (k)) & 1) && P.ph_lo <= (k) && (k) < P.ph_hi)
#else
#define PHASE(k) if (P.ph_lo <= (k) && (k) < P.ph_hi)
#endif
#define SYNC0() do { if (P.coop) { asm volatile("s_waitcnt vmcnt(0) lgkmcnt(0)" ::: "memory"); grid.sync(); \
        if (threadIdx.x < 64) { __builtin_amdgcn_fence(__ATOMIC_ACQUIRE, "agent"); asm volatile("s_waitcnt vmcnt(0)" ::: "memory"); } __syncthreads(); } } while (0)
#define SYNC() do { if (P.coop) xcd_barrier(xb); } while (0)
    volatile LAS unsigned* bst = (volatile LAS unsigned*)(lds + (LDS_BYTES - 16));
    XcdBarrier xb; xb.bar = (unsigned*)(ws + MISC_BAR); xb.x = 0; xb.st = bst;
    if (P.coop) { if (threadIdx.x == 0) { bst[0] = 0u; bst[1] = 0u; } xb = xcd_barrier_post((unsigned*)(ws + MISC_BAR), bst); }
    PHASE(0) prep_phase(P, lds);
    SYNC0();
    PHASE(1) run_gemm(lds, X, (const bf16_t*)(ws + W_GU1), 5632, 1024, EpiSwiglu{H});
    SYNC();
    PHASE(2) run_gemm(lds, H, (const bf16_t*)(ws + W_D1), 1024, FH, EpiResid<false, false, true>{P.x, nullptr, Y, 0.5f});
    SYNC();
    PHASE(3) ln_phase<true, true>(Y, P.ln_g, P.ln_b, X);
    SYNC();
    PHASE(4) run_gemm(lds, X, (const bf16_t*)(ws + W_IN), NIN_PAD, 1024, EpiWin{(bf16_t*)(ws + WS_QK), gates, (float*)(ws + MISC_IF), (const float*)(ws + W_BIAS)});
    SYNC();
    PHASE(5) mlstm_phase1(P, lds);
    SYNC();
    PHASE(6) {
#ifndef NO_ML2
        mlstm_phase2(P, lds);
#endif
#ifndef NO_ATT
        attn_phase(P, lds);
#endif
    }
    SYNC();
    PHASE(7) {
        run_gemm(lds, (const bf16_t*)(ws + WS_VA), (const bf16_t*)(ws + W_A), 1024, 1024, EpiGateMul<false>{gates, 0, nullptr, (bf16_t*)(ws + WS_T)});
        run_gemm(lds, (const bf16_t*)(ws + WS_QB), (const bf16_t*)(ws + W_B), 1024, 1024, EpiGateMul<true>{gates, DM, (const bf16_t*)(ws + WS_T), (bf16_t*)(ws + WS_MG)});
    }
    SYNC();
    PHASE(8) run_gemm(lds, (const bf16_t*)(ws + WS_MG), (const bf16_t*)(ws + W_O), 1024, 1024, EpiResid<true, false, true>{X, nullptr, Y, 1.0f});
    SYNC();
    PHASE(9) ln_phase<true, true>(Y, P.ln_g + DM, P.ln_b + DM, X);
    SYNC();
    PHASE(10) run_gemm(lds, X, (const bf16_t*)(ws + W_GU2), 5632, 1024, EpiSwiglu{H});
    SYNC();
    PHASE(11) run_gemm(lds, H, (const bf16_t*)(ws + W_D2), 1024, FH, EpiResid<true, false, true>{X, nullptr, Y, 0.5f});
    SYNC();
    PHASE(12) { ln_phase<true, true>(Y, P.ln_g + 2 * DM, P.ln_b + 2 * DM, X); cvt_bf16_phase(P.p, (bf16_t*)(ws + WS_PB), (size_t)MTOK * 256 / 8); }
    SYNC();
    PHASE(13) {
        run_gemm(lds, X, (const bf16_t*)(ws + W_PG), 1024, 1024, EpiSigBias{P.b_pg, (bf16_t*)(ws + WS_PG)});
        run_gemm(lds, (const bf16_t*)(ws + WS_PB), (const bf16_t*)(ws + W_P), 1024, 256, EpiResid<true, true, true>{X, (const bf16_t*)(ws + WS_PG), (float*)(ws + WS_VA), 1.0f});
    }
    SYNC();
    PHASE(14) ln_phase<false, true>((const float*)(ws + WS_VA), P.ln_g + 3 * DM, P.ln_b + 3 * DM, P.out);
#undef PHASE
#undef SYNC
#undef SYNC0
}

extern "C" void kernel_launch(void* const* d_in, const int* in_sizes, int n_in, void* d_out, int out_size, void* d_ws, size_t ws_size, hipStream_t stream) {
    static int grid_blocks = 0;
    if (grid_blocks == 0) {
        if (n_in != 19 || out_size != MTOK * DM || ws_size < WS_END) { fprintf(stderr, "kernel_launch: unexpected shapes (n_in %d, out %d, ws %zu, need %zu)\n", n_in, out_size, ws_size, (size_t)WS_END); grid_blocks = -1; return; }
        int dev = 0, cus = 0, per_cu = 0;
        hipGetDevice(&dev);
        hipDeviceGetAttribute(&cus, hipDeviceAttributeMultiprocessorCount, dev);
        if (hipFuncSetAttribute((const void*)fwd_megakernel, hipFuncAttributeMaxDynamicSharedMemorySize, LDS_BYTES) != hipSuccess) { fprintf(stderr, "kernel_launch: hipFuncSetAttribute failed\n"); grid_blocks = -1; return; }
        if (hipOccupancyMaxActiveBlocksPerMultiprocessor(&per_cu, (const void*)fwd_megakernel, NTHREADS, LDS_BYTES) != hipSuccess || per_cu < 1) { fprintf(stderr, "kernel_launch: occupancy query failed (%d)\n", per_cu); per_cu = 1; (void)hipGetLastError(); }
        grid_blocks = cus * per_cu;
    }
    if (grid_blocks < 0) return;
    Params p{};
    p.x = (const float*)d_in[0]; p.p = (const float*)d_in[1]; p.ln_g = (const float*)d_in[2]; p.ln_b = (const float*)d_in[3];
    p.wg = (const float*)d_in[4]; p.wu = (const float*)d_in[5]; p.wd = (const float*)d_in[6]; p.w_in = (const float*)d_in[7]; p.b_in = (const float*)d_in[8];
    p.b_forget = (const float*)d_in[9]; p.conv_w = (const float*)d_in[10]; p.conv_b = (const float*)d_in[11]; p.mh_g = (const float*)d_in[12];
    p.w_a = (const float*)d_in[13]; p.w_b = (const float*)d_in[14]; p.w_o = (const float*)d_in[15]; p.w_ple = (const float*)d_in[16]; p.w_pg = (const float*)d_in[17]; p.b_pg = (const float*)d_in[18];
    p.out = (float*)d_out; p.ws = (unsigned char*)d_ws; p.pad = 0;
#if ONE_LAUNCH
    if (hipMemsetAsync((char*)d_ws + MISC_BAR, 0, XCD_BAR_WORDS * 4, stream) != hipSuccess) { fprintf(stderr, "kernel_launch: memset of the barrier words failed\n"); return; }
    p.ph_lo = 0; p.ph_hi = NPHASE; p.coop = 1;
    void* args[] = {&p};
    hipError_t e = hipLaunchCooperativeKernel((const void*)fwd_megakernel, dim3(grid_blocks), dim3(NTHREADS), args, LDS_BYTES, stream);
    if (e != hipSuccess) fprintf(stderr, "cooperative launch failed: %s (grid %d)\n", hipGetErrorString(e), grid_blocks);
#else
    p.coop = 0;
    for (int ph = 0; ph < 15; ++ph) { p.ph_lo = ph; p.ph_hi = ph + 1; hipLaunchKernelGGL(fwd_megakernel, dim3(grid_blocks), dim3(NTHREADS), LDS_BYTES, stream, p); }
#endif
}
```

```cpp
#include <hip/hip_runtime.h>
#include <hip/hip_cooperative_groups.h>
#include <cstdio>
namespace cg = cooperative_groups;

#ifndef ONE_LAUNCH
#define ONE_LAUNCH 1
#endif

#define LAS __attribute__((address_space(3)))
typedef unsigned short bf16_t;
typedef short bf16x8 __attribute__((ext_vector_type(8)));
typedef float f32x4 __attribute__((ext_vector_type(4)));
typedef float f32x2 __attribute__((ext_vector_type(2)));
typedef unsigned u32x4 __attribute__((ext_vector_type(4)));
typedef unsigned u32x2 __attribute__((ext_vector_type(2)));

constexpr int MTOK = 65536, DM = 1024, FH = 2816, SEQ = 8192;
constexpr int NIN_PAD = 8448;
constexpr float ALPHA = 1.189207115002721f;
constexpr float LN_EPS = 1e-5f;
constexpr float LOG2E = 1.4426950408889634f;
constexpr int NTHREADS = 512;

constexpr size_t QB_ = 33554432ull;
constexpr size_t WS_W = 0;
constexpr size_t W_GU1 = 0;
constexpr size_t W_D1 = W_GU1 + 5632ull * 1024 * 2;
constexpr size_t W_GU2 = W_D1 + 1024ull * 2816 * 2;
constexpr size_t W_D2 = W_GU2 + 5632ull * 1024 * 2;
constexpr size_t W_IN = W_D2 + 1024ull * 2816 * 2;
constexpr size_t W_A = W_IN + 8448ull * 1024 * 2;
constexpr size_t W_B = W_A + 1024ull * 1024 * 2;
constexpr size_t W_O = W_B + 1024ull * 1024 * 2;
constexpr size_t W_PG = W_O + 1024ull * 1024 * 2;
constexpr size_t W_P = W_PG + 1024ull * 1024 * 2;
constexpr size_t W_BIAS = W_P + 1024ull * 256 * 2;
static_assert(W_BIAS + 8448 * 4 <= 2 * QB_, "weights overflow");
constexpr size_t WS_PB = 2 * QB_;
constexpr size_t WS_MISC = 3 * QB_;
constexpr size_t MISC_IF = WS_MISC;
constexpr size_t MISC_CNT = WS_MISC + 2097152ull;
constexpr size_t MISC_BAR = MISC_CNT + 4096;
constexpr size_t WS_X = 4 * QB_;
constexpr size_t WS_H = 8 * QB_;
constexpr size_t WS_QK = 8 * QB_, WS_VA = 12 * QB_, WS_OA = 16 * QB_, WS_QB = 20 * QB_, WS_KB = 24 * QB_, WS_VB = 28 * QB_;
constexpr size_t WS_T = WS_QK, WS_MG = WS_KB, WS_PG = 8 * QB_;
constexpr size_t WS_END = 32 * QB_;
constexpr int STATE_FLOATS = 32768 + 128;

typedef __bf16 bf16x2_t __attribute__((ext_vector_type(2)));
__device__ __forceinline__ unsigned cvt_pk_bf16(float lo, float hi) { f32x2 v = {lo, hi}; bf16x2_t r = __builtin_convertvector(v, bf16x2_t); return __builtin_bit_cast(unsigned, r); }
__device__ __forceinline__ float bf_lo(unsigned u) { return __uint_as_float(u << 16); }
__device__ __forceinline__ float bf_hi(unsigned u) { return __uint_as_float(u & 0xffff0000u); }
__device__ __forceinline__ float fast_exp2(float x) { return __builtin_amdgcn_exp2f(x); }
__device__ __forceinline__ float fast_log2(float x) { return __builtin_amdgcn_logf(x); }
__device__ __forceinline__ float fast_rcp(float x) { return __builtin_amdgcn_rcpf(x); }
__device__ __forceinline__ float sigmoid_f(float x) { return fast_rcp(1.0f + fast_exp2(-x * LOG2E)); }
__device__ __forceinline__ f32x4 mfma16(bf16x8 a, bf16x8 b, f32x4 c) { return __builtin_amdgcn_mfma_f32_16x16x32_bf16(a, b, c, 0, 0, 0); }
__device__ __forceinline__ bf16x8 mk8(u32x2 lo, u32x2 hi) { u32x4 v; v.x = lo.x; v.y = lo.y; v.z = hi.x; v.w = hi.y; return __builtin_bit_cast(bf16x8, v); }
__device__ __forceinline__ float wave_sum(float v) {
#pragma unroll
    for (int o = 32; o > 0; o >>= 1) v += __shfl_xor(v, o);
    return v;
}
__device__ __forceinline__ float wave_max(float v) {
#pragma unroll
    for (int o = 32; o > 0; o >>= 1) v = fmaxf(v, __shfl_xor(v, o));
    return v;
}
__device__ __forceinline__ float wave_incl_sum(float v, int lane) {
#pragma unroll
    for (int o = 1; o < 64; o <<= 1) { float t = __shfl_up(v, o); if (lane >= o) v += t; }
    return v;
}
__device__ __forceinline__ float wave_incl_max(float v, int lane) {
#pragma unroll
    for (int o = 1; o < 64; o <<= 1) { float t = __shfl_up(v, o); if (lane >= o) v = fmaxf(v, t); }
    return v;
}

namespace pg8 {
constexpr int BM = 256, BK = 64, HALF = 128, HTB = HALF * BK * 2, STAGE_BYTES = 8 * HTB, NXCD = 8, WGM = 4;
__host__ __device__ __forceinline__ int lds_byte(int r, int c) { const int st = (r >> 4) * 2 + (c >> 5), rr = r & 15, cc = c & 31, ob = rr * 64 + cc * 2; return st * 1024 + (ob ^ (((ob >> 9) & 1) << 5)); }
__host__ __device__ __forceinline__ void stage_rc(int b, int& R, int& C) { const int st = b / 1024, sb = b % 1024, swz = sb ^ (((sb >> 9) & 1) << 5); R = (st >> 1) * 16 + swz / 64; C = (st & 1) * 32 + (swz % 64) / 2; }
__host__ __device__ __forceinline__ int perm32(int rho) { const int n = rho >> 4, i = rho & 15; return 8 * (i >> 2) + 4 * n + (i & 3); }
struct Unit { int pm, pn; };
struct Gemm { const bf16_t* A; const bf16_t* Bt; int M, N, K; };
struct StaticOrder {
    int nM, nN, nwg, G, c;
    __device__ void init(int M, int N, int G_, int c_) { nM = M / BM; nN = N / BM; nwg = nM * nN; G = G_; c = c_; }
    __device__ bool next(int i, Unit& u) const {
        const long L = (long)i * G + c; if (L >= nwg) return false;
        int wgid = (int)L; { const int q = nwg / NXCD, r = nwg % NXCD, xcd = wgid % NXCD, off = wgid / NXCD; wgid = (xcd < r ? xcd * (q + 1) : r * (q + 1) + (xcd - r) * q) + off; }
        const int nig = WGM * nN, gid = wgid / nig, fm = gid * WGM, gsz = (nM - fm) < WGM ? (nM - fm) : WGM;
        u.pm = fm + ((wgid % nig) % gsz); u.pn = (wgid % nig) / gsz; return true;
    }
};
template <class Epi, class Sched, bool ALIGN_EPI = false, bool SP2 = false>
__device__ __forceinline__ void gemm_phase(LAS unsigned char* lds, const Gemm g, const Sched& S, const Epi& E) {
    const int tid = threadIdx.x, wid = __builtin_amdgcn_readfirstlane(tid >> 6), lane = tid & 63, wr = wid >> 2, wc = wid & 3, fr = lane & 15, fq = lane >> 4;
    const int K = g.K, nt = K / BK;
    unsigned voffA[2], voffB[2];
#pragma unroll
    for (int i = 0; i < 2; ++i) { int R, C; stage_rc(tid * 16 + i * 8192, R, C); const int Rb = ((R & ~31) + perm32(R & 31));
        voffA[i] = (unsigned)(R * K + C) * 2u; voffB[i] = (unsigned)(Rb * K + C) * 2u; }
    const size_t kstep = (size_t)(BK * 2);
    const size_t hstep = (size_t)HALF * K * 2;
    const size_t tstep = 2 * hstep;
    const unsigned ldsw = (unsigned)wid * 1024u;
    const int aoff = lds_byte(wr * 64 + fr, fq * 8), boff = lds_byte(wc * 32 + fr, fq * 8);
#define PG8_SA(b, h) (((b) * 2 + (h)) * HTB)
#define PG8_SB(b, h) ((4 + (b) * 2 + (h)) * HTB)
#define PG8_STAGE(bufoff, gbase, voff) do { _Pragma("unroll") for (int _i = 0; _i < 2; ++_i) \
        __builtin_amdgcn_global_load_lds((const unsigned*)((const char*)(gbase) + (voff)[_i]), (LAS unsigned*)(lds + (bufoff) + ldsw + _i * 8192), 16, 0, 0); } while (0)
#define PG8_LDA(dst, b, h) do { _Pragma("unroll") for (int m = 0; m < 4; ++m) _Pragma("unroll") for (int k = 0; k < 2; ++k) dst[m][k] = *(const LAS bf16x8*)(lds + PG8_SA(b, h) + aoff + m * 2048 + k * 1024); } while (0)
#define PG8_LDB(dst, b, h) do { _Pragma("unroll") for (int n = 0; n < 2; ++n) _Pragma("unroll") for (int k = 0; k < 2; ++k) dst[n][k] = *(const LAS bf16x8*)(lds + PG8_SB(b, h) + boff + n * 2048 + k * 1024); } while (0)
#define PG8_MMA(ai, bj, At, Bt) do { __builtin_amdgcn_s_setprio(1); _Pragma("unroll") for (int m = 0; m < 4; ++m) _Pragma("unroll") for (int n = 0; n < 2; ++n) _Pragma("unroll") for (int k = 0; k < 2; ++k) \
        acc[ai][bj][m][n] = __builtin_amdgcn_mfma_f32_16x16x32_bf16(Bt[n][k], At[m][k], acc[ai][bj][m][n], 0, 0, 0); __builtin_amdgcn_s_setprio(0); } while (0)
#define PG8_WAIT_V(n) asm volatile("s_waitcnt vmcnt(" #n ")" ::: "memory")
#define PG8_WAIT_L(n) asm volatile("s_waitcnt lgkmcnt(" #n ")" ::: "memory")
#define PG8_BAR __builtin_amdgcn_s_barrier()
#define PG8_SCHED __builtin_amdgcn_sched_barrier(0)
    Unit cur, nxt; int ui = 0;
    if (!S.next(0, cur)) return;
    f32x4 acc[2][2][4][2];
#pragma unroll
    for (int a = 0; a < 2; ++a)
#pragma unroll
        for (int b = 0; b < 2; ++b)
#pragma unroll
            for (int m = 0; m < 4; ++m)
#pragma unroll
                for (int n = 0; n < 2; ++n) acc[a][b][m][n] = (f32x4){0.f, 0.f, 0.f, 0.f};
    bf16x8 At[4][2], B0[2][2], B1[2][2];
    const char* cA = (const char*)g.A + (size_t)cur.pm * tstep; const char* cB = (const char*)g.Bt + (size_t)cur.pn * tstep;

    if constexpr (SP2) {
        PG8_STAGE(PG8_SB(0, 0), cB, voffB); PG8_STAGE(PG8_SB(0, 1), cB + hstep, voffB); PG8_STAGE(PG8_SA(0, 0), cA, voffA); PG8_STAGE(PG8_SA(0, 1), cA + hstep, voffA);
        if (wr == 1) PG8_BAR;
        PG8_WAIT_V(2); PG8_BAR;
        PG8_STAGE(PG8_SB(1, 0), cB + kstep, voffB); PG8_STAGE(PG8_SA(1, 0), cA + kstep, voffA); PG8_STAGE(PG8_SB(1, 1), cB + hstep + kstep, voffB);
        PG8_WAIT_V(6); PG8_BAR;
    } else {
        PG8_STAGE(PG8_SB(0, 0), cB, voffB); PG8_STAGE(PG8_SA(0, 0), cA, voffA); PG8_STAGE(PG8_SB(0, 1), cB + hstep, voffB); PG8_STAGE(PG8_SA(0, 1), cA + hstep, voffA);
        if (wr == 1) PG8_BAR;
        PG8_WAIT_V(4); PG8_BAR;
        PG8_STAGE(PG8_SB(1, 0), cB + kstep, voffB); PG8_STAGE(PG8_SA(1, 0), cA + kstep, voffA); PG8_STAGE(PG8_SB(1, 1), cB + hstep + kstep, voffB);
        PG8_WAIT_V(6); PG8_BAR;
    }
    for (;;) {
        const bool has_next = S.next(ui + 1, nxt);
        const char* nA = has_next ? (const char*)g.A + (size_t)nxt.pm * tstep : cA; const char* nB = has_next ? (const char*)g.Bt + (size_t)nxt.pn * tstep : cB;
        for (int t = 0; t < nt; t += 2) {
            const bool last = (t == nt - 2);
            const char* a1 = cA + (size_t)(t + 1) * kstep;
            const char* a2 = last ? nA : cA + (size_t)(t + 2) * kstep; const char* b2 = last ? nB : cB + (size_t)(t + 2) * kstep;
            const char* a3 = a2 + kstep; const char* b3 = b2 + kstep;

            if constexpr (SP2) {
            PG8_LDB(B0, 0, 0); PG8_LDB(B1, 0, 1); PG8_SCHED; PG8_LDA(At, 0, 0); PG8_STAGE(PG8_SA(1, 1), a1 + hstep, voffA);
            PG8_WAIT_V(8); PG8_WAIT_L(0); PG8_BAR; PG8_MMA(0, 0, At, B0); PG8_MMA(0, 1, At, B1); PG8_BAR; PG8_SCHED;
            PG8_LDA(At, 0, 1); PG8_STAGE(PG8_SB(0, 0), b2, voffB); PG8_STAGE(PG8_SB(0, 1), b2 + hstep, voffB); PG8_STAGE(PG8_SA(0, 0), a2, voffA);
            PG8_WAIT_V(8); PG8_WAIT_L(0); PG8_BAR; PG8_MMA(1, 0, At, B0); PG8_MMA(1, 1, At, B1); PG8_BAR; PG8_SCHED;
            PG8_LDB(B0, 1, 0); PG8_LDB(B1, 1, 1); PG8_SCHED; PG8_LDA(At, 1, 0); PG8_STAGE(PG8_SA(0, 1), a2 + hstep, voffA);
            PG8_WAIT_V(8); PG8_WAIT_L(0); PG8_BAR; PG8_MMA(0, 0, At, B0); PG8_MMA(0, 1, At, B1); PG8_BAR; PG8_SCHED;
            PG8_LDA(At, 1, 1); PG8_STAGE(PG8_SB(1, 0), b3, voffB); PG8_STAGE(PG8_SB(1, 1), b3 + hstep, voffB); PG8_STAGE(PG8_SA(1, 0), a3, voffA);
            PG8_WAIT_V(8); PG8_WAIT_L(0); PG8_BAR; PG8_MMA(1, 0, At, B0); PG8_MMA(1, 1, At, B1); PG8_BAR; PG8_SCHED;
            } else {
            PG8_LDB(B0, 0, 0); PG8_SCHED; PG8_LDA(At, 0, 0); PG8_STAGE(PG8_SA(1, 1), a1 + hstep, voffA);
            PG8_WAIT_L(8); PG8_BAR; PG8_WAIT_L(0); PG8_MMA(0, 0, At, B0); PG8_BAR; PG8_SCHED;
            PG8_LDB(B1, 0, 1); PG8_STAGE(PG8_SB(0, 0), b2, voffB);
            PG8_BAR; PG8_WAIT_L(0); PG8_MMA(0, 1, At, B1); PG8_BAR;
            PG8_LDA(At, 0, 1); PG8_STAGE(PG8_SA(0, 0), a2, voffA);
            PG8_BAR; PG8_WAIT_L(0); PG8_MMA(1, 0, At, B0); PG8_BAR; PG8_SCHED;
            PG8_STAGE(PG8_SB(0, 1), b2 + hstep, voffB);
            PG8_WAIT_V(6); PG8_BAR; PG8_MMA(1, 1, At, B1); PG8_BAR;
            PG8_LDB(B0, 1, 0); PG8_SCHED; PG8_LDA(At, 1, 0); PG8_STAGE(PG8_SA(0, 1), a2 + hstep, voffA);
            PG8_WAIT_L(8); PG8_BAR; PG8_WAIT_L(0); PG8_MMA(0, 0, At, B0); PG8_BAR; PG8_SCHED;
            PG8_LDB(B1, 1, 1); PG8_STAGE(PG8_SB(1, 0), b3, voffB);
            PG8_BAR; PG8_WAIT_L(0); PG8_MMA(0, 1, At, B1); PG8_BAR;
            PG8_LDA(At, 1, 1); PG8_STAGE(PG8_SA(1, 0), a3, voffA);
            PG8_BAR; PG8_WAIT_L(0); PG8_MMA(1, 0, At, B0); PG8_BAR; PG8_SCHED;
            PG8_STAGE(PG8_SB(1, 1), b3 + hstep, voffB);
            PG8_WAIT_V(6); PG8_BAR; PG8_MMA(1, 1, At, B1); PG8_BAR;
            }
        }
        if constexpr (ALIGN_EPI) { if (wr == 0) PG8_BAR; }
        E(acc, cur, wr, wc, fr, fq);
        if (!has_next) break;
#pragma unroll
        for (int a = 0; a < 2; ++a)
#pragma unroll
            for (int b = 0; b < 2; ++b)
#pragma unroll
                for (int m = 0; m < 4; ++m)
#pragma unroll
                    for (int n = 0; n < 2; ++n) acc[a][b][m][n] = (f32x4){0.f, 0.f, 0.f, 0.f};
        cur = nxt; cA = nA; cB = nB; ++ui;
        if constexpr (ALIGN_EPI) { if (wr == 1) PG8_BAR; }
    }
    PG8_WAIT_V(0);
    if constexpr (!ALIGN_EPI) { if (wr == 0) PG8_BAR; }
    PG8_BAR;
#undef PG8_SA
#undef PG8_SB
#undef PG8_STAGE
#undef PG8_LDA
#undef PG8_LDB
#undef PG8_MMA
#undef PG8_WAIT_V
#undef PG8_WAIT_L
#undef PG8_BAR
#undef PG8_SCHED
}
}
using pg8::Unit;

#define EPI_ROWS(ai, m) (u.pm * 256 + (ai) * 128 + wr * 64 + (m) * 16 + fr)
struct EpiSwiglu {
    bf16_t* H;
    __device__ __forceinline__ void operator()(const f32x4 (&acc)[2][2][4][2], const Unit& u, int wr, int wc, int fr, int fq) const {
        const int col = u.pn * 128 + wc * 32 + 8 * fq;
#pragma unroll
        for (int ai = 0; ai < 2; ++ai)
#pragma unroll
            for (int m = 0; m < 4; ++m) {
                const size_t row = EPI_ROWS(ai, m);
                float h[8];
#pragma unroll
                for (int n = 0; n < 2; ++n)
#pragma unroll
                    for (int j = 0; j < 4; ++j) { const float g = acc[ai][0][m][n][j], uu = acc[ai][1][m][n][j]; h[4 * n + j] = g * uu * sigmoid_f(g); }
                u32x4 w; w.x = cvt_pk_bf16(h[0], h[1]); w.y = cvt_pk_bf16(h[2], h[3]); w.z = cvt_pk_bf16(h[4], h[5]); w.w = cvt_pk_bf16(h[6], h[7]);
                *(u32x4*)(H + row * FH + col) = w;
            }
    }
};
template <bool RES_BF16, bool HAS_MUL, bool OUT_BF16 = false>
struct EpiResid {
    const void* res; const bf16_t* mul; float* Y; float scale;
    __device__ __forceinline__ void operator()(const f32x4 (&acc)[2][2][4][2], const Unit& u, int wr, int wc, int fr, int fq) const {
#pragma unroll
        for (int ai = 0; ai < 2; ++ai)
#pragma unroll
            for (int m = 0; m < 4; ++m) {
                const size_t row = EPI_ROWS(ai, m);
#pragma unroll
                for (int bj = 0; bj < 2; ++bj) {
                    const size_t off = row * DM + u.pn * 256 + bj * 128 + wc * 32 + 8 * fq;
                    float r[8];
                    if (RES_BF16) { const u32x4 rv = *(const u32x4*)((const bf16_t*)res + off);
                        r[0] = bf_lo(rv.x); r[1] = bf_hi(rv.x); r[2] = bf_lo(rv.y); r[3] = bf_hi(rv.y); r[4] = bf_lo(rv.z); r[5] = bf_hi(rv.z); r[6] = bf_lo(rv.w); r[7] = bf_hi(rv.w); }
                    else { const f32x4 a = *(const f32x4*)((const float*)res + off), b = *(const f32x4*)((const float*)res + off + 4);
                        r[0] = a[0]; r[1] = a[1]; r[2] = a[2]; r[3] = a[3]; r[4] = b[0]; r[5] = b[1]; r[6] = b[2]; r[7] = b[3]; }
                    float mv[8];
                    if (HAS_MUL) { const u32x4 rv = *(const u32x4*)(mul + off);
                        mv[0] = bf_lo(rv.x); mv[1] = bf_hi(rv.x); mv[2] = bf_lo(rv.y); mv[3] = bf_hi(rv.y); mv[4] = bf_lo(rv.z); mv[5] = bf_hi(rv.z); mv[6] = bf_lo(rv.w); mv[7] = bf_hi(rv.w); }
                    f32x4 o0, o1;
#pragma unroll
                    for (int j = 0; j < 4; ++j) {
                        const float a0 = acc[ai][bj][m][0][j] * scale, a1 = acc[ai][bj][m][1][j] * scale;
                        o0[j] = ALPHA * r[j] + (HAS_MUL ? mv[j] * a0 : a0); o1[j] = ALPHA * r[4 + j] + (HAS_MUL ? mv[4 + j] * a1 : a1); }
                    if (OUT_BF16) { u32x4 w; w.x = cvt_pk_bf16(o0[0], o0[1]); w.y = cvt_pk_bf16(o0[2], o0[3]); w.z = cvt_pk_bf16(o1[0], o1[1]); w.w = cvt_pk_bf16(o1[2], o1[3]); *(u32x4*)((bf16_t*)Y + off) = w; }
                    else { *(f32x4*)(Y + off) = o0; *(f32x4*)(Y + off + 4) = o1; }
                }
            }
    }
};
struct EpiWin {
    bf16_t* proj; bf16_t* gates; float* ifg; const float* bias;
    __device__ __forceinline__ void operator()(const f32x4 (&acc)[2][2][4][2], const Unit& u, int wr, int wc, int fr, int fq) const {
        const int pn = u.pn;
        if (pn == 32) {
            if (wc == 0 && fq == 0) {
                const f32x4 bi = *(const f32x4*)(bias + 8192), bf = *(const f32x4*)(bias + 8196);
#pragma unroll
                for (int ai = 0; ai < 2; ++ai)
#pragma unroll
                    for (int m = 0; m < 4; ++m) {
                        const size_t row = EPI_ROWS(ai, m);
                        f32x4 iv = acc[ai][0][m][0] + bi, fv = acc[ai][0][m][1] + bf, lf;
#pragma unroll
                        for (int j = 0; j < 4; ++j) { const float xx = fv[j]; lf[j] = xx >= 0.f ? -log1pf(expf(-xx)) : xx - log1pf(expf(xx)); }
                        *(f32x4*)(ifg + row * 8) = iv; *(f32x4*)(ifg + row * 8 + 4) = lf;
                    }
            }
            return;
        }
        bf16_t* dst; int ld, c0; int act = 0; float sc = 1.0f;
        if (pn < 24) { const int sec = pn >> 2; dst = proj + (size_t)sec * ((size_t)MTOK * DM); ld = DM; c0 = (pn & 3) * 256; if (sec == 2) act = 1; if (sec == 3) sc = 0.08838834764831845f * LOG2E; }
        else { dst = gates; ld = 2 * DM; c0 = (pn - 24) * 256; act = 1; }
#pragma unroll
        for (int bj = 0; bj < 2; ++bj) {
            const int cl = bj * 128 + wc * 32 + 8 * fq;
            const f32x4 b0 = *(const f32x4*)(bias + pn * 256 + cl), b1 = *(const f32x4*)(bias + pn * 256 + cl + 4);
#pragma unroll
            for (int ai = 0; ai < 2; ++ai)
#pragma unroll
                for (int m = 0; m < 4; ++m) {
                    const size_t row = EPI_ROWS(ai, m);
                    f32x4 v0 = acc[ai][bj][m][0] + b0, v1 = acc[ai][bj][m][1] + b1;
                    if (act) {
#pragma unroll
                        for (int j = 0; j < 4; ++j) { v0[j] = sigmoid_f(v0[j]); v1[j] = sigmoid_f(v1[j]); } }
                    else { v0 *= sc; v1 *= sc; }
                    u32x4 w; w.x = cvt_pk_bf16(v0[0], v0[1]); w.y = cvt_pk_bf16(v0[2], v0[3]); w.z = cvt_pk_bf16(v1[0], v1[1]); w.w = cvt_pk_bf16(v1[2], v1[3]);
                    *(u32x4*)(dst + row * ld + c0 + cl) = w;
                }
        }
    }
};
template <bool ADD>
struct EpiGateMul {
    const bf16_t* gate; int goff; const bf16_t* tin; bf16_t* out;
    __device__ __forceinline__ void operator()(const f32x4 (&acc)[2][2][4][2], const Unit& u, int wr, int wc, int fr, int fq) const {
#pragma unroll
        for (int ai = 0; ai < 2; ++ai)
#pragma unroll
            for (int m = 0; m < 4; ++m) {
                const size_t row = EPI_ROWS(ai, m);
#pragma unroll
                for (int bj = 0; bj < 2; ++bj) {
                    const int c = u.pn * 256 + bj * 128 + wc * 32 + 8 * fq;
                    const u32x4 gv = *(const u32x4*)(gate + row * (2 * DM) + goff + c);
                    float gg[8] = {bf_lo(gv.x), bf_hi(gv.x), bf_lo(gv.y), bf_hi(gv.y), bf_lo(gv.z), bf_hi(gv.z), bf_lo(gv.w), bf_hi(gv.w)};
                    float tt[8] = {0.f, 0.f, 0.f, 0.f, 0.f, 0.f, 0.f, 0.f};
                    if (ADD) { const u32x4 tv = *(const u32x4*)(tin + row * DM + c);
                        tt[0] = bf_lo(tv.x); tt[1] = bf_hi(tv.x); tt[2] = bf_lo(tv.y); tt[3] = bf_hi(tv.y); tt[4] = bf_lo(tv.z); tt[5] = bf_hi(tv.z); tt[6] = bf_lo(tv.w); tt[7] = bf_hi(tv.w); }
                    float o[8];
#pragma unroll
                    for (int j = 0; j < 4; ++j) { o[j] = tt[j] + gg[j] * acc[ai][bj][m][0][j]; o[4 + j] = tt[4 + j] + gg[4 + j] * acc[ai][bj][m][1][j]; }
                    u32x4 w; w.x = cvt_pk_bf16(o[0], o[1]); w.y = cvt_pk_bf16(o[2], o[3]); w.z = cvt_pk_bf16(o[4], o[5]); w.w = cvt_pk_bf16(o[6], o[7]);
                    *(u32x4*)(out + row * DM + c) = w;
                }
            }
    }
};
struct EpiSigBias {
    const float* bias; bf16_t* out;
    __device__ __forceinline__ void operator()(const f32x4 (&acc)[2][2][4][2], const Unit& u, int wr, int wc, int fr, int fq) const {
#pragma unroll
        for (int bj = 0; bj < 2; ++bj) {
            const int c = u.pn * 256 + bj * 128 + wc * 32 + 8 * fq;
            const f32x4 b0 = *(const f32x4*)(bias + c), b1 = *(const f32x4*)(bias + c + 4);
#pragma unroll
            for (int ai = 0; ai < 2; ++ai)
#pragma unroll
                for (int m = 0; m < 4; ++m) {
                    const size_t row = EPI_ROWS(ai, m);
                    f32x4 v0 = acc[ai][bj][m][0] + b0, v1 = acc[ai][bj][m][1] + b1;
#pragma unroll
                    for (int j = 0; j < 4; ++j) { v0[j] = sigmoid_f(v0[j]); v1[j] = sigmoid_f(v1[j]); }
                    u32x4 w; w.x = cvt_pk_bf16(v0[0], v0[1]); w.y = cvt_pk_bf16(v0[2], v0[3]); w.z = cvt_pk_bf16(v1[0], v1[1]); w.w = cvt_pk_bf16(v1[2], v1[3]);
                    *(u32x4*)(out + row * DM + c) = w;
                }
        }
    }
};

struct Params {
    const float *x, *p, *ln_g, *ln_b, *wg, *wu, *wd, *w_in, *b_in, *b_forget, *conv_w, *conv_b, *mh_g, *w_a, *w_b, *w_o, *w_ple, *w_pg, *b_pg;
    float* out; unsigned char* ws;
    int ph_lo, ph_hi, coop, pad;
};

__device__ void cvt_bf16_phase(const float* src, bf16_t* dst, size_t n8) {
    const size_t stride = (size_t)gridDim.x * NTHREADS;
    size_t i = (size_t)blockIdx.x * NTHREADS + threadIdx.x;
    for (; i + 3 * stride < n8; i += 4 * stride) {
        f32x4 a[4], b[4];
#pragma unroll
        for (int u = 0; u < 4; ++u) { a[u] = __builtin_nontemporal_load((const f32x4*)(src + (i + u * stride) * 8)); b[u] = __builtin_nontemporal_load((const f32x4*)(src + (i + u * stride) * 8 + 4)); }
#pragma unroll
        for (int u = 0; u < 4; ++u) { u32x4 w; w.x = cvt_pk_bf16(a[u][0], a[u][1]); w.y = cvt_pk_bf16(a[u][2], a[u][3]); w.z = cvt_pk_bf16(b[u][0], b[u][1]); w.w = cvt_pk_bf16(b[u][2], b[u][3]);
            *(u32x4*)(dst + (i + u * stride) * 8) = w; }
    }
    for (; i < n8; i += stride) {
        const f32x4 a = *(const f32x4*)(src + i * 8), b = *(const f32x4*)(src + i * 8 + 4);
        u32x4 w; w.x = cvt_pk_bf16(a[0], a[1]); w.y = cvt_pk_bf16(a[2], a[3]); w.z = cvt_pk_bf16(b[0], b[1]); w.w = cvt_pk_bf16(b[2], b[3]);
        *(u32x4*)(dst + i * 8) = w;
    }
}
template <int MODE>
__device__ __forceinline__ f32x4 tsrc_val4(const float* w0, const float* w1, int ldn, int k, int n) {
    if (MODE == 0) return *(const f32x4*)(w0 + (size_t)k * ldn + n);
    if (MODE == 1) { const int pn = n >> 8, sel = (n >> 7) & 1, i = n & 127; const float* w = sel ? w1 : w0; return *(const f32x4*)(w + (size_t)k * ldn + pn * 128 + i); }
    int col; if (n < 3072) col = n; else if (n < 8192) col = n + 8; else if (n < 8200) col = 3072 + (n - 8192); else return (f32x4){0.f, 0.f, 0.f, 0.f};
    return *(const f32x4*)(w0 + (size_t)k * ldn + col);
}
template <int MODE>
__device__ __forceinline__ void transpose_mat(LAS float* tile, const float* w0, const float* w1, int ldn, bf16_t* dst, int NP, int K, int& base) {
    const int tid = threadIdx.x;
    const int tn = NP / 128, tk = K / 128, nt = tn * tk;
    int first = ((int)blockIdx.x - base) % (int)gridDim.x; if (first < 0) first += gridDim.x;
    for (int t = first; t < nt; t += gridDim.x) {
        const int n0 = (t / tk) * 128, k0 = (t % tk) * 128;
#pragma unroll
        for (int e = 0; e < 8; ++e) { const int idx = e * NTHREADS + tid, kk = idx >> 5, n4 = (idx & 31) * 4; const f32x4 v = tsrc_val4<MODE>(w0, w1, ldn, k0 + kk, n0 + n4);
            tile[kk * 129 + n4] = v[0]; tile[kk * 129 + n4 + 1] = v[1]; tile[kk * 129 + n4 + 2] = v[2]; tile[kk * 129 + n4 + 3] = v[3]; }
        __syncthreads();
#pragma unroll 8
        for (int e = 0; e < 16; ++e) { const int idx = e * NTHREADS + tid, nn = idx >> 6, kk = (idx & 63) * 2;
            *(unsigned*)(dst + (size_t)(n0 + nn) * K + k0 + kk) = cvt_pk_bf16(tile[kk * 129 + nn], tile[(kk + 1) * 129 + nn]); }
        __syncthreads();
    }
    base += nt;
}
__device__ void prep_phase(const Params& P, LAS unsigned char* lds) {
    unsigned char* ws = P.ws;
    cvt_bf16_phase(P.x, (bf16_t*)(ws + WS_X), (size_t)MTOK * DM / 8);
    if (blockIdx.x == 0 && threadIdx.x < 64) ((unsigned*)(ws + MISC_CNT))[threadIdx.x] = 0u;
    for (int n = blockIdx.x * NTHREADS + threadIdx.x; n < NIN_PAD; n += gridDim.x * NTHREADS) {
        float b;
        if (n < 3072) b = P.b_in[n]; else if (n < 8192) b = P.b_in[n + 8]; else if (n < 8196) b = P.b_in[3072 + n - 8192];
        else if (n < 8200) b = P.b_in[3072 + n - 8192] + P.b_forget[n - 8196]; else b = 0.f;
        ((float*)(ws + W_BIAS))[n] = b;
    }
    LAS float* tile = (LAS float*)lds;
    int base = 0;
    transpose_mat<1>(tile, P.wg, P.wu, FH, (bf16_t*)(ws + W_GU1), 5632, 1024, base);
    transpose_mat<0>(tile, P.wd, nullptr, DM, (bf16_t*)(ws + W_D1), 1024, FH, base);
    transpose_mat<1>(tile, P.wg + (size_t)DM * FH, P.wu + (size_t)DM * FH, FH, (bf16_t*)(ws + W_GU2), 5632, 1024, base);
    transpose_mat<0>(tile, P.wd + (size_t)DM * FH, nullptr, DM, (bf16_t*)(ws + W_D2), 1024, FH, base);
    transpose_mat<2>(tile, P.w_in, nullptr, 8200, (bf16_t*)(ws + W_IN), NIN_PAD, 1024, base);
    transpose_mat<0>(tile, P.w_a, nullptr, DM, (bf16_t*)(ws + W_A), 1024, 1024, base);
    transpose_mat<0>(tile, P.w_b, nullptr, DM, (bf16_t*)(ws + W_B), 1024, 1024, base);
    transpose_mat<0>(tile, P.w_o, nullptr, DM, (bf16_t*)(ws + W_O), 1024, 1024, base);
    transpose_mat<0>(tile, P.w_pg, nullptr, DM, (bf16_t*)(ws + W_PG), 1024, 1024, base);
    transpose_mat<0>(tile, P.w_ple, nullptr, DM, (bf16_t*)(ws + W_P), 1024, 256, base);
}
template <bool OUT_BF16, bool IN_BF16 = false>
__device__ void ln_phase(const float* Y, const float* g, const float* b, void* out) {
    const int wid = threadIdx.x >> 6, lane = threadIdx.x & 63;
    f32x4 gv[4], bv[4];
#pragma unroll
    for (int i = 0; i < 4; ++i) { gv[i] = *(const f32x4*)(g + i * 256 + lane * 4); bv[i] = *(const f32x4*)(b + i * 256 + lane * 4); }
    for (int row0 = (blockIdx.x * 8 + wid) * 2; row0 < MTOK; row0 += gridDim.x * 16) {
        f32x4 v[2][4]; float s[2] = {0.f, 0.f};
#pragma unroll
        for (int r = 0; r < 2; ++r)
#pragma unroll
            for (int i = 0; i < 4; ++i) {
                if (IN_BF16) { const u32x2 t = __builtin_nontemporal_load((const u32x2*)((const bf16_t*)Y + (size_t)(row0 + r) * DM + i * 256 + lane * 4)); v[r][i] = (f32x4){bf_lo(t.x), bf_hi(t.x), bf_lo(t.y), bf_hi(t.y)}; }
                else v[r][i] = *(const f32x4*)(Y + (size_t)(row0 + r) * DM + i * 256 + lane * 4); }
#pragma unroll
        for (int r = 0; r < 2; ++r) {
#pragma unroll
            for (int i = 0; i < 4; ++i) s[r] += (v[r][i][0] + v[r][i][1]) + (v[r][i][2] + v[r][i][3]);
            const float mean = wave_sum(s[r]) * (1.0f / DM);
            float q = 0.f;
#pragma unroll
            for (int i = 0; i < 4; ++i) { const f32x4 d = v[r][i] - mean; q += (d[0] * d[0] + d[1] * d[1]) + (d[2] * d[2] + d[3] * d[3]); }
            const float rstd = rsqrtf(wave_sum(q) * (1.0f / DM) + LN_EPS);
#pragma unroll
            for (int i = 0; i < 4; ++i) {
                const f32x4 o = (v[r][i] - mean) * rstd * gv[i] + bv[i];
                if (OUT_BF16) { u32x2 w; w.x = cvt_pk_bf16(o[0], o[1]); w.y = cvt_pk_bf16(o[2], o[3]); *(u32x2*)((bf16_t*)out + (size_t)(row0 + r) * DM + i * 256 + lane * 4) = w; }
                else __builtin_nontemporal_store(o, (f32x4*)((float*)out + (size_t)(row0 + r) * DM + i * 256 + lane * 4));
            }
        }
    }
}

constexpr int L_QI = 0, L_KI = 17408, L_KT = 34816, L_VT = 53248, L_PI = 90112, L_F = 99328;
constexpr int F_N = 0, F_QN = 128, F_RS = 192, F_HS = 320, F_BL = 1344, F_GM = 1472, F_M = 1600, F_CW = 1732, F_SA = 3012, F_SB2 = 3028, F_SMU = 4052, F_SWI = 5076, F_SWN = 6100, F_SEM = 7124, F_END = 8148;
constexpr int MIX_LDS = L_F + F_END * 4;

__device__ void mlstm_prologue(const Params& P, LAS unsigned char* lds, int b, int h, int gi) {
    LAS float* F = (LAS float*)(lds + L_F);
    const float* ifg = (const float*)(P.ws + MISC_IF);
    const int tid = threadIdx.x, w = tid >> 6, lane = tid & 63;
    const int nch = 16 * (gi + 1);
    for (int c0 = w; c0 < nch; c0 += 32) {
        float ivv[4], lfv[4];
#pragma unroll
        for (int u = 0; u < 4; ++u) { const int c = c0 + 8 * u; if (c < nch) { const size_t tok = (size_t)b * SEQ + c * 64 + lane; ivv[u] = ifg[tok * 8 + h]; lfv[u] = ifg[tok * 8 + 4 + h]; } else { ivv[u] = 0.f; lfv[u] = 0.f; } }
#pragma unroll
        for (int u = 0; u < 4; ++u) { const int c = c0 + 8 * u; if (c < nch) {
            const float bc = wave_incl_sum(lfv[u], lane);
            const float bl = __shfl(bc, 63);
            const float gm = wave_max(bl - bc + ivv[u]);
            if (lane == 0) { F[F_BL + c] = bl; F[F_GM + c] = gm; } } }
    }
    for (int i = tid; i < 1280; i += NTHREADS) {
        const int j = i >> 8, ch = i & 255; const int gc = ch < 128 ? h * 128 + ch : 512 + h * 128 + (ch - 128);
        F[F_CW + i] = j < 4 ? P.conv_w[j * 1024 + gc] : P.conv_b[gc];
    }
    if (tid < 128) F[F_N + tid] = 0.f;
    __syncthreads();
    if (tid == 0) { float m = 0.f; F[F_M] = 0.f; for (int c = 0; c < nch; ++c) { m = fmaxf(F[F_BL + c] + m, F[F_GM + c]); F[F_M + c + 1] = m; } }
    __syncthreads();
    for (int lc = w; lc < 16; lc += 8) {
        const int c = gi * 16 + lc;
        const size_t tok = (size_t)b * SEQ + c * 64 + lane;
        const float iv = ifg[tok * 8 + h], lf = ifg[tok * 8 + 4 + h];
        const float bc = wave_incl_sum(lf, lane);
        const float bl = __shfl(bc, 63);
        const float mst = F[F_M + c], mnew = F[F_M + c + 1];
        const float beta = iv - bc;
        const float mu = fmaxf(mst, wave_incl_max(beta, lane));
        F[F_SB2 + lc * 64 + lane] = beta * LOG2E;
        F[F_SMU + lc * 64 + lane] = mu * LOG2E;
        F[F_SWI + lc * 64 + lane] = expf(mst - mu);
        F[F_SWN + lc * 64 + lane] = expf(bl - bc + iv - mnew);
        F[F_SEM + lc * 64 + lane] = expf(-(bc + mu));
        if (lane == 0) F[F_SA + lc] = expf(bl + mst - mnew);
    }
    __syncthreads();
}

struct MlRaw { u32x4 vr[4]; u32x4 raw[7]; };
template <bool NEED_Q>
__device__ __forceinline__ void mlstm_issue(const Params& P, int b, int h, int c, MlRaw& R) {
    const bf16_t* QK = (const bf16_t*)(P.ws + WS_QK);
    const bf16_t* VA = (const bf16_t*)(P.ws + WS_VA);
    const int tid = threadIdx.x, tg = tid & 15, cg = tid >> 4;
#pragma unroll
    for (int tt = 0; tt < 4; ++tt) R.vr[tt] = *(const u32x4*)(VA + ((size_t)b * SEQ + c * 64 + 4 * tg + tt) * DM + h * 256 + 8 * cg);
    if (NEED_Q || cg >= 16) {
        const int gc = cg < 16 ? h * 128 + 8 * cg : 512 + h * 128 + 8 * (cg - 16);
#pragma unroll
        for (int i = 0; i < 7; ++i) {
            const int pos = c * 64 + 4 * tg - 3 + i;
            R.raw[i] = pos >= 0 ? *(const u32x4*)(QK + ((size_t)b * SEQ + pos) * DM + gc) : (u32x4){0u, 0u, 0u, 0u};
        }
    }
}
template <bool NEED_Q>
__device__ __forceinline__ void mlstm_load(LAS unsigned char* lds, const MlRaw& R, int lc) {
    LAS float* F = (LAS float*)(lds + L_F);
    const int tid = threadIdx.x, tg = tid & 15, cg = tid >> 4;
    {
        const u32x4 (&vr)[4] = R.vr;
#pragma unroll
        for (int e = 0; e < 8; ++e) {
            unsigned short x0, x1, x2, x3;
            { const unsigned a0 = vr[0][e >> 1], a1 = vr[1][e >> 1], a2 = vr[2][e >> 1], a3 = vr[3][e >> 1];
              if (e & 1) { x0 = a0 >> 16; x1 = a1 >> 16; x2 = a2 >> 16; x3 = a3 >> 16; } else { x0 = a0 & 0xffff; x1 = a1 & 0xffff; x2 = a2 & 0xffff; x3 = a3 & 0xffff; } }
            u32x2 wv; wv.x = (unsigned)x0 | ((unsigned)x1 << 16); wv.y = (unsigned)x2 | ((unsigned)x3 << 16);
            *(LAS u32x2*)(lds + L_VT + (8 * cg + e) * 144 + 8 * tg) = wv;
        }
    }
    __builtin_amdgcn_sched_barrier(0);
    if (NEED_Q || cg >= 16) {
        const u32x4 (&raw)[7] = R.raw;
        float o[4][8];
#pragma unroll
        for (int e = 0; e < 8; ++e) {
            float rv[7];
#pragma unroll
            for (int i = 0; i < 7; ++i) rv[i] = (e & 1) ? bf_hi(raw[i][e >> 1]) : bf_lo(raw[i][e >> 1]);
            const float w0 = F[F_CW + 0 * 256 + 8 * cg + e], w1 = F[F_CW + 1 * 256 + 8 * cg + e], w2 = F[F_CW + 2 * 256 + 8 * cg + e], w3 = F[F_CW + 3 * 256 + 8 * cg + e], cb = F[F_CW + 4 * 256 + 8 * cg + e];
#pragma unroll
            for (int tt = 0; tt < 4; ++tt) { const float v = cb + w0 * rv[tt] + w1 * rv[tt + 1] + w2 * rv[tt + 2] + w3 * rv[tt + 3]; o[tt][e] = v * sigmoid_f(v); }
            __builtin_amdgcn_sched_barrier(0);
        }
        if (cg < 16) {
#pragma unroll
            for (int tt = 0; tt < 4; ++tt) { u32x4 wv; wv.x = cvt_pk_bf16(o[tt][0], o[tt][1]); wv.y = cvt_pk_bf16(o[tt][2], o[tt][3]); wv.z = cvt_pk_bf16(o[tt][4], o[tt][5]); wv.w = cvt_pk_bf16(o[tt][6], o[tt][7]);
                *(LAS u32x4*)(lds + L_QI + (4 * tg + tt) * 272 + 16 * cg) = wv; }
        } else {
            const int kc = cg - 16;
            const f32x4 wn = *(const LAS f32x4*)(F + F_SWN + lc * 64 + 4 * tg);
#pragma unroll
            for (int tt = 0; tt < 4; ++tt) {
#pragma unroll
                for (int e = 0; e < 8; ++e) o[tt][e] *= 0.08838834764831845f;
                u32x4 wv; wv.x = cvt_pk_bf16(o[tt][0], o[tt][1]); wv.y = cvt_pk_bf16(o[tt][2], o[tt][3]); wv.z = cvt_pk_bf16(o[tt][4], o[tt][5]); wv.w = cvt_pk_bf16(o[tt][6], o[tt][7]);
                *(LAS u32x4*)(lds + L_KI + (4 * tg + tt) * 272 + 16 * kc) = wv; }
#pragma unroll
            for (int e = 0; e < 8; ++e) { u32x2 wv; wv.x = cvt_pk_bf16(o[0][e] * wn[0], o[1][e] * wn[1]); wv.y = cvt_pk_bf16(o[2][e] * wn[2], o[3][e] * wn[3]);
                *(LAS u32x2*)(lds + L_KT + (8 * kc + e) * 144 + 8 * tg) = wv; }
        }
    }
}

__device__ __forceinline__ void mlstm_update(LAS unsigned char* lds, f32x4 (&C)[2][8], int lc, int w, int r, int g) {
    LAS float* F = (LAS float*)(lds + L_F);
    const float a = F[F_SA + lc];
    const LAS unsigned char* vp = lds + (L_VT + (32 * w + r) * 144 + 16 * g);
    const LAS unsigned char* kp = lds + (L_KT + r * 144 + 16 * g);
#pragma unroll
    for (int dvb = 0; dvb < 2; ++dvb)
#pragma unroll
        for (int dkb = 0; dkb < 8; ++dkb) C[dvb][dkb] *= a;
#pragma unroll
    for (int ks = 0; ks < 2; ++ks) {
        bf16x8 vf[2];
#pragma unroll
        for (int dvb = 0; dvb < 2; ++dvb) vf[dvb] = *(const LAS bf16x8*)(vp + (16 * dvb * 144 + 64 * ks));
#pragma unroll
        for (int dkb = 0; dkb < 8; ++dkb) {
            const bf16x8 kf = *(const LAS bf16x8*)(kp + (16 * dkb * 144 + 64 * ks));
#pragma unroll
            for (int dvb = 0; dvb < 2; ++dvb) C[dvb][dkb] = mfma16(kf, vf[dvb], C[dvb][dkb]);
        }
        __builtin_amdgcn_sched_barrier(0);
    }
    const int tid = threadIdx.x, dk = tid >> 2, part = tid & 3;
    const u32x4 k0 = *(const LAS u32x4*)(lds + L_KT + dk * 144 + 32 * part), k1 = *(const LAS u32x4*)(lds + L_KT + dk * 144 + 32 * part + 16);
    float s = 0.f;
#pragma unroll
    for (int i = 0; i < 4; ++i) s += bf_lo(k0[i]) + bf_hi(k0[i]) + bf_lo(k1[i]) + bf_hi(k1[i]);
    s += __shfl_xor(s, 1); s += __shfl_xor(s, 2);
    if (part == 0) F[F_N + dk] = a * F[F_N + dk] + s;
}

__device__ void mlstm_phase1(const Params& P, LAS unsigned char* lds) {
    const int tid = threadIdx.x, w = tid >> 6, lane = tid & 63, r = lane & 15, g = lane >> 4;
    LAS float* F = (LAS float*)(lds + L_F);
    for (int task = blockIdx.x; task < 256; task += gridDim.x) {
        const int gi = task & 7, st = task >> 3, b = st >> 2, h = st & 3;
        if (gi == 7) continue;
        mlstm_prologue(P, lds, b, h, gi);
        f32x4 C[2][8];
#pragma unroll
        for (int i = 0; i < 2; ++i)
#pragma unroll
            for (int j = 0; j < 8; ++j) C[i][j] = (f32x4){0.f, 0.f, 0.f, 0.f};
        MlRaw R;
        mlstm_issue<false>(P, b, h, gi * 16, R);
        for (int lc = 0; lc < 16; ++lc) {
            mlstm_load<false>(lds, R, lc);
            __syncthreads();
            if (lc < 15) mlstm_issue<false>(P, b, h, gi * 16 + lc + 1, R);
            mlstm_update(lds, C, lc, w, r, g);
            __syncthreads();
        }
        float* slot = (float*)(P.ws + WS_PB) + (size_t)(st * 7 + gi) * STATE_FLOATS;
#pragma unroll
        for (int dvb = 0; dvb < 2; ++dvb)
#pragma unroll
            for (int dkb = 0; dkb < 8; ++dkb) *(f32x4*)(slot + (((w * 2 + dvb) * 8 + dkb) * 64 + lane) * 4) = C[dvb][dkb];
        if (tid < 128) slot[32768 + tid] = F[F_N + tid];
        __syncthreads();
    }
}

__device__ void mlstm_phase2(const Params& P, LAS unsigned char* lds) {
    const int tid = threadIdx.x, w = tid >> 6, lane = tid & 63, r = lane & 15, g = lane >> 4;
    LAS float* F = (LAS float*)(lds + L_F);
    const bf16_t* OA = (const bf16_t*)(P.ws + WS_OA);
    bf16_t* VA = (bf16_t*)(P.ws + WS_VA);
    for (int task = blockIdx.x; task < 256; task += gridDim.x) {
        const int gi = task & 7, st = task >> 3, b = st >> 2, h = st & 3;
        mlstm_prologue(P, lds, b, h, gi);
        f32x4 C[2][8];
#pragma unroll
        for (int i = 0; i < 2; ++i)
#pragma unroll
            for (int j = 0; j < 8; ++j) C[i][j] = (f32x4){0.f, 0.f, 0.f, 0.f};
        float nreg = 0.f;
        for (int j = 0; j < gi; ++j) {
            float Bj = 0.f;
            for (int c = 0; c < 16; ++c) Bj += F[F_BL + j * 16 + c];
            const float Aj = expf(Bj + F[F_M + 16 * j] - F[F_M + 16 * j + 16]);
            const float* slot = (const float*)(P.ws + WS_PB) + (size_t)(st * 7 + j) * STATE_FLOATS;
#pragma unroll
            for (int dvb = 0; dvb < 2; ++dvb)
#pragma unroll
                for (int dkb = 0; dkb < 8; ++dkb) C[dvb][dkb] = C[dvb][dkb] * Aj + *(const f32x4*)(slot + (((w * 2 + dvb) * 8 + dkb) * 64 + lane) * 4);
            if (tid < 128) nreg = nreg * Aj + slot[32768 + tid];
        }
        if (tid < 128) F[F_N + tid] = nreg;
        __syncthreads();
        for (int lc = 0; lc < 16; ++lc) {
            const int c = gi * 16 + lc;
            MlRaw R;
            mlstm_issue<true>(P, b, h, c, R);
            mlstm_load<true>(lds, R, lc);
            __syncthreads();
            {
                const int tb = w >> 1, par = w & 1;
                const LAS unsigned char* qpS = lds + (L_QI + (16 * tb + r) * 272 + 16 * g);
                const LAS unsigned char* kpS = lds + (L_KI + (16 * par + r) * 272 + 16 * g);
                LAS unsigned char* ppS = lds + (L_PI + (16 * tb + r) * 144 + 32 * par + 8 * g);
                bf16x8 qf[4];
#pragma unroll
                for (int kd = 0; kd < 4; ++kd) qf[kd] = *(const LAS bf16x8*)(qpS + 64 * kd);
                const float mu2 = F[F_SMU + lc * 64 + 16 * tb + r];
                float rs = 0.f;
#pragma unroll
                for (int sbi = 0; sbi < 2; ++sbi) {
                    const int sb = par + 2 * sbi;
                    u32x2 pw = (u32x2){0u, 0u};
                    if (sb <= tb) {
                        f32x4 acc = (f32x4){0.f, 0.f, 0.f, 0.f};
#pragma unroll
                        for (int kd = 0; kd < 4; ++kd) { const bf16x8 kf = *(const LAS bf16x8*)(kpS + (32 * sbi * 272 + 64 * kd)); acc = mfma16(kf, qf[kd], acc); }
                        const f32x4 b2 = *(const LAS f32x4*)(F + F_SB2 + lc * 64 + 16 * sb + 4 * g);
                        float pv[4];
#pragma unroll
                        for (int j = 0; j < 4; ++j) { const int s = 16 * sb + 4 * g + j, t = 16 * tb + r; pv[j] = (s <= t) ? acc[j] * fast_exp2(b2[j] - mu2) : 0.f; }
                        pw.x = cvt_pk_bf16(pv[0], pv[1]); pw.y = cvt_pk_bf16(pv[2], pv[3]);
                        rs += bf_lo(pw.x) + bf_hi(pw.x) + bf_lo(pw.y) + bf_hi(pw.y);
                    }
                    *(LAS u32x2*)(ppS + 64 * sbi) = pw;
                }
                rs += __shfl_xor(rs, 16); rs += __shfl_xor(rs, 32);
                if (g == 0) F[F_RS + par * 64 + 16 * tb + r] = rs;
            }
            __builtin_amdgcn_sched_barrier(0);
            const LAS unsigned char* q8p = lds + (L_QI + r * 272 + 8 * g);
            f32x4 num[2][4];
#pragma unroll
            for (int i = 0; i < 2; ++i)
#pragma unroll
                for (int j = 0; j < 4; ++j) num[i][j] = (f32x4){0.f, 0.f, 0.f, 0.f};
#pragma unroll
            for (int kk = 0; kk < 4; ++kk) {
                bf16x8 af[2];
#pragma unroll
                for (int dvb = 0; dvb < 2; ++dvb) {
                    u32x2 lo, hi; lo.x = cvt_pk_bf16(C[dvb][2 * kk][0], C[dvb][2 * kk][1]); lo.y = cvt_pk_bf16(C[dvb][2 * kk][2], C[dvb][2 * kk][3]);
                    hi.x = cvt_pk_bf16(C[dvb][2 * kk + 1][0], C[dvb][2 * kk + 1][1]); hi.y = cvt_pk_bf16(C[dvb][2 * kk + 1][2], C[dvb][2 * kk + 1][3]);
                    af[dvb] = mk8(lo, hi);
                }
#pragma unroll
                for (int tb = 0; tb < 4; ++tb) {
                    const u32x2 q0 = *(const LAS u32x2*)(q8p + (16 * tb * 272 + 64 * kk)), q1 = *(const LAS u32x2*)(q8p + (16 * tb * 272 + 64 * kk + 32));
                    const bf16x8 bq = mk8(q0, q1);
#pragma unroll
                    for (int dvb = 0; dvb < 2; ++dvb) num[dvb][tb] = mfma16(af[dvb], bq, num[dvb][tb]);
                }
                __builtin_amdgcn_sched_barrier(0);
            }
#pragma unroll
            for (int tb = 0; tb < 4; ++tb) { const float wi = F[F_SWI + lc * 64 + 16 * tb + r];
#pragma unroll
                for (int dvb = 0; dvb < 2; ++dvb) num[dvb][tb] *= wi; }
            {
                const int t = tid >> 3, part = tid & 7;
                const u32x4 q0 = *(const LAS u32x4*)(lds + L_QI + t * 272 + 32 * part), q1 = *(const LAS u32x4*)(lds + L_QI + t * 272 + 32 * part + 16);
                float s = 0.f;
#pragma unroll
                for (int i = 0; i < 4; ++i) {
                    s += bf_lo(q0[i]) * F[F_N + 16 * part + 2 * i] + bf_hi(q0[i]) * F[F_N + 16 * part + 2 * i + 1];
                    s += bf_lo(q1[i]) * F[F_N + 16 * part + 8 + 2 * i] + bf_hi(q1[i]) * F[F_N + 16 * part + 8 + 2 * i + 1];
                }
                s += __shfl_xor(s, 1); s += __shfl_xor(s, 2); s += __shfl_xor(s, 4);
                if (part == 0) F[F_QN + t] = s;
            }
            __builtin_amdgcn_sched_barrier(0);
            __syncthreads();
            const LAS unsigned char* vpC = lds + (L_VT + (32 * w + r) * 144 + 16 * g);
            const LAS unsigned char* ppC = lds + (L_PI + r * 144 + 16 * g);
#pragma unroll
            for (int ks = 0; ks < 2; ++ks) {
                bf16x8 vf[2];
#pragma unroll
                for (int dvb = 0; dvb < 2; ++dvb) vf[dvb] = *(const LAS bf16x8*)(vpC + (16 * dvb * 144 + 64 * ks));
#pragma unroll
                for (int tb = 0; tb < 4; ++tb) {
                    if (ks == 0 || tb >= 2) {
                        const bf16x8 pb = *(const LAS bf16x8*)(ppC + (16 * tb * 144 + 64 * ks));
#pragma unroll
                        for (int dvb = 0; dvb < 2; ++dvb) num[dvb][tb] = mfma16(vf[dvb], pb, num[dvb][tb]);
                    }
                }
                __builtin_amdgcn_sched_barrier(0);
            }
#pragma unroll
            for (int tb = 0; tb < 4; ++tb) {
                const int t = 16 * tb + r;
                const float den = F[F_SWI + lc * 64 + t] * F[F_QN + t] + F[F_RS + t] + F[F_RS + 64 + t];
                const float inv = 1.0f / fmaxf(fabsf(den), F[F_SEM + lc * 64 + t]);
                float s1 = 0.f, s2 = 0.f;
#pragma unroll
                for (int dvb = 0; dvb < 2; ++dvb) { num[dvb][tb] *= inv;
#pragma unroll
                    for (int j = 0; j < 4; ++j) { const float v = num[dvb][tb][j]; s1 += v; s2 += v * v; } }
                s1 += __shfl_xor(s1, 16); s1 += __shfl_xor(s1, 32); s2 += __shfl_xor(s2, 16); s2 += __shfl_xor(s2, 32);
                if (g == 0) { F[F_HS + (w * 64 + t) * 2] = s1; F[F_HS + (w * 64 + t) * 2 + 1] = s2; }
                __builtin_amdgcn_sched_barrier(0);
            }
            mlstm_update(lds, C, lc, w, r, g);
            __builtin_amdgcn_sched_barrier(0);
            __syncthreads();
#pragma unroll
            for (int tb = 0; tb < 4; ++tb) {
                const int t = 16 * tb + r;
                float s1 = 0.f, s2 = 0.f;
#pragma unroll
                for (int ww = 0; ww < 8; ++ww) { s1 += F[F_HS + (ww * 64 + t) * 2]; s2 += F[F_HS + (ww * 64 + t) * 2 + 1]; }
                const float mean = s1 * (1.0f / 256.0f), var = fmaxf(s2 * (1.0f / 256.0f) - mean * mean, 0.f), rstd = rsqrtf(var + LN_EPS);
                const size_t tok = (size_t)b * SEQ + c * 64 + t;
#pragma unroll
                for (int dvb = 0; dvb < 2; ++dvb) {
                    const int dv0 = 32 * w + 16 * dvb + 4 * g;
                    const f32x4 gn = *(const f32x4*)(P.mh_g + h * 256 + dv0);
                    const u32x2 og = *(const u32x2*)(OA + tok * DM + h * 256 + dv0);
                    const float y0 = (num[dvb][tb][0] - mean) * rstd * gn[0] * bf_lo(og.x), y1 = (num[dvb][tb][1] - mean) * rstd * gn[1] * bf_hi(og.x);
                    const float y2 = (num[dvb][tb][2] - mean) * rstd * gn[2] * bf_lo(og.y), y3 = (num[dvb][tb][3] - mean) * rstd * gn[3] * bf_hi(og.y);
                    u32x2 wv; wv.x = cvt_pk_bf16(y0, y1); wv.y = cvt_pk_bf16(y2, y3);
                    *(u32x2*)(VA + tok * DM + h * 256 + dv0) = wv;
                }
            }
        }
        __syncthreads();
    }
}

constexpr int A_KI = 0, A_VT = 17408, A_FL = 35840;
constexpr float SB_DONE_LOG2 = -40.0f;

__device__ void attn_phase(const Params& P, LAS unsigned char* lds) {
    const int tid = threadIdx.x, w = tid >> 6, lane = tid & 63, r = lane & 15, g = lane >> 4;
    bf16_t* QB = (bf16_t*)(P.ws + WS_QB);
    const bf16_t* KB = (const bf16_t*)(P.ws + WS_KB);
    const bf16_t* VB = (const bf16_t*)(P.ws + WS_VB);
    unsigned* cnt = (unsigned*)(P.ws + MISC_CNT);
    LAS int* FL = (LAS int*)(lds + A_FL);
    for (;;) {
        if (tid == 0) FL[32] = (int)atomicAdd(cnt, 1u);
        __syncthreads();
        const int item = FL[32];
        __syncthreads();
        if (item >= 4096) break;
        const int qb = 63 - (item >> 6), b = (item >> 3) & 7, h = item & 7;
        const int q0w = qb * 128 + 16 * w;
        const size_t qtok = (size_t)b * SEQ + q0w + r;
        bf16x8 qf[4];
#pragma unroll
        for (int kd = 0; kd < 4; ++kd) qf[kd] = *(const bf16x8*)(QB + qtok * DM + h * 128 + 32 * kd + 8 * g);
        f32x4 O[8];
#pragma unroll
        for (int i = 0; i < 8; ++i) O[i] = (f32x4){0.f, 0.f, 0.f, 0.f};
        float R = 0.f;
        int wdone = 0, it = 0;
        u32x4 pre[4];
        const int ptg = tid & 15, pcg = (tid >> 4) & 15, prow = (tid - 256) >> 2, pch = tid & 3;
        auto issue_tile = [&](int kt_) {
            if (tid < 256) {
#pragma unroll
                for (int tt = 0; tt < 4; ++tt) pre[tt] = *(const u32x4*)(VB + ((size_t)b * SEQ + kt_ * 64 + 4 * ptg + tt) * DM + h * 128 + 8 * pcg);
            } else {
                const bf16_t* src_ = KB + ((size_t)b * SEQ + kt_ * 64 + prow) * DM + h * 128 + 32 * pch;
#pragma unroll
                for (int i = 0; i < 4; ++i) pre[i] = *(const u32x4*)(src_ + 8 * i);
            }
        };
        issue_tile(2 * qb + 1);
        for (int kt = 2 * qb + 1; kt >= 0; --kt, ++it) {
            if (tid < 256) {
#pragma unroll
                for (int e = 0; e < 8; ++e) {
                    unsigned short x0, x1, x2, x3;
                    { const unsigned a0 = pre[0][e >> 1], a1 = pre[1][e >> 1], a2 = pre[2][e >> 1], a3 = pre[3][e >> 1];
                      if (e & 1) { x0 = a0 >> 16; x1 = a1 >> 16; x2 = a2 >> 16; x3 = a3 >> 16; } else { x0 = a0 & 0xffff; x1 = a1 & 0xffff; x2 = a2 & 0xffff; x3 = a3 & 0xffff; } }
                    u32x2 wv; wv.x = (unsigned)x0 | ((unsigned)x1 << 16); wv.y = (unsigned)x2 | ((unsigned)x3 << 16);
                    *(LAS u32x2*)(lds + A_VT + (8 * pcg + e) * 144 + 8 * ptg) = wv;
                }
            } else {
#pragma unroll
                for (int i = 0; i < 4; ++i) *(LAS u32x4*)(lds + A_KI + prow * 272 + 64 * pch + 16 * i) = pre[i];
            }
            __syncthreads();
            if (kt > 0) issue_tile(kt - 1);
            const int key0 = kt * 64;
            if (!wdone && key0 <= q0w + 14) {
                const int qpos = q0w + r;
                float wgt[4][4];
                float Rrun = R;
#pragma unroll
                for (int sb = 3; sb >= 0; --sb) {
                    f32x4 acc = (f32x4){0.f, 0.f, 0.f, 0.f};
#pragma unroll
                    for (int kd = 0; kd < 4; ++kd) { const bf16x8 kf = *(const LAS bf16x8*)(lds + A_KI + (16 * sb + r) * 272 + 64 * kd + 16 * g); acc = mfma16(kf, qf[kd], acc); }
                    float lk[4], z[4];
#pragma unroll
                    for (int j = 0; j < 4; ++j) {
                        const int key = key0 + 16 * sb + 4 * g + j;
                        z[j] = fminf(acc[j], 80.0f);
                        lk[j] = (key < qpos) ? -fast_log2(1.0f + fast_exp2(z[j])) : 0.f;
                    }
                    const float s3 = lk[3], s2 = s3 + lk[2], s1 = s2 + lk[1], s0 = s1 + lk[0];
                    const float t1 = __shfl_xor(s0, 16), t2 = __shfl_xor(s0, 32), t3 = __shfl_xor(t1, 32);
                    const float above = g == 0 ? (t1 + t2 + t3) : (g == 1 ? (t2 + t3) : (g == 2 ? t1 : 0.f));
                    const float base = Rrun + above;
                    const float sj[4] = {s0, s1, s2, s3};
#pragma unroll
                    for (int j = 0; j < 4; ++j) { const int key = key0 + 16 * sb + 4 * g + j; wgt[sb][j] = (key < qpos) ? fast_exp2(z[j] + base + sj[j]) : 0.f; }
                    Rrun += (s0 + t1) + (t2 + t3);
                }
                R = Rrun;
#pragma unroll
                for (int ks = 0; ks < 2; ++ks) {
                    u32x2 lo, hi; lo.x = cvt_pk_bf16(wgt[2 * ks][0], wgt[2 * ks][1]); lo.y = cvt_pk_bf16(wgt[2 * ks][2], wgt[2 * ks][3]);
                    hi.x = cvt_pk_bf16(wgt[2 * ks + 1][0], wgt[2 * ks + 1][1]); hi.y = cvt_pk_bf16(wgt[2 * ks + 1][2], wgt[2 * ks + 1][3]);
                    const bf16x8 pf = mk8(lo, hi);
#pragma unroll
                    for (int db = 0; db < 8; ++db) {
                        const u32x2 v0 = *(const LAS u32x2*)(lds + A_VT + (16 * db + r) * 144 + 64 * ks + 8 * g), v1 = *(const LAS u32x2*)(lds + A_VT + (16 * db + r) * 144 + 64 * ks + 32 + 8 * g);
                        O[db] = mfma16(mk8(v0, v1), pf, O[db]);
                    }
                }
                wdone = __all(R < SB_DONE_LOG2) ? 1 : 0;
            }
            if (lane == 0) FL[(it & 1) * 8 + w] = wdone;
            __syncthreads();
            int alld = 1;
#pragma unroll
            for (int i = 0; i < 8; ++i) alld &= FL[(it & 1) * 8 + i];
            if (alld) break;
        }
#pragma unroll
        for (int db = 0; db < 8; ++db) { u32x2 wv; wv.x = cvt_pk_bf16(O[db][0], O[db][1]); wv.y = cvt_pk_bf16(O[db][2], O[db][3]);
            *(u32x2*)(QB + qtok * DM + h * 128 + 16 * db + 4 * g) = wv; }
        __syncthreads();
    }
}


#ifdef DIAG
__device__ void diag_count_f32(const float* p, size_t n, float thr, unsigned* ctr) {
    unsigned c = 0;
    for (size_t i = (size_t)blockIdx.x * NTHREADS + threadIdx.x; i < n; i += (size_t)gridDim.x * NTHREADS) { const float v = p[i]; if (!(fabsf(v) <= thr)) ++c; }
    if (c) atomicAdd(ctr, c);
}
__device__ void diag_count_bf16(const bf16_t* p, size_t n, float thr, unsigned* ctr) {
    unsigned c = 0;
    for (size_t i = (size_t)blockIdx.x * NTHREADS + threadIdx.x; i < n; i += (size_t)gridDim.x * NTHREADS) { const float v = __uint_as_float((unsigned)p[i] << 16); if (!(fabsf(v) <= thr)) ++c; }
    if (c) atomicAdd(ctr, c);
}
#endif
#define XB_TMO      128
#define XB_XCNT(j)  (256  + 64 * (j))
#define XB_XSUB(j)  (1280 + 64 * (j))
#define XB_XGEN(j)  (2304 + 64 * (j))
#define XB_TOP      3328
#define XB_TOPGEN   3392
#define XCD_BAR_WORDS 3456
#define XB_SPIN_CAP (1u << 18)

__device__ __forceinline__ unsigned xb_ld(unsigned* p)              { return __hip_atomic_load(p, __ATOMIC_RELAXED, __HIP_MEMORY_SCOPE_AGENT); }
__device__ __forceinline__ unsigned xb_add(unsigned* p, unsigned v) { return __hip_atomic_fetch_add(p, v, __ATOMIC_RELAXED, __HIP_MEMORY_SCOPE_AGENT); }
__device__ __forceinline__ unsigned xb_xcc_id() { return (unsigned)__builtin_amdgcn_s_getreg((3 << 11) | 20) & 0xFu; }
#define XB_SPIN(cond, bar) do { unsigned _sp = 0; while (cond) { __builtin_amdgcn_s_sleep(1); \
    if ((++_sp & 255u) == 0u) { if (xb_ld(&(bar)[XB_TMO])) break; if (_sp > XB_SPIN_CAP) { atomicAdd(&(bar)[XB_TMO], 1u); break; } } } } while (0)

struct XcdBarrier {
    unsigned* bar; unsigned x;
    volatile LAS unsigned* st;
};

__device__ __forceinline__ XcdBarrier xcd_barrier_post(unsigned* bar, volatile LAS unsigned* st) {
    XcdBarrier b; b.bar = bar; b.x = xb_xcc_id(); b.st = st;
    if (threadIdx.x == 0) (void)xb_add(&bar[XB_XCNT(b.x)], 1u);
    return b;
}
__device__ __forceinline__ void xcd_barrier_complete(unsigned* bar, unsigned x, unsigned& nloc, unsigned& nx) {
    const unsigned G = gridDim.x * gridDim.y * gridDim.z;
    unsigned sum, cnt, mine, sp = 0u;
    for (;;) {
        sum = 0u; cnt = 0u; mine = 0u;
#pragma unroll
        for (unsigned j = 0; j < 16; ++j) { const unsigned c = xb_ld(&bar[XB_XCNT(j)]); sum += c; cnt += (c > 0u) ? 1u : 0u; mine = (j == x) ? c : mine; }
        if (sum == G) break;
        __builtin_amdgcn_s_sleep(1);
        if ((++sp & 255u) == 0u) { if (xb_ld(&bar[XB_TMO])) break; if (sp > XB_SPIN_CAP) { atomicAdd(&bar[XB_TMO], 1u); break; } }
    }
    nloc = mine > 0u ? mine : 1u; nx = cnt > 0u ? cnt : 1u;
}

__device__ __forceinline__ void xcd_barrier(const XcdBarrier& b) {
    asm volatile("s_waitcnt vmcnt(0)" ::: "memory");
    __syncthreads();
    if (threadIdx.x == 0) {
        unsigned* bar = b.bar;
        __builtin_amdgcn_s_waitcnt(0);
        unsigned nloc = b.st[0], nx = b.st[1];
        if (nloc == 0u) { xcd_barrier_complete(bar, b.x, nloc, nx); b.st[0] = nloc; b.st[1] = nx; }
        const unsigned old = xb_add(&bar[XB_XSUB(b.x)], 1u);
        const unsigned gen = old / nloc;
        if (old + 1u == (gen + 1u) * nloc) {
            __builtin_amdgcn_fence(__ATOMIC_RELEASE, "agent");
            asm volatile("s_waitcnt vmcnt(0)" ::: "memory");
            const unsigned og = xb_add(&bar[XB_TOP], 1u);
            const unsigned tg = og / nx;
            if (og + 1u == (tg + 1u) * nx) xb_add(&bar[XB_TOPGEN], 1u);
            else XB_SPIN(xb_ld(&bar[XB_TOPGEN]) == tg, bar);
            __builtin_amdgcn_fence(__ATOMIC_ACQUIRE, "agent");
            xb_add(&bar[XB_XGEN(b.x)], 1u);
            asm volatile("s_waitcnt vmcnt(0)" ::: "memory");
        } else {
            XB_SPIN(xb_ld(&bar[XB_XGEN(b.x)]) == gen, bar);
            __builtin_amdgcn_fence(__ATOMIC_ACQUIRE, "agent");
            asm volatile("s_waitcnt vmcnt(0)" ::: "memory");
        }
    }
    __syncthreads();
}

constexpr int LDS_BYTES = 135168;
static_assert(MIX_LDS <= LDS_BYTES && 128 * 129 * 4 <= LDS_BYTES && pg8::STAGE_BYTES <= LDS_BYTES, "LDS budget");
constexpr int NPHASE = 17;

template <class Epi>
__device__ __forceinline__ void run_gemm(LAS unsigned char* lds, const bf16_t* A, const bf16_t* Bt, int N, int K, const Epi& E) {
    pg8::Gemm g{A, Bt, MTOK, N, K};
    pg8::StaticOrder S; S.init(MTOK, N, gridDim.x, blockIdx.x);
    pg8::gemm_phase<Epi, pg8::StaticOrder, true, true>(lds, g, S, E);
}

__global__ void __launch_bounds__(NTHREADS, 2) fwd_megakernel(Params P) {
    extern __shared__ __attribute__((aligned(16))) unsigned char smem[];
    LAS unsigned char* lds = (LAS unsigned char*)smem;
    cg::grid_group grid = cg::this_grid();
    unsigned char* ws = P.ws;
    bf16_t* X = (bf16_t*)(ws + WS_X);
    bf16_t* H = (bf16_t*)(ws + WS_H);
    float* Y = P.out;
    bf16_t* gates = (bf16_t*)P.out;
#ifdef ONLYMASK
#define PHASE(k) if (((ONLYMASK >> (k)) & 1) && P.ph_lo <= (k) && (k) < P.ph_hi)
#else
#define PHASE(k) if (P.ph_lo <= (k) && (k) < P.ph_hi)
#endif
#define SYNC0() do { if (P.coop) { asm volatile("s_waitcnt vmcnt(0) lgkmcnt(0)" ::: "memory"); grid.sync(); \
        if (threadIdx.x < 64) { __builtin_amdgcn_fence(__ATOMIC_ACQUIRE, "agent"); asm volatile("s_waitcnt vmcnt(0)" ::: "memory"); } __syncthreads(); } } while (0)
#define SYNC() do { if (P.coop) xcd_barrier(xb); } while (0)
    volatile LAS unsigned* bst = (volatile LAS unsigned*)(lds + (LDS_BYTES - 16));
    XcdBarrier xb; xb.bar = (unsigned*)(ws + MISC_BAR); xb.x = 0; xb.st = bst;
    if (P.coop) { if (threadIdx.x == 0) { bst[0] = 0u; bst[1] = 0u; } xb = xcd_barrier_post((unsigned*)(ws + MISC_BAR), bst); }
    PHASE(0) prep_phase(P, lds);
    SYNC0();
    PHASE(1) run_gemm(lds, X, (const bf16_t*)(ws + W_GU1), 5632, 1024, EpiSwiglu{H});
    SYNC();
    PHASE(2) run_gemm(lds, H, (const bf16_t*)(ws + W_D1), 1024, FH, EpiResid<false, false, true>{P.x, nullptr, Y, 0.5f});
    SYNC();
    PHASE(3) ln_phase<true, true>(Y, P.ln_g, P.ln_b, X);
    SYNC();
    PHASE(4) run_gemm(lds, X, (const bf16_t*)(ws + W_IN), NIN_PAD, 1024, EpiWin{(bf16_t*)(ws + WS_QK), gates, (float*)(ws + MISC_IF), (const float*)(ws + W_BIAS)});
    SYNC();
    PHASE(5) mlstm_phase1(P, lds);
    SYNC();
    PHASE(6) {
#ifndef NO_ML2
        mlstm_phase2(P, lds);
#endif
#ifndef NO_ATT
        attn_phase(P, lds);
#endif
    }
    SYNC();
    PHASE(7) {
        run_gemm(lds, (const bf16_t*)(ws + WS_VA), (const bf16_t*)(ws + W_A), 1024, 1024, EpiGateMul<false>{gates, 0, nullptr, (bf16_t*)(ws + WS_T)});
        run_gemm(lds, (const bf16_t*)(ws + WS_QB), (const bf16_t*)(ws + W_B), 1024, 1024, EpiGateMul<true>{gates, DM, (const bf16_t*)(ws + WS_T), (bf16_t*)(ws + WS_MG)});
    }
    SYNC();
    PHASE(8) run_gemm(lds, (const bf16_t*)(ws + WS_MG), (const bf16_t*)(ws + W_O), 1024, 1024, EpiResid<true, false, true>{X, nullptr, Y, 1.0f});
    SYNC();
    PHASE(9) ln_phase<true, true>(Y, P.ln_g + DM, P.ln_b + DM, X);
    SYNC();
    PHASE(10) run_gemm(lds, X, (const bf16_t*)(ws + W_GU2), 5632, 1024, EpiSwiglu{H});
    SYNC();
    PHASE(11) run_gemm(lds, H, (const bf16_t*)(ws + W_D2), 1024, FH, EpiResid<true, false, true>{X, nullptr, Y, 0.5f});
    SYNC();
    PHASE(12) { ln_phase<true, true>(Y, P.ln_g + 2 * DM, P.ln_b + 2 * DM, X); cvt_bf16_phase(P.p, (bf16_t*)(ws + WS_PB), (size_t)MTOK * 256 / 8); }
    SYNC();
    PHASE(13) {
        run_gemm(lds, X, (const bf16_t*)(ws + W_PG), 1024, 1024, EpiSigBias{P.b_pg, (bf16_t*)(ws + WS_PG)});
        run_gemm(lds, (const bf16_t*)(ws + WS_PB), (const bf16_t*)(ws + W_P), 1024, 256, EpiResid<true, true, true>{X, (const bf16_t*)(ws + WS_PG), (float*)(ws + WS_VA), 1.0f});
    }
    SYNC();
    PHASE(14) ln_phase<false, true>((const float*)(ws + WS_VA), P.ln_g + 3 * DM, P.ln_b + 3 * DM, P.out);
#undef PHASE
#undef SYNC
#undef SYNC0
}

extern "C" void kernel_launch(void* const* d_in, const int* in_sizes, int n_in, void* d_out, int out_size, void* d_ws, size_t ws_size, hipStream_t stream) {
    static int grid_blocks = 0;
    if (grid_blocks == 0) {
        if (n_in != 19 || out_size != MTOK * DM || ws_size < WS_END) { fprintf(stderr, "kernel_launch: unexpected shapes (n_in %d, out %d, ws %zu, need %zu)\n", n_in, out_size, ws_size, (size_t)WS_END); grid_blocks = -1; return; }
        int dev = 0, cus = 0, per_cu = 0;
        hipGetDevice(&dev);
        hipDeviceGetAttribute(&cus, hipDeviceAttributeMultiprocessorCount, dev);
        if (hipFuncSetAttribute((const void*)fwd_megakernel, hipFuncAttributeMaxDynamicSharedMemorySize, LDS_BYTES) != hipSuccess) { fprintf(stderr, "kernel_launch: hipFuncSetAttribute failed\n"); grid_blocks = -1; return; }
        if (hipOccupancyMaxActiveBlocksPerMultiprocessor(&per_cu, (const void*)fwd_megakernel, NTHREADS, LDS_BYTES) != hipSuccess || per_cu < 1) { fprintf(stderr, "kernel_launch: occupancy query failed (%d)\n", per_cu); per_cu = 1; (void)hipGetLastError(); }
        grid_blocks = cus * per_cu;
    }
    if (grid_blocks < 0) return;
    Params p{};
    p.x = (const float*)d_in[0]; p.p = (const float*)d_in[1]; p.ln_g = (const float*)d_in[2]; p.ln_b = (const float*)d_in[3];
    p.wg = (const float*)d_in[4]; p.wu = (const float*)d_in[5]; p.wd = (const float*)d_in[6]; p.w_in = (const float*)d_in[7]; p.b_in = (const float*)d_in[8];
    p.b_forget = (const float*)d_in[9]; p.conv_w = (const float*)d_in[10]; p.conv_b = (const float*)d_in[11]; p.mh_g = (const float*)d_in[12];
    p.w_a = (const float*)d_in[13]; p.w_b = (const float*)d_in[14]; p.w_o = (const float*)d_in[15]; p.w_ple = (const float*)d_in[16]; p.w_pg = (const float*)d_in[17]; p.b_pg = (const float*)d_in[18];
    p.out = (float*)d_out; p.ws = (unsigned char*)d_ws; p.pad = 0;
#if ONE_LAUNCH
    if (hipMemsetAsync((char*)d_ws + MISC_BAR, 0, XCD_BAR_WORDS * 4, stream) != hipSuccess) { fprintf(stderr, "kernel_launch: memset of the barrier words failed\n"); return; }
    p.ph_lo = 0; p.ph_hi = NPHASE; p.coop = 1;
    void* args[] = {&p};
    hipError_t e = hipLaunchCooperativeKernel((const void*)fwd_megakernel, dim3(grid_blocks), dim3(NTHREADS), args, LDS_BYTES, stream);
    if (e != hipSuccess) fprintf(stderr, "cooperative launch failed: %s (grid %d)\n", hipGetErrorString(e), grid_blocks);
#else
    p.coop = 0;
    for (int ph = 0; ph < 15; ++ph) { p.ph_lo = ph; p.ph_hi = ph + 1; hipLaunchKernelGGL(fwd_megakernel, dim3(grid_blocks), dim3(NTHREADS), LDS_BYTES, stream, p); }
#endif
}
```
